# Optimizing an MI355X kernel written in HIP

```python
import math
import jax, jax.numpy as jnp
from jax import lax
import numpy as np

D_MODEL = 2048
BATCH = 4
SEQ = 2048
DEPTH = 4

M_HEADS = 8
M_QK = D_MODEL // 16
M_V = D_MODEL // 8
M_WIDTH = M_HEADS * M_V
M_CHUNK = 64
A_HEADS = 8
A_QK = D_MODEL // 16
A_V = 2 * A_QK
A_WIDTH = A_HEADS * A_V
ROPE_DIM = A_QK // 4
ROPE_THETA = 500000.0
Q_BLOCK = 128
D_FF = ((8 * D_MODEL // 3 + 255) // 256) * 256
CONV_W = 3
EPS = 1e-6
N_BRANCH = 2

SPLITS = [M_HEADS * M_QK, M_HEADS * M_QK, M_WIDTH, M_WIDTH, M_HEADS, M_HEADS,
          2 * A_HEADS * A_QK, 2 * A_HEADS * A_QK, A_WIDTH, N_BRANCH * D_MODEL]
OFFSETS = [int(o) for o in np.cumsum(SPLITS)[:-1]]
N_IN = int(sum(SPLITS))
F_GATE_OFF = OFFSETS[4]

kernel_name = "hybrid_mlstm_diffattn_convglu"


def rms_norm(x, g):
    xf = x.astype(jnp.float32)
    y = xf * lax.rsqrt(jnp.mean(xf * xf, axis=-1, keepdims=True) + EPS)
    return (y * g.astype(jnp.float32)).astype(x.dtype)


def partial_rotary(x, pos):
    half = ROPE_DIM // 2
    inv = ROPE_THETA ** (-jnp.arange(half, dtype=jnp.float32) / half)
    ang = pos.astype(jnp.float32)[:, None] * inv[None, :]
    cos = jnp.cos(ang)[None, :, None, None, :]
    sin = jnp.sin(ang)[None, :, None, None, :]
    xr = x[..., :ROPE_DIM].astype(jnp.float32)
    x1, x2 = xr[..., :half], xr[..., half:]
    rot = jnp.concatenate([x1 * cos - x2 * sin, x2 * cos + x1 * sin], axis=-1)
    return jnp.concatenate([rot.astype(x.dtype), x[..., ROPE_DIM:]], axis=-1)


def mlstm_chunkwise(q, k, v, i_pre, f_pre):
    B, H, S, dk = q.shape
    dv = v.shape[-1]
    L = M_CHUNK
    NC = S // L
    f32 = jnp.float32
    q = q.astype(f32)
    k = k.astype(f32) * (dk ** -0.5)
    v = v.astype(f32)
    log_f = jax.nn.log_sigmoid(f_pre.astype(f32))
    i_log = i_pre.astype(f32)

    def to_chunks(a):
        return jnp.moveaxis(a.reshape(B, H, NC, L, *a.shape[3:]), 2, 0)

    qc, kc, vc, ic = to_chunks(q), to_chunks(k), to_chunks(v), to_chunks(i_log)
    bc = jnp.cumsum(to_chunks(log_f), axis=-1)
    causal = jnp.tril(jnp.ones((L, L), dtype=bool))

    def step(carry, xs):
        C, n, m = carry
        q_, k_, v_, i_, b_ = xs
        log_d = b_[..., :, None] - b_[..., None, :] + i_[..., None, :]
        log_d = jnp.where(causal, log_d, -jnp.inf)
        inter_log = b_ + m[..., None]
        m_t = jnp.maximum(inter_log, jnp.max(log_d, axis=-1))
        d_mat = jnp.where(causal, jnp.exp(log_d - m_t[..., None]), 0.0)
        inter = jnp.exp(inter_log - m_t)
        s_mat = jnp.einsum('bhtd,bhsd->bhts', q_, k_) * d_mat
        num = (jnp.einsum('bhts,bhsv->bhtv', s_mat, v_)
               + inter[..., None] * jnp.einsum('bhtd,bhvd->bhtv', q_, C))
        den = s_mat.sum(-1) + inter * jnp.einsum('bhtd,bhd->bht', q_, n)
        h = num / jnp.maximum(jnp.abs(den), jnp.exp(-m_t))[..., None]
        g = b_[..., -1]
        w_log = g[..., None] - b_ + i_
        m_new = jnp.maximum(g + m, jnp.max(w_log, axis=-1))
        decay = jnp.exp(g + m - m_new)
        w = jnp.exp(w_log - m_new[..., None])
        C_new = decay[..., None, None] * C + jnp.einsum('bhs,bhsv,bhsd->bhvd', w, v_, k_)
        n_new = decay[..., None] * n + jnp.einsum('bhs,bhsd->bhd', w, k_)
        return (C_new, n_new, m_new), h

    init = (jnp.zeros((B, H, dv, dk), f32), jnp.zeros((B, H, dk), f32), jnp.zeros((B, H), f32))
    _, hs = lax.scan(step, init, (qc, kc, vc, ic, bc))
    return jnp.moveaxis(hs, 0, 2).reshape(B, H, S, dv)


def diff_attention(q, k, v, lam):
    B, H, _, S, d = q.shape
    dv = v.shape[-1]
    nb = S // Q_BLOCK
    scale = d ** -0.5
    kpos = jnp.arange(S)

    def block(i):
        start = i * Q_BLOCK
        qb = lax.dynamic_slice_in_dim(q, start, Q_BLOCK, axis=3)
        s = jnp.einsum('bhcqd,bhckd->bhcqk', qb, k).astype(jnp.float32) * scale
        qpos = start + jnp.arange(Q_BLOCK)
        s = jnp.where(kpos[None, :] <= qpos[:, None], s, -jnp.inf)
        p = jax.nn.softmax(s, axis=-1)
        a = p[:, :, 0] - lam * p[:, :, 1]
        return jnp.einsum('bhqk,bhkv->bhqv', a.astype(v.dtype), v)

    out = lax.map(block, jnp.arange(nb))
    return jnp.moveaxis(out, 0, 2).reshape(B, H, S, dv)


def hybrid_mixer(h, pos, layer, w_in, b_in, m_norm, a_norm, lam_qk, w_bm, w_bd, w_o):
    B, S, _ = h.shape
    z = h @ w_in + b_in
    mq, mk, mv, mo, mi, mf, aq, ak, av, gt = jnp.split(z, OFFSETS, axis=-1)

    q = mq.reshape(B, S, M_HEADS, M_QK).transpose(0, 2, 1, 3)
    k = mk.reshape(B, S, M_HEADS, M_QK).transpose(0, 2, 1, 3)
    v = mv.reshape(B, S, M_HEADS, M_V).transpose(0, 2, 1, 3)
    hm = mlstm_chunkwise(q, k, v, mi.transpose(0, 2, 1), mf.transpose(0, 2, 1))
    hm = hm.transpose(0, 2, 1, 3).astype(h.dtype)
    hm = rms_norm(hm, m_norm.reshape(M_HEADS, M_V)).reshape(B, S, M_WIDTH)
    hm = hm * jax.nn.sigmoid(mo)
    ym = hm @ w_bm

    lam_init = 0.8 - 0.6 * math.exp(-0.3 * layer)
    lq = lam_qk.astype(jnp.float32)
    lam = jnp.exp(jnp.sum(lq[0] * lq[1])) - jnp.exp(jnp.sum(lq[2] * lq[3])) + lam_init
    qa = partial_rotary(aq.reshape(B, S, A_HEADS, 2, A_QK), pos).transpose(0, 2, 3, 1, 4)
    ka = partial_rotary(ak.reshape(B, S, A_HEADS, 2, A_QK), pos).transpose(0, 2, 3, 1, 4)
    va = av.reshape(B, S, A_HEADS, A_V).transpose(0, 2, 1, 3)
    ha = diff_attention(qa, ka, va, lam).transpose(0, 2, 1, 3)
    ha = rms_norm(ha, a_norm.reshape(A_HEADS, A_V)) * (1.0 - lam_init)
    yd = ha.reshape(B, S, A_WIDTH) @ w_bd

    g_m, g_d = jnp.split(gt, N_BRANCH, axis=-1)
    y = jax.nn.sigmoid(g_m) * ym + jax.nn.sigmoid(g_d) * yd
    return y @ w_o


def conv_glu(h, w_up, conv_w, conv_b, w_down):
    S = h.shape[1]
    gate, val = jnp.split(h @ w_up, 2, axis=-1)
    gp = jnp.pad(gate, ((0, 0), (CONV_W - 1, 0), (0, 0)))
    conv = sum(conv_w[j] * gp[:, j:j + S] for j in range(CONV_W)) + conv_b
    return (jax.nn.silu(conv) * val) @ w_down


def setup_inputs(seed: int = 0) -> dict:
    key = jax.random.key(seed)
    ks = jax.random.split(key, 16)
    f32 = jnp.float32
    out_scale = (2.0 * DEPTH) ** -0.5

    def nrm(k, shape, scale):
        return jax.random.normal(k, shape, f32) * scale

    x = nrm(ks[0], (BATCH, SEQ, D_MODEL), 1.0)
    norm_mix = 1.0 + nrm(ks[1], (DEPTH, D_MODEL), 0.02)
    w_in = nrm(ks[2], (DEPTH, D_MODEL, N_IN), D_MODEL ** -0.5)
    b_in = nrm(ks[3], (DEPTH, N_IN), 0.01)
    b_in = b_in.at[:, F_GATE_OFF:F_GATE_OFF + M_HEADS].add(jnp.linspace(3.0, 6.0, M_HEADS, dtype=f32))
    m_norm = 1.0 + nrm(ks[4], (DEPTH, M_WIDTH), 0.02)
    a_norm = 1.0 + nrm(ks[5], (DEPTH, A_WIDTH), 0.02)
    lam_qk = nrm(ks[6], (DEPTH, 4, A_QK), 0.1)
    w_bm = nrm(ks[7], (DEPTH, M_WIDTH, D_MODEL), M_WIDTH ** -0.5)
    w_bd = nrm(ks[8], (DEPTH, A_WIDTH, D_MODEL), A_WIDTH ** -0.5)
    w_o = nrm(ks[9], (DEPTH, D_MODEL, D_MODEL), D_MODEL ** -0.5 * out_scale)
    norm_ffn = 1.0 + nrm(ks[10], (DEPTH, D_MODEL), 0.02)
    w_up = nrm(ks[11], (DEPTH, D_MODEL, 2 * D_FF), D_MODEL ** -0.5)
    conv_w = nrm(ks[12], (DEPTH, CONV_W, D_FF), CONV_W ** -0.5)
    conv_b = nrm(ks[13], (DEPTH, D_FF), 0.01)
    w_down = nrm(ks[14], (DEPTH, D_FF, D_MODEL), D_FF ** -0.5 * out_scale)
    norm_final = 1.0 + nrm(ks[15], (D_MODEL,), 0.02)
    return {"x": x, "norm_mix": norm_mix, "w_in": w_in, "b_in": b_in, "m_norm": m_norm,
            "a_norm": a_norm, "lam_qk": lam_qk, "w_bm": w_bm, "w_bd": w_bd, "w_o": w_o,
            "norm_ffn": norm_ffn, "w_up": w_up, "conv_w": conv_w, "conv_b": conv_b,
            "w_down": w_down, "norm_final": norm_final}


def reference(x, norm_mix, w_in, b_in, m_norm, a_norm, lam_qk, w_bm, w_bd, w_o,
              norm_ffn, w_up, conv_w, conv_b, w_down, norm_final):
    pos = jnp.arange(x.shape[1])
    h = x
    for l in range(DEPTH):
        h = h + hybrid_mixer(rms_norm(h, norm_mix[l]), pos, l, w_in[l], b_in[l], m_norm[l],
                             a_norm[l], lam_qk[l], w_bm[l], w_bd[l], w_o[l])
        h = h + conv_glu(rms_norm(h, norm_ffn[l]), w_up[l], conv_w[l], conv_b[l], w_down[l])
    return rms_norm(h, norm_final)
```

```cpp
#include <hip/hip_runtime.h>
#include <cstdio>
#include <cstdint>

#ifndef MK_SPLIT
#define MK_SPLIT 0
#endif

namespace pg8 {
#define PG8_LAS __attribute__((address_space(3)))
typedef unsigned short bf16_t;
typedef short bf16x8 __attribute__((ext_vector_type(8)));
typedef float f32x4 __attribute__((ext_vector_type(4)));
typedef float f32x2 __attribute__((ext_vector_type(2)));
typedef unsigned u32x4 __attribute__((ext_vector_type(4)));
typedef unsigned u32x2 __attribute__((ext_vector_type(2)));
constexpr int BM = 256, BK = 64, HALF = 128, HTB = HALF * BK * 2, STAGE_BYTES = 8 * HTB, NXCD = 8, WGM = 8;

__host__ __device__ __forceinline__ int lds_byte(int r, int c) { const int st = (r >> 4) * 2 + (c >> 5), rr = r & 15, cc = c & 31, ob = rr * 64 + cc * 2; return st * 1024 + (ob ^ (((ob >> 9) & 1) << 5)); }
__host__ __device__ __forceinline__ void stage_rc(int b, int& R, int& C) { const int st = b / 1024, sb = b % 1024, swz = sb ^ (((sb >> 9) & 1) << 5); R = (st >> 1) * 16 + swz / 64; C = (st & 1) * 32 + (swz % 64) / 2; }
__host__ __device__ __forceinline__ int perm32(int rho) { const int n = rho >> 4, i = rho & 15; return 8 * (i >> 2) + 4 * n + (i & 3); }

struct Unit { int pm, pn, sel; };
struct Gemm { const bf16_t* A; const bf16_t* Bt; int M, N, K; const bf16_t* A1; const bf16_t* Bt1; };

struct StaticOrder {
    int nM, nN, nwg, G, c;
    __host__ __device__ __forceinline__ void init(int M, int N, int G_, int c_) { nM = M / BM; nN = N / BM; nwg = nM * nN; G = G_; c = c_; }
    __host__ __device__ __forceinline__ bool next(int i, Unit& u) const {
        const long L = (long)i * G + c; if (L >= nwg) return false;
        int wgid = (int)L; { const int q = nwg / NXCD, r = nwg % NXCD, xcd = wgid % NXCD, off = wgid / NXCD; wgid = (xcd < r ? xcd * (q + 1) : r * (q + 1) + (xcd - r) * q) + off; }
        const int nig = WGM * nN, gid = wgid / nig, fm = gid * WGM, gsz = (nM - fm) < WGM ? (nM - fm) : WGM;
        u.pm = fm + ((wgid % nig) % gsz); u.pn = (wgid % nig) / gsz; u.sel = 0; return true;
    }
    __device__ __forceinline__ void a_ready(const Unit&) const {}
    __device__ __forceinline__ void done(const Unit&) const {}
};
struct PairOrder : StaticOrder {
    __host__ __device__ __forceinline__ bool next(int i, Unit& u) const { if (!StaticOrder::next(i >> 1, u)) return false; u.sel = i & 1; return true; }
};

__device__ __forceinline__ unsigned cvt_pk_bf16(float lo, float hi) { unsigned r; asm volatile("v_cvt_pk_bf16_f32 %0, %1, %2" : "=v"(r) : "v"(lo), "v"(hi)); return r; }
__device__ __forceinline__ float bf_lo(unsigned w) { return __uint_as_float(w << 16); }
__device__ __forceinline__ float bf_hi(unsigned w) { return __uint_as_float(w & 0xffff0000u); }
__device__ __forceinline__ float sigmoidf_fast(float x) { return __builtin_amdgcn_rcpf(1.0f + __builtin_amdgcn_exp2f(-1.4426950408889634f * x)); }

struct EpiInProj {
    static constexpr bool PERM = true, AFTER_DRAIN = false, CHAIN = false;
    bf16_t *mq, *mk, *mv, *smo, *aq, *ak, *av, *sg; const float* bias; const float* rope; const float* rowss;
    __device__ __forceinline__ void operator()(const f32x4 (&acc)[2][2][4][2], const Unit& u, int wr, int wc, int fr, int fq) const {
        const int pn = u.pn; bf16_t* base; int ldc, colt, kind = 0; float sc = 1.f;
        if (pn < 4) { base = mq; ldc = 1024; colt = pn * 256; }
        else if (pn < 8) { base = mk; ldc = 1024; colt = (pn - 4) * 256; sc = 0.08838834764831845f; }
        else if (pn < 16) { base = mv; ldc = 2048; colt = (pn - 8) * 256; }
        else if (pn < 24) { base = smo; ldc = 2048; colt = (pn - 16) * 256; kind = 2; }
        else if (pn < 32) { base = aq; ldc = 2048; colt = (pn - 24) * 256; kind = 1; }
        else if (pn < 40) { base = ak; ldc = 2048; colt = (pn - 32) * 256; kind = 1; }
        else if (pn < 48) { base = av; ldc = 2048; colt = (pn - 40) * 256; }
        else { base = sg; ldc = 4096; colt = (pn - 48) * 256; kind = 2; }
        const int row0 = u.pm * BM + wr * 64 + fr, col0 = colt + wc * 32 + 8 * fq, bcol0 = pn * BM + wc * 32 + 8 * fq;
        f32x4 bv[2][2];
#pragma unroll
        for (int bj = 0; bj < 2; ++bj)
#pragma unroll
            for (int n = 0; n < 2; ++n) bv[bj][n] = *(const f32x4*)(bias + bcol0 + bj * HALF + 4 * n);
        const bool dorope = (kind == 1) && (wc == 0);
        float rsv[2][4];
#pragma unroll
        for (int ai = 0; ai < 2; ++ai)
#pragma unroll
            for (int m = 0; m < 4; ++m) rsv[ai][m] = rowss[row0 + ai * HALF + m * 16];
#pragma unroll
        for (int ai = 0; ai < 2; ++ai) {
            f32x4 cvv[4], svv[4];
#pragma unroll
            for (int m = 0; m < 4; ++m) { cvv[m] = (f32x4){1.f, 1.f, 1.f, 1.f}; svv[m] = (f32x4){0.f, 0.f, 0.f, 0.f}; }
            if (dorope) {
#pragma unroll
                for (int m = 0; m < 4; ++m) { const float* cs = rope + (size_t)((row0 + ai * HALF + m * 16) & 2047) * 32 + 4 * fq; cvv[m] = *(const f32x4*)cs; svv[m] = *(const f32x4*)(cs + 16); } }
#pragma unroll
            for (int m = 0; m < 4; ++m) { const int row = row0 + ai * HALF + m * 16; bf16_t* rowp = base + (size_t)row * ldc + col0;
                const float rs = 1.0f / sqrtf(rsv[ai][m] * (1.0f / 2048.0f) + 1e-6f);
                const f32x4 cv = cvv[m], sv = svv[m];
#pragma unroll
                for (int bj = 0; bj < 2; ++bj) { f32x4 v0 = (acc[ai][bj][m][0] * rs + bv[bj][0]) * sc, v1 = (acc[ai][bj][m][1] * rs + bv[bj][1]) * sc;
                    if (dorope) { f32x4 r0, r1;
                        r0[0] = v0[0] * cv[0] - v0[1] * sv[0]; r0[1] = v0[1] * cv[0] + v0[0] * sv[0]; r0[2] = v0[2] * cv[1] - v0[3] * sv[1]; r0[3] = v0[3] * cv[1] + v0[2] * sv[1];
                        r1[0] = v1[0] * cv[2] - v1[1] * sv[2]; r1[1] = v1[1] * cv[2] + v1[0] * sv[2]; r1[2] = v1[2] * cv[3] - v1[3] * sv[3]; r1[3] = v1[3] * cv[3] + v1[2] * sv[3];
                        v0 = r0; v1 = r1; }
                    if (kind == 2) {
#pragma unroll
                        for (int j = 0; j < 4; ++j) { v0[j] = sigmoidf_fast(v0[j]); v1[j] = sigmoidf_fast(v1[j]); } }
                    u32x4 w; w.x = cvt_pk_bf16(v0[0], v0[1]); w.y = cvt_pk_bf16(v0[2], v0[3]); w.z = cvt_pk_bf16(v1[0], v1[1]); w.w = cvt_pk_bf16(v1[2], v1[3]);
                    *(u32x4*)(rowp + bj * HALF) = w; } } }
    }
};
template <int CTRL> __device__ __forceinline__ f32x4 dpp4(const f32x4 v) { f32x4 r;
#pragma unroll
    for (int j = 0; j < 4; ++j) r[j] = __uint_as_float(__builtin_amdgcn_update_dpp(0u, __float_as_uint(v[j]), CTRL, 0xf, 0xf, false));
    return r; }
struct EpiUpConv {
    static constexpr bool PERM = true, AFTER_DRAIN = false, CHAIN = false;
    bf16_t* u; int ldc; const float* rowss; const float* cw; const float* cb; float *fxc, *fxv, *fxg;
    __device__ __forceinline__ void operator()(const f32x4 (&acc)[2][2][4][2], const Unit& un, int wr, int wc, int fr, int fq) const {
        const int col0 = un.pn * HALF + wc * 32 + 8 * fq, blk = un.pm * 2 + wr, rowb = blk * 128 + fr;
        f32x4 w0[2], w1[2], w2[2], bb[2];
#pragma unroll
        for (int n = 0; n < 2; ++n) { w0[n] = *(const f32x4*)(cw + col0 + 4 * n); w1[n] = *(const f32x4*)(cw + ldc + col0 + 4 * n); w2[n] = *(const f32x4*)(cw + 2 * ldc + col0 + 4 * n); bb[n] = *(const f32x4*)(cb + col0 + 4 * n); }
        f32x4 p1[2], p2[2];
        p1[0] = p1[1] = p2[0] = p2[1] = (f32x4){0.f, 0.f, 0.f, 0.f};
        float rsv[8];
#pragma unroll
        for (int q = 0; q < 8; ++q) rsv[q] = rowss[rowb + 16 * q];
#pragma unroll
        for (int q = 0; q < 8; ++q) { const int ai = q >> 2, m = q & 3, row = rowb + 16 * q;
            const float rs = 1.0f / sqrtf(rsv[q] * (1.0f / 2048.0f) + 1e-6f);
            u32x4 w;
#pragma unroll
            for (int n = 0; n < 2; ++n) { const f32x4 g = acc[ai][0][m][n] * rs, v = acc[ai][1][m][n] * rs;
                const f32x4 r1 = dpp4<0x121>(g), r2 = dpp4<0x122>(g);
                f32x4 g1, g2;
#pragma unroll
                for (int j = 0; j < 4; ++j) { g1[j] = fr >= 1 ? r1[j] : p1[n][j]; g2[j] = fr >= 2 ? r2[j] : p2[n][j]; }
                p1[n] = r1; p2[n] = r2;
                const f32x4 cv = w0[n] * g2 + w1[n] * g1 + w2[n] * g + bb[n];
                f32x4 o;
#pragma unroll
                for (int j = 0; j < 4; ++j) o[j] = cv[j] * sigmoidf_fast(cv[j]) * v[j];
                if (n == 0) { w.x = cvt_pk_bf16(o[0], o[1]); w.y = cvt_pk_bf16(o[2], o[3]); } else { w.z = cvt_pk_bf16(o[0], o[1]); w.w = cvt_pk_bf16(o[2], o[3]); }
                if (q == 0 && fr < 2) { *(f32x4*)(fxc + ((size_t)blk * 2 + fr) * ldc + col0 + 4 * n) = cv; *(f32x4*)(fxv + ((size_t)blk * 2 + fr) * ldc + col0 + 4 * n) = v; }
                if (q == 7 && fr >= 14) *(f32x4*)(fxg + ((size_t)blk * 2 + (fr - 14)) * ldc + col0 + 4 * n) = g; }
            *(u32x4*)(u + (size_t)row * ldc + col0) = w; }
    }
};
struct EpiMerge {
    static constexpr bool PERM = false, AFTER_DRAIN = false, CHAIN = true;
    bf16_t* y; const bf16_t* sg;
    __device__ __forceinline__ void mid(f32x4 (&acc)[2][2][4][2], const Unit& u, int wr, int wc, int fr, int fq) const {
        const int row0 = u.pm * BM + wr * 64 + fr, col0 = u.pn * BM + wc * 32 + 4 * fq;
#pragma unroll
        for (int ai = 0; ai < 2; ++ai)
#pragma unroll
            for (int m = 0; m < 4; ++m) { const int row = row0 + ai * HALF + m * 16;
                u32x2 gm[2][2], gd[2][2];
#pragma unroll
                for (int bj = 0; bj < 2; ++bj)
#pragma unroll
                    for (int n = 0; n < 2; ++n) { const int col = col0 + bj * HALF + n * 16; gm[bj][n] = *(const u32x2*)(sg + (size_t)row * 4096 + col); gd[bj][n] = *(const u32x2*)(sg + (size_t)row * 4096 + 2048 + col); }
#pragma unroll
                for (int bj = 0; bj < 2; ++bj)
#pragma unroll
                    for (int n = 0; n < 2; ++n) { const u32x2 a = gm[bj][n], d = gd[bj][n];
                        const f32x4 num = (f32x4){bf_lo(a.x), bf_hi(a.x), bf_lo(a.y), bf_hi(a.y)}, den = (f32x4){bf_lo(d.x), bf_hi(d.x), bf_lo(d.y), bf_hi(d.y)};
#pragma unroll
                        for (int j = 0; j < 4; ++j) acc[ai][bj][m][n][j] *= num[j] * __builtin_amdgcn_rcpf(fmaxf(den[j], 1e-30f)); } }
    }
    __device__ __forceinline__ void operator()(const f32x4 (&acc)[2][2][4][2], const Unit& u, int wr, int wc, int fr, int fq) const {
        const int row0 = u.pm * BM + wr * 64 + fr, col0 = u.pn * BM + wc * 32 + 4 * fq;
#pragma unroll
        for (int ai = 0; ai < 2; ++ai)
#pragma unroll
            for (int mp = 0; mp < 2; ++mp) {
                u32x2 gw[2][2][2];
#pragma unroll
                for (int mm = 0; mm < 2; ++mm)
#pragma unroll
                    for (int bj = 0; bj < 2; ++bj)
#pragma unroll
                        for (int n = 0; n < 2; ++n) gw[mm][bj][n] = *(const u32x2*)(sg + (size_t)(row0 + ai * HALF + (2 * mp + mm) * 16) * 4096 + 2048 + col0 + bj * HALF + n * 16);
#pragma unroll
                for (int mm = 0; mm < 2; ++mm)
#pragma unroll
                    for (int bj = 0; bj < 2; ++bj)
#pragma unroll
                        for (int n = 0; n < 2; ++n) { const int m = 2 * mp + mm, row = row0 + ai * HALF + m * 16, col = col0 + bj * HALF + n * 16;
                            const u32x2 g2 = gw[mm][bj][n]; f32x4 g = (f32x4){bf_lo(g2.x), bf_hi(g2.x), bf_lo(g2.y), bf_hi(g2.y)};
#pragma unroll
                            for (int j = 0; j < 4; ++j) g[j] = fmaxf(g[j], 1e-30f);
                            const f32x4 v = acc[ai][bj][m][n] * g;
                            u32x2 w; w.x = cvt_pk_bf16(v[0], v[1]); w.y = cvt_pk_bf16(v[2], v[3]); *(u32x2*)(y + (size_t)row * 2048 + col) = w; }
                asm volatile("" ::: "memory"); }
    }
};
template <bool STATS> struct EpiRes {
    static constexpr bool PERM = false, AFTER_DRAIN = false, CHAIN = false;
    float* h; int ldc; bf16_t* hb; float* rowss;
    __device__ __forceinline__ void operator()(const f32x4 (&acc)[2][2][4][2], const Unit& u, int wr, int wc, int fr, int fq) const {
        const int row0 = u.pm * BM + wr * 64 + fr, col0 = u.pn * BM + wc * 32 + 4 * fq;
#pragma unroll
        for (int ai = 0; ai < 2; ++ai)
#pragma unroll
            for (int mp = 0; mp < 2; ++mp) {
                f32x4 hv[2][2][2];
#pragma unroll
                for (int mm = 0; mm < 2; ++mm)
#pragma unroll
                    for (int bj = 0; bj < 2; ++bj)
#pragma unroll
                        for (int n = 0; n < 2; ++n) hv[mm][bj][n] = *(const f32x4*)(h + (size_t)(row0 + ai * HALF + (2 * mp + mm) * 16) * ldc + col0 + bj * HALF + n * 16);
#pragma unroll
                for (int mm = 0; mm < 2; ++mm) { const int m = 2 * mp + mm, row = row0 + ai * HALF + m * 16; float* rowp = h + (size_t)row * ldc + col0; float ss = 0.f;
#pragma unroll
                    for (int bj = 0; bj < 2; ++bj)
#pragma unroll
                        for (int n = 0; n < 2; ++n) { const f32x4 v = hv[mm][bj][n] + acc[ai][bj][m][n]; *(f32x4*)(rowp + bj * HALF + n * 16) = v;
                            if (STATS) { ss += (v[0] * v[0] + v[1] * v[1]) + (v[2] * v[2] + v[3] * v[3]); u32x2 w; w.x = cvt_pk_bf16(v[0], v[1]); w.y = cvt_pk_bf16(v[2], v[3]);
                                *(u32x2*)(hb + (size_t)row * ldc + col0 + bj * HALF + n * 16) = w; } }
                    if (STATS) {
                        { auto rr = __builtin_amdgcn_permlane16_swap(__float_as_uint(ss), __float_as_uint(ss), false, false); ss = __uint_as_float(rr[0]) + __uint_as_float(rr[1]); }
                        { auto rr = __builtin_amdgcn_permlane32_swap(__float_as_uint(ss), __float_as_uint(ss), false, false); ss = __uint_as_float(rr[0]) + __uint_as_float(rr[1]); }
                        if (fq == 0) __hip_atomic_fetch_add(rowss + row, ss, __ATOMIC_RELAXED, __HIP_MEMORY_SCOPE_AGENT); } }
                asm volatile("" ::: "memory"); }
    }
};

template <class Epi, class Sched, bool ALIGN_EPI = false, bool SP2 = false, bool APERM = false>
__device__ __forceinline__ void gemm_phase(PG8_LAS unsigned char* lds, const Gemm g, const Sched& S, const Epi& E, const int tid) {
    const int wid = __builtin_amdgcn_readfirstlane(tid >> 6), lane = tid & 63, wr = wid >> 2, wc = wid & 3, fr = lane & 15, fq = lane >> 4;
    const int K = g.K, nt = K / BK;
    unsigned voffA[2], voffB[2];
#pragma unroll
    for (int i = 0; i < 2; ++i) { int R, C; stage_rc(tid * 16 + i * 8192, R, C); const int Rb = Epi::PERM ? ((R & ~31) + perm32(R & 31)) : R;
        const int Ra = APERM ? ((R >> 6) * 128 + (R & 63)) : R;
        voffA[i] = (unsigned)(Ra * K + C) * 2u; voffB[i] = (unsigned)(Rb * K + C) * 2u; }
    const size_t kstep = (size_t)(BK * 2);
    const size_t hstep = (size_t)HALF * K * 2;
    const size_t hstepA = APERM ? (size_t)64 * K * 2 : hstep;
    const size_t tstep = 2 * hstep;
    const unsigned ldsw = (unsigned)wid * 1024u;
    const int aoff = lds_byte(wr * 64 + fr, fq * 8), boff = lds_byte(wc * 32 + fr, fq * 8);
#define PG8_SA(b, h) (((b) * 2 + (h)) * HTB)
#define PG8_SB(b, h) ((4 + (b) * 2 + (h)) * HTB)
#define PG8_STAGE(bufoff, gbase, voff) do { _Pragma("unroll") for (int _i = 0; _i < 2; ++_i) \
        __builtin_amdgcn_global_load_lds((const unsigned*)((const char*)(gbase) + (voff)[_i]), (PG8_LAS unsigned*)(lds + (bufoff) + ldsw + _i * 8192), 16, 0, 0); } while (0)
#define PG8_LDA(dst, b, h) do { _Pragma("unroll") for (int m = 0; m < 4; ++m) _Pragma("unroll") for (int k = 0; k < 2; ++k) dst[m][k] = *(const PG8_LAS bf16x8*)(lds + PG8_SA(b, h) + aoff + m * 2048 + k * 1024); } while (0)
#define PG8_LDB(dst, b, h) do { _Pragma("unroll") for (int n = 0; n < 2; ++n) _Pragma("unroll") for (int k = 0; k < 2; ++k) dst[n][k] = *(const PG8_LAS bf16x8*)(lds + PG8_SB(b, h) + boff + n * 2048 + k * 1024); } while (0)
#define PG8_MMA(ai, bj, At, Bt) do { __builtin_amdgcn_s_setprio(1); _Pragma("unroll") for (int m = 0; m < 4; ++m) _Pragma("unroll") for (int n = 0; n < 2; ++n) _Pragma("unroll") for (int k = 0; k < 2; ++k) \
        acc[ai][bj][m][n] = __builtin_amdgcn_mfma_f32_16x16x32_bf16(Bt[n][k], At[m][k], acc[ai][bj][m][n], 0, 0, 0); __builtin_amdgcn_s_setprio(0); } while (0)
#define PG8_WAIT_V(n) asm volatile("s_waitcnt vmcnt(" #n ")" ::: "memory")
#define PG8_WAIT_L(n) asm volatile("s_waitcnt lgkmcnt(" #n ")" ::: "memory")
#define PG8_BAR __builtin_amdgcn_s_barrier()
#define PG8_SCHED __builtin_amdgcn_sched_barrier(0)
    Unit cur, nxt; int ui = 0;
    if (!S.next(0, cur)) return;
    f32x4 acc[2][2][4][2];
#pragma unroll
    for (int a = 0; a < 2; ++a)
#pragma unroll
        for (int b = 0; b < 2; ++b)
#pragma unroll
            for (int m = 0; m < 4; ++m)
#pragma unroll
                for (int n = 0; n < 2; ++n) acc[a][b][m][n] = (f32x4){0.f, 0.f, 0.f, 0.f};
    bf16x8 At[4][2], B0[2][2], B1[2][2];
    const char* cA = (const char*)(cur.sel ? g.A1 : g.A) + (size_t)cur.pm * tstep; const char* cB = (const char*)(cur.sel ? g.Bt1 : g.Bt) + (size_t)cur.pn * tstep;
    S.a_ready(cur);
    if constexpr (SP2) {
        PG8_STAGE(PG8_SB(0, 0), cB, voffB); PG8_STAGE(PG8_SB(0, 1), cB + hstep, voffB); PG8_STAGE(PG8_SA(0, 0), cA, voffA); PG8_STAGE(PG8_SA(0, 1), cA + hstepA, voffA);
        if (wr == 1) PG8_BAR;
        PG8_WAIT_V(2); PG8_BAR;
        PG8_STAGE(PG8_SB(1, 0), cB + kstep, voffB); PG8_STAGE(PG8_SA(1, 0), cA + kstep, voffA); PG8_STAGE(PG8_SB(1, 1), cB + hstep + kstep, voffB);
        PG8_WAIT_V(6); PG8_BAR;
    } else {
        PG8_STAGE(PG8_SB(0, 0), cB, voffB); PG8_STAGE(PG8_SA(0, 0), cA, voffA); PG8_STAGE(PG8_SB(0, 1), cB + hstep, voffB); PG8_STAGE(PG8_SA(0, 1), cA + hstepA, voffA);
        if (wr == 1) PG8_BAR;
        PG8_WAIT_V(4); PG8_BAR;
        PG8_STAGE(PG8_SB(1, 0), cB + kstep, voffB); PG8_STAGE(PG8_SA(1, 0), cA + kstep, voffA); PG8_STAGE(PG8_SB(1, 1), cB + hstep + kstep, voffB);
        PG8_WAIT_V(6); PG8_BAR;
    }
    for (;;) {
        const bool has_next = S.next(ui + 1, nxt);
        const char* nA = has_next ? (const char*)(nxt.sel ? g.A1 : g.A) + (size_t)nxt.pm * tstep : cA; const char* nB = has_next ? (const char*)(nxt.sel ? g.Bt1 : g.Bt) + (size_t)nxt.pn * tstep : cB;
        for (int t = 0; t < nt; t += 2) {
            const bool last = (t == nt - 2);
            const char* a1 = cA + (size_t)(t + 1) * kstep;
            const char* a2 = last ? nA : cA + (size_t)(t + 2) * kstep; const char* b2 = last ? nB : cB + (size_t)(t + 2) * kstep;
            const char* a3 = a2 + kstep; const char* b3 = b2 + kstep;
            if (last && has_next) S.a_ready(nxt);
            if constexpr (SP2) {
            PG8_LDB(B0, 0, 0); PG8_LDB(B1, 0, 1); PG8_SCHED; PG8_LDA(At, 0, 0); PG8_STAGE(PG8_SA(1, 1), a1 + hstepA, voffA);
            PG8_WAIT_V(8); PG8_WAIT_L(0); PG8_BAR; PG8_MMA(0, 0, At, B0); PG8_MMA(0, 1, At, B1); PG8_BAR; PG8_SCHED;
            PG8_LDA(At, 0, 1); PG8_STAGE(PG8_SB(0, 0), b2, voffB); PG8_STAGE(PG8_SB(0, 1), b2 + hstep, voffB); PG8_STAGE(PG8_SA(0, 0), a2, voffA);
            PG8_WAIT_V(8); PG8_WAIT_L(0); PG8_BAR; PG8_MMA(1, 0, At, B0); PG8_MMA(1, 1, At, B1); PG8_BAR; PG8_SCHED;
            PG8_LDB(B0, 1, 0); PG8_LDB(B1, 1, 1); PG8_SCHED; PG8_LDA(At, 1, 0); PG8_STAGE(PG8_SA(0, 1), a2 + hstepA, voffA);
            PG8_WAIT_V(8); PG8_WAIT_L(0); PG8_BAR; PG8_MMA(0, 0, At, B0); PG8_MMA(0, 1, At, B1); PG8_BAR; PG8_SCHED;
            PG8_LDA(At, 1, 1); PG8_STAGE(PG8_SB(1, 0), b3, voffB); PG8_STAGE(PG8_SB(1, 1), b3 + hstep, voffB); PG8_STAGE(PG8_SA(1, 0), a3, voffA);
            PG8_WAIT_V(8); PG8_WAIT_L(0); PG8_BAR; PG8_MMA(1, 0, At, B0); PG8_MMA(1, 1, At, B1); PG8_BAR; PG8_SCHED;
            } else {
            PG8_LDB(B0, 0, 0); PG8_SCHED; PG8_LDA(At, 0, 0); PG8_STAGE(PG8_SA(1, 1), a1 + hstepA, voffA);
            PG8_WAIT_L(8); PG8_BAR; PG8_WAIT_L(0); PG8_MMA(0, 0, At, B0); PG8_BAR; PG8_SCHED;
            PG8_LDB(B1, 0, 1); PG8_STAGE(PG8_SB(0, 0), b2, voffB);
            PG8_BAR; PG8_WAIT_L(0); PG8_MMA(0, 1, At, B1); PG8_BAR;
            PG8_LDA(At, 0, 1); PG8_STAGE(PG8_SA(0, 0), a2, voffA);
            PG8_BAR; PG8_WAIT_L(0); PG8_MMA(1, 0, At, B0); PG8_BAR; PG8_SCHED;
            PG8_STAGE(PG8_SB(0, 1), b2 + hstep, voffB);
            PG8_WAIT_V(6); PG8_BAR; PG8_MMA(1, 1, At, B1); PG8_BAR;
            PG8_LDB(B0, 1, 0); PG8_SCHED; PG8_LDA(At, 1, 0); PG8_STAGE(PG8_SA(0, 1), a2 + hstepA, voffA);
            PG8_WAIT_L(8); PG8_BAR; PG8_WAIT_L(0); PG8_MMA(0, 0, At, B0); PG8_BAR; PG8_SCHED;
            PG8_LDB(B1, 1, 1); PG8_STAGE(PG8_SB(1, 0), b3, voffB);
            PG8_BAR; PG8_WAIT_L(0); PG8_MMA(0, 1, At, B1); PG8_BAR;
            PG8_LDA(At, 1, 1); PG8_STAGE(PG8_SA(1, 0), a3, voffA);
            PG8_BAR; PG8_WAIT_L(0); PG8_MMA(1, 0, At, B0); PG8_BAR; PG8_SCHED;
            PG8_STAGE(PG8_SB(1, 1), b3 + hstep, voffB);
            PG8_WAIT_V(6); PG8_BAR; PG8_MMA(1, 1, At, B1); PG8_BAR;
            }
        }
        if constexpr (ALIGN_EPI) { if (wr == 0) PG8_BAR; }
        bool chained = false;
        if constexpr (Epi::CHAIN) { if (cur.sel == 0) { E.mid(acc, cur, wr, wc, fr, fq); chained = true; } }
        if (!chained) { E(acc, cur, wr, wc, fr, fq); S.done(cur); }
        if (!has_next) break;
        if (!chained) {
#pragma unroll
        for (int a = 0; a < 2; ++a)
#pragma unroll
            for (int b = 0; b < 2; ++b)
#pragma unroll
                for (int m = 0; m < 4; ++m)
#pragma unroll
                    for (int n = 0; n < 2; ++n) acc[a][b][m][n] = (f32x4){0.f, 0.f, 0.f, 0.f};
        }
        cur = nxt; cA = nA; cB = nB; ++ui;
        if constexpr (ALIGN_EPI) { if (wr == 1) PG8_BAR; }
    }
    PG8_WAIT_V(0);
    if constexpr (!ALIGN_EPI) { if (wr == 0) PG8_BAR; }
    PG8_BAR;
#undef PG8_SA
#undef PG8_SB
#undef PG8_STAGE
#undef PG8_LDA
#undef PG8_LDB
#undef PG8_MMA
#undef PG8_WAIT_V
#undef PG8_WAIT_L
#undef PG8_BAR
#undef PG8_SCHED
}
}

namespace ab {
typedef unsigned short bf16;
typedef short bf16x8 __attribute__((ext_vector_type(8)));
typedef short s16x4 __attribute__((ext_vector_type(4)));
typedef float f32x16 __attribute__((ext_vector_type(16)));
typedef float f32x4 __attribute__((ext_vector_type(4)));
typedef unsigned u32x4 __attribute__((ext_vector_type(4)));
constexpr int D = 128, NW = 8, QBLK = 32, KVBLK = 64, QB = NW * QBLK;
constexpr int SHM_V = KVBLK * D * 2, SHM_K = KVBLK * D * 2;
constexpr int BODY_LDS = 2 * SHM_V + 2 * SHM_K + NW * 64 * 4;
constexpr int A2_OFF = BODY_LDS, M2_OFF = A2_OFF + 8192, E2_OFF = M2_OFF + 8192, SCAN_OFF = E2_OFF + 8192, LDS_NEED = SCAN_OFF + 256;
constexpr float SCALE = 0.08838834764831845f, THR = 8.f;
#define KSWZ(row, colB) ((row) * 256 + ((colB) ^ (((row) & 7) << 4)))
#define SBAR() __builtin_amdgcn_sched_barrier(0)
__device__ __forceinline__ int v_st(int k, int c) { const int kk = (k & ~0xC) | ((k & 4) << 1) | ((k & 8) >> 1); return ((kk >> 3) * 4 + (c >> 5)) * 512 + ((kk & 7) * 32 + (c & 31)) * 2; }
__device__ __forceinline__ int v_rd_base(int lane) { return ((lane & 3) << 3) | (((lane >> 2) & 3) << 6) | (((lane >> 4) & 1) << 5) | (((lane >> 5) & 1) << 8); }
constexpr int v_rd_off(int d0, int ks, int half) { return d0 * 512 + ks * 4096 + half * 2048; }
__device__ __forceinline__ int crow(int r, int hi) { return (r & 3) + 8 * (r >> 2) + 4 * hi; }
__device__ __forceinline__ unsigned cvtpk(float lo, float hi) { unsigned r; asm volatile("v_cvt_pk_bf16_f32 %0, %1, %2" : "=v"(r) : "v"(lo), "v"(hi)); return r; }
__device__ __forceinline__ bf16x8 load8(const bf16* p) { return *reinterpret_cast<const bf16x8*>(p); }
template <int MODE> __device__ __forceinline__ void mask_tile(f32x16& p0, f32x16& p1, int dq) {
    const float NEG = MODE == 0 ? -__builtin_inff() : 0.f;
#pragma unroll
    for (int r = 0; r < 16; ++r) { const int c = (r & 3) + 8 * (r >> 2);
        if (dq - c < 0) p0[r] = NEG;
        if (dq - c - 32 < 0) p1[r] = NEG; }
}
__device__ __forceinline__ void partialSM(f32x16& p0, f32x16& p1, float& m_reg, float& mn, float& alpha) {
    float pmax = p0[0];
#pragma unroll
    for (int r = 1; r < 16; ++r) pmax = fmaxf(pmax, p0[r]);
#pragma unroll
    for (int r = 0; r < 16; ++r) pmax = fmaxf(pmax, p1[r]);
    { auto rr = __builtin_amdgcn_permlane32_swap(__float_as_uint(pmax), __float_as_uint(pmax), false, false);
      pmax = fmaxf(__uint_as_float(rr[0]), __uint_as_float(rr[1])); }
    constexpr float C2 = 1.4426950408889634f * SCALE;
    if (__builtin_expect(__all((pmax - m_reg) * SCALE <= THR), 1)) { mn = m_reg; alpha = 1.f; }
    else { mn = fmaxf(m_reg, pmax); alpha = __builtin_amdgcn_exp2f((m_reg - mn) * C2); m_reg = mn; }
    const float mnL = -mn * C2;
#pragma unroll
    for (int r = 0; r < 16; ++r) p0[r] = fmaf(p0[r], C2, mnL);
#pragma unroll
    for (int r = 0; r < 16; ++r) p1[r] = fmaf(p1[r], C2, mnL);
#pragma unroll
    for (int r = 0; r < 16; ++r) p0[r] = __builtin_amdgcn_exp2f(p0[r]);
}
__device__ __forceinline__ void partialM(f32x16& p0, f32x16& p1, const float* a2k, float M2t, int hi) {
#pragma unroll
    for (int g = 0; g < 4; ++g) { const f32x4 a = *(const f32x4*)(a2k + 8 * g + 4 * hi);
#pragma unroll
        for (int j = 0; j < 4; ++j) p0[4 * g + j] *= __builtin_amdgcn_exp2f(fminf(a[j] - M2t, 0.f)); }
    SBAR();
#pragma unroll
    for (int g = 0; g < 4; ++g) { const f32x4 b = *(const f32x4*)(a2k + 32 + 8 * g + 4 * hi);
#pragma unroll
        for (int j = 0; j < 4; ++j) p1[4 * g + j] *= __builtin_amdgcn_exp2f(fminf(b[j] - M2t, 0.f)); }
}
#define AB_PK4(P, B_, OUT) do { unsigned a0 = cvtpk(P[B_+0], P[B_+1]), a1 = cvtpk(P[B_+2], P[B_+3]);                          \
        unsigned b0 = cvtpk(P[B_+4], P[B_+5]), b1 = cvtpk(P[B_+6], P[B_+7]);                                             \
        auto r0 = __builtin_amdgcn_permlane32_swap(a0, b0, false, false); auto r1 = __builtin_amdgcn_permlane32_swap(a1, b1, false, false); \
        u32x4 w = {r0[0], r1[0], r0[1], r1[1]}; OUT = *reinterpret_cast<bf16x8*>(&w); } while (0)
template <int MODE> __device__ __forceinline__ void finishSM(f32x16& p0, f32x16& p1, float alpha, float& l_reg, bf16x8& pa0, bf16x8& pa1, bf16x8& pa2, bf16x8& pa3) {
    if (MODE == 0) {
#pragma unroll
        for (int r = 0; r < 16; ++r) p1[r] = __builtin_amdgcn_exp2f(p1[r]); }
    float ps = 0;
#pragma unroll
    for (int r = 0; r < 16; ++r) ps += p0[r];
#pragma unroll
    for (int r = 0; r < 16; ++r) ps += p1[r];
    { auto rr = __builtin_amdgcn_permlane32_swap(__float_as_uint(ps), __float_as_uint(ps), false, false);
      ps = __uint_as_float(rr[0]) + __uint_as_float(rr[1]); }
    l_reg = l_reg * alpha + ps;
    AB_PK4(p0, 0, pa0); AB_PK4(p0, 8, pa1); AB_PK4(p1, 0, pa2); AB_PK4(p1, 8, pa3);
}
template <int KB>
__device__ __forceinline__ void qkt(f32x16& p0, f32x16& p1, const char* K_lds, int r32, int hi, const bf16x8* qr) {
    p0 = f32x16{}; p1 = f32x16{};
    const char* kb[4];
#pragma unroll
    for (int dd = 0; dd < 4; ++dd) kb[dd] = K_lds + KB * SHM_K + KSWZ(r32, (dd * 16 + hi * 8) * 2);
#pragma unroll
    for (int d0 = 0; d0 < 8; ++d0) { const char* a = kb[d0 & 3] + (d0 >> 2) * 128;
        bf16x8 b0 = *reinterpret_cast<const bf16x8*>(a);
        bf16x8 b1 = *reinterpret_cast<const bf16x8*>(a + 32 * 256);
        p0 = __builtin_amdgcn_mfma_f32_32x32x16_bf16(b0, qr[d0], p0, 0, 0, 0);
        p1 = __builtin_amdgcn_mfma_f32_32x32x16_bf16(b1, qr[d0], p1, 0, 0, 0); }
}
template <int VB>
__device__ __forceinline__ void pv_tile(f32x16* o, int vb0, bf16x8 pa0, bf16x8 pa1, bf16x8 pa2, bf16x8 pa3) {
#define TRRD(dst, off) asm volatile("ds_read_b64_tr_b16 %0, %1 offset:%2" : "=&v"(dst) : "v"(vb0), "i"(off) : "memory")
#define PV_D0(d0) do { s16x4 l0, l1, l2, l3, h0, h1, h2, h3; constexpr int b_ = VB * SHM_V + v_rd_off(d0, 0, 0); \
        TRRD(l0, b_); TRRD(h0, b_ + 2048); TRRD(l1, b_ + 4096); TRRD(h1, b_ + 6144); TRRD(l2, b_ + 8192); TRRD(h2, b_ + 10240); TRRD(l3, b_ + 12288); TRRD(h3, b_ + 14336); \
        asm volatile("s_waitcnt lgkmcnt(0)" ::: "memory"); SBAR();   \
        o[d0] = __builtin_amdgcn_mfma_f32_32x32x16_bf16(pa0, (bf16x8){l0[0], l0[1], l0[2], l0[3], h0[0], h0[1], h0[2], h0[3]}, o[d0], 0, 0, 0);   \
        o[d0] = __builtin_amdgcn_mfma_f32_32x32x16_bf16(pa1, (bf16x8){l1[0], l1[1], l1[2], l1[3], h1[0], h1[1], h1[2], h1[3]}, o[d0], 0, 0, 0);   \
        o[d0] = __builtin_amdgcn_mfma_f32_32x32x16_bf16(pa2, (bf16x8){l2[0], l2[1], l2[2], l2[3], h2[0], h2[1], h2[2], h2[3]}, o[d0], 0, 0, 0);   \
        o[d0] = __builtin_amdgcn_mfma_f32_32x32x16_bf16(pa3, (bf16x8){l3[0], l3[1], l3[2], l3[3], h3[0], h3[1], h3[2], h3[3]}, o[d0], 0, 0, 0); } while (0)
    PV_D0(0); PV_D0(1); PV_D0(2); PV_D0(3);
#undef PV_D0
#undef TRRD
}
template <int KB>
__device__ __forceinline__ void qkt2(f32x16& p0, f32x16& p1, const char* K_lds, int r32, int hi, const bf16x8* qr) {
    p0 = f32x16{}; p1 = f32x16{};
    int ka[4];
#pragma unroll
    for (int dd = 0; dd < 4; ++dd) ka[dd] = (int)(uintptr_t)K_lds + KB * SHM_K + KSWZ(r32, (dd * 16 + hi * 8) * 2);
#define KRD(dst, addr, off) asm volatile("ds_read_b128 %0, %1 offset:%2" : "=&v"(dst) : "v"(addr), "i"(off) : "memory")
#define QK_RD(X, Y, b) do { KRD(X[0], ka[(2 * (b)) & 3], ((2 * (b)) >> 2) * 128); KRD(Y[0], ka[(2 * (b)) & 3], ((2 * (b)) >> 2) * 128 + 32 * 256); \
        KRD(X[1], ka[(2 * (b) + 1) & 3], ((2 * (b) + 1) >> 2) * 128); KRD(Y[1], ka[(2 * (b) + 1) & 3], ((2 * (b) + 1) >> 2) * 128 + 32 * 256); } while (0)
#define QK_MM(X, Y, b) do { p0 = __builtin_amdgcn_mfma_f32_32x32x16_bf16(X[0], qr[2 * (b)], p0, 0, 0, 0); p1 = __builtin_amdgcn_mfma_f32_32x32x16_bf16(Y[0], qr[2 * (b)], p1, 0, 0, 0); \
        p0 = __builtin_amdgcn_mfma_f32_32x32x16_bf16(X[1], qr[2 * (b) + 1], p0, 0, 0, 0); p1 = __builtin_amdgcn_mfma_f32_32x32x16_bf16(Y[1], qr[2 * (b) + 1], p1, 0, 0, 0); } while (0)
    bf16x8 xa[2], ya[2], xb[2], yb[2];
    QK_RD(xa, ya, 0); QK_RD(xb, yb, 1);
    asm volatile("s_waitcnt lgkmcnt(4)" ::: "memory"); SBAR(); QK_MM(xa, ya, 0); SBAR(); QK_RD(xa, ya, 2);
    asm volatile("s_waitcnt lgkmcnt(4)" ::: "memory"); SBAR(); QK_MM(xb, yb, 1); SBAR(); QK_RD(xb, yb, 3);
    asm volatile("s_waitcnt lgkmcnt(4)" ::: "memory"); SBAR(); QK_MM(xa, ya, 2); SBAR();
    asm volatile("s_waitcnt lgkmcnt(0)" ::: "memory"); SBAR(); QK_MM(xb, yb, 3);
#undef QK_MM
#undef QK_RD
#undef KRD
}
template <int VB, bool PF>
__device__ __forceinline__ void pv_tile2(f32x16* o, int vb0, bf16x8 pa0, bf16x8 pa1, bf16x8 pa2, bf16x8 pa3) {
#define TRRD(dst, off) asm volatile("ds_read_b64_tr_b16 %0, %1 offset:%2" : "=&v"(dst) : "v"(vb0), "i"(off) : "memory")
#define PV_RD(L, H, ks) do { constexpr int b_ = VB * SHM_V + (ks) * 4096; TRRD(L[0], b_); TRRD(H[0], b_ + 2048); TRRD(L[1], b_ + 512); TRRD(H[1], b_ + 512 + 2048); \
        TRRD(L[2], b_ + 1024); TRRD(H[2], b_ + 1024 + 2048); TRRD(L[3], b_ + 1536); TRRD(H[3], b_ + 1536 + 2048); } while (0)
#define PV_MM(L, H, PA) do { _Pragma("unroll") for (int d0 = 0; d0 < 4; ++d0) \
        o[d0] = __builtin_amdgcn_mfma_f32_32x32x16_bf16(PA, (bf16x8){L[d0][0], L[d0][1], L[d0][2], L[d0][3], H[d0][0], H[d0][1], H[d0][2], H[d0][3]}, o[d0], 0, 0, 0); } while (0)
    s16x4 la[4], ha[4];
    if constexpr (PF) {
        s16x4 lb[4], hb[4];
        PV_RD(la, ha, 0); PV_RD(lb, hb, 1);
        asm volatile("s_waitcnt lgkmcnt(8)" ::: "memory"); SBAR(); PV_MM(la, ha, pa0); SBAR();
        PV_RD(la, ha, 2);
        asm volatile("s_waitcnt lgkmcnt(8)" ::: "memory"); SBAR(); PV_MM(lb, hb, pa1); SBAR();
        PV_RD(lb, hb, 3);
        asm volatile("s_waitcnt lgkmcnt(8)" ::: "memory"); SBAR(); PV_MM(la, ha, pa2); SBAR();
        asm volatile("s_waitcnt lgkmcnt(0)" ::: "memory"); SBAR(); PV_MM(lb, hb, pa3);
    } else {
        PV_RD(la, ha, 0); asm volatile("s_waitcnt lgkmcnt(0)" ::: "memory"); SBAR(); PV_MM(la, ha, pa0); SBAR();
        PV_RD(la, ha, 1); asm volatile("s_waitcnt lgkmcnt(0)" ::: "memory"); SBAR(); PV_MM(la, ha, pa1); SBAR();
        PV_RD(la, ha, 2); asm volatile("s_waitcnt lgkmcnt(0)" ::: "memory"); SBAR(); PV_MM(la, ha, pa2); SBAR();
        PV_RD(la, ha, 3); asm volatile("s_waitcnt lgkmcnt(0)" ::: "memory"); SBAR(); PV_MM(la, ha, pa3);
    }
#undef PV_MM
#undef PV_RD
#undef TRRD
}
struct BlockRef { const bf16* Q; const bf16* K; const bf16* V; float* O; int P0; const bf16* Cst; const float* nst; };
struct Seam { bf16x8 qr[8]; bf16x8 st_v0, st_v1, st_k0, st_k1; bf16x8 sb_v0, sb_v1, sb_k0, sb_k1; };
#define VMW() asm volatile("s_waitcnt vmcnt(0)" ::: "memory")
#define VMWN(n) asm volatile("s_waitcnt vmcnt(%0)" :: "i"(n) : "memory")
#define SLOAD_H(Kp, Vp, k0) do { const bf16* vb_ = (Vp) + (size_t)((k0) + wid * 4) * VP; const bf16* kb_ = (Kp) + (size_t)((k0) + wid * 4) * KP;    \
                         S.st_v0 = load8(vb_ + lov); S.st_v1 = load8(vb_ + 32 * VP + lov); S.st_k0 = load8(kb_ + lok); S.st_k1 = load8(kb_ + 32 * KP + lok); } while (0)
#define SWRITE_HK(bf) do { *(bf16x8*)(K_lds + (bf) * SHM_K + kws) = S.st_k0; *(bf16x8*)(K_lds + (bf) * SHM_K + kws + 32 * 256) = S.st_k1; } while (0)
#define SWRITE_HV(bf) do { *(bf16x8*)(V_lds + (bf) * SHM_V + vst0) = S.st_v0; *(bf16x8*)(V_lds + (bf) * SHM_V + vst1) = S.st_v1; } while (0)
#define SWRITE_H(bf) do { SWRITE_HV(bf); SWRITE_HK(bf); } while (0)
template <int QP, int KP, int VP>
__device__ __forceinline__ void prime(const BlockRef& cur, char* lds, Seam& S, const int tid, const int k0) {
    const int wid = __builtin_amdgcn_readfirstlane(tid >> 6), lane = tid & 63, r32 = lane & 31, hi = lane >> 5;
    const int sr = tid >> 4, sc = (tid & 15) * 8, kws = KSWZ(sr, sc * 2); char* K_lds = lds + 2 * SHM_V;
    const unsigned lov = (unsigned)((lane >> 4) * VP + sc), lok = (unsigned)((lane >> 4) * KP + sc), loq = (unsigned)(r32 * QP + hi * 8);
    { const bf16* qb_ = cur.Q + (size_t)(wid * QBLK) * QP;
#pragma unroll
      for (int d0 = 0; d0 < 8; ++d0) S.qr[d0] = load8(qb_ + d0 * 16 + loq); }
    SLOAD_H(cur.K, cur.V, k0); VMW(); SWRITE_HK(0);
    __syncthreads();
}
template <int MODE, int QP, int KP, int VP, int OP>
__device__ __forceinline__ void block(const BlockRef& cur, const BlockRef& nxt, char* lds, Seam& S, const int tid) {
    const int wid = __builtin_amdgcn_readfirstlane(tid >> 6), lane = tid & 63, r32 = lane & 31, hi = lane >> 5;
    const int T0 = (MODE == 1) ? cur.P0 / KVBLK : 0;
    int NT = (MODE == 1) ? QB / KVBLK : cur.P0 / KVBLK + QB / KVBLK;
    if (MODE == 1) asm volatile("" : "+s"(NT));
    const int qlo = cur.P0 + wid * QBLK, qm = qlo + r32 - 4 * hi;
    char* V_lds = lds; char* K_lds = lds + 2 * SHM_V;
    float* ws = (float*)(lds + 2 * SHM_V + 2 * SHM_K) + wid * 64; float* li_l = ws, * al_l = ws + 32;
    const float* a2 = (const float*)(lds + A2_OFF);
    float M2t = 0.f;
    if (MODE == 1) M2t = ((const float*)(lds + M2_OFF))[qlo + r32];
    float m_reg = -1e30f, l_reg = 0; f32x16 o[4] = {};
    const int sr = tid >> 4, sc = (tid & 15) * 8, vst0 = v_st(sr, sc), vst1 = v_st(32 + sr, sc), kws = KSWZ(sr, sc * 2);
    const int vb0 = (int)(uintptr_t)V_lds + v_rd_base(lane);
    const unsigned lov = (unsigned)((lane >> 4) * VP + sc), lok = (unsigned)((lane >> 4) * KP + sc), loq = (unsigned)(r32 * QP + hi * 8), loo = (unsigned)(4 * hi * OP + r32);
    const bf16* Kh = cur.K; const bf16* Vh = cur.V;
#define RESC(a) do { if (MODE == 0) { if (__any((a) < 1.f)) { if (hi == 0) al_l[r32] = (a); asm volatile("s_waitcnt lgkmcnt(0)" ::: "memory");              \
                     for (int d_ = 0; d_ < 4; ++d_) for (int r = 0; r < 16; ++r) o[d_][r] *= al_l[crow(r, hi)]; } } } while (0)
#define KBASE(t) ((T0 + (t)) * KVBLK)
#define MASKT(P0_, P1_, t) do { const int kb_ = KBASE(t); if (kb_ + KVBLK - 1 > qlo) mask_tile<MODE>(P0_, P1_, qm - kb_); } while (0)
#define PARTIAL(P0_, P1_, mnX, alX, t) do { if (MODE == 0) partialSM(P0_, P1_, m_reg, mnX, alX); else { alX = 1.f; partialM(P0_, P1_, a2 + KBASE(t), M2t, hi); } } while (0)
    constexpr int NQL = 8;
#define SEAM_K0() do { VMWN(NQL); SWRITE_HK(0); SBAR(); } while (0)
    f32x16 pA0, pA1, pB0, pB1; float mnA, mnB, alA, alB; bf16x8 pa0, pa1, pa2, pa3;
    if (MODE == 1 && cur.Cst != nullptr) {
        const bf16* Cp = cur.Cst + (size_t)(wid * 4) * 256; const unsigned loc = (unsigned)((lane >> 4) * 256 + sc);
        const bf16x8 c0 = load8(Cp + loc), c1 = load8(Cp + 32 * 256 + loc), c2 = load8(Cp + 64 * 256 + loc), c3 = load8(Cp + 96 * 256 + loc);
        float dn = 0.f;
#pragma unroll
        for (int d0 = 0; d0 < 8; ++d0) { const f32x4 n0 = *(const f32x4*)(cur.nst + 16 * d0 + 8 * hi), n1 = *(const f32x4*)(cur.nst + 16 * d0 + 8 * hi + 4);
            const u32x4 qw = *reinterpret_cast<const u32x4*>(&S.qr[d0]);
            dn += __uint_as_float(qw.x << 16) * n0[0] + __uint_as_float(qw.x & 0xffff0000u) * n0[1] + __uint_as_float(qw.y << 16) * n0[2] + __uint_as_float(qw.y & 0xffff0000u) * n0[3];
            dn += __uint_as_float(qw.z << 16) * n1[0] + __uint_as_float(qw.z & 0xffff0000u) * n1[1] + __uint_as_float(qw.w << 16) * n1[2] + __uint_as_float(qw.w & 0xffff0000u) * n1[3]; }
        { auto rr = __builtin_amdgcn_permlane32_swap(__float_as_uint(dn), __float_as_uint(dn), false, false); dn = __uint_as_float(rr[0]) + __uint_as_float(rr[1]); }
        VMW();
        *(bf16x8*)(V_lds + vst0) = c0; *(bf16x8*)(V_lds + vst1) = c1; *(bf16x8*)(V_lds + SHM_V + vst0) = c2; *(bf16x8*)(V_lds + SHM_V + vst1) = c3;
        __syncthreads();
        pv_tile<0>(o, vb0, S.qr[0], S.qr[1], S.qr[2], S.qr[3]); pv_tile<1>(o, vb0, S.qr[4], S.qr[5], S.qr[6], S.qr[7]);
        const float st = __builtin_amdgcn_exp2f(((const float*)(lds + M2_OFF))[cur.P0 - 1] - M2t);
        l_reg = st * dn;
        if (hi == 0) al_l[r32] = st;
        asm volatile("s_waitcnt lgkmcnt(0)" ::: "memory");
#pragma unroll
        for (int d_ = 0; d_ < 4; ++d_)
#pragma unroll
            for (int r = 0; r < 16; ++r) o[d_][r] *= al_l[crow(r, hi)];
        __syncthreads();
    }
    SWRITE_HV(0); SBAR();
    if (NT > 1) { SLOAD_H(Kh, Vh, KBASE(1)); }
    SBAR(); qkt<0>(pA0, pA1, K_lds, r32, hi, S.qr);
    MASKT(pA0, pA1, 0); PARTIAL(pA0, pA1, mnA, alA, 0);
    if (NT > 1) { VMW(); SWRITE_H(1); }
    __syncthreads();
#define HALF_STEP(PX0, PX1, mnX, alX, PY0, PY1, alY, t, KB, VB, SB) do {                                                      \
        SBAR(); qkt<KB>(PX0, PX1, K_lds, r32, hi, S.qr);                                             \
        finishSM<MODE>(PY0, PY1, alY, l_reg, pa0, pa1, pa2, pa3); SBAR();                                                           \
        if ((t) + 1 < NT) { SLOAD_H(Kh, Vh, KBASE((t) + 1)); SBAR(); }                                               \
        pv_tile<VB>(o, vb0, pa0, pa1, pa2, pa3); MASKT(PX0, PX1, (t)); PARTIAL(PX0, PX1, mnX, alX, (t));                                        \
        __syncthreads();                                                                                                      \
        if ((t) + 1 < NT) { VMW(); SWRITE_H(SB); }                                                                          \
        RESC(alX); __syncthreads(); } while (0)
    for (int t = 1; t + 1 < NT; t += 2) {
        HALF_STEP(pB0, pB1, mnB, alB, pA0, pA1, alA, t, 1, 0, 0);
        HALF_STEP(pA0, pA1, mnA, alA, pB0, pB1, alB, t + 1, 0, 1, 1);
    }
    const bool even = (NT & 1) == 0;
    if (even) { SBAR(); qkt<1>(pB0, pB1, K_lds, r32, hi, S.qr); SBAR(); }
    SLOAD_H(nxt.K, nxt.V, (MODE == 1) ? nxt.P0 : 0); SBAR();
    { const bf16* qb_ = nxt.Q + (size_t)(wid * QBLK) * QP;
#pragma unroll
      for (int d0 = 0; d0 < 8; ++d0) S.qr[d0] = load8(qb_ + d0 * 16 + loq); }
    SBAR();
    finishSM<MODE>(pA0, pA1, alA, l_reg, pa0, pa1, pa2, pa3); SBAR();
    pv_tile<0>(o, vb0, pa0, pa1, pa2, pa3);
    if (even) { MASKT(pB0, pB1, NT - 1); PARTIAL(pB0, pB1, mnB, alB, NT - 1); __syncthreads(); RESC(alB);
        finishSM<MODE>(pB0, pB1, alB, l_reg, pa0, pa1, pa2, pa3); SBAR(); pv_tile<1>(o, vb0, pa0, pa1, pa2, pa3); }
    SBAR(); SEAM_K0();
    if (hi == 0) li_l[r32] = (MODE == 0) ? l_reg : fmaxf(fabsf(l_reg), __builtin_amdgcn_exp2f(((const float*)(lds + E2_OFF))[qlo + r32]));
    asm volatile("s_waitcnt lgkmcnt(0)" ::: "memory");
    float rli[16];
#pragma unroll
    for (int r = 0; r < 16; ++r) rli[r] = __builtin_amdgcn_rcpf(li_l[crow(r, hi)]);
    float* Ow = cur.O + (size_t)(wid * QBLK) * OP;
#pragma unroll
    for (int r = 0; r < 16; ++r) { float* Or = Ow + (size_t)((r & 3) + 8 * (r >> 2)) * OP;
#pragma unroll
        for (int d0 = 0; d0 < 4; ++d0) Or[d0 * 32 + loo] = o[d0][r] * rli[r]; }
    __syncthreads();
#undef RESC
#undef KBASE
#undef MASKT
#undef PARTIAL
#undef SEAM_K0
#undef HALF_STEP
}

#define PP_BAR() do { asm volatile("s_waitcnt lgkmcnt(0)" ::: "memory"); __builtin_amdgcn_s_barrier(); asm volatile("" ::: "memory"); SBAR(); } while (0)
constexpr int SB_OFF = 98304;
static_assert(LDS_NEED <= SB_OFF && SB_OFF + 2 * SHM_V <= 131072, "lds map");
template <int MODE, int QP, int KP, int VP>
__device__ __forceinline__ void prime2(const BlockRef& cur, char* lds, Seam& S, const int tid) {
    const int wid = __builtin_amdgcn_readfirstlane(tid >> 6), lane = tid & 63, r32 = lane & 31, hi = lane >> 5;
    const int sr = tid >> 4, sc = (tid & 15) * 8, kws = KSWZ(sr, sc * 2); char* K_lds = lds + 2 * SHM_V;
    const unsigned lov = (unsigned)((lane >> 4) * VP + sc), lok = (unsigned)((lane >> 4) * KP + sc), loq = (unsigned)(r32 * QP + hi * 8);
    const int k0 = (MODE == 1) ? cur.P0 : 0;
    { const bf16* qb_ = cur.Q + (size_t)(wid * QBLK) * QP;
#pragma unroll
      for (int d0 = 0; d0 < 8; ++d0) S.qr[d0] = load8(qb_ + d0 * 16 + loq); }
    { const bf16* kb_ = cur.K + (size_t)(k0 + wid * 4) * KP; S.st_k0 = load8(kb_ + lok); S.st_k1 = load8(kb_ + 32 * KP + lok); }
    *(bf16x8*)(K_lds + kws) = S.st_k0; *(bf16x8*)(K_lds + kws + 32 * 256) = S.st_k1;
    SBAR();
    { const bf16* kb_ = cur.K + (size_t)(k0 + KVBLK + wid * 4) * KP; const bf16* vb_ = cur.V + (size_t)(k0 + wid * 4) * VP;
      S.st_k0 = load8(kb_ + lok); S.st_k1 = load8(kb_ + 32 * KP + lok); S.st_v0 = load8(vb_ + lov); S.st_v1 = load8(vb_ + 32 * VP + lov);
      if (MODE == 0) { S.sb_k0 = load8(kb_ + (size_t)KVBLK * KP + lok); S.sb_k1 = load8(kb_ + (size_t)(KVBLK + 32) * KP + lok); S.sb_v0 = load8(vb_ + (size_t)KVBLK * VP + lov); S.sb_v1 = load8(vb_ + (size_t)(KVBLK + 32) * VP + lov); } }
    PP_BAR();
    if (wid >= 4) PP_BAR();
}
__device__ __forceinline__ void pp_realign(const int tid) { if (__builtin_amdgcn_readfirstlane(tid >> 6) < 4) PP_BAR(); }
template <int MODE, int QP, int KP, int VP, int OP>
__device__ __forceinline__ void block2(const BlockRef& cur, const BlockRef& nxt, char* lds, Seam& S, const int tid) {
    const int wid = __builtin_amdgcn_readfirstlane(tid >> 6), lane = tid & 63, r32 = lane & 31, hi = lane >> 5;
    const int T0 = (MODE == 1) ? cur.P0 / KVBLK : 0, T0n = (MODE == 1) ? nxt.P0 / KVBLK : 0;
    int NT = (MODE == 1) ? QB / KVBLK : cur.P0 / KVBLK + QB / KVBLK;
    if (MODE == 1) asm volatile("" : "+s"(NT));
    const int qlo = cur.P0 + wid * QBLK, qm = qlo + r32 - 4 * hi;
    char* V_lds = lds; char* K_lds = lds + 2 * SHM_V;
    float* ws = (float*)(lds + 2 * SHM_V + 2 * SHM_K) + wid * 64; float* li_l = ws, * al_l = ws + 32;
    const float* a2 = (const float*)(lds + A2_OFF);
    float M2t = 0.f;
    if (MODE == 1) M2t = ((const float*)(lds + M2_OFF))[qlo + r32];
    float m_reg = -1e30f, l_reg = 0; f32x16 o[4] = {};
    const int sr = tid >> 4, sc = (tid & 15) * 8, vst0 = v_st(sr, sc), vst1 = v_st(32 + sr, sc), kws = KSWZ(sr, sc * 2);
    const int vb0 = (int)(uintptr_t)V_lds + v_rd_base(lane);
    const unsigned lov = (unsigned)((lane >> 4) * VP + sc), lok = (unsigned)((lane >> 4) * KP + sc), loq = (unsigned)(r32 * QP + hi * 8), loo = (unsigned)(4 * hi * OP + r32);
#define KBASE2(t) ((T0 + (t)) * KVBLK)
#define LOADKV(K0, K1, V0, V1, kt, vt) do { const bool kn_ = (kt) >= NT, vn_ = (vt) >= NT;                                                            \
        const bf16* kb_ = (kn_ ? nxt.K : cur.K) + (size_t)(((kn_ ? T0n - NT : T0) + (kt)) * KVBLK + wid * 4) * KP;                                   \
        const bf16* vb_ = (vn_ ? nxt.V : cur.V) + (size_t)(((vn_ ? T0n - NT : T0) + (vt)) * KVBLK + wid * 4) * VP;                                   \
        K0 = load8(kb_ + lok); K1 = load8(kb_ + 32 * KP + lok); V0 = load8(vb_ + lov); V1 = load8(vb_ + 32 * VP + lov); } while (0)
#define WRITEKV(K0, K1, V0, V1, kbuf, vbuf) do { *(bf16x8*)(K_lds + (kbuf) * SHM_K + kws) = K0; *(bf16x8*)(K_lds + (kbuf) * SHM_K + kws + 32 * 256) = K1;    \
        *(bf16x8*)(V_lds + (vbuf) * SHM_V + vst0) = V0; *(bf16x8*)(V_lds + (vbuf) * SHM_V + vst1) = V1; } while (0)
#define WRITE_A(kbuf, vbuf) WRITEKV(S.st_k0, S.st_k1, S.st_v0, S.st_v1, kbuf, vbuf)
#define WRITE_B(kbuf, vbuf) WRITEKV(S.sb_k0, S.sb_k1, S.sb_v0, S.sb_v1, kbuf, vbuf)
#define LOAD_A(kt, vt) LOADKV(S.st_k0, S.st_k1, S.st_v0, S.st_v1, kt, vt)
#define LOAD_B(kt, vt) LOADKV(S.sb_k0, S.sb_k1, S.sb_v0, S.sb_v1, kt, vt)
    f32x16 p0, p1; float mn, al; bf16x8 pa0, pa1, pa2, pa3;
#define VV_STAGE(t) do { { const int kb_ = KBASE2(t); if (kb_ + KVBLK - 1 > qlo) mask_tile<MODE>(p0, p1, qm - kb_); }                                 \
        if (MODE == 0) { partialSM(p0, p1, m_reg, mn, al);                                                                                             \
            if (__any(al < 1.f)) { if (hi == 0) al_l[r32] = al; asm volatile("s_waitcnt lgkmcnt(0)" ::: "memory");                                     \
                _Pragma("unroll") for (int d_ = 0; d_ < 4; ++d_) _Pragma("unroll") for (int r = 0; r < 16; ++r) o[d_][r] *= al_l[crow(r, hi)]; } }                  \
        else { al = 1.f; partialM(p0, p1, a2 + KBASE2(t), M2t, hi); }                                                                                  \
        finishSM<MODE>(p0, p1, al, l_reg, pa0, pa1, pa2, pa3); } while (0)
    if (MODE == 1 && cur.Cst != nullptr) {
        const bf16* Cp = cur.Cst + (size_t)(wid * 4) * 256; const unsigned loc = (unsigned)((lane >> 4) * 256 + sc);
        const bf16x8 c0 = load8(Cp + loc), c1 = load8(Cp + 32 * 256 + loc), c2 = load8(Cp + 64 * 256 + loc), c3 = load8(Cp + 96 * 256 + loc);
        *(bf16x8*)(lds + SB_OFF + vst0) = c0; *(bf16x8*)(lds + SB_OFF + vst1) = c1; *(bf16x8*)(lds + SB_OFF + SHM_V + vst0) = c2; *(bf16x8*)(lds + SB_OFF + SHM_V + vst1) = c3;
        PP_BAR();
        float dn = 0.f;
#pragma unroll
        for (int d0 = 0; d0 < 8; ++d0) { const f32x4 n0 = *(const f32x4*)(cur.nst + 16 * d0 + 8 * hi), n1 = *(const f32x4*)(cur.nst + 16 * d0 + 8 * hi + 4);
            const u32x4 qw = *reinterpret_cast<const u32x4*>(&S.qr[d0]);
            dn += __uint_as_float(qw.x << 16) * n0[0] + __uint_as_float(qw.x & 0xffff0000u) * n0[1] + __uint_as_float(qw.y << 16) * n0[2] + __uint_as_float(qw.y & 0xffff0000u) * n0[3];
            dn += __uint_as_float(qw.z << 16) * n1[0] + __uint_as_float(qw.z & 0xffff0000u) * n1[1] + __uint_as_float(qw.w << 16) * n1[2] + __uint_as_float(qw.w & 0xffff0000u) * n1[3]; }
        { auto rr = __builtin_amdgcn_permlane32_swap(__float_as_uint(dn), __float_as_uint(dn), false, false); dn = __uint_as_float(rr[0]) + __uint_as_float(rr[1]); }
        PP_BAR();
        pv_tile2<0, MODE == 0>(o, vb0 + SB_OFF, S.qr[0], S.qr[1], S.qr[2], S.qr[3]); pv_tile2<1, MODE == 0>(o, vb0 + SB_OFF, S.qr[4], S.qr[5], S.qr[6], S.qr[7]);
        const float st = __builtin_amdgcn_exp2f(((const float*)(lds + M2_OFF))[cur.P0 - 1] - M2t);
        l_reg = st * dn;
        if (hi == 0) al_l[r32] = st;
        asm volatile("s_waitcnt lgkmcnt(0)" ::: "memory");
#pragma unroll
        for (int d_ = 0; d_ < 4; ++d_)
#pragma unroll
            for (int r = 0; r < 16; ++r) o[d_][r] *= al_l[crow(r, hi)];
        PP_BAR();
    }
    for (int t = 0; t < NT; t += 2) {
        WRITE_A(1, 0); SBAR(); if (MODE == 0) LOAD_A(t + 3, t + 2); else LOAD_A(t + 2, t + 1); SBAR();
        if (t > 0) pv_tile2<1, MODE == 0>(o, vb0, pa0, pa1, pa2, pa3);
        qkt2<0>(p0, p1, K_lds, r32, hi, S.qr);
        PP_BAR();
        VV_STAGE(t);
        PP_BAR();
        if (MODE == 0) { WRITE_B(0, 1); SBAR(); LOAD_B(t + 4, t + 3); } else { WRITE_A(0, 1); SBAR(); LOAD_A(t + 3, t + 2); } SBAR();
        pv_tile2<0, MODE == 0>(o, vb0, pa0, pa1, pa2, pa3);
        qkt2<1>(p0, p1, K_lds, r32, hi, S.qr);
        PP_BAR();
        VV_STAGE(t + 1);
        PP_BAR();
    }
    { const bf16* qb_ = nxt.Q + (size_t)(wid * QBLK) * QP;
#pragma unroll
      for (int d0 = 0; d0 < 8; ++d0) S.qr[d0] = load8(qb_ + d0 * 16 + loq); }
    SBAR();
    pv_tile2<1, MODE == 0>(o, vb0, pa0, pa1, pa2, pa3);
    PP_BAR();
    if (hi == 0) li_l[r32] = (MODE == 0) ? l_reg : fmaxf(fabsf(l_reg), __builtin_amdgcn_exp2f(((const float*)(lds + E2_OFF))[qlo + r32]));
    asm volatile("s_waitcnt lgkmcnt(0)" ::: "memory");
    float rli[16];
#pragma unroll
    for (int r = 0; r < 16; ++r) rli[r] = __builtin_amdgcn_rcpf(li_l[crow(r, hi)]);
    { bf16* Ow = (bf16*)cur.O + (size_t)(wid * QBLK) * OP;
#pragma unroll
      for (int r = 0; r < 16; ++r) { bf16* Or = Ow + (size_t)((r & 3) + 8 * (r >> 2)) * OP;
#pragma unroll
          for (int d0 = 0; d0 < 4; ++d0) { const float v = o[d0][r] * rli[r];
              const float nb = __uint_as_float(__builtin_amdgcn_update_dpp(0u, __float_as_uint(v), 0xB1, 0xf, 0xf, false));
              if ((r32 & 1) == 0) *(unsigned*)(Or + d0 * 32 + loo) = cvtpk(v, nb); } } }
    PP_BAR();
#undef KBASE2
#undef LOADKV
#undef WRITEKV
#undef WRITE_A
#undef WRITE_B
#undef LOAD_A
#undef LOAD_B
#undef VV_STAGE
}
#undef VMW
#undef VMWN
#undef SLOAD_H
#undef SWRITE_HK
#undef SWRITE_HV
#undef SWRITE_H
}

constexpr int NWAVES = 8;
constexpr int BATCH = 4, SEQ = 2048, DM = 2048, DEPTH = 4, MTOK = BATCH * SEQ;
constexpr int NIN = 16400, NING = 16384, GATE_COL = 6144, DFF = 5632, NUP = 2 * DFF;
constexpr float EPS = 1e-6f;
constexpr int NPH_L = 7, NPHASE = 2 + DEPTH * NPH_L;
constexpr size_t MiB = 1u << 20;
constexpr size_t WS_CTL = 0, CTL_ZERO_BYTES = 1 * MiB;
constexpr size_t WS_ROPE = 1 * MiB;
constexpr size_t WS_BIASG = WS_ROPE + 512 * 1024;
constexpr size_t WS_GATES = 2 * MiB;
constexpr size_t WS_ROWSS_B = 3 * MiB - 64 * 1024;
constexpr size_t WS_ROWSS = 3 * MiB;
constexpr size_t WS_WIN = 4 * MiB, SZ_WIN = 64 * MiB;
constexpr size_t WS_WBM = WS_WIN + 4 * SZ_WIN, SZ_WSQ = 8 * MiB;
constexpr size_t WS_WBD = WS_WBM + 4 * SZ_WSQ, WS_WO = WS_WBD + 4 * SZ_WSQ;
constexpr size_t WS_WUP = WS_WO + 4 * SZ_WSQ, SZ_WUP = 44 * MiB;
constexpr size_t WS_WDN = WS_WUP + 4 * SZ_WUP, SZ_WDN = 22 * MiB;
constexpr size_t WS_H = WS_WDN + 4 * SZ_WDN;
constexpr size_t WS_XN = WS_H + 64 * MiB;
constexpr size_t WS_MQ = WS_XN + 32 * MiB, WS_MK = WS_MQ + 16 * MiB, WS_MV = WS_MK + 16 * MiB, WS_SMO = WS_MV + 32 * MiB;
constexpr size_t WS_AQ = WS_SMO + 32 * MiB, WS_AK = WS_AQ + 32 * MiB, WS_AV = WS_AK + 32 * MiB, WS_SG = WS_AV + 32 * MiB;
constexpr size_t WS_OATT = WS_SG + 64 * MiB;
constexpr size_t WS_HRAW = WS_OATT + 128 * MiB;
constexpr size_t WS_HMN = WS_HRAW + 64 * MiB, WS_HAN = WS_HMN + 32 * MiB;
constexpr size_t WS_P = WS_HAN + 32 * MiB;
constexpr size_t WS_Y = WS_P + 64 * MiB;
constexpr size_t WS_FXC = WS_Y + 32 * MiB, WS_FXV = WS_FXC + 3 * MiB, WS_FXG = WS_FXV + 3 * MiB;
constexpr size_t WS_U = WS_FXG + 3 * MiB;
constexpr size_t WS_CST = WS_U + 88 * MiB;
constexpr size_t WS_NST = WS_CST + 16 * MiB;
constexpr size_t WS_END = WS_NST + 1 * MiB;
constexpr int CW_TMO = 0, CW_CODE = 1, CW_BAR = 4096, CW_GCNT = 200000, CW_SFLAG = 210000, CW_TICK = 240000, CW_ATICK = 250000;
constexpr int LDS_BYTES = 131072 + 2048, MISC_OFF = 131072;
static_assert(ab::LDS_NEED <= 131072, "lds");

#define GAS __attribute__((address_space(1)))
#define LAS __attribute__((address_space(3)))
typedef unsigned short bf16;
typedef unsigned v4u __attribute__((ext_vector_type(4)));
typedef unsigned v2u __attribute__((ext_vector_type(2)));
typedef float f32x4 __attribute__((ext_vector_type(4)));
typedef GAS unsigned gu32;
#define RLX_AGENT __ATOMIC_RELAXED, __HIP_MEMORY_SCOPE_AGENT
#define LDS_WAIT() asm volatile("s_waitcnt lgkmcnt(0)" ::: "memory")
#define VM_WAIT() asm volatile("s_waitcnt vmcnt(0)" ::: "memory")
__device__ __forceinline__ unsigned pk2(float lo, float hi) { return pg8::cvt_pk_bf16(lo, hi); }

#define XB_TMO      128
#define XB_XCNT(j)  (256  + 64 * (j))
#define XB_XSUB(j)  (1280 + 64 * (j))
#define XB_XGEN(j)  (2304 + 64 * (j))
#define XB_TOP      3328
#define XB_TOPGEN   3392
#define XCD_BAR_WORDS 3456
#define XB_SPIN_CAP (1u << 18)
__device__ __forceinline__ unsigned xb_ld(unsigned* p)              { return __hip_atomic_load(p, __ATOMIC_RELAXED, __HIP_MEMORY_SCOPE_AGENT); }
__device__ __forceinline__ unsigned xb_add(unsigned* p, unsigned v) { return __hip_atomic_fetch_add(p, v, __ATOMIC_RELAXED, __HIP_MEMORY_SCOPE_AGENT); }
__device__ __forceinline__ unsigned xb_xcc_id() { return (unsigned)__builtin_amdgcn_s_getreg((3 << 11) | 20) & 0xFu; }
#define XB_SPIN(cond, bar) do { unsigned _sp = 0; while (cond) { __builtin_amdgcn_s_sleep(1); \
    if ((++_sp & 255u) == 0u) { if (xb_ld(&(bar)[XB_TMO])) break; if (_sp > XB_SPIN_CAP) { atomicAdd(&(bar)[XB_TMO], 1u); break; } } } } while (0)
struct XcdBarrier { unsigned* bar; unsigned x; volatile LAS unsigned* st; };
__device__ __forceinline__ XcdBarrier xcd_barrier_post(unsigned* bar, volatile LAS unsigned* st) {
    XcdBarrier b; b.bar = bar; b.x = xb_xcc_id(); b.st = st;
    if (threadIdx.x == 0) (void)xb_add(&bar[XB_XCNT(b.x)], 1u);
    return b;
}
__device__ __forceinline__ void xcd_barrier_complete(unsigned* bar, unsigned x, unsigned& nloc, unsigned& nx) {
    const unsigned G = gridDim.x * gridDim.y * gridDim.z;
    unsigned sum, cnt, mine, sp = 0u;
    for (;;) {
        sum = 0u; cnt = 0u; mine = 0u;
#pragma unroll
        for (unsigned j = 0; j < 16; ++j) { const unsigned c = xb_ld(&bar[XB_XCNT(j)]); sum += c; cnt += (c > 0u) ? 1u : 0u; mine = (j == x) ? c : mine; }
        if (sum == G) break;
        __builtin_amdgcn_s_sleep(1);
        if ((++sp & 255u) == 0u) { if (xb_ld(&bar[XB_TMO])) break; if (sp > XB_SPIN_CAP) { atomicAdd(&bar[XB_TMO], 1u); break; } }
    }
    nloc = mine > 0u ? mine : 1u; nx = cnt > 0u ? cnt : 1u;
}
__device__ __forceinline__ void xcd_barrier(const XcdBarrier& b) {
    asm volatile("s_waitcnt vmcnt(0)" ::: "memory");
    __syncthreads();
    if (threadIdx.x == 0) {
        unsigned* bar = b.bar;
        __builtin_amdgcn_s_waitcnt(0);
        unsigned nloc = b.st[0], nx = b.st[1];
        if (nloc == 0u) { xcd_barrier_complete(bar, b.x, nloc, nx); b.st[0] = nloc; b.st[1] = nx; }
        const unsigned old = xb_add(&bar[XB_XSUB(b.x)], 1u);
        const unsigned gen = old / nloc;
        if (old + 1u == (gen + 1u) * nloc) {
            __builtin_amdgcn_fence(__ATOMIC_RELEASE, "agent");
            asm volatile("s_waitcnt vmcnt(0)" ::: "memory");
            const unsigned og = xb_add(&bar[XB_TOP], 1u);
            const unsigned tg = og / nx;
            if (og + 1u == (tg + 1u) * nx) xb_add(&bar[XB_TOPGEN], 1u);
            else XB_SPIN(xb_ld(&bar[XB_TOPGEN]) == tg, bar);
            __builtin_amdgcn_fence(__ATOMIC_ACQUIRE, "agent");
            xb_add(&bar[XB_XGEN(b.x)], 1u);
            asm volatile("s_waitcnt vmcnt(0)" ::: "memory");
        } else {
            XB_SPIN(xb_ld(&bar[XB_XGEN(b.x)]) == gen, bar);
            __builtin_amdgcn_fence(__ATOMIC_ACQUIRE, "agent");
            asm volatile("s_waitcnt vmcnt(0)" ::: "memory");
        }
    }
    __syncthreads();
}

struct Frame {
    LAS unsigned char* lds; unsigned char* ldsg;
    int tid, lane, wave, bid, vcu, G;
    unsigned char* ws;
};
enum { I_X = 0, I_NORM_MIX, I_W_IN, I_B_IN, I_M_NORM, I_A_NORM, I_LAM_QK, I_W_BM, I_W_BD, I_W_O, I_NORM_FFN, I_W_UP, I_CONV_W, I_CONV_B, I_W_DOWN, I_NORM_FINAL, I_OUT, I_NPTR };
constexpr int PTAB_OFF = 131072 + 256;
__device__ __forceinline__ const float* inp(const Frame& F, int i) {
    const LAS unsigned* t = (const LAS unsigned*)(F.lds + PTAB_OFF) + 2 * i;
    const unsigned lo = __builtin_amdgcn_readfirstlane(t[0]), hi = __builtin_amdgcn_readfirstlane(t[1]);
    return (const float*)(const GAS float*)(((unsigned long long)hi << 32) | lo);
}
template <int CTRL, int RM> __device__ __forceinline__ float dppf(float old, float src) {
    return __uint_as_float(__builtin_amdgcn_update_dpp(__float_as_uint(old), __float_as_uint(src), CTRL, RM, 0xf, false)); }
__device__ __forceinline__ float wave_sum(float v) {
    v += dppf<0xB1, 0xf>(0.f, v); v += dppf<0x4E, 0xf>(0.f, v); v += dppf<0x141, 0xf>(0.f, v); v += dppf<0x140, 0xf>(0.f, v);
    { auto rr = __builtin_amdgcn_permlane16_swap(__float_as_uint(v), __float_as_uint(v), false, false); v = __uint_as_float(rr[0]) + __uint_as_float(rr[1]); }
    { auto rr = __builtin_amdgcn_permlane32_swap(__float_as_uint(v), __float_as_uint(v), false, false); v = __uint_as_float(rr[0]) + __uint_as_float(rr[1]); }
    return v;
}
__device__ __forceinline__ float wave_scan_sum(float v) {
    v += dppf<0x111, 0xf>(0.f, v); v += dppf<0x112, 0xf>(0.f, v); v += dppf<0x114, 0xf>(0.f, v); v += dppf<0x118, 0xf>(0.f, v);
    v += dppf<0x142, 0xa>(0.f, v); v += dppf<0x143, 0xc>(0.f, v); return v;
}
__device__ __forceinline__ float wave_scan_max(float v) {
    const float NEG = -__builtin_inff();
    v = fmaxf(v, dppf<0x111, 0xf>(NEG, v)); v = fmaxf(v, dppf<0x112, 0xf>(NEG, v)); v = fmaxf(v, dppf<0x114, 0xf>(NEG, v)); v = fmaxf(v, dppf<0x118, 0xf>(NEG, v));
    v = fmaxf(v, dppf<0x142, 0xa>(NEG, v)); v = fmaxf(v, dppf<0x143, 0xc>(NEG, v)); return v;
}

struct CvtJob { const float* W; bf16* Bt; const float* gain; int Nsrc, K, k0, srccol0, dstrow0, rope; };
constexpr int IT_IN = 32 * 256, IT_SQ = 32 * 32, IT_UP = 32 * 176, IT_DN = 88 * 32, IT_LAYER = IT_IN + 3 * IT_SQ + IT_UP + IT_DN, IT_TOTAL = DEPTH * IT_LAYER;
__device__ __forceinline__ void cvt_decode(const Frame& F, int it, CvtJob& j) {
    const int l = it / IT_LAYER; int r = it - l * IT_LAYER; j.rope = 0; j.gain = nullptr;
    if (r < IT_IN) { const int nb = r >> 5, kt = r & 31, n0 = nb * 64;
        j.W = inp(F, I_W_IN) + (size_t)l * DM * NIN; j.Bt = (bf16*)(F.ws + WS_WIN + (size_t)l * SZ_WIN); j.Nsrc = NIN; j.K = DM; j.k0 = kt * 64; j.gain = inp(F, I_NORM_MIX) + (size_t)l * DM;
        j.srccol0 = n0 < GATE_COL ? n0 : n0 + 16; j.dstrow0 = n0; j.rope = (n0 >= 6144 && n0 < 10240 && (n0 & 127) == 0) ? 1 : 0; return; }
    r -= IT_IN;
    if (r < 3 * IT_SQ) { const int w = r / IT_SQ; r -= w * IT_SQ; const int nb = r >> 5, kt = r & 31;
        j.W = (w == 0 ? inp(F, I_W_BM) : (w == 1 ? inp(F, I_W_BD) : inp(F, I_W_O))) + (size_t)l * DM * DM;
        j.Bt = (bf16*)(F.ws + (w == 0 ? WS_WBM : (w == 1 ? WS_WBD : WS_WO)) + (size_t)l * SZ_WSQ); j.Nsrc = DM; j.K = DM; j.k0 = kt * 64; j.srccol0 = nb * 64; j.dstrow0 = nb * 64; return; }
    r -= 3 * IT_SQ;
    if (r < IT_UP) { const int nb = r >> 5, kt = r & 31, n0 = nb * 64, pn = n0 >> 8, w = n0 & 255;
        j.W = inp(F, I_W_UP) + (size_t)l * DM * NUP; j.Bt = (bf16*)(F.ws + WS_WUP + (size_t)l * SZ_WUP); j.Nsrc = NUP; j.K = DM; j.k0 = kt * 64; j.gain = inp(F, I_NORM_FFN) + (size_t)l * DM;
        j.srccol0 = (w < 128) ? pn * 128 + w : DFF + pn * 128 + (w - 128); j.dstrow0 = n0; return; }
    r -= IT_UP;
    { const int nb = r / 88, kt = r - nb * 88;
      j.W = inp(F, I_W_DOWN) + (size_t)l * DFF * DM; j.Bt = (bf16*)(F.ws + WS_WDN + (size_t)l * SZ_WDN); j.Nsrc = DM; j.K = DFF; j.k0 = kt * 64; j.srccol0 = nb * 64; j.dstrow0 = nb * 64; }
}
__device__ __forceinline__ void cvt_load(const CvtJob& j, int lane, f32x4 (&v)[16], float (&gn)[16]) {
    const float* p = j.W + (size_t)(j.k0 + (lane >> 4)) * j.Nsrc + j.srccol0 + (lane & 15) * 4;
#pragma unroll
    for (int i = 0; i < 16; ++i) v[i] = *(const f32x4*)(p + (size_t)(4 * i) * j.Nsrc);
#pragma unroll
    for (int i = 0; i < 16; ++i) gn[i] = j.gain ? j.gain[j.k0 + (lane >> 4) + 4 * i] : 1.0f;
}
__device__ __forceinline__ void cvt_store(const CvtJob& j, int lane, const f32x4 (&v)[16], const float (&gn)[16], LAS float* scr) {
#pragma unroll
    for (int i = 0; i < 16; ++i) { const int r = (lane >> 4) + 4 * i, n = (lane & 15) * 4; *(LAS f32x4*)(scr + r * 64 + (n ^ ((i >> 1) << 2))) = v[i] * gn[i]; }
    LDS_WAIT(); asm volatile("" ::: "memory");
    const int c = lane & 7;
#pragma unroll
    for (int i = 0; i < 8; ++i) { const int n = (lane >> 3) + 8 * i; const LAS float* s = scr + (8 * c) * 64 + (n ^ (c << 2));
        v4u o; o.x = pk2(s[0 * 64], s[1 * 64]); o.y = pk2(s[2 * 64], s[3 * 64]); o.z = pk2(s[4 * 64], s[5 * 64]); o.w = pk2(s[6 * 64], s[7 * 64]);
        int nd = n; if (j.rope && n < 32) nd = (n < 16) ? 2 * n : 2 * (n - 16) + 1;
        *(v4u*)(j.Bt + (size_t)(j.dstrow0 + nd) * j.K + j.k0 + 8 * c) = o; }
    LDS_WAIT(); asm volatile("" ::: "memory");
}
__device__ __forceinline__ void sincos_d(double ang, float& s, float& c) {
    const double TWO_PI = 6.283185307179586476925286766559; const double k = rint(ang / TWO_PI); const double r = ang - k * TWO_PI; const double r2 = r * r;
    double ts = 1.0, tc = 1.0, ss = 1.0, cc = 1.0;
#pragma unroll
    for (int i = 1; i <= 16; ++i) { tc = -tc * r2 / (double)((2 * i - 1) * (2 * i)); ts = -ts * r2 / (double)((2 * i) * (2 * i + 1)); cc += tc; ss += ts; }
    s = (float)(ss * r); c = (float)cc;
}
__device__ __forceinline__ void cvt_run(Frame& F, int it0, int n, int w, int nw) {
    LAS float* scr = (LAS float*)(F.lds + F.wave * 16384);
    const int per = (n + nw - 1) / nw; int it = it0 + w * per; const int it1 = (it + per < it0 + n) ? it + per : it0 + n;
    CvtJob j0, j1; f32x4 v0[16], v1[16]; float g0[16], g1[16];
    if (it < it1) { cvt_decode(F, it, j0); cvt_load(j0, F.lane, v0, g0); }
    for (; it < it1; it += 2) {
        if (it + 1 < it1) { cvt_decode(F, it + 1, j1); cvt_load(j1, F.lane, v1, g1); }
        cvt_store(j0, F.lane, v0, g0, scr);
        if (it + 1 >= it1) break;
        if (it + 2 < it1) { cvt_decode(F, it + 2, j0); cvt_load(j0, F.lane, v0, g0); }
        cvt_store(j1, F.lane, v1, g1, scr);
    }
}
__device__ __forceinline__ void p0_prologue(Frame& F) {
    const int gw = F.bid * NWAVES + F.wave, NGW = F.G * NWAVES;
    cvt_run(F, 0, IT_LAYER, gw, NGW);
    const int gt = F.bid * 512 + F.tid, NGT = F.G * 512;
    { float* bg = (float*)(F.ws + WS_BIASG);
      for (int i = gt; i < DEPTH * NING; i += NGT) { const int l = i >> 14, n = i & (NING - 1); int src = n < GATE_COL ? n : n + 16;
          if (n >= 6144 && n < 10240 && (n & 127) < 32) { const int p = n & 127, dim = (p & 1) ? 16 + (p >> 1) : (p >> 1); src = (n & ~127) + dim + 16; }
          bg[i] = inp(F, I_B_IN)[(size_t)l * NIN + src]; } }
    { float* rp = (float*)(F.ws + WS_ROPE);
      for (int i = gt; i < SEQ * 16; i += NGT) { const int pos = i >> 4, k = i & 15; const double inv = exp2(-(double)k * (18.931568569324174 / 16.0));
          float s, c; sincos_d((double)pos * inv, s, c); rp[pos * 32 + k] = c; rp[pos * 32 + 16 + k] = s; } }
    { float* hdst = (float*)(F.ws + WS_H); bf16* xn = (bf16*)(F.ws + WS_XN); float* rb = (float*)(F.ws + WS_ROWSS_B); const float* x = inp(F, I_X);
      for (int row = gw; row < MTOK; row += NGW) { const f32x4* xr = (const f32x4*)(x + (size_t)row * DM) + F.lane; f32x4* hr = (f32x4*)(hdst + (size_t)row * DM) + F.lane; v2u* o8 = (v2u*)(xn + (size_t)row * DM) + F.lane; float ss = 0.f;
          f32x4 xv8[8];
#pragma unroll
          for (int j = 0; j < 8; ++j) xv8[j] = xr[64 * j];
#pragma unroll
          for (int j = 0; j < 8; ++j) { const f32x4 v = xv8[j]; hr[64 * j] = v; ss += (v.x * v.x + v.y * v.y) + (v.z * v.z + v.w * v.w); v2u w; w.x = pk2(v.x, v.y); w.y = pk2(v.z, v.w); o8[64 * j] = w; }
          ss = wave_sum(ss); if (F.lane == 0) rb[row] = ss; } }
}

__device__ __forceinline__ void gates_step(Frame& F, int l, gu32* cnt) {
    const float* wl = inp(F, I_W_IN) + (size_t)l * DM * NIN; const float* bl = inp(F, I_B_IN) + (size_t)l * NIN; const float* gain = inp(F, I_NORM_MIX) + (size_t)l * DM;
    const bf16* hb = (const bf16*)(F.ws + WS_XN); const float* rowss = (const float*)(F.ws + WS_ROWSS_B); float* gates = (float*)(F.ws + WS_GATES);
    LAS float* WT = (LAS float*)F.lds;
    for (int k = F.tid; k < DM; k += 512) { const f32x4* src = (const f32x4*)(wl + (size_t)k * NIN + GATE_COL); const float g = gain[k];
#pragma unroll
        for (int q = 0; q < 4; ++q) { const f32x4 a = src[q] * g; WT[(4 * q + 0) * DM + k] = a.x; WT[(4 * q + 1) * DM + k] = a.y; WT[(4 * q + 2) * DM + k] = a.z; WT[(4 * q + 3) * DM + k] = a.w; } }
    __syncthreads();
    const int gw = F.bid * NWAVES + F.wave, NGW = F.G * NWAVES;
    const float bgl = bl[GATE_COL + (F.lane & 15)];
    for (int rp = gw; rp < MTOK / 2; rp += NGW) {
        f32x4 xv[2][4][2];
#pragma unroll
        for (int r = 0; r < 2; ++r)
#pragma unroll
            for (int j = 0; j < 4; ++j) { const v4u w = *((const v4u*)(hb + (size_t)(2 * rp + r) * DM) + 64 * j + F.lane);
                xv[r][j][0] = (f32x4){pg8::bf_lo(w.x), pg8::bf_hi(w.x), pg8::bf_lo(w.y), pg8::bf_hi(w.y)}; xv[r][j][1] = (f32x4){pg8::bf_lo(w.z), pg8::bf_hi(w.z), pg8::bf_lo(w.w), pg8::bf_hi(w.w)}; }
        const float rs0 = 1.0f / sqrtf(rowss[2 * rp] * (1.0f / DM) + EPS), rs1 = 1.0f / sqrtf(rowss[2 * rp + 1] * (1.0f / DM) + EPS);
        float my0 = 0.f, my1 = 0.f;
#pragma unroll
        for (int c = 0; c < 16; ++c) { float a0 = 0.f, a1 = 0.f;
#pragma unroll
            for (int j = 0; j < 4; ++j)
#pragma unroll
                for (int hh = 0; hh < 2; ++hh) { const f32x4 w = *(const LAS f32x4*)(WT + c * DM + 512 * j + 8 * F.lane + 4 * hh);
                    a0 += (xv[0][j][hh].x * w.x + xv[0][j][hh].y * w.y) + (xv[0][j][hh].z * w.z + xv[0][j][hh].w * w.w);
                    a1 += (xv[1][j][hh].x * w.x + xv[1][j][hh].y * w.y) + (xv[1][j][hh].z * w.z + xv[1][j][hh].w * w.w); }
            const float s0 = wave_sum(a0), s1 = wave_sum(a1);
            if (F.lane == c) { my0 = s0; my1 = s1; }
            __builtin_amdgcn_sched_barrier(0); }
        if (F.lane < 16) { __hip_atomic_store(gates + (size_t)(2 * rp) * 16 + F.lane, my0 * rs0 + bgl, RLX_AGENT); __hip_atomic_store(gates + (size_t)(2 * rp + 1) * 16 + F.lane, my1 * rs1 + bgl, RLX_AGENT); }
    }
    VM_WAIT(); __syncthreads();
    if (F.tid == 0) __hip_atomic_fetch_add(cnt, 1u, RLX_AGENT);
}
__device__ __forceinline__ void gates_wait(Frame& F, gu32* cnt) {
    if (threadIdx.x == 0) { unsigned sp = 0; gu32* tmo = (gu32*)(F.ws + WS_CTL) + CW_TMO;
        while (__hip_atomic_load(cnt, RLX_AGENT) < (unsigned)F.G) { __builtin_amdgcn_s_sleep(2); if (++sp > (1u << 22)) { __hip_atomic_store(tmo, 1u, RLX_AGENT); break; } }
        __builtin_amdgcn_fence(__ATOMIC_ACQUIRE, "agent"); VM_WAIT(); }
    __syncthreads();
}

__device__ __forceinline__ float logsigmoidf_(float x) { return fminf(x, 0.f) - log1pf(__expf(-fabsf(x))); }
__device__ __forceinline__ void mlstm_prep(Frame& F, int b, int hh) {
    const float* gates = (const float*)(F.ws + WS_GATES);
    float* a2 = (float*)(F.ldsg + ab::A2_OFF); float* M2 = (float*)(F.ldsg + ab::M2_OFF); float* e2 = (float*)(F.ldsg + ab::E2_OFF); float* sc = (float*)(F.ldsg + ab::SCAN_OFF);
    int tid_ = F.tid; asm volatile("" : "+v"(tid_));
    const int lane_ = tid_ & 63;
    float lf[4], ig[4];
#pragma unroll
    for (int e = 0; e < 4; ++e) { const size_t idx = (size_t)(b * SEQ + 4 * tid_ + e) * 16; ig[e] = gates[idx + hh]; lf[e] = logsigmoidf_(gates[idx + 8 + hh]); }
    float c[4]; c[0] = lf[0]; c[1] = c[0] + lf[1]; c[2] = c[1] + lf[2]; c[3] = c[2] + lf[3];
    const float incl = wave_scan_sum(c[3]);
    if (lane_ == 63) sc[F.wave] = incl;
    __syncthreads();
    float wp = 0.f;
    for (int w = 0; w < F.wave; ++w) wp += sc[w];
    const float base = wp + incl - c[3];
    float Bv[4], av[4], mx[4];
#pragma unroll
    for (int e = 0; e < 4; ++e) { Bv[e] = base + c[e]; av[e] = ig[e] - Bv[e]; }
    mx[0] = av[0]; mx[1] = fmaxf(mx[0], av[1]); mx[2] = fmaxf(mx[1], av[2]); mx[3] = fmaxf(mx[2], av[3]);
    const float im = wave_scan_max(mx[3]);
    if (lane_ == 63) sc[16 + F.wave] = im;
    const float ex = dppf<0x138, 0xf>(-__builtin_inff(), im);
    __syncthreads();
    float wm = -__builtin_inff();
    for (int w = 0; w < F.wave; ++w) wm = fmaxf(wm, sc[16 + w]);
    const float pre = fmaxf(wm, ex);
    const float L2E = 1.4426950408889634f;
#pragma unroll
    for (int e = 0; e < 4; ++e) { const float M = fmaxf(pre, mx[e]); const int t = 4 * tid_ + e; a2[t] = av[e] * L2E; M2[t] = M * L2E; e2[t] = -(Bv[e] + M) * L2E; }
    __syncthreads();
}
__device__ __forceinline__ ab::BlockRef att_ref(Frame& F, int qt) {
    const int q = qt >> 8, t = qt & 255, hv = 16 * q + (t & 15), qb = 7 - (t >> 4), vh = hv & 1, c = (hv >> 1) & 1, hh = (hv >> 2) & 7, b = hv >> 5;
    ab::BlockRef r;
    r.Q = (const bf16*)(F.ws + WS_AQ) + (size_t)(b * SEQ + qb * 256) * 2048 + hh * 256 + c * 128;
    r.K = (const bf16*)(F.ws + WS_AK) + (size_t)(b * SEQ) * 2048 + hh * 256 + c * 128;
    r.V = (const bf16*)(F.ws + WS_AV) + (size_t)(b * SEQ) * 2048 + hh * 256 + vh * 128;
    r.O = (float*)((bf16*)(F.ws + WS_OATT) + (size_t)(b * SEQ + qb * 256) * 4096 + hh * 512 + c * 256 + vh * 128);
    r.P0 = qb * 256; r.Cst = nullptr; r.nst = nullptr; return r;
}
__device__ __forceinline__ ab::BlockRef mls_ref(Frame& F, int t) {
    const int bh = t >> 4, qb = (t >> 1) & 7, vh = t & 1, hh = bh & 7, b = bh >> 3;
    ab::BlockRef r;
    r.Q = (const bf16*)(F.ws + WS_MQ) + (size_t)(b * SEQ + qb * 256) * 1024 + hh * 128;
    r.K = (const bf16*)(F.ws + WS_MK) + (size_t)(b * SEQ) * 1024 + hh * 128;
    r.V = (const bf16*)(F.ws + WS_MV) + (size_t)(b * SEQ) * 2048 + hh * 256 + vh * 128;
    r.O = (float*)((bf16*)(F.ws + WS_HRAW) + (size_t)(b * SEQ + qb * 256) * 2048 + hh * 256 + vh * 128);
    r.P0 = qb * 256;
    r.Cst = qb ? (const bf16*)(F.ws + WS_CST) + ((size_t)(bh * 7 + qb - 1) * 128) * 256 + vh * 128 : nullptr;
    r.nst = qb ? (const float*)(F.ws + WS_NST) + (size_t)(bh * 7 + qb - 1) * 128 : nullptr;
    return r;
}
__device__ __forceinline__ ab::bf16x8 scale8(ab::bf16x8 v, float w) {
    ab::u32x4 q = *reinterpret_cast<ab::u32x4*>(&v); ab::u32x4 o;
    o.x = ab::cvtpk(__uint_as_float(q.x << 16) * w, __uint_as_float(q.x & 0xffff0000u) * w); o.y = ab::cvtpk(__uint_as_float(q.y << 16) * w, __uint_as_float(q.y & 0xffff0000u) * w);
    o.z = ab::cvtpk(__uint_as_float(q.z << 16) * w, __uint_as_float(q.z & 0xffff0000u) * w); o.w = ab::cvtpk(__uint_as_float(q.w << 16) * w, __uint_as_float(q.w & 0xffff0000u) * w);
    return *reinterpret_cast<ab::bf16x8*>(&o);
}
__device__ __forceinline__ float sum8(ab::bf16x8 v) {
    const ab::u32x4 q = *reinterpret_cast<const ab::u32x4*>(&v);
    return ((__uint_as_float(q.x << 16) + __uint_as_float(q.x & 0xffff0000u)) + (__uint_as_float(q.y << 16) + __uint_as_float(q.y & 0xffff0000u)))
         + ((__uint_as_float(q.z << 16) + __uint_as_float(q.z & 0xffff0000u)) + (__uint_as_float(q.w << 16) + __uint_as_float(q.w & 0xffff0000u)));
}
__device__ __forceinline__ void mls_scan(Frame& F, int bh, const int tid) {
    using namespace ab;
    char* lds = (char*)F.ldsg; const int b = bh >> 3, hh = bh & 7;
    const float* a2 = (const float*)(lds + A2_OFF); const float* M2 = (const float*)(lds + M2_OFF);
    const int wid = __builtin_amdgcn_readfirstlane(tid >> 6), lane = tid & 63, r32 = lane & 31, hi = lane >> 5, dgrp = wid & 3, vh = wid >> 2;
    const int sr = tid >> 4, sc = (tid & 15) * 8, vst0 = v_st(sr, sc), vst1 = v_st(32 + sr, sc);
    const bf16* Kp = (const bf16*)(F.ws + WS_MK) + (size_t)(b * SEQ) * 1024 + hh * 128;
    const bf16* Vp = (const bf16*)(F.ws + WS_MV) + (size_t)(b * SEQ) * 2048 + hh * 256;
    bf16* Cst = (bf16*)(F.ws + WS_CST) + (size_t)(bh * 7) * 128 * 256; float* nst = (float*)(F.ws + WS_NST) + (size_t)(bh * 7) * 128;
    const unsigned lok = (unsigned)((lane >> 4) * 1024 + sc), lov = (unsigned)((lane >> 4) * 2048 + sc);
    f32x16 C[4] = {}; float nacc = 0.f;
    const int vbA = (int)(uintptr_t)lds + v_rd_base(lane) + dgrp * 512;
    const int vbB = (int)(uintptr_t)lds + v_rd_base(lane) + 16384 * (1 + vh);
    bf16x8 ka[4], kb[4], va[4], vb[4], vc[4], vd[4];
#define SC_LOAD(i, s0) do { const bf16* kp_ = Kp + (size_t)((s0) + wid * 4) * 1024; const bf16* vp_ = Vp + (size_t)((s0) + wid * 4) * 2048; \
        ka[i] = load8(kp_ + lok); kb[i] = load8(kp_ + 32 * 1024 + lok); va[i] = load8(vp_ + lov); vb[i] = load8(vp_ + 32 * 2048 + lov); vc[i] = load8(vp_ + 128 + lov); vd[i] = load8(vp_ + 32 * 2048 + 128 + lov); } while (0)
#define SC_TRRD(dst, base, off) asm volatile("ds_read_b64_tr_b16 %0, %1 offset:%2" : "=&v"(dst) : "v"(base), "i"(off) : "memory")
#define SC_D0(d0) do { s16x4 l0, l1, l2, l3, h0, h1, h2, h3; constexpr int b_ = (d0) * 512; \
            SC_TRRD(l0, vbB, b_); SC_TRRD(h0, vbB, b_ + 2048); SC_TRRD(l1, vbB, b_ + 4096); SC_TRRD(h1, vbB, b_ + 6144); SC_TRRD(l2, vbB, b_ + 8192); SC_TRRD(h2, vbB, b_ + 10240); SC_TRRD(l3, vbB, b_ + 12288); SC_TRRD(h3, vbB, b_ + 14336); \
            asm volatile("s_waitcnt lgkmcnt(0)" ::: "memory"); SBAR(); \
            C[d0] = __builtin_amdgcn_mfma_f32_32x32x16_bf16(A0, (bf16x8){l0[0], l0[1], l0[2], l0[3], h0[0], h0[1], h0[2], h0[3]}, C[d0], 0, 0, 0); \
            C[d0] = __builtin_amdgcn_mfma_f32_32x32x16_bf16(A1, (bf16x8){l1[0], l1[1], l1[2], l1[3], h1[0], h1[1], h1[2], h1[3]}, C[d0], 0, 0, 0); \
            C[d0] = __builtin_amdgcn_mfma_f32_32x32x16_bf16(A2, (bf16x8){l2[0], l2[1], l2[2], l2[3], h2[0], h2[1], h2[2], h2[3]}, C[d0], 0, 0, 0); \
            C[d0] = __builtin_amdgcn_mfma_f32_32x32x16_bf16(A3, (bf16x8){l3[0], l3[1], l3[2], l3[3], h3[0], h3[1], h3[2], h3[3]}, C[d0], 0, 0, 0); } while (0)
#pragma unroll
    for (int i = 0; i < 4; ++i) SC_LOAD(i, 64 * i);
    for (int j = 0; j < 7; ++j) {
        const float mNew = M2[256 * (j + 1) - 1];
        if (j > 0) { const float dec = __builtin_amdgcn_exp2f(M2[256 * j - 1] - mNew);
#pragma unroll
            for (int d_ = 0; d_ < 4; ++d_)
#pragma unroll
                for (int r = 0; r < 16; ++r) C[d_][r] *= dec;
            nacc *= dec; }
#pragma unroll
        for (int tt = 0; tt < 4; ++tt) {
            const int s0 = 256 * j + 64 * tt;
            const float w0 = __builtin_amdgcn_exp2f(a2[s0 + sr] - mNew), w1 = __builtin_amdgcn_exp2f(a2[s0 + 32 + sr] - mNew);
            if (j < 6) { asm volatile("s_waitcnt vmcnt(18)" ::: "memory"); } else { asm volatile("s_waitcnt vmcnt(0)" ::: "memory"); }
            const bf16x8 ks0 = scale8(ka[tt], w0), ks1 = scale8(kb[tt], w1);
            __syncthreads();
            *(bf16x8*)(lds + vst0) = ks0; *(bf16x8*)(lds + vst1) = ks1;
            *(bf16x8*)(lds + 16384 + vst0) = va[tt]; *(bf16x8*)(lds + 16384 + vst1) = vb[tt]; *(bf16x8*)(lds + 32768 + vst0) = vc[tt]; *(bf16x8*)(lds + 32768 + vst1) = vd[tt];
            SBAR();
            if (j < 6) SC_LOAD(tt, s0 + 256);
            __syncthreads();
            s16x4 al0, ah0, al1, ah1, al2, ah2, al3, ah3;
            SC_TRRD(al0, vbA, 0); SC_TRRD(ah0, vbA, 2048); SC_TRRD(al1, vbA, 4096); SC_TRRD(ah1, vbA, 6144); SC_TRRD(al2, vbA, 8192); SC_TRRD(ah2, vbA, 10240); SC_TRRD(al3, vbA, 12288); SC_TRRD(ah3, vbA, 14336);
            asm volatile("s_waitcnt lgkmcnt(0)" ::: "memory"); SBAR();
            const bf16x8 A0 = (bf16x8){al0[0], al0[1], al0[2], al0[3], ah0[0], ah0[1], ah0[2], ah0[3]}, A1 = (bf16x8){al1[0], al1[1], al1[2], al1[3], ah1[0], ah1[1], ah1[2], ah1[3]};
            const bf16x8 A2 = (bf16x8){al2[0], al2[1], al2[2], al2[3], ah2[0], ah2[1], ah2[2], ah2[3]}, A3 = (bf16x8){al3[0], al3[1], al3[2], al3[3], ah3[0], ah3[1], ah3[2], ah3[3]};
            if (vh == 0) nacc += (sum8(A0) + sum8(A1)) + (sum8(A2) + sum8(A3));
            SC_D0(0); SC_D0(1); SC_D0(2); SC_D0(3);
        }
        { float nt = nacc; auto rr = __builtin_amdgcn_permlane32_swap(__float_as_uint(nt), __float_as_uint(nt), false, false); nt = __uint_as_float(rr[0]) + __uint_as_float(rr[1]);
          if (vh == 0 && hi == 0) nst[j * 128 + 32 * dgrp + r32] = nt; }
        bf16* Cj = Cst + ((size_t)j * 128 + 32 * dgrp) * 256 + 128 * vh; const unsigned loc = (unsigned)(4 * hi * 256 + r32);
#pragma unroll
        for (int r = 0; r < 16; ++r) { bf16* Cr = Cj + (size_t)((r & 3) + 8 * (r >> 2)) * 256;
#pragma unroll
            for (int d0 = 0; d0 < 4; ++d0) { const float v = C[d0][r]; const float nb = dppf<0xB1, 0xf>(0.f, v);
                if ((r32 & 1) == 0) *(unsigned*)(Cr + d0 * 32 + loc) = cvtpk(v, nb); } }
    }
#undef SC_LOAD
#undef SC_TRRD
#undef SC_D0
}
__device__ __forceinline__ void wait_word_ge(Frame& F, gu32* w, unsigned need) {
    if (threadIdx.x == 0) { unsigned sp = 0; gu32* tmo = (gu32*)(F.ws + WS_CTL) + CW_TMO;
        while (__hip_atomic_load(w, RLX_AGENT) < need) { __builtin_amdgcn_s_sleep(2); if (++sp > (1u << 22)) { __hip_atomic_store(tmo, 1u, RLX_AGENT); break; } }
        __builtin_amdgcn_fence(__ATOMIC_ACQUIRE, "agent"); VM_WAIT(); }
    __syncthreads();
}
__device__ __forceinline__ void mix_phase(Frame& F, int l, int rep) {
    char* lds = (char*)F.ldsg;
    constexpr int NMLS = 512, NSCAN = 32, NCVT = 32;
    gu32* ctl = (gu32*)(F.ws + WS_CTL);
    gu32* gcnt = ctl + CW_GCNT + 64 * (l + 4 * rep); gu32* sflag = ctl + CW_SFLAG + 64 * ((l + 4 * rep) * 32); gu32* tick = ctl + CW_TICK + 64 * (l + 4 * rep);
    gates_step(F, l, gcnt);
    if (l + 1 < DEPTH && rep == 0 && F.bid >= NSCAN && F.bid < NSCAN + NCVT) {
        cvt_run(F, (l + 1) * IT_LAYER, IT_LAYER, (F.bid - NSCAN) * NWAVES + F.wave, NCVT * NWAVES);
        VM_WAIT(); __syncthreads();
    }
    if (F.bid < NSCAN) {
        gates_wait(F, gcnt);
        int tid_s = threadIdx.x; asm volatile("" : "+v"(tid_s));
        mlstm_prep(F, F.bid >> 3, F.bid & 7);
        mls_scan(F, F.bid, tid_s);
        VM_WAIT(); __syncthreads();
        if (threadIdx.x == 0) { __builtin_amdgcn_fence(__ATOMIC_RELEASE, "agent"); VM_WAIT(); __hip_atomic_store(sflag + 64 * F.bid, 1u, RLX_AGENT); }
        __syncthreads();
    }
#ifndef NO_ATT
    { volatile LAS unsigned* tw = (volatile LAS unsigned*)(F.lds + MISC_OFF) + 16; gu32* atick = ctl + CW_ATICK + 64 * (8 * (l + 4 * rep));
      const int q0 = (int)(xb_xcc_id() & 7u); int qdone = 0;
#define TAKE_ATT(dst) do { if (threadIdx.x == 0) { int r_ = -1; for (int i_ = 0; i_ < 8; ++i_) { const int q_ = (q0 + i_) & 7; if (qdone & (1 << q_)) continue;               \
            const unsigned t_ = __hip_atomic_fetch_add(atick + 64 * q_, 1u, RLX_AGENT); if (t_ < 128u) { r_ = (q_ << 8) | (int)t_; break; } qdone |= 1 << q_; } tw[0] = (unsigned)r_; } \
        PP_BAR(); dst = __builtin_amdgcn_readfirstlane((int)tw[0]); PP_BAR(); } while (0)
      int qt; TAKE_ATT(qt);
      if (qt >= 0) {
          ab::BlockRef cur = att_ref(F, qt); ab::Seam S;
          int tid_a = threadIdx.x; asm volatile("" : "+v"(tid_a));
          ab::prime2<0, 2048, 2048, 2048>(cur, lds, S, tid_a);
          for (;;) {
              int qn; TAKE_ATT(qn);
              const bool last = qn < 0;
              const ab::BlockRef nxt = last ? cur : att_ref(F, qn);
              ab::block2<0, 2048, 2048, 2048, 4096>(cur, nxt, lds, S, tid_a);
              if (last) break;
              cur = nxt;
          }
          ab::pp_realign(tid_a);
      }
#undef TAKE_ATT
    }
#endif
    VM_WAIT(); __syncthreads();
#ifndef NO_MLS
    gates_wait(F, gcnt);
    { volatile LAS unsigned* tw = (volatile LAS unsigned*)(F.lds + MISC_OFF) + 16;
#define TAKE_TICKET(dst) do { if (threadIdx.x == 0) tw[0] = __hip_atomic_fetch_add(tick, 1u, RLX_AGENT); __syncthreads(); dst = __builtin_amdgcn_readfirstlane((int)tw[0]); __syncthreads(); } while (0)
      for (;;) {
          int t2; TAKE_TICKET(t2);
          if (t2 >= NMLS / 2) break;
          int tid_m = threadIdx.x; asm volatile("" : "+v"(tid_m));
          const int bh = t2 >> 3;
          mlstm_prep(F, bh >> 3, bh & 7); wait_word_ge(F, sflag + 64 * bh, 1u);
          const ab::BlockRef c0 = mls_ref(F, 2 * t2), c1 = mls_ref(F, 2 * t2 + 1); ab::Seam S;
          ab::prime2<1, 1024, 1024, 2048>(c0, lds, S, tid_m);
          ab::block2<1, 1024, 1024, 2048, 2048>(c0, c1, lds, S, tid_m);
          ab::block2<1, 1024, 1024, 2048, 2048>(c1, c1, lds, S, tid_m);
          ab::pp_realign(tid_m);
          VM_WAIT(); __syncthreads();
      }
#undef TAKE_TICKET
    }
    VM_WAIT(); __syncthreads();
#endif
}

__device__ __forceinline__ void fin_phase(Frame& F, int l) {
    const float* lq = inp(F, I_LAM_QK) + (size_t)l * 512;
    const float s1 = wave_sum(lq[F.lane] * lq[128 + F.lane] + lq[64 + F.lane] * lq[192 + F.lane]);
    const float s2 = wave_sum(lq[256 + F.lane] * lq[384 + F.lane] + lq[320 + F.lane] * lq[448 + F.lane]);
    const float lam_init = l == 0 ? 0.2f : (l == 1 ? 0.3555090675909693f : (l == 2 ? 0.4707130183435842f : 0.5560582041556406f));
    const float lam = expf(s1) - expf(s2) + lam_init, post = 1.0f - lam_init;
    const bf16* hraw = (const bf16*)(F.ws + WS_HRAW); const bf16* oat = (const bf16*)(F.ws + WS_OATT); const bf16* smo = (const bf16*)(F.ws + WS_SMO);
    bf16* hmn = (bf16*)(F.ws + WS_HMN); bf16* han = (bf16*)(F.ws + WS_HAN);
    { float* rowss = (float*)(F.ws + WS_ROWSS); float* rowsb = (float*)(F.ws + WS_ROWSS_B); for (int i = F.bid * 512 + F.tid; i < MTOK; i += F.G * 512) { rowss[i] = 0.f; rowsb[i] = 0.f; } }
    const int gw = F.bid * NWAVES + F.wave, NGW = F.G * NWAVES;
    const float* mg = inp(F, I_M_NORM) + (size_t)l * 2048; const float* ag = inp(F, I_A_NORM) + (size_t)l * 2048;
    f32x4 mgv[8], agv[8];
#pragma unroll
    for (int hh = 0; hh < 8; ++hh) { mgv[hh] = *(const f32x4*)(mg + hh * 256 + 4 * F.lane); agv[hh] = *(const f32x4*)(ag + hh * 256 + 4 * F.lane); }
    for (int row = gw; row < MTOK; row += NGW) {
        f32x4 hv[8], o0[8], o1[8]; v2u sw[8];
#pragma unroll
        for (int hh = 0; hh < 8; ++hh) { const v2u a = *(const v2u*)(hraw + (size_t)row * 2048 + hh * 256 + 4 * F.lane); hv[hh] = (f32x4){pg8::bf_lo(a.x), pg8::bf_hi(a.x), pg8::bf_lo(a.y), pg8::bf_hi(a.y)}; sw[hh] = *(const v2u*)(smo + (size_t)row * 2048 + hh * 256 + 4 * F.lane); }
#pragma unroll
        for (int hh = 0; hh < 8; ++hh) { const v2u a = *(const v2u*)(oat + (size_t)row * 4096 + hh * 512 + 4 * F.lane), c = *(const v2u*)(oat + (size_t)row * 4096 + hh * 512 + 256 + 4 * F.lane);
            o0[hh] = (f32x4){pg8::bf_lo(a.x), pg8::bf_hi(a.x), pg8::bf_lo(a.y), pg8::bf_hi(a.y)}; o1[hh] = (f32x4){pg8::bf_lo(c.x), pg8::bf_hi(c.x), pg8::bf_lo(c.y), pg8::bf_hi(c.y)}; }
#pragma unroll
        for (int hh = 0; hh < 8; ++hh) { const int col = hh * 256 + 4 * F.lane; const f32x4 v = hv[hh];
            const float rs = 1.0f / sqrtf(wave_sum((v.x * v.x + v.y * v.y) + (v.z * v.z + v.w * v.w)) * (1.0f / 256.0f) + EPS);
            const f32x4 g = mgv[hh]; const f32x4 sg = (f32x4){pg8::bf_lo(sw[hh].x), pg8::bf_hi(sw[hh].x), pg8::bf_lo(sw[hh].y), pg8::bf_hi(sw[hh].y)};
            const f32x4 o = v * rs * g * sg; v2u w; w.x = pk2(o.x, o.y); w.y = pk2(o.z, o.w); *(v2u*)(hmn + (size_t)row * 2048 + col) = w; }
#pragma unroll
        for (int hh = 0; hh < 8; ++hh) { const int col = hh * 256 + 4 * F.lane; const f32x4 v = o0[hh] - o1[hh] * lam;
            const float rs = 1.0f / sqrtf(wave_sum((v.x * v.x + v.y * v.y) + (v.z * v.z + v.w * v.w)) * (1.0f / 256.0f) + EPS);
            const f32x4 g = agv[hh];
            const f32x4 o = v * rs * g * post; v2u w; w.x = pk2(o.x, o.y); w.y = pk2(o.z, o.w); *(v2u*)(han + (size_t)row * 2048 + col) = w; }
    }
}

__device__ __forceinline__ void conv_fixup_panel(Frame& F, int l, int pm) {
    const float* fxc = (const float*)(F.ws + WS_FXC); const float* fxv = (const float*)(F.ws + WS_FXV); const float* fxg = (const float*)(F.ws + WS_FXG); bf16* u = (bf16*)(F.ws + WS_U);
    const float* cw = inp(F, I_CONV_W) + (size_t)l * 3 * DFF;
    constexpr int NI = 2 * 2 * (DFF / 4) / 512;
    static_assert(2 * 2 * (DFF / 4) == NI * 512, "fix-up item count");
#pragma unroll
    for (int i0 = 0; i0 < NI; i0 += 4) {
        f32x4 cp[4], vv[4], ga[4], gb[4], wa[4], wb[4]; int blkv[4], colv[4], rhov[4];
#pragma unroll
        for (int k = 0; k < 4; ++k) if (i0 + k < NI) { const int i = F.tid + (i0 + k) * 512, c4 = i % (DFF / 4), rr = i / (DFF / 4), rho = rr & 1, blk = pm * 2 + (rr >> 1), col = c4 * 4, pb = (blk & 15) ? blk - 1 : blk;
            blkv[k] = blk; colv[k] = col; rhov[k] = rho;
            cp[k] = *(const f32x4*)(fxc + ((size_t)blk * 2 + rho) * DFF + col); vv[k] = *(const f32x4*)(fxv + ((size_t)blk * 2 + rho) * DFF + col);
            ga[k] = *(const f32x4*)(fxg + ((size_t)pb * 2 + 1) * DFF + col); gb[k] = *(const f32x4*)(fxg + ((size_t)pb * 2) * DFF + col);
            wa[k] = *(const f32x4*)(cw + col); wb[k] = *(const f32x4*)(cw + DFF + col); }
#pragma unroll
        for (int k = 0; k < 4; ++k) if (i0 + k < NI) {
            if ((blkv[k] & 15) == 0) continue;
            const f32x4 cv = rhov[k] == 0 ? cp[k] + wb[k] * ga[k] + wa[k] * gb[k] : cp[k] + wa[k] * ga[k];
            f32x4 o;
#pragma unroll
            for (int j = 0; j < 4; ++j) o[j] = cv[j] * pg8::sigmoidf_fast(cv[j]) * vv[k][j];
            v2u w; w.x = pk2(o[0], o[1]); w.y = pk2(o[2], o[3]);
            *(v2u*)(u + ((size_t)blkv[k] * 128 + rhov[k]) * DFF + colv[k]) = w; }
    }
}

__device__ __forceinline__ void out_phase(Frame& F) {
    const float* h = (const float*)(F.ws + WS_H); const float* gf = inp(F, I_NORM_FINAL); float* out = (float*)inp(F, I_OUT);
    const int gw = F.bid * NWAVES + F.wave, NGW = F.G * NWAVES;
    f32x4 gv[8];
#pragma unroll
    for (int j = 0; j < 8; ++j) gv[j] = *((const f32x4*)gf + 64 * j + F.lane);
    for (int row = gw; row < MTOK; row += NGW) { const f32x4* xr = (const f32x4*)(h + (size_t)row * DM) + F.lane; f32x4 xv[8]; float ss = 0.f;
#pragma unroll
        for (int j = 0; j < 8; ++j) { xv[j] = xr[64 * j]; ss += (xv[j].x * xv[j].x + xv[j].y * xv[j].y) + (xv[j].z * xv[j].z + xv[j].w * xv[j].w); }
        const float rs = 1.0f / sqrtf(wave_sum(ss) * (1.0f / DM) + EPS); f32x4* o = (f32x4*)(out + (size_t)row * DM) + F.lane;
#pragma unroll
        for (int j = 0; j < 8; ++j) o[64 * j] = xv[j] * rs * gv[j]; }
}

__device__ __forceinline__ int nrep_opaque(int n) { asm volatile("" : "+s"(n)); return n; }
struct Args { const float* in[16]; float* out; unsigned char* ws; int ph_lo, ph_hi, li, pad; };
__global__ void __launch_bounds__(NWAVES * 64, 2) fwd(Args args) {
    extern __shared__ __attribute__((aligned(16))) unsigned char lds[];
    Frame F;
    F.lds = (LAS unsigned char*)lds; F.ldsg = lds;
    F.tid = threadIdx.x; F.lane = F.tid & 63; F.wave = __builtin_amdgcn_readfirstlane(F.tid >> 6);
    F.G = gridDim.x; F.bid = blockIdx.x; F.vcu = (F.G % 8 == 0) ? (F.bid % 8) * (F.G / 8) + F.bid / 8 : F.bid;
    F.ws = args.ws;
    volatile LAS unsigned* MISC = (volatile LAS unsigned*)(F.lds + MISC_OFF);
    for (int u = F.tid; u < 64; u += NWAVES * 64) MISC[u] = 0u;
    if (F.tid < I_NPTR) { const unsigned long long p = (F.tid == I_OUT) ? (unsigned long long)args.out : (unsigned long long)args.in[F.tid & 15];
        ((LAS unsigned*)(F.lds + PTAB_OFF))[2 * F.tid] = (unsigned)p; ((LAS unsigned*)(F.lds + PTAB_OFF))[2 * F.tid + 1] = (unsigned)(p >> 32); }
    __syncthreads();
    gu32* ctl = (gu32*)(F.ws + WS_CTL);
    XcdBarrier bar = xcd_barrier_post((unsigned*)(ctl + CW_BAR) + args.li * XCD_BAR_WORDS, MISC + 8);
    const int lo = args.ph_lo, hi = args.ph_hi;
#ifndef PH_MASK
#define PH_MASK 0xFFFF
#endif
#define EN(j) ((PH_MASK >> (j)) & 1)
#ifndef PROBE_REP
#define PROBE_REP 0
#endif
#define NREP(j) nrep_opaque(1 + ((PROBE_REP >> (j)) & 1))
#define IN(k) (lo <= (k) && (k) < hi)
#define LAUNDER() do { unsigned long long z_ = 0ull; asm volatile("" : "+s"(z_), "+s"(F.vcu), "+s"(F.bid), "+s"(F.G)); F.ws = args.ws + z_; F.tid = threadIdx.x; asm volatile("" : "+v"(F.tid)); F.lane = F.tid & 63; } while (0)
#define SEAM(k) do { if (IN(k) && IN((k) + 1)) xcd_barrier(bar); } while (0)
    if (EN(12) && IN(0)) { for (int rep_ = 0; rep_ < NREP(12); ++rep_) { LAUNDER(); p0_prologue(F); } SEAM(0); }
    for (int l = 0; l < DEPTH; ++l) {
        const int pb = 1 + l * NPH_L;
        bf16* XN = (bf16*)(F.ws + WS_XN);
        if (EN(0) && IN(pb + 0)) { for (int rep_ = 0; rep_ < NREP(0); ++rep_) { LAUNDER();
            pg8::Gemm g{XN, (const bf16*)(F.ws + WS_WIN + (size_t)l * SZ_WIN), MTOK, NING, DM, nullptr, nullptr}; pg8::StaticOrder S; S.init(MTOK, NING, F.G, F.bid);
            pg8::EpiInProj E{(bf16*)(F.ws + WS_MQ), (bf16*)(F.ws + WS_MK), (bf16*)(F.ws + WS_MV), (bf16*)(F.ws + WS_SMO), (bf16*)(F.ws + WS_AQ), (bf16*)(F.ws + WS_AK), (bf16*)(F.ws + WS_AV), (bf16*)(F.ws + WS_SG),
                             (const float*)(F.ws + WS_BIASG) + (size_t)l * NING, (const float*)(F.ws + WS_ROPE), (const float*)(F.ws + WS_ROWSS_B)};
            pg8::gemm_phase<pg8::EpiInProj, pg8::StaticOrder, true, true>(F.lds, g, S, E, F.tid);
            } SEAM(pb + 0); }
        if (EN(1) && IN(pb + 1)) { for (int rep_ = 0; rep_ < NREP(1); ++rep_) { LAUNDER(); mix_phase(F, l, rep_); } SEAM(pb + 1); }
        if (EN(2) && IN(pb + 2)) { for (int rep_ = 0; rep_ < NREP(2); ++rep_) { LAUNDER(); fin_phase(F, l); } SEAM(pb + 2); }
        if (EN(3) && IN(pb + 3)) { for (int rep_ = 0; rep_ < NREP(3); ++rep_) { LAUNDER();
            pg8::Gemm g{(const bf16*)(F.ws + WS_HMN), (const bf16*)(F.ws + WS_WBM + (size_t)l * SZ_WSQ), MTOK, DM, DM, (const bf16*)(F.ws + WS_HAN), (const bf16*)(F.ws + WS_WBD + (size_t)l * SZ_WSQ)};
            pg8::PairOrder S; S.init(MTOK, DM, F.G, F.bid);
            pg8::EpiMerge E{(bf16*)(F.ws + WS_Y), (const bf16*)(F.ws + WS_SG)};
            pg8::gemm_phase<pg8::EpiMerge, pg8::PairOrder, true, true>(F.lds, g, S, E, F.tid);
            } SEAM(pb + 3); }
        if (EN(4) && IN(pb + 4)) { for (int rep_ = 0; rep_ < NREP(4); ++rep_) { LAUNDER();
            pg8::Gemm g{(const bf16*)(F.ws + WS_Y), (const bf16*)(F.ws + WS_WO + (size_t)l * SZ_WSQ), MTOK, DM, DM, nullptr, nullptr}; pg8::StaticOrder S; S.init(MTOK, DM, F.G, F.bid);
            if (rep_ == 0) { pg8::EpiRes<true> E{(float*)(F.ws + WS_H), DM, XN, (float*)(F.ws + WS_ROWSS)};
            pg8::gemm_phase<pg8::EpiRes<true>, pg8::StaticOrder, false, true>(F.lds, g, S, E, F.tid); }
            else { pg8::EpiRes<false> E{(float*)(F.ws + WS_P), DM, nullptr, nullptr};
            pg8::gemm_phase<pg8::EpiRes<false>, pg8::StaticOrder, false, true>(F.lds, g, S, E, F.tid); }
            } SEAM(pb + 4); }
        if (EN(5) && IN(pb + 5)) { for (int rep_ = 0; rep_ < NREP(5); ++rep_) { LAUNDER();
            pg8::Gemm g{XN, (const bf16*)(F.ws + WS_WUP + (size_t)l * SZ_WUP), MTOK, NUP, DM, nullptr, nullptr}; pg8::StaticOrder S; S.init(MTOK, NUP, F.G, F.bid);
            pg8::EpiUpConv E{(bf16*)(F.ws + WS_U), DFF, (const float*)(F.ws + WS_ROWSS), inp(F, I_CONV_W) + (size_t)l * 3 * DFF, inp(F, I_CONV_B) + (size_t)l * DFF,
                             (float*)(F.ws + WS_FXC), (float*)(F.ws + WS_FXV), (float*)(F.ws + WS_FXG)};
            pg8::gemm_phase<pg8::EpiUpConv, pg8::StaticOrder, true, true, true>(F.lds, g, S, E, F.tid);
            } SEAM(pb + 5); }
        if (EN(6) && IN(pb + 6)) { for (int rep_ = 0; rep_ < NREP(6); ++rep_) { LAUNDER();
            pg8::Gemm g{(const bf16*)(F.ws + WS_U), (const bf16*)(F.ws + WS_WDN + (size_t)l * SZ_WDN), MTOK, DM, DFF, nullptr, nullptr}; pg8::StaticOrder S; S.init(MTOK, DM, F.G, F.bid);
            { pg8::Unit fu; for (int i = 0; S.next(i, fu); ++i) conv_fixup_panel(F, l, fu.pm); VM_WAIT(); __syncthreads(); }
            if (rep_ == 0) { pg8::EpiRes<true> E{(float*)(F.ws + WS_H), DM, XN, (float*)(F.ws + WS_ROWSS_B)};
            pg8::gemm_phase<pg8::EpiRes<true>, pg8::StaticOrder, false, true>(F.lds, g, S, E, F.tid); }
            else { pg8::EpiRes<false> E{(float*)(F.ws + WS_P), DM, nullptr, nullptr};
            pg8::gemm_phase<pg8::EpiRes<false>, pg8::StaticOrder, false, true>(F.lds, g, S, E, F.tid); }
            } SEAM(pb + 6); }
    }
    if (EN(11) && IN(NPHASE - 1)) { LAUNDER(); out_phase(F); }
#undef IN
#undef SEAM
}

extern "C" void kernel_launch(void* const* d_in, const int* in_sizes, int n_in, void* d_out, int out_size, void* d_ws, size_t ws_size, hipStream_t stream) {
    static int grid = 0;
    if (grid == 0) {
        if (n_in != 16 || in_sizes[0] != MTOK * DM || out_size != MTOK * DM || ws_size < WS_END) {
            fprintf(stderr, "kernel_launch: unexpected shapes (n_in %d, in0 %d, out %d, ws %zu, need %zu)\n", n_in, n_in > 0 ? in_sizes[0] : -1, out_size, ws_size, (size_t)WS_END); grid = -1; return; }
        int dev = 0, cus = 0, per_cu = 0;
        if (hipGetDevice(&dev) != hipSuccess || hipDeviceGetAttribute(&cus, hipDeviceAttributeMultiprocessorCount, dev) != hipSuccess) { grid = -1; return; }
        if (hipFuncSetAttribute((const void*)fwd, hipFuncAttributeMaxDynamicSharedMemorySize, LDS_BYTES) != hipSuccess) { fprintf(stderr, "kernel_launch: hipFuncSetAttribute failed\n"); grid = -1; return; }
        if (hipOccupancyMaxActiveBlocksPerMultiprocessor(&per_cu, (const void*)fwd, NWAVES * 64, LDS_BYTES) != hipSuccess || per_cu < 1)
            fprintf(stderr, "kernel_launch: note: occupancy query reports %d workgroups per CU\n", per_cu);
        (void)hipGetLastError();
        grid = cus;
    }
    if (grid < 0) return;
    if (hipMemsetAsync((char*)d_ws + WS_CTL, 0, CTL_ZERO_BYTES, stream) != hipSuccess) return;
    Args a{};
    for (int i = 0; i < 16; ++i) a.in[i] = (const float*)d_in[i];
    a.out = (float*)d_out; a.ws = (unsigned char*)d_ws;
#if MK_SPLIT
    for (int p = 0; p < NPHASE; ++p) { a.ph_lo = p; a.ph_hi = p + 1; a.li = p; hipLaunchKernelGGL(fwd, dim3(grid), dim3(NWAVES * 64), LDS_BYTES, stream, a); }
#else
    a.ph_lo = 0; a.ph_hi = NPHASE; a.li = 0;
    hipLaunchKernelGGL(fwd, dim3(grid), dim3(NWAVES * 64), LDS_BYTES, stream, a);
#endif
    const hipError_t le = hipPeekAtLastError();
    if (le != hipSuccess) fprintf(stderr, "kernel_launch: launch failed: %s\n", hipGetErrorName(le));
}
```

```cpp
#include <hip/hip_runtime.h>
#include <cstdio>
#include <cstdint>

#ifndef MK_SPLIT
#define MK_SPLIT 0
#endif

namespace pg8 {
#define PG8_LAS __attribute__((address_space(3)))
typedef unsigned short bf16_t;
typedef short bf16x8 __attribute__((ext_vector_type(8)));
typedef float f32x4 __attribute__((ext_vector_type(4)));
typedef float f32x2 __attribute__((ext_vector_type(2)));
typedef unsigned u32x4 __attribute__((ext_vector_type(4)));
typedef unsigned u32x2 __attribute__((ext_vector_type(2)));
constexpr int BM = 256, BK = 64, HALF = 128, HTB = HALF * BK * 2, STAGE_BYTES = 8 * HTB, NXCD = 8, WGM = 8;

__host__ __device__ __forceinline__ int lds_byte(int r, int c) { const int st = (r >> 4) * 2 + (c >> 5), rr = r & 15, cc = c & 31, ob = rr * 64 + cc * 2; return st * 1024 + (ob ^ (((ob >> 9) & 1) << 5)); }
__host__ __device__ __forceinline__ void stage_rc(int b, int& R, int& C) { const int st = b / 1024, sb = b % 1024, swz = sb ^ (((sb >> 9) & 1) << 5); R = (st >> 1) * 16 + swz / 64; C = (st & 1) * 32 + (swz % 64) / 2; }
__host__ __device__ __forceinline__ int perm32(int rho) { const int n = rho >> 4, i = rho & 15; return 8 * (i >> 2) + 4 * n + (i & 3); }

struct Unit { int pm, pn, sel; };
struct Gemm { const bf16_t* A; const bf16_t* Bt; int M, N, K; const bf16_t* A1; const bf16_t* Bt1; };

struct StaticOrder {
    int nM, nN, nwg, G, c;
    __host__ __device__ __forceinline__ void init(int M, int N, int G_, int c_) { nM = M / BM; nN = N / BM; nwg = nM * nN; G = G_; c = c_; }
    __host__ __device__ __forceinline__ bool next(int i, Unit& u) const {
        const long L = (long)i * G + c; if (L >= nwg) return false;
        int wgid = (int)L; { const int q = nwg / NXCD, r = nwg % NXCD, xcd = wgid % NXCD, off = wgid / NXCD; wgid = (xcd < r ? xcd * (q + 1) : r * (q + 1) + (xcd - r) * q) + off; }
        const int nig = WGM * nN, gid = wgid / nig, fm = gid * WGM, gsz = (nM - fm) < WGM ? (nM - fm) : WGM;
        u.pm = fm + ((wgid % nig) % gsz); u.pn = (wgid % nig) / gsz; u.sel = 0; return true;
    }
    __device__ __forceinline__ void a_ready(const Unit&) const {}
    __device__ __forceinline__ void done(const Unit&) const {}
};
struct PairOrder : StaticOrder {
    __host__ __device__ __forceinline__ bool next(int i, Unit& u) const { if (!StaticOrder::next(i >> 1, u)) return false; u.sel = i & 1; return true; }
};

__device__ __forceinline__ unsigned cvt_pk_bf16(float lo, float hi) { unsigned r; asm volatile("v_cvt_pk_bf16_f32 %0, %1, %2" : "=v"(r) : "v"(lo), "v"(hi)); return r; }
__device__ __forceinline__ float bf_lo(unsigned w) { return __uint_as_float(w << 16); }
__device__ __forceinline__ float bf_hi(unsigned w) { return __uint_as_float(w & 0xffff0000u); }
__device__ __forceinline__ float sigmoidf_fast(float x) { return __builtin_amdgcn_rcpf(1.0f + __builtin_amdgcn_exp2f(-1.4426950408889634f * x)); }

struct EpiInProj {
    static constexpr bool PERM = true, AFTER_DRAIN = false, CHAIN = false;
    bf16_t *mq, *mk, *mv, *smo, *aq, *ak, *av, *sg; const float* bias; const float* rope; const float* rowss;
    __device__ __forceinline__ void operator()(const f32x4 (&acc)[2][2][4][2], const Unit& u, int wr, int wc, int fr, int fq) const {
        const int pn = u.pn; bf16_t* base; int ldc, colt, kind = 0; float sc = 1.f;
        if (pn < 4) { base = mq; ldc = 1024; colt = pn * 256; }
        else if (pn < 8) { base = mk; ldc = 1024; colt = (pn - 4) * 256; sc = 0.08838834764831845f; }
        else if (pn < 16) { base = mv; ldc = 2048; colt = (pn - 8) * 256; }
        else if (pn < 24) { base = smo; ldc = 2048; colt = (pn - 16) * 256; kind = 2; }
        else if (pn < 32) { base = aq; ldc = 2048; colt = (pn - 24) * 256; kind = 1; }
        else if (pn < 40) { base = ak; ldc = 2048; colt = (pn - 32) * 256; kind = 1; }
        else if (pn < 48) { base = av; ldc = 2048; colt = (pn - 40) * 256; }
        else { base = sg; ldc = 4096; colt = (pn - 48) * 256; kind = 2; }
        const int row0 = u.pm * BM + wr * 64 + fr, col0 = colt + wc * 32 + 8 * fq, bcol0 = pn * BM + wc * 32 + 8 * fq;
        f32x4 bv[2][2];
#pragma unroll
        for (int bj = 0; bj < 2; ++bj)
#pragma unroll
            for (int n = 0; n < 2; ++n) bv[bj][n] = *(const f32x4*)(bias + bcol0 + bj * HALF + 4 * n);
        const bool dorope = (kind == 1) && (wc == 0);
        float rsv[2][4];
#pragma unroll
        for (int ai = 0; ai < 2; ++ai)
#pragma unroll
            for (int m = 0; m < 4; ++m) rsv[ai][m] = rowss[row0 + ai * HALF + m * 16];
#pragma unroll
        for (int ai = 0; ai < 2; ++ai) {
            f32x4 cvv[4], svv[4];
#pragma unroll
            for (int m = 0; m < 4; ++m) { cvv[m] = (f32x4){1.f, 1.f, 1.f, 1.f}; svv[m] = (f32x4){0.f, 0.f, 0.f, 0.f}; }
            if (dorope) {
#pragma unroll
                for (int m = 0; m < 4; ++m) { const float* cs = rope + (size_t)((row0 + ai * HALF + m * 16) & 2047) * 32 + 4 * fq; cvv[m] = *(const f32x4*)cs; svv[m] = *(const f32x4*)(cs + 16); } }
#pragma unroll
            for (int m = 0; m < 4; ++m) { const int row = row0 + ai * HALF + m * 16; bf16_t* rowp = base + (size_t)row * ldc + col0;
                const float rs = 1.0f / sqrtf(rsv[ai][m] * (1.0f / 2048.0f) + 1e-6f);
                const f32x4 cv = cvv[m], sv = svv[m];
#pragma unroll
                for (int bj = 0; bj < 2; ++bj) { f32x4 v0 = (acc[ai][bj][m][0] * rs + bv[bj][0]) * sc, v1 = (acc[ai][bj][m][1] * rs + bv[bj][1]) * sc;
                    if (dorope) { f32x4 r0, r1;
                        r0[0] = v0[0] * cv[0] - v0[1] * sv[0]; r0[1] = v0[1] * cv[0] + v0[0] * sv[0]; r0[2] = v0[2] * cv[1] - v0[3] * sv[1]; r0[3] = v0[3] * cv[1] + v0[2] * sv[1];
                        r1[0] = v1[0] * cv[2] - v1[1] * sv[2]; r1[1] = v1[1] * cv[2] + v1[0] * sv[2]; r1[2] = v1[2] * cv[3] - v1[3] * sv[3]; r1[3] = v1[3] * cv[3] + v1[2] * sv[3];
                        v0 = r0; v1 = r1; }
                    if (kind == 2) {
#pragma unroll
                        for (int j = 0; j < 4; ++j) { v0[j] = sigmoidf_fast(v0[j]); v1[j] = sigmoidf_fast(v1[j]); } }
                    u32x4 w; w.x = cvt_pk_bf16(v0[0], v0[1]); w.y = cvt_pk_bf16(v0[2], v0[3]); w.z = cvt_pk_bf16(v1[0], v1[1]); w.w = cvt_pk_bf16(v1[2], v1[3]);
                    *(u32x4*)(rowp + bj * HALF) = w; } } }
    }
};
template <int CTRL> __device__ __forceinline__ f32x4 dpp4(const f32x4 v) { f32x4 r;
#pragma unroll
    for (int j = 0; j < 4; ++j) r[j] = __uint_as_float(__builtin_amdgcn_update_dpp(0u, __float_as_uint(v[j]), CTRL, 0xf, 0xf, false));
    return r; }
struct EpiUpConv {
    static constexpr bool PERM = true, AFTER_DRAIN = false, CHAIN = false;
    bf16_t* u; int ldc; const float* rowss; const float* cw; const float* cb; float *fxc, *fxv, *fxg;
    __device__ __forceinline__ void operator()(const f32x4 (&acc)[2][2][4][2], const Unit& un, int wr, int wc, int fr, int fq) const {
        const int col0 = un.pn * HALF + wc * 32 + 8 * fq, blk = un.pm * 2 + wr, rowb = blk * 128 + fr;
        f32x4 w0[2], w1[2], w2[2], bb[2];
#pragma unroll
        for (int n = 0; n < 2; ++n) { w0[n] = *(const f32x4*)(cw + col0 + 4 * n); w1[n] = *(const f32x4*)(cw + ldc + col0 + 4 * n); w2[n] = *(const f32x4*)(cw + 2 * ldc + col0 + 4 * n); bb[n] = *(const f32x4*)(cb + col0 + 4 * n); }
        f32x4 p1[2], p2[2];
        p1[0] = p1[1] = p2[0] = p2[1] = (f32x4){0.f, 0.f, 0.f, 0.f};
        float rsv[8];
#pragma unroll
        for (int q = 0; q < 8; ++q) rsv[q] = rowss[rowb + 16 * q];
#pragma unroll
        for (int q = 0; q < 8; ++q) { const int ai = q >> 2, m = q & 3, row = rowb + 16 * q;
            const float rs = 1.0f / sqrtf(rsv[q] * (1.0f / 2048.0f) + 1e-6f);
            u32x4 w;
#pragma unroll
            for (int n = 0; n < 2; ++n) { const f32x4 g = acc[ai][0][m][n] * rs, v = acc[ai][1][m][n] * rs;
                const f32x4 r1 = dpp4<0x121>(g), r2 = dpp4<0x122>(g);
                f32x4 g1, g2;
#pragma unroll
                for (int j = 0; j < 4; ++j) { g1[j] = fr >= 1 ? r1[j] : p1[n][j]; g2[j] = fr >= 2 ? r2[j] : p2[n][j]; }
                p1[n] = r1; p2[n] = r2;
                const f32x4 cv = w0[n] * g2 + w1[n] * g1 + w2[n] * g + bb[n];
                f32x4 o;
#pragma unroll
                for (int j = 0; j < 4; ++j) o[j] = cv[j] * sigmoidf_fast(cv[j]) * v[j];
                if (n == 0) { w.x = cvt_pk_bf16(o[0], o[1]); w.y = cvt_pk_bf16(o[2], o[3]); } else { w.z = cvt_pk_bf16(o[0], o[1]); w.w = cvt_pk_bf16(o[2], o[3]); }
                if (q == 0 && fr < 2) { *(f32x4*)(fxc + ((size_t)blk * 2 + fr) * ldc + col0 + 4 * n) = cv; *(f32x4*)(fxv + ((size_t)blk * 2 + fr) * ldc + col0 + 4 * n) = v; }
                if (q == 7 && fr >= 14) *(f32x4*)(fxg + ((size_t)blk * 2 + (fr - 14)) * ldc + col0 + 4 * n) = g; }
            *(u32x4*)(u + (size_t)row * ldc + col0) = w; }
    }
};
struct EpiMerge {
    static constexpr bool PERM = false, AFTER_DRAIN = false, CHAIN = true;
    bf16_t* y; const bf16_t* sg;
    __device__ __forceinline__ void mid(f32x4 (&acc)[2][2][4][2], const Unit& u, int wr, int wc, int fr, int fq) const {
        const int row0 = u.pm * BM + wr * 64 + fr, col0 = u.pn * BM + wc * 32 + 4 * fq;
#pragma unroll
        for (int ai = 0; ai < 2; ++ai)
#pragma unroll
            for (int m = 0; m < 4; ++m) { const int row = row0 + ai * HALF + m * 16;
                u32x2 gm[2][2], gd[2][2];
#pragma unroll
                for (int bj = 0; bj < 2; ++bj)
#pragma unroll
                    for (int n = 0; n < 2; ++n) { const int col = col0 + bj * HALF + n * 16; gm[bj][n] = *(const u32x2*)(sg + (size_t)row * 4096 + col); gd[bj][n] = *(const u32x2*)(sg + (size_t)row * 4096 + 2048 + col); }
#pragma unroll
                for (int bj = 0; bj < 2; ++bj)
#pragma unroll
                    for (int n = 0; n < 2; ++n) { const u32x2 a = gm[bj][n], d = gd[bj][n];
                        const f32x4 num = (f32x4){bf_lo(a.x), bf_hi(a.x), bf_lo(a.y), bf_hi(a.y)}, den = (f32x4){bf_lo(d.x), bf_hi(d.x), bf_lo(d.y), bf_hi(d.y)};
#pragma unroll
                        for (int j = 0; j < 4; ++j) acc[ai][bj][m][n][j] *= num[j] * __builtin_amdgcn_rcpf(fmaxf(den[j], 1e-30f)); } }
    }
    __device__ __forceinline__ void operator()(const f32x4 (&acc)[2][2][4][2], const Unit& u, int wr, int wc, int fr, int fq) const {
        const int row0 = u.pm * BM + wr * 64 + fr, col0 = u.pn * BM + wc * 32 + 4 * fq;
#pragma unroll
        for (int ai = 0; ai < 2; ++ai)
#pragma unroll
            for (int mp = 0; mp < 2; ++mp) {
                u32x2 gw[2][2][2];
#pragma unroll
                for (int mm = 0; mm < 2; ++mm)
#pragma unroll
                    for (int bj = 0; bj < 2; ++bj)
#pragma unroll
                        for (int n = 0; n < 2; ++n) gw[mm][bj][n] = *(const u32x2*)(sg + (size_t)(row0 + ai * HALF + (2 * mp + mm) * 16) * 4096 + 2048 + col0 + bj * HALF + n * 16);
#pragma unroll
                for (int mm = 0; mm < 2; ++mm)
#pragma unroll
                    for (int bj = 0; bj < 2; ++bj)
#pragma unroll
                        for (int n = 0; n < 2; ++n) { const int m = 2 * mp + mm, row = row0 + ai * HALF + m * 16, col = col0 + bj * HALF + n * 16;
                            const u32x2 g2 = gw[mm][bj][n]; f32x4 g = (f32x4){bf_lo(g2.x), bf_hi(g2.x), bf_lo(g2.y), bf_hi(g2.y)};
#pragma unroll
                            for (int j = 0; j < 4; ++j) g[j] = fmaxf(g[j], 1e-30f);
                            const f32x4 v = acc[ai][bj][m][n] * g;
                            u32x2 w; w.x = cvt_pk_bf16(v[0], v[1]); w.y = cvt_pk_bf16(v[2], v[3]); *(u32x2*)(y + (size_t)row * 2048 + col) = w; }
                asm volatile("" ::: "memory"); }
    }
};
template <bool STATS> struct EpiRes {
    static constexpr bool PERM = false, AFTER_DRAIN = false, CHAIN = false;
    float* h; int ldc; bf16_t* hb; float* rowss;
    __device__ __forceinline__ void operator()(const f32x4 (&acc)[2][2][4][2], const Unit& u, int wr, int wc, int fr, int fq) const {
        const int row0 = u.pm * BM + wr * 64 + fr, col0 = u.pn * BM + wc * 32 + 4 * fq;
#pragma unroll
        for (int ai = 0; ai < 2; ++ai)
#pragma unroll
            for (int mp = 0; mp < 2; ++mp) {
                f32x4 hv[2][2][2];
#pragma unroll
                for (int mm = 0; mm < 2; ++mm)
#pragma unroll
                    for (int bj = 0; bj < 2; ++bj)
#pragma unroll
                        for (int n = 0; n < 2; ++n) hv[mm][bj][n] = *(const f32x4*)(h + (size_t)(row0 + ai * HALF + (2 * mp + mm) * 16) * ldc + col0 + bj * HALF + n * 16);
#pragma unroll
                for (int mm = 0; mm < 2; ++mm) { const int m = 2 * mp + mm, row = row0 + ai * HALF + m * 16; float* rowp = h + (size_t)row * ldc + col0; float ss = 0.f;
#pragma unroll
                    for (int bj = 0; bj < 2; ++bj)
#pragma unroll
                        for (int n = 0; n < 2; ++n) { const f32x4 v = hv[mm][bj][n] + acc[ai][bj][m][n]; *(f32x4*)(rowp + bj * HALF + n * 16) = v;
                            if (STATS) { ss += (v[0] * v[0] + v[1] * v[1]) + (v[2] * v[2] + v[3] * v[3]); u32x2 w; w.x = cvt_pk_bf16(v[0], v[1]); w.y = cvt_pk_bf16(v[2], v[3]);
                                *(u32x2*)(hb + (size_t)row * ldc + col0 + bj * HALF + n * 16) = w; } }
                    if (STATS) {
                        { auto rr = __builtin_amdgcn_permlane16_swap(__float_as_uint(ss), __float_as_uint(ss), false, false); ss = __uint_as_float(rr[0]) + __uint_as_float(rr[1]); }
                        { auto rr = __builtin_amdgcn_permlane32_swap(__float_as_uint(ss), __float_as_uint(ss), false, false); ss = __uint_as_float(rr[0]) + __uint_as_float(rr[1]); }
                        if (fq == 0) __hip_atomic_fetch_add(rowss + row, ss, __ATOMIC_RELAXED, __HIP_MEMORY_SCOPE_AGENT); } }
                asm volatile("" ::: "memory"); }
    }
};

template <class Epi, class Sched, bool ALIGN_EPI = false, bool SP2 = false, bool APERM = false>
__device__ __forceinline__ void gemm_phase(PG8_LAS unsigned char* lds, const Gemm g, const Sched& S, const Epi& E, const int tid) {
    const int wid = __builtin_amdgcn_readfirstlane(tid >> 6), lane = tid & 63, wr = wid >> 2, wc = wid & 3, fr = lane & 15, fq = lane >> 4;
    const int K = g.K, nt = K / BK;
    unsigned voffA[2], voffB[2];
#pragma unroll
    for (int i = 0; i < 2; ++i) { int R, C; stage_rc(tid * 16 + i * 8192, R, C); const int Rb = Epi::PERM ? ((R & ~31) + perm32(R & 31)) : R;
        const int Ra = APERM ? ((R >> 6) * 128 + (R & 63)) : R;
        voffA[i] = (unsigned)(Ra * K + C) * 2u; voffB[i] = (unsigned)(Rb * K + C) * 2u; }
    const size_t kstep = (size_t)(BK * 2);
    const size_t hstep = (size_t)HALF * K * 2;
    const size_t hstepA = APERM ? (size_t)64 * K * 2 : hstep;
    const size_t tstep = 2 * hstep;
    const unsigned ldsw = (unsigned)wid * 1024u;
    const int aoff = lds_byte(wr * 64 + fr, fq * 8), boff = lds_byte(wc * 32 + fr, fq * 8);
#define PG8_SA(b, h) (((b) * 2 + (h)) * HTB)
#define PG8_SB(b, h) ((4 + (b) * 2 + (h)) * HTB)
#define PG8_STAGE(bufoff, gbase, voff) do { _Pragma("unroll") for (int _i = 0; _i < 2; ++_i) \
        __builtin_amdgcn_global_load_lds((const unsigned*)((const char*)(gbase) + (voff)[_i]), (PG8_LAS unsigned*)(lds + (bufoff) + ldsw + _i * 8192), 16, 0, 0); } while (0)
#define PG8_LDA(dst, b, h) do { _Pragma("unroll") for (int m = 0; m < 4; ++m) _Pragma("unroll") for (int k = 0; k < 2; ++k) dst[m][k] = *(const PG8_LAS bf16x8*)(lds + PG8_SA(b, h) + aoff + m * 2048 + k * 1024); } while (0)
#define PG8_LDB(dst, b, h) do { _Pragma("unroll") for (int n = 0; n < 2; ++n) _Pragma("unroll") for (int k = 0; k < 2; ++k) dst[n][k] = *(const PG8_LAS bf16x8*)(lds + PG8_SB(b, h) + boff + n * 2048 + k * 1024); } while (0)
#define PG8_MMA(ai, bj, At, Bt) do { __builtin_amdgcn_s_setprio(1); _Pragma("unroll") for (int m = 0; m < 4; ++m) _Pragma("unroll") for (int n = 0; n < 2; ++n) _Pragma("unroll") for (int k = 0; k < 2; ++k) \
        acc[ai][bj][m][n] = __builtin_amdgcn_mfma_f32_16x16x32_bf16(Bt[n][k], At[m][k], acc[ai][bj][m][n], 0, 0, 0); __builtin_amdgcn_s_setprio(0); } while (0)
#define PG8_WAIT_V(n) asm volatile("s_waitcnt vmcnt(" #n ")" ::: "memory")
#define PG8_WAIT_L(n) asm volatile("s_waitcnt lgkmcnt(" #n ")" ::: "memory")
#define PG8_BAR __builtin_amdgcn_s_barrier()
#define PG8_SCHED __builtin_amdgcn_sched_barrier(0)
    Unit cur, nxt; int ui = 0;
    if (!S.next(0, cur)) return;
    f32x4 acc[2][2][4][2];
#pragma unroll
    for (int a = 0; a < 2; ++a)
#pragma unroll
        for (int b = 0; b < 2; ++b)
#pragma unroll
            for (int m = 0; m < 4; ++m)
#pragma unroll
                for (int n = 0; n < 2; ++n) acc[a][b][m][n] = (f32x4){0.f, 0.f, 0.f, 0.f};
    bf16x8 At[4][2], B0[2][2], B1[2][2];
    const char* cA = (const char*)(cur.sel ? g.A1 : g.A) + (size_t)cur.pm * tstep; const char* cB = (const char*)(cur.sel ? g.Bt1 : g.Bt) + (size_t)cur.pn * tstep;
    S.a_ready(cur);
    if constexpr (SP2) {
        PG8_STAGE(PG8_SB(0, 0), cB, voffB); PG8_STAGE(PG8_SB(0, 1), cB + hstep, voffB); PG8_STAGE(PG8_SA(0, 0), cA, voffA); PG8_STAGE(PG8_SA(0, 1), cA + hstepA, voffA);
        if (wr == 1) PG8_BAR;
        PG8_WAIT_V(2); PG8_BAR;
        PG8_STAGE(PG8_SB(1, 0), cB + kstep, voffB); PG8_STAGE(PG8_SA(1, 0), cA + kstep, voffA); PG8_STAGE(PG8_SB(1, 1), cB + hstep + kstep, voffB);
        PG8_WAIT_V(6); PG8_BAR;
    } else {
        PG8_STAGE(PG8_SB(0, 0), cB, voffB); PG8_STAGE(PG8_SA(0, 0), cA, voffA); PG8_STAGE(PG8_SB(0, 1), cB + hstep, voffB); PG8_STAGE(PG8_SA(0, 1), cA + hstepA, voffA);
        if (wr == 1) PG8_BAR;
        PG8_WAIT_V(4); PG8_BAR;
        PG8_STAGE(PG8_SB(1, 0), cB + kstep, voffB); PG8_STAGE(PG8_SA(1, 0), cA + kstep, voffA); PG8_STAGE(PG8_SB(1, 1), cB + hstep + kstep, voffB);
        PG8_WAIT_V(6); PG8_BAR;
    }
    for (;;) {
        const bool has_next = S.next(ui + 1, nxt);
        const char* nA = has_next ? (const char*)(nxt.sel ? g.A1 : g.A) + (size_t)nxt.pm * tstep : cA; const char* nB = has_next ? (const char*)(nxt.sel ? g.Bt1 : g.Bt) + (size_t)nxt.pn * tstep : cB;
        for (int t = 0; t < nt; t += 2) {
            const bool last = (t == nt - 2);
            const char* a1 = cA + (size_t)(t + 1) * kstep;
            const char* a2 = last ? nA : cA + (size_t)(t + 2) * kstep; const char* b2 = last ? nB : cB + (size_t)(t + 2) * kstep;
            const char* a3 = a2 + kstep; const char* b3 = b2 + kstep;
            if (last && has_next) S.a_ready(nxt);
            if constexpr (SP2) {
            PG8_LDB(B0, 0, 0); PG8_LDB(B1, 0, 1); PG8_SCHED; PG8_LDA(At, 0, 0); PG8_STAGE(PG8_SA(1, 1), a1 + hstepA, voffA);
            PG8_WAIT_V(8); PG8_WAIT_L(0); PG8_BAR; PG8_MMA(0, 0, At, B0); PG8_MMA(0, 1, At, B1); PG8_BAR; PG8_SCHED;
            PG8_LDA(At, 0, 1); PG8_STAGE(PG8_SB(0, 0), b2, voffB); PG8_STAGE(PG8_SB(0, 1), b2 + hstep, voffB); PG8_STAGE(PG8_SA(0, 0), a2, voffA);
            PG8_WAIT_V(8); PG8_WAIT_L(0); PG8_BAR; PG8_MMA(1, 0, At, B0); PG8_MMA(1, 1, At, B1); PG8_BAR; PG8_SCHED;
            PG8_LDB(B0, 1, 0); PG8_LDB(B1, 1, 1); PG8_SCHED; PG8_LDA(At, 1, 0); PG8_STAGE(PG8_SA(0, 1), a2 + hstepA, voffA);
            PG8_WAIT_V(8); PG8_WAIT_L(0); PG8_BAR; PG8_MMA(0, 0, At, B0); PG8_MMA(0, 1, At, B1); PG8_BAR; PG8_SCHED;
            PG8_LDA(At, 1, 1); PG8_STAGE(PG8_SB(1, 0), b3, voffB); PG8_STAGE(PG8_SB(1, 1), b3 + hstep, voffB); PG8_STAGE(PG8_SA(1, 0), a3, voffA);
            PG8_WAIT_V(8); PG8_WAIT_L(0); PG8_BAR; PG8_MMA(1, 0, At, B0); PG8_MMA(1, 1, At, B1); PG8_BAR; PG8_SCHED;
            } else {
            PG8_LDB(B0, 0, 0); PG8_SCHED; PG8_LDA(At, 0, 0); PG8_STAGE(PG8_SA(1, 1), a1 + hstepA, voffA);
            PG8_WAIT_L(8); PG8_BAR; PG8_WAIT_L(0); PG8_MMA(0, 0, At, B0); PG8_BAR; PG8_SCHED;
            PG8_LDB(B1, 0, 1); PG8_STAGE(PG8_SB(0, 0), b2, voffB);
            PG8_BAR; PG8_WAIT_L(0); PG8_MMA(0, 1, At, B1); PG8_BAR;
            PG8_LDA(At, 0, 1); PG8_STAGE(PG8_SA(0, 0), a2, voffA);
            PG8_BAR; PG8_WAIT_L(0); PG8_MMA(1, 0, At, B0); PG8_BAR; PG8_SCHED;
            PG8_STAGE(PG8_SB(0, 1), b2 + hstep, voffB);
            PG8_WAIT_V(6); PG8_BAR; PG8_MMA(1, 1, At, B1); PG8_BAR;
            PG8_LDB(B0, 1, 0); PG8_SCHED; PG8_LDA(At, 1, 0); PG8_STAGE(PG8_SA(0, 1), a2 + hstepA, voffA);
            PG8_WAIT_L(8); PG8_BAR; PG8_WAIT_L(0); PG8_MMA(0, 0, At, B0); PG8_BAR; PG8_SCHED;
            PG8_LDB(B1, 1, 1); PG8_STAGE(PG8_SB(1, 0), b3, voffB);
            PG8_BAR; PG8_WAIT_L(0); PG8_MMA(0, 1, At, B1); PG8_BAR;
            PG8_LDA(At, 1, 1); PG8_STAGE(PG8_SA(1, 0), a3, voffA);
            PG8_BAR; PG8_WAIT_L(0); PG8_MMA(1, 0, At, B0); PG8_BAR; PG8_SCHED;
            PG8_STAGE(PG8_SB(1, 1), b3 + hstep, voffB);
            PG8_WAIT_V(6); PG8_BAR; PG8_MMA(1, 1, At, B1); PG8_BAR;
            }
        }
        if constexpr (ALIGN_EPI) { if (wr == 0) PG8_BAR; }
        bool chained = false;
        if constexpr (Epi::CHAIN) { if (cur.sel == 0) { E.mid(acc, cur, wr, wc, fr, fq); chained = true; } }
        if (!chained) { E(acc, cur, wr, wc, fr, fq); S.done(cur); }
        if (!has_next) break;
        if (!chained) {
#pragma unroll
        for (int a = 0; a < 2; ++a)
#pragma unroll
            for (int b = 0; b < 2; ++b)
#pragma unroll
                for (int m = 0; m < 4; ++m)
#pragma unroll
                    for (int n = 0; n < 2; ++n) acc[a][b][m][n] = (f32x4){0.f, 0.f, 0.f, 0.f};
        }
        cur = nxt; cA = nA; cB = nB; ++ui;
        if constexpr (ALIGN_EPI) { if (wr == 1) PG8_BAR; }
    }
    PG8_WAIT_V(0);
    if constexpr (!ALIGN_EPI) { if (wr == 0) PG8_BAR; }
    PG8_BAR;
#undef PG8_SA
#undef PG8_SB
#undef PG8_STAGE
#undef PG8_LDA
#undef PG8_LDB
#undef PG8_MMA
#undef PG8_WAIT_V
#undef PG8_WAIT_L
#undef PG8_BAR
#undef PG8_SCHED
}
}

namespace ab {
typedef unsigned short bf16;
typedef short bf16x8 __attribute__((ext_vector_type(8)));
typedef short s16x4 __attribute__((ext_vector_type(4)));
typedef float f32x16 __attribute__((ext_vector_type(16)));
typedef float f32x4 __attribute__((ext_vector_type(4)));
typedef unsigned u32x4 __attribute__((ext_vector_type(4)));
constexpr int D = 128, NW = 8, QBLK = 32, KVBLK = 64, QB = NW * QBLK;
constexpr int SHM_V = KVBLK * D * 2, SHM_K = KVBLK * D * 2;
constexpr int BODY_LDS = 2 * SHM_V + 2 * SHM_K + NW * 64 * 4;
constexpr int A2_OFF = BODY_LDS, M2_OFF = A2_OFF + 8192, E2_OFF = M2_OFF + 8192, SCAN_OFF = E2_OFF + 8192, LDS_NEED = SCAN_OFF + 256;
constexpr float SCALE = 0.08838834764831845f, THR = 8.f;
#define KSWZ(row, colB) ((row) * 256 + ((colB) ^ (((row) & 7) << 4)))
#define SBAR() __builtin_amdgcn_sched_barrier(0)
__device__ __forceinline__ int v_st(int k, int c) { const int kk = (k & ~0xC) | ((k & 4) << 1) | ((k & 8) >> 1); return ((kk >> 3) * 4 + (c >> 5)) * 512 + ((kk & 7) * 32 + (c & 31)) * 2; }
__device__ __forceinline__ int v_rd_base(int lane) { return ((lane & 3) << 3) | (((lane >> 2) & 3) << 6) | (((lane >> 4) & 1) << 5) | (((lane >> 5) & 1) << 8); }
constexpr int v_rd_off(int d0, int ks, int half) { return d0 * 512 + ks * 4096 + half * 2048; }
__device__ __forceinline__ int crow(int r, int hi) { return (r & 3) + 8 * (r >> 2) + 4 * hi; }
__device__ __forceinline__ unsigned cvtpk(float lo, float hi) { unsigned r; asm volatile("v_cvt_pk_bf16_f32 %0, %1, %2" : "=v"(r) : "v"(lo), "v"(hi)); return r; }
__device__ __forceinline__ bf16x8 load8(const bf16* p) { return *reinterpret_cast<const bf16x8*>(p); }
template <int MODE> __device__ __forceinline__ void mask_tile(f32x16& p0, f32x16& p1, int dq) {
    const float NEG = MODE == 0 ? -__builtin_inff() : 0.f;
#pragma unroll
    for (int r = 0; r < 16; ++r) { const int c = (r & 3) + 8 * (r >> 2);
        if (dq - c < 0) p0[r] = NEG;
        if (dq - c - 32 < 0) p1[r] = NEG; }
}
__device__ __forceinline__ void partialSM(f32x16& p0, f32x16& p1, float& m_reg, float& mn, float& alpha) {
    float pmax = p0[0];
#pragma unroll
    for (int r = 1; r < 16; ++r) pmax = fmaxf(pmax, p0[r]);
#pragma unroll
    for (int r = 0; r < 16; ++r) pmax = fmaxf(pmax, p1[r]);
    { auto rr = __builtin_amdgcn_permlane32_swap(__float_as_uint(pmax), __float_as_uint(pmax), false, false);
      pmax = fmaxf(__uint_as_float(rr[0]), __uint_as_float(rr[1])); }
    constexpr float C2 = 1.4426950408889634f * SCALE;
    if (__builtin_expect(__all((pmax - m_reg) * SCALE <= THR), 1)) { mn = m_reg; alpha = 1.f; }
    else { mn = fmaxf(m_reg, pmax); alpha = __builtin_amdgcn_exp2f((m_reg - mn) * C2); m_reg = mn; }
    const float mnL = -mn * C2;
#pragma unroll
    for (int r = 0; r < 16; ++r) p0[r] = fmaf(p0[r], C2, mnL);
#pragma unroll
    for (int r = 0; r < 16; ++r) p1[r] = fmaf(p1[r], C2, mnL);
#pragma unroll
    for (int r = 0; r < 16; ++r) p0[r] = __builtin_amdgcn_exp2f(p0[r]);
}
__device__ __forceinline__ void partialM(f32x16& p0, f32x16& p1, const float* a2k, float M2t, int hi) {
#pragma unroll
    for (int g = 0; g < 4; ++g) { const f32x4 a = *(const f32x4*)(a2k + 8 * g + 4 * hi);
#pragma unroll
        for (int j = 0; j < 4; ++j) p0[4 * g + j] *= __builtin_amdgcn_exp2f(fminf(a[j] - M2t, 0.f)); }
    SBAR();
#pragma unroll
    for (int g = 0; g < 4; ++g) { const f32x4 b = *(const f32x4*)(a2k + 32 + 8 * g + 4 * hi);
#pragma unroll
        for (int j = 0; j < 4; ++j) p1[4 * g + j] *= __builtin_amdgcn_exp2f(fminf(b[j] - M2t, 0.f)); }
}
#define AB_PK4(P, B_, OUT) do { unsigned a0 = cvtpk(P[B_+0], P[B_+1]), a1 = cvtpk(P[B_+2], P[B_+3]);                          \
        unsigned b0 = cvtpk(P[B_+4], P[B_+5]), b1 = cvtpk(P[B_+6], P[B_+7]);                                             \
        auto r0 = __builtin_amdgcn_permlane32_swap(a0, b0, false, false); auto r1 = __builtin_amdgcn_permlane32_swap(a1, b1, false, false); \
        u32x4 w = {r0[0], r1[0], r0[1], r1[1]}; OUT = *reinterpret_cast<bf16x8*>(&w); } while (0)
template <int MODE> __device__ __forceinline__ void finishSM(f32x16& p0, f32x16& p1, float alpha, float& l_reg, bf16x8& pa0, bf16x8& pa1, bf16x8& pa2, bf16x8& pa3) {
    if (MODE == 0) {
#pragma unroll
        for (int r = 0; r < 16; ++r) p1[r] = __builtin_amdgcn_exp2f(p1[r]); }
    float ps = 0;
#pragma unroll
    for (int r = 0; r < 16; ++r) ps += p0[r];
#pragma unroll
    for (int r = 0; r < 16; ++r) ps += p1[r];
    { auto rr = __builtin_amdgcn_permlane32_swap(__float_as_uint(ps), __float_as_uint(ps), false, false);
      ps = __uint_as_float(rr[0]) + __uint_as_float(rr[1]); }
    l_reg = l_reg * alpha + ps;
    AB_PK4(p0, 0, pa0); AB_PK4(p0, 8, pa1); AB_PK4(p1, 0, pa2); AB_PK4(p1, 8, pa3);
}
template <int KB>
__device__ __forceinline__ void qkt(f32x16& p0, f32x16& p1, const char* K_lds, int r32, int hi, const bf16x8* qr) {
    p0 = f32x16{}; p1 = f32x16{};
    const char* kb[4];
#pragma unroll
    for (int dd = 0; dd < 4; ++dd) kb[dd] = K_lds + KB * SHM_K + KSWZ(r32, (dd * 16 + hi * 8) * 2);
#pragma unroll
    for (int d0 = 0; d0 < 8; ++d0) { const char* a = kb[d0 & 3] + (d0 >> 2) * 128;
        bf16x8 b0 = *reinterpret_cast<const bf16x8*>(a);
        bf16x8 b1 = *reinterpret_cast<const bf16x8*>(a + 32 * 256);
        p0 = __builtin_amdgcn_mfma_f32_32x32x16_bf16(b0, qr[d0], p0, 0, 0, 0);
        p1 = __builtin_amdgcn_mfma_f32_32x32x16_bf16(b1, qr[d0], p1, 0, 0, 0); }
}
template <int VB>
__device__ __forceinline__ void pv_tile(f32x16* o, int vb0, bf16x8 pa0, bf16x8 pa1, bf16x8 pa2, bf16x8 pa3) {
#define TRRD(dst, off) asm volatile("ds_read_b64_tr_b16 %0, %1 offset:%2" : "=&v"(dst) : "v"(vb0), "i"(off) : "memory")
#define PV_D0(d0) do { s16x4 l0, l1, l2, l3, h0, h1, h2, h3; constexpr int b_ = VB * SHM_V + v_rd_off(d0, 0, 0); \
        TRRD(l0, b_); TRRD(h0, b_ + 2048); TRRD(l1, b_ + 4096); TRRD(h1, b_ + 6144); TRRD(l2, b_ + 8192); TRRD(h2, b_ + 10240); TRRD(l3, b_ + 12288); TRRD(h3, b_ + 14336); \
        asm volatile("s_waitcnt lgkmcnt(0)" ::: "memory"); SBAR();   \
        o[d0] = __builtin_amdgcn_mfma_f32_32x32x16_bf16(pa0, (bf16x8){l0[0], l0[1], l0[2], l0[3], h0[0], h0[1], h0[2], h0[3]}, o[d0], 0, 0, 0);   \
        o[d0] = __builtin_amdgcn_mfma_f32_32x32x16_bf16(pa1, (bf16x8){l1[0], l1[1], l1[2], l1[3], h1[0], h1[1], h1[2], h1[3]}, o[d0], 0, 0, 0);   \
        o[d0] = __builtin_amdgcn_mfma_f32_32x32x16_bf16(pa2, (bf16x8){l2[0], l2[1], l2[2], l2[3], h2[0], h2[1], h2[2], h2[3]}, o[d0], 0, 0, 0);   \
        o[d0] = __builtin_amdgcn_mfma_f32_32x32x16_bf16(pa3, (bf16x8){l3[0], l3[1], l3[2], l3[3], h3[0], h3[1], h3[2], h3[3]}, o[d0], 0, 0, 0); } while (0)
    PV_D0(0); PV_D0(1); PV_D0(2); PV_D0(3);
#undef PV_D0
#undef TRRD
}
template <int KB>
__device__ __forceinline__ void qkt2(f32x16& p0, f32x16& p1, const char* K_lds, int r32, int hi, const bf16x8* qr) {
    p0 = f32x16{}; p1 = f32x16{};
    int ka[4];
#pragma unroll
    for (int dd = 0; dd < 4; ++dd) ka[dd] = (int)(uintptr_t)K_lds + KB * SHM_K + KSWZ(r32, (dd * 16 + hi * 8) * 2);
#define KRD(dst, addr, off) asm volatile("ds_read_b128 %0, %1 offset:%2" : "=&v"(dst) : "v"(addr), "i"(off) : "memory")
#define QK_RD(X, Y, b) do { KRD(X[0], ka[(2 * (b)) & 3], ((2 * (b)) >> 2) * 128); KRD(Y[0], ka[(2 * (b)) & 3], ((2 * (b)) >> 2) * 128 + 32 * 256); \
        KRD(X[1], ka[(2 * (b) + 1) & 3], ((2 * (b) + 1) >> 2) * 128); KRD(Y[1], ka[(2 * (b) + 1) & 3], ((2 * (b) + 1) >> 2) * 128 + 32 * 256); } while (0)
#define QK_MM(X, Y, b) do { p0 = __builtin_amdgcn_mfma_f32_32x32x16_bf16(X[0], qr[2 * (b)], p0, 0, 0, 0); p1 = __builtin_amdgcn_mfma_f32_32x32x16_bf16(Y[0], qr[2 * (b)], p1, 0, 0, 0); \
        p0 = __builtin_amdgcn_mfma_f32_32x32x16_bf16(X[1], qr[2 * (b) + 1], p0, 0, 0, 0); p1 = __builtin_amdgcn_mfma_f32_32x32x16_bf16(Y[1], qr[2 * (b) + 1], p1, 0, 0, 0); } while (0)
    bf16x8 xa[2], ya[2], xb[2], yb[2];
    QK_RD(xa, ya, 0); QK_RD(xb, yb, 1);
    asm volatile("s_waitcnt lgkmcnt(4)" ::: "memory"); SBAR(); QK_MM(xa, ya, 0); SBAR(); QK_RD(xa, ya, 2);
    asm volatile("s_waitcnt lgkmcnt(4)" ::: "memory"); SBAR(); QK_MM(xb, yb, 1); SBAR(); QK_RD(xb, yb, 3);
    asm volatile("s_waitcnt lgkmcnt(4)" ::: "memory"); SBAR(); QK_MM(xa, ya, 2); SBAR();
    asm volatile("s_waitcnt lgkmcnt(0)" ::: "memory"); SBAR(); QK_MM(xb, yb, 3);
#undef QK_MM
#undef QK_RD
#undef KRD
}
template <int VB, bool PF>
__device__ __forceinline__ void pv_tile2(f32x16* o, int vb0, bf16x8 pa0, bf16x8 pa1, bf16x8 pa2, bf16x8 pa3) {
#define TRRD(dst, off) asm volatile("ds_read_b64_tr_b16 %0, %1 offset:%2" : "=&v"(dst) : "v"(vb0), "i"(off) : "memory")
#define PV_RD(L, H, ks) do { constexpr int b_ = VB * SHM_V + (ks) * 4096; TRRD(L[0], b_); TRRD(H[0], b_ + 2048); TRRD(L[1], b_ + 512); TRRD(H[1], b_ + 512 + 2048); \
        TRRD(L[2], b_ + 1024); TRRD(H[2], b_ + 1024 + 2048); TRRD(L[3], b_ + 1536); TRRD(H[3], b_ + 1536 + 2048); } while (0)
#define PV_MM(L, H, PA) do { _Pragma("unroll") for (int d0 = 0; d0 < 4; ++d0) \
        o[d0] = __builtin_amdgcn_mfma_f32_32x32x16_bf16(PA, (bf16x8){L[d0][0], L[d0][1], L[d0][2], L[d0][3], H[d0][0], H[d0][1], H[d0][2], H[d0][3]}, o[d0], 0, 0, 0); } while (0)
    s16x4 la[4], ha[4];
    if constexpr (PF) {
        s16x4 lb[4], hb[4];
        PV_RD(la, ha, 0); PV_RD(lb, hb, 1);
        asm volatile("s_waitcnt lgkmcnt(8)" ::: "memory"); SBAR(); PV_MM(la, ha, pa0); SBAR();
        PV_RD(la, ha, 2);
        asm volatile("s_waitcnt lgkmcnt(8)" ::: "memory"); SBAR(); PV_MM(lb, hb, pa1); SBAR();
        PV_RD(lb, hb, 3);
        asm volatile("s_waitcnt lgkmcnt(8)" ::: "memory"); SBAR(); PV_MM(la, ha, pa2); SBAR();
        asm volatile("s_waitcnt lgkmcnt(0)" ::: "memory"); SBAR(); PV_MM(lb, hb, pa3);
    } else {
        PV_RD(la, ha, 0); asm volatile("s_waitcnt lgkmcnt(0)" ::: "memory"); SBAR(); PV_MM(la, ha, pa0); SBAR();
        PV_RD(la, ha, 1); asm volatile("s_waitcnt lgkmcnt(0)" ::: "memory"); SBAR(); PV_MM(la, ha, pa1); SBAR();
        PV_RD(la, ha, 2); asm volatile("s_waitcnt lgkmcnt(0)" ::: "memory"); SBAR(); PV_MM(la, ha, pa2); SBAR();
        PV_RD(la, ha, 3); asm volatile("s_waitcnt lgkmcnt(0)" ::: "memory"); SBAR(); PV_MM(la, ha, pa3);
    }
#undef PV_MM
#undef PV_RD
#undef TRRD
}
struct BlockRef { const bf16* Q; const bf16* K; const bf16* V; float* O; int P0; const bf16* Cst; const float* nst; };
struct Seam { bf16x8 qr[8]; bf16x8 st_v0, st_v1, st_k0, st_k1; bf16x8 sb_v0, sb_v1, sb_k0, sb_k1; };
#define VMW() asm volatile("s_waitcnt vmcnt(0)" ::: "memory")
#define VMWN(n) asm volatile("s_waitcnt vmcnt(%0)" :: "i"(n) : "memory")
#define SLOAD_H(Kp, Vp, k0) do { const bf16* vb_ = (Vp) + (size_t)((k0) + wid * 4) * VP; const bf16* kb_ = (Kp) + (size_t)((k0) + wid * 4) * KP;    \
                         S.st_v0 = load8(vb_ + lov); S.st_v1 = load8(vb_ + 32 * VP + lov); S.st_k0 = load8(kb_ + lok); S.st_k1 = load8(kb_ + 32 * KP + lok); } while (0)
#define SWRITE_HK(bf) do { *(bf16x8*)(K_lds + (bf) * SHM_K + kws) = S.st_k0; *(bf16x8*)(K_lds + (bf) * SHM_K + kws + 32 * 256) = S.st_k1; } while (0)
#define SWRITE_HV(bf) do { *(bf16x8*)(V_lds + (bf) * SHM_V + vst0) = S.st_v0; *(bf16x8*)(V_lds + (bf) * SHM_V + vst1) = S.st_v1; } while (0)
#define SWRITE_H(bf) do { SWRITE_HV(bf); SWRITE_HK(bf); } while (0)
template <int QP, int KP, int VP>
__device__ __forceinline__ void prime(const BlockRef& cur, char* lds, Seam& S, const int tid, const int k0) {
    const int wid = __builtin_amdgcn_readfirstlane(tid >> 6), lane = tid & 63, r32 = lane & 31, hi = lane >> 5;
    const int sr = tid >> 4, sc = (tid & 15) * 8, kws = KSWZ(sr, sc * 2); char* K_lds = lds + 2 * SHM_V;
    const unsigned lov = (unsigned)((lane >> 4) * VP + sc), lok = (unsigned)((lane >> 4) * KP + sc), loq = (unsigned)(r32 * QP + hi * 8);
    { const bf16* qb_ = cur.Q + (size_t)(wid * QBLK) * QP;
#pragma unroll
      for (int d0 = 0; d0 < 8; ++d0) S.qr[d0] = load8(qb_ + d0 * 16 + loq); }
    SLOAD_H(cur.K, cur.V, k0); VMW(); SWRITE_HK(0);
    __syncthreads();
}
template <int MODE, int QP, int KP, int VP, int OP>
__device__ __forceinline__ void block(const BlockRef& cur, const BlockRef& nxt, char* lds, Seam& S, const int tid) {
    const int wid = __builtin_amdgcn_readfirstlane(tid >> 6), lane = tid & 63, r32 = lane & 31, hi = lane >> 5;
    const int T0 = (MODE == 1) ? cur.P0 / KVBLK : 0;
    int NT = (MODE == 1) ? QB / KVBLK : cur.P0 / KVBLK + QB / KVBLK;
    if (MODE == 1) asm volatile("" : "+s"(NT));
    const int qlo = cur.P0 + wid * QBLK, qm = qlo + r32 - 4 * hi;
    char* V_lds = lds; char* K_lds = lds + 2 * SHM_V;
    float* ws = (float*)(lds + 2 * SHM_V + 2 * SHM_K) + wid * 64; float* li_l = ws, * al_l = ws + 32;
    const float* a2 = (const float*)(lds + A2_OFF);
    float M2t = 0.f;
    if (MODE == 1) M2t = ((const float*)(lds + M2_OFF))[qlo + r32];
    float m_reg = -1e30f, l_reg = 0; f32x16 o[4] = {};
    const int sr = tid >> 4, sc = (tid & 15) * 8, vst0 = v_st(sr, sc), vst1 = v_st(32 + sr, sc), kws = KSWZ(sr, sc * 2);
    const int vb0 = (int)(uintptr_t)V_lds + v_rd_base(lane);
    const unsigned lov = (unsigned)((lane >> 4) * VP + sc), lok = (unsigned)((lane >> 4) * KP + sc), loq = (unsigned)(r32 * QP + hi * 8), loo = (unsigned)(4 * hi * OP + r32);
    const bf16* Kh = cur.K; const bf16* Vh = cur.V;
#define RESC(a) do { if (MODE == 0) { if (__any((a) < 1.f)) { if (hi == 0) al_l[r32] = (a); asm volatile("s_waitcnt lgkmcnt(0)" ::: "memory");              \
                     for (int d_ = 0; d_ < 4; ++d_) for (int r = 0; r < 16; ++r) o[d_][r] *= al_l[crow(r, hi)]; } } } while (0)
#define KBASE(t) ((T0 + (t)) * KVBLK)
#define MASKT(P0_, P1_, t) do { const int kb_ = KBASE(t); if (kb_ + KVBLK - 1 > qlo) mask_tile<MODE>(P0_, P1_, qm - kb_); } while (0)
#define PARTIAL(P0_, P1_, mnX, alX, t) do { if (MODE == 0) partialSM(P0_, P1_, m_reg, mnX, alX); else { alX = 1.f; partialM(P0_, P1_, a2 + KBASE(t), M2t, hi); } } while (0)
    constexpr int NQL = 8;
#define SEAM_K0() do { VMWN(NQL); SWRITE_HK(0); SBAR(); } while (0)
    f32x16 pA0, pA1, pB0, pB1; float mnA, mnB, alA, alB; bf16x8 pa0, pa1, pa2, pa3;
    if (MODE == 1 && cur.Cst != nullptr) {
        const bf16* Cp = cur.Cst + (size_t)(wid * 4) * 256; const unsigned loc = (unsigned)((lane >> 4) * 256 + sc);
        const bf16x8 c0 = load8(Cp + loc), c1 = load8(Cp + 32 * 256 + loc), c2 = load8(Cp + 64 * 256 + loc), c3 = load8(Cp + 96 * 256 + loc);
        float dn = 0.f;
#pragma unroll
        for (int d0 = 0; d0 < 8; ++d0) { const f32x4 n0 = *(const f32x4*)(cur.nst + 16 * d0 + 8 * hi), n1 = *(const f32x4*)(cur.nst + 16 * d0 + 8 * hi + 4);
            const u32x4 qw = *reinterpret_cast<const u32x4*>(&S.qr[d0]);
            dn += __uint_as_float(qw.x << 16) * n0[0] + __uint_as_float(qw.x & 0xffff0000u) * n0[1] + __uint_as_float(qw.y << 16) * n0[2] + __uint_as_float(qw.y & 0xffff0000u) * n0[3];
            dn += __uint_as_float(qw.z << 16) * n1[0] + __uint_as_float(qw.z & 0xffff0000u) * n1[1] + __uint_as_float(qw.w << 16) * n1[2] + __uint_as_float(qw.w & 0xffff0000u) * n1[3]; }
        { auto rr = __builtin_amdgcn_permlane32_swap(__float_as_uint(dn), __float_as_uint(dn), false, false); dn = __uint_as_float(rr[0]) + __uint_as_float(rr[1]); }
        VMW();
        *(bf16x8*)(V_lds + vst0) = c0; *(bf16x8*)(V_lds + vst1) = c1; *(bf16x8*)(V_lds + SHM_V + vst0) = c2; *(bf16x8*)(V_lds + SHM_V + vst1) = c3;
        __syncthreads();
        pv_tile<0>(o, vb0, S.qr[0], S.qr[1], S.qr[2], S.qr[3]); pv_tile<1>(o, vb0, S.qr[4], S.qr[5], S.qr[6], S.qr[7]);
        const float st = __builtin_amdgcn_exp2f(((const float*)(lds + M2_OFF))[cur.P0 - 1] - M2t);
        l_reg = st * dn;
        if (hi == 0) al_l[r32] = st;
        asm volatile("s_waitcnt lgkmcnt(0)" ::: "memory");
#pragma unroll
        for (int d_ = 0; d_ < 4; ++d_)
#pragma unroll
            for (int r = 0; r < 16; ++r) o[d_][r] *= al_l[crow(r, hi)];
        __syncthreads();
    }
    SWRITE_HV(0); SBAR();
    if (NT > 1) { SLOAD_H(Kh, Vh, KBASE(1)); }
    SBAR(); qkt<0>(pA0, pA1, K_lds, r32, hi, S.qr);
    MASKT(pA0, pA1, 0); PARTIAL(pA0, pA1, mnA, alA, 0);
    if (NT > 1) { VMW(); SWRITE_H(1); }
    __syncthreads();
#define HALF_STEP(PX0, PX1, mnX, alX, PY0, PY1, alY, t, KB, VB, SB) do {                                                      \
        SBAR(); qkt<KB>(PX0, PX1, K_lds, r32, hi, S.qr);                                             \
        finishSM<MODE>(PY0, PY1, alY, l_reg, pa0, pa1, pa2, pa3); SBAR();                                                           \
        if ((t) + 1 < NT) { SLOAD_H(Kh, Vh, KBASE((t) + 1)); SBAR(); }                                               \
        pv_tile<VB>(o, vb0, pa0, pa1, pa2, pa3); MASKT(PX0, PX1, (t)); PARTIAL(PX0, PX1, mnX, alX, (t));                                        \
        __syncthreads();                                                                                                      \
        if ((t) + 1 < NT) { VMW(); SWRITE_H(SB); }                                                                          \
        RESC(alX); __syncthreads(); } while (0)
    for (int t = 1; t + 1 < NT; t += 2) {
        HALF_STEP(pB0, pB1, mnB, alB, pA0, pA1, alA, t, 1, 0, 0);
        HALF_STEP(pA0, pA1, mnA, alA, pB0, pB1, alB, t + 1, 0, 1, 1);
    }
    const bool even = (NT & 1) == 0;
    if (even) { SBAR(); qkt<1>(pB0, pB1, K_lds, r32, hi, S.qr); SBAR(); }
    SLOAD_H(nxt.K, nxt.V, (MODE == 1) ? nxt.P0 : 0); SBAR();
    { const bf16* qb_ = nxt.Q + (size_t)(wid * QBLK) * QP;
#pragma unroll
      for (int d0 = 0; d0 < 8; ++d0) S.qr[d0] = load8(qb_ + d0 * 16 + loq); }
    SBAR();
    finishSM<MODE>(pA0, pA1, alA, l_reg, pa0, pa1, pa2, pa3); SBAR();
    pv_tile<0>(o, vb0, pa0, pa1, pa2, pa3);
    if (even) { MASKT(pB0, pB1, NT - 1); PARTIAL(pB0, pB1, mnB, alB, NT - 1); __syncthreads(); RESC(alB);
        finishSM<MODE>(pB0, pB1, alB, l_reg, pa0, pa1, pa2, pa3); SBAR(); pv_tile<1>(o, vb0, pa0, pa1, pa2, pa3); }
    SBAR(); SEAM_K0();
    if (hi == 0) li_l[r32] = (MODE == 0) ? l_reg : fmaxf(fabsf(l_reg), __builtin_amdgcn_exp2f(((const float*)(lds + E2_OFF))[qlo + r32]));
    asm volatile("s_waitcnt lgkmcnt(0)" ::: "memory");
    float rli[16];
#pragma unroll
    for (int r = 0; r < 16; ++r) rli[r] = __builtin_amdgcn_rcpf(li_l[crow(r, hi)]);
    float* Ow = cur.O + (size_t)(wid * QBLK) * OP;
#pragma unroll
    for (int r = 0; r < 16; ++r) { float* Or = Ow + (size_t)((r & 3) + 8 * (r >> 2)) * OP;
#pragma unroll
        for (int d0 = 0; d0 < 4; ++d0) Or[d0 * 32 + loo] = o[d0][r] * rli[r]; }
    __syncthreads();
#undef RESC
#undef KBASE
#undef MASKT
#undef PARTIAL
#undef SEAM_K0
#undef HALF_STEP
}

#define PP_BAR() do { asm volatile("s_waitcnt lgkmcnt(0)" ::: "memory"); __builtin_amdgcn_s_barrier(); asm volatile("" ::: "memory"); SBAR(); } while (0)
constexpr int SB_OFF = 98304;
static_assert(LDS_NEED <= SB_OFF && SB_OFF + 2 * SHM_V <= 131072, "lds map");
template <int MODE, int QP, int KP, int VP>
__device__ __forceinline__ void prime2(const BlockRef& cur, char* lds, Seam& S, const int tid) {
    const int wid = __builtin_amdgcn_readfirstlane(tid >> 6), lane = tid & 63, r32 = lane & 31, hi = lane >> 5;
    const int sr = tid >> 4, sc = (tid & 15) * 8, kws = KSWZ(sr, sc * 2); char* K_lds = lds + 2 * SHM_V;
    const unsigned lov = (unsigned)((lane >> 4) * VP + sc), lok = (unsigned)((lane >> 4) * KP + sc), loq = (unsigned)(r32 * QP + hi * 8);
    const int k0 = (MODE == 1) ? cur.P0 : 0;
    { const bf16* qb_ = cur.Q + (size_t)(wid * QBLK) * QP;
#pragma unroll
      for (int d0 = 0; d0 < 8; ++d0) S.qr[d0] = load8(qb_ + d0 * 16 + loq); }
    { const bf16* kb_ = cur.K + (size_t)(k0 + wid * 4) * KP; S.st_k0 = load8(kb_ + lok); S.st_k1 = load8(kb_ + 32 * KP + lok); }
    *(bf16x8*)(K_lds + kws) = S.st_k0; *(bf16x8*)(K_lds + kws + 32 * 256) = S.st_k1;
    SBAR();
    { const bf16* kb_ = cur.K + (size_t)(k0 + KVBLK + wid * 4) * KP; const bf16* vb_ = cur.V + (size_t)(k0 + wid * 4) * VP;
      S.st_k0 = load8(kb_ + lok); S.st_k1 = load8(kb_ + 32 * KP + lok); S.st_v0 = load8(vb_ + lov); S.st_v1 = load8(vb_ + 32 * VP + lov);
      if (MODE == 0) { S.sb_k0 = load8(kb_ + (size_t)KVBLK * KP + lok); S.sb_k1 = load8(kb_ + (size_t)(KVBLK + 32) * KP + lok); S.sb_v0 = load8(vb_ + (size_t)KVBLK * VP + lov); S.sb_v1 = load8(vb_ + (size_t)(KVBLK + 32) * VP + lov); } }
    PP_BAR();
    if (wid >= 4) PP_BAR();
}
__device__ __forceinline__ void pp_realign(const int tid) { if (__builtin_amdgcn_readfirstlane(tid >> 6) < 4) PP_BAR(); }
template <int MODE, int QP, int KP, int VP, int OP>
__device__ __forceinline__ void block2(const BlockRef& cur, const BlockRef& nxt, char* lds, Seam& S, const int tid) {
    const int wid = __builtin_amdgcn_readfirstlane(tid >> 6), lane = tid & 63, r32 = lane & 31, hi = lane >> 5;
    const int T0 = (MODE == 1) ? cur.P0 / KVBLK : 0, T0n = (MODE == 1) ? nxt.P0 / KVBLK : 0;
    int NT = (MODE == 1) ? QB / KVBLK : cur.P0 / KVBLK + QB / KVBLK;
    if (MODE == 1) asm volatile("" : "+s"(NT));
    const int qlo = cur.P0 + wid * QBLK, qm = qlo + r32 - 4 * hi;
    char* V_lds = lds; char* K_lds = lds + 2 * SHM_V;
    float* ws = (float*)(lds + 2 * SHM_V + 2 * SHM_K) + wid * 64; float* li_l = ws, * al_l = ws + 32;
    const float* a2 = (const float*)(lds + A2_OFF);
    float M2t = 0.f;
    if (MODE == 1) M2t = ((const float*)(lds + M2_OFF))[qlo + r32];
    float m_reg = -1e30f, l_reg = 0; f32x16 o[4] = {};
    const int sr = tid >> 4, sc = (tid & 15) * 8, vst0 = v_st(sr, sc), vst1 = v_st(32 + sr, sc), kws = KSWZ(sr, sc * 2);
    const int vb0 = (int)(uintptr_t)V_lds + v_rd_base(lane);
    const unsigned lov = (unsigned)((lane >> 4) * VP + sc), lok = (unsigned)((lane >> 4) * KP + sc), loq = (unsigned)(r32 * QP + hi * 8), loo = (unsigned)(4 * hi * OP + r32);
#define KBASE2(t) ((T0 + (t)) * KVBLK)
#define LOADKV(K0, K1, V0, V1, kt, vt) do { const bool kn_ = (kt) >= NT, vn_ = (vt) >= NT;                                                            \
        const bf16* kb_ = (kn_ ? nxt.K : cur.K) + (size_t)(((kn_ ? T0n - NT : T0) + (kt)) * KVBLK + wid * 4) * KP;                                   \
        const bf16* vb_ = (vn_ ? nxt.V : cur.V) + (size_t)(((vn_ ? T0n - NT : T0) + (vt)) * KVBLK + wid * 4) * VP;                                   \
        K0 = load8(kb_ + lok); K1 = load8(kb_ + 32 * KP + lok); V0 = load8(vb_ + lov); V1 = load8(vb_ + 32 * VP + lov); } while (0)
#define WRITEKV(K0, K1, V0, V1, kbuf, vbuf) do { *(bf16x8*)(K_lds + (kbuf) * SHM_K + kws) = K0; *(bf16x8*)(K_lds + (kbuf) * SHM_K + kws + 32 * 256) = K1;    \
        *(bf16x8*)(V_lds + (vbuf) * SHM_V + vst0) = V0; *(bf16x8*)(V_lds + (vbuf) * SHM_V + vst1) = V1; } while (0)
#define WRITE_A(kbuf, vbuf) WRITEKV(S.st_k0, S.st_k1, S.st_v0, S.st_v1, kbuf, vbuf)
#define WRITE_B(kbuf, vbuf) WRITEKV(S.sb_k0, S.sb_k1, S.sb_v0, S.sb_v1, kbuf, vbuf)
#define LOAD_A(kt, vt) LOADKV(S.st_k0, S.st_k1, S.st_v0, S.st_v1, kt, vt)
#define LOAD_B(kt, vt) LOADKV(S.sb_k0, S.sb_k1, S.sb_v0, S.sb_v1, kt, vt)
    f32x16 p0, p1; float mn, al; bf16x8 pa0, pa1, pa2, pa3;
#define VV_STAGE(t) do { { const int kb_ = KBASE2(t); if (kb_ + KVBLK - 1 > qlo) mask_tile<MODE>(p0, p1, qm - kb_); }                                 \
        if (MODE == 0) { partialSM(p0, p1, m_reg, mn, al);                                                                                             \
            if (__any(al < 1.f)) { if (hi == 0) al_l[r32] = al; asm volatile("s_waitcnt lgkmcnt(0)" ::: "memory");                                     \
                _Pragma("unroll") for (int d_ = 0; d_ < 4; ++d_) _Pragma("unroll") for (int r = 0; r < 16; ++r) o[d_][r] *= al_l[crow(r, hi)]; } }                  \
        else { al = 1.f; partialM(p0, p1, a2 + KBASE2(t), M2t, hi); }                                                                                  \
        finishSM<MODE>(p0, p1, al, l_reg, pa0, pa1, pa2, pa3); } while (0)
    if (MODE == 1 && cur.Cst != nullptr) {
        const bf16* Cp = cur.Cst + (size_t)(wid * 4) * 256; const unsigned loc = (unsigned)((lane >> 4) * 256 + sc);
        const bf16x8 c0 = load8(Cp + loc), c1 = load8(Cp + 32 * 256 + loc), c2 = load8(Cp + 64 * 256 + loc), c3 = load8(Cp + 96 * 256 + loc);
        *(bf16x8*)(lds + SB_OFF + vst0) = c0; *(bf16x8*)(lds + SB_OFF + vst1) = c1; *(bf16x8*)(lds + SB_OFF + SHM_V + vst0) = c2; *(bf16x8*)(lds + SB_OFF + SHM_V + vst1) = c3;
        PP_BAR();
        float dn = 0.f;
#pragma unroll
        for (int d0 = 0; d0 < 8; ++d0) { const f32x4 n0 = *(const f32x4*)(cur.nst + 16 * d0 + 8 * hi), n1 = *(const f32x4*)(cur.nst + 16 * d0 + 8 * hi + 4);
            const u32x4 qw = *reinterpret_cast<const u32x4*>(&S.qr[d0]);
            dn += __uint_as_float(qw.x << 16) * n0[0] + __uint_as_float(qw.x & 0xffff0000u) * n0[1] + __uint_as_float(qw.y << 16) * n0[2] + __uint_as_float(qw.y & 0xffff0000u) * n0[3];
            dn += __uint_as_float(qw.z << 16) * n1[0] + __uint_as_float(qw.z & 0xffff0000u) * n1[1] + __uint_as_float(qw.w << 16) * n1[2] + __uint_as_float(qw.w & 0xffff0000u) * n1[3]; }
        { auto rr = __builtin_amdgcn_permlane32_swap(__float_as_uint(dn), __float_as_uint(dn), false, false); dn = __uint_as_float(rr[0]) + __uint_as_float(rr[1]); }
        PP_BAR();
        pv_tile2<0, MODE == 0>(o, vb0 + SB_OFF, S.qr[0], S.qr[1], S.qr[2], S.qr[3]); pv_tile2<1, MODE == 0>(o, vb0 + SB_OFF, S.qr[4], S.qr[5], S.qr[6], S.qr[7]);
        const float st = __builtin_amdgcn_exp2f(((const float*)(lds + M2_OFF))[cur.P0 - 1] - M2t);
        l_reg = st * dn;
        if (hi == 0) al_l[r32] = st;
        asm volatile("s_waitcnt lgkmcnt(0)" ::: "memory");
#pragma unroll
        for (int d_ = 0; d_ < 4; ++d_)
#pragma unroll
            for (int r = 0; r < 16; ++r) o[d_][r] *= al_l[crow(r, hi)];
        PP_BAR();
    }
    for (int t = 0; t < NT; t += 2) {
        WRITE_A(1, 0); SBAR(); if (MODE == 0) LOAD_A(t + 3, t + 2); else LOAD_A(t + 2, t + 1); SBAR();
        if (t > 0) pv_tile2<1, MODE == 0>(o, vb0, pa0, pa1, pa2, pa3);
        qkt2<0>(p0, p1, K_lds, r32, hi, S.qr);
        PP_BAR();
        VV_STAGE(t);
        PP_BAR();
        if (MODE == 0) { WRITE_B(0, 1); SBAR(); LOAD_B(t + 4, t + 3); } else { WRITE_A(0, 1); SBAR(); LOAD_A(t + 3, t + 2); } SBAR();
        pv_tile2<0, MODE == 0>(o, vb0, pa0, pa1, pa2, pa3);
        qkt2<1>(p0, p1, K_lds, r32, hi, S.qr);
        PP_BAR();
        VV_STAGE(t + 1);
        PP_BAR();
    }
    { const bf16* qb_ = nxt.Q + (size_t)(wid * QBLK) * QP;
#pragma unroll
      for (int d0 = 0; d0 < 8; ++d0) S.qr[d0] = load8(qb_ + d0 * 16 + loq); }
    SBAR();
    pv_tile2<1, MODE == 0>(o, vb0, pa0, pa1, pa2, pa3);
    PP_BAR();
    if (hi == 0) li_l[r32] = (MODE == 0) ? l_reg : fmaxf(fabsf(l_reg), __builtin_amdgcn_exp2f(((const float*)(lds + E2_OFF))[qlo + r32]));
    asm volatile("s_waitcnt lgkmcnt(0)" ::: "memory");
    float rli[16];
#pragma unroll
    for (int r = 0; r < 16; ++r) rli[r] = __builtin_amdgcn_rcpf(li_l[crow(r, hi)]);
    { bf16* Ow = (bf16*)cur.O + (size_t)(wid * QBLK) * OP;
#pragma unroll
      for (int r = 0; r < 16; ++r) { bf16* Or = Ow + (size_t)((r & 3) + 8 * (r >> 2)) * OP;
#pragma unroll
          for (int d0 = 0; d0 < 4; ++d0) { const float v = o[d0][r] * rli[r];
              const float nb = __uint_as_float(__builtin_amdgcn_update_dpp(0u, __float_as_uint(v), 0xB1, 0xf, 0xf, false));
              if ((r32 & 1) == 0) *(unsigned*)(Or + d0 * 32 + loo) = cvtpk(v, nb); } } }
    PP_BAR();
#undef KBASE2
#undef LOADKV
#undef WRITEKV
#undef WRITE_A
#undef WRITE_B
#undef LOAD_A
#undef LOAD_B
#undef VV_STAGE
}
#undef VMW
#undef VMWN
#undef SLOAD_H
#undef SWRITE_HK
#undef SWRITE_HV
#undef SWRITE_H
}

constexpr int NWAVES = 8;
constexpr int BATCH = 4, SEQ = 2048, DM = 2048, DEPTH = 4, MTOK = BATCH * SEQ;
constexpr int NIN = 16400, NING = 16384, GATE_COL = 6144, DFF = 5632, NUP = 2 * DFF;
constexpr float EPS = 1e-6f;
constexpr int NPH_L = 7, NPHASE = 2 + DEPTH * NPH_L;
constexpr size_t MiB = 1u << 20;
constexpr size_t WS_CTL = 0, CTL_ZERO_BYTES = 1 * MiB;
constexpr size_t WS_ROPE = 1 * MiB;
constexpr size_t WS_BIASG = WS_ROPE + 512 * 1024;
constexpr size_t WS_GATES = 2 * MiB;
constexpr size_t WS_ROWSS_B = 3 * MiB - 64 * 1024;
constexpr size_t WS_ROWSS = 3 * MiB;
constexpr size_t WS_WIN = 4 * MiB, SZ_WIN = 64 * MiB;
constexpr size_t WS_WBM = WS_WIN + 4 * SZ_WIN, SZ_WSQ = 8 * MiB;
constexpr size_t WS_WBD = WS_WBM + 4 * SZ_WSQ, WS_WO = WS_WBD + 4 * SZ_WSQ;
constexpr size_t WS_WUP = WS_WO + 4 * SZ_WSQ, SZ_WUP = 44 * MiB;
constexpr size_t WS_WDN = WS_WUP + 4 * SZ_WUP, SZ_WDN = 22 * MiB;
constexpr size_t WS_H = WS_WDN + 4 * SZ_WDN;
constexpr size_t WS_XN = WS_H + 64 * MiB;
constexpr size_t WS_MQ = WS_XN + 32 * MiB, WS_MK = WS_MQ + 16 * MiB, WS_MV = WS_MK + 16 * MiB, WS_SMO = WS_MV + 32 * MiB;
constexpr size_t WS_AQ = WS_SMO + 32 * MiB, WS_AK = WS_AQ + 32 * MiB, WS_AV = WS_AK + 32 * MiB, WS_SG = WS_AV + 32 * MiB;
constexpr size_t WS_OATT = WS_SG + 64 * MiB;
constexpr size_t WS_HRAW = WS_OATT + 128 * MiB;
constexpr size_t WS_HMN = WS_HRAW + 64 * MiB, WS_HAN = WS_HMN + 32 * MiB;
constexpr size_t WS_P = WS_HAN + 32 * MiB;
constexpr size_t WS_Y = WS_P + 64 * MiB;
constexpr size_t WS_FXC = WS_Y + 32 * MiB, WS_FXV = WS_FXC + 3 * MiB, WS_FXG = WS_FXV + 3 * MiB;
constexpr size_t WS_U = WS_FXG + 3 * MiB;
constexpr size_t WS_CST = WS_U + 88 * MiB;
constexpr size_t WS_NST = WS_CST + 16 * MiB;
constexpr size_t WS_END = WS_NST + 1 * MiB;
constexpr int CW_TMO = 0, CW_CODE = 1, CW_BAR = 4096, CW_GCNT = 200000, CW_SFLAG = 210000, CW_TICK = 240000, CW_ATICK = 250000;
constexpr int LDS_BYTES = 131072 + 2048, MISC_OFF = 131072;
static_assert(ab::LDS_NEED <= 131072, "lds");

#define GAS __attribute__((address_space(1)))
#define LAS __attribute__((address_space(3)))
typedef unsigned short bf16;
typedef unsigned v4u __attribute__((ext_vector_type(4)));
typedef unsigned v2u __attribute__((ext_vector_type(2)));
typedef float f32x4 __attribute__((ext_vector_type(4)));
typedef GAS unsigned gu32;
#define RLX_AGENT __ATOMIC_RELAXED, __HIP_MEMORY_SCOPE_AGENT
#define LDS_WAIT() asm volatile("s_waitcnt lgkmcnt(0)" ::: "memory")
#define VM_WAIT() asm volatile("s_waitcnt vmcnt(0)" ::: "memory")
__device__ __forceinline__ unsigned pk2(float lo, float hi) { return pg8::cvt_pk_bf16(lo, hi); }

#define XB_TMO      128
#define XB_XCNT(j)  (256  + 64 * (j))
#define XB_XSUB(j)  (1280 + 64 * (j))
#define XB_XGEN(j)  (2304 + 64 * (j))
#define XB_TOP      3328
#define XB_TOPGEN   3392
#define XCD_BAR_WORDS 3456
#define XB_SPIN_CAP (1u << 18)
__device__ __forceinline__ unsigned xb_ld(unsigned* p)              { return __hip_atomic_load(p, __ATOMIC_RELAXED, __HIP_MEMORY_SCOPE_AGENT); }
__device__ __forceinline__ unsigned xb_add(unsigned* p, unsigned v) { return __hip_atomic_fetch_add(p, v, __ATOMIC_RELAXED, __HIP_MEMORY_SCOPE_AGENT); }
__device__ __forceinline__ unsigned xb_xcc_id() { return (unsigned)__builtin_amdgcn_s_getreg((3 << 11) | 20) & 0xFu; }
#define XB_SPIN(cond, bar) do { unsigned _sp = 0; while (cond) { __builtin_amdgcn_s_sleep(1); \
    if ((++_sp & 255u) == 0u) { if (xb_ld(&(bar)[XB_TMO])) break; if (_sp > XB_SPIN_CAP) { atomicAdd(&(bar)[XB_TMO], 1u); break; } } } } while (0)
struct XcdBarrier { unsigned* bar; unsigned x; volatile LAS unsigned* st; };
__device__ __forceinline__ XcdBarrier xcd_barrier_post(unsigned* bar, volatile LAS unsigned* st) {
    XcdBarrier b; b.bar = bar; b.x = xb_xcc_id(); b.st = st;
    if (threadIdx.x == 0) (void)xb_add(&bar[XB_XCNT(b.x)], 1u);
    return b;
}
__device__ __forceinline__ void xcd_barrier_complete(unsigned* bar, unsigned x, unsigned& nloc, unsigned& nx) {
    const unsigned G = gridDim.x * gridDim.y * gridDim.z;
    unsigned sum, cnt, mine, sp = 0u;
    for (;;) {
        sum = 0u; cnt = 0u; mine = 0u;
#pragma unroll
        for (unsigned j = 0; j < 16; ++j) { const unsigned c = xb_ld(&bar[XB_XCNT(j)]); sum += c; cnt += (c > 0u) ? 1u : 0u; mine = (j == x) ? c : mine; }
        if (sum == G) break;
        __builtin_amdgcn_s_sleep(1);
        if ((++sp & 255u) == 0u) { if (xb_ld(&bar[XB_TMO])) break; if (sp > XB_SPIN_CAP) { atomicAdd(&bar[XB_TMO], 1u); break; } }
    }
    nloc = mine > 0u ? mine : 1u; nx = cnt > 0u ? cnt : 1u;
}
__device__ __forceinline__ void xcd_barrier(const XcdBarrier& b) {
    asm volatile("s_waitcnt vmcnt(0)" ::: "memory");
    __syncthreads();
    if (threadIdx.x == 0) {
        unsigned* bar = b.bar;
        __builtin_amdgcn_s_waitcnt(0);
        unsigned nloc = b.st[0], nx = b.st[1];
        if (nloc == 0u) { xcd_barrier_complete(bar, b.x, nloc, nx); b.st[0] = nloc; b.st[1] = nx; }
        const unsigned old = xb_add(&bar[XB_XSUB(b.x)], 1u);
        const unsigned gen = old / nloc;
        if (old + 1u == (gen + 1u) * nloc) {
            __builtin_amdgcn_fence(__ATOMIC_RELEASE, "agent");
            asm volatile("s_waitcnt vmcnt(0)" ::: "memory");
            const unsigned og = xb_add(&bar[XB_TOP], 1u);
            const unsigned tg = og / nx;
            if (og + 1u == (tg + 1u) * nx) xb_add(&bar[XB_TOPGEN], 1u);
            else XB_SPIN(xb_ld(&bar[XB_TOPGEN]) == tg, bar);
            __builtin_amdgcn_fence(__ATOMIC_ACQUIRE, "agent");
            xb_add(&bar[XB_XGEN(b.x)], 1u);
            asm volatile("s_waitcnt vmcnt(0)" ::: "memory");
        } else {
            XB_SPIN(xb_ld(&bar[XB_XGEN(b.x)]) == gen, bar);
            __builtin_amdgcn_fence(__ATOMIC_ACQUIRE, "agent");
            asm volatile("s_waitcnt vmcnt(0)" ::: "memory");
        }
    }
    __syncthreads();
}

struct Frame {
    LAS unsigned char* lds; unsigned char* ldsg;
    int tid, lane, wave, bid, vcu, G;
    unsigned char* ws;
};
enum { I_X = 0, I_NORM_MIX, I_W_IN, I_B_IN, I_M_NORM, I_A_NORM, I_LAM_QK, I_W_BM, I_W_BD, I_W_O, I_NORM_FFN, I_W_UP, I_CONV_W, I_CONV_B, I_W_DOWN, I_NORM_FINAL, I_OUT, I_NPTR };
constexpr int PTAB_OFF = 131072 + 256;
__device__ __forceinline__ const float* inp(const Frame& F, int i) {
    const LAS unsigned* t = (const LAS unsigned*)(F.lds + PTAB_OFF) + 2 * i;
    const unsigned lo = __builtin_amdgcn_readfirstlane(t[0]), hi = __builtin_amdgcn_readfirstlane(t[1]);
    return (const float*)(const GAS float*)(((unsigned long long)hi << 32) | lo);
}
template <int CTRL, int RM> __device__ __forceinline__ float dppf(float old, float src) {
    return __uint_as_float(__builtin_amdgcn_update_dpp(__float_as_uint(old), __float_as_uint(src), CTRL, RM, 0xf, false)); }
__device__ __forceinline__ float wave_sum(float v) {
    v += dppf<0xB1, 0xf>(0.f, v); v += dppf<0x4E, 0xf>(0.f, v); v += dppf<0x141, 0xf>(0.f, v); v += dppf<0x140, 0xf>(0.f, v);
    { auto rr = __builtin_amdgcn_permlane16_swap(__float_as_uint(v), __float_as_uint(v), false, false); v = __uint_as_float(rr[0]) + __uint_as_float(rr[1]); }
    { auto rr = __builtin_amdgcn_permlane32_swap(__float_as_uint(v), __float_as_uint(v), false, false); v = __uint_as_float(rr[0]) + __uint_as_float(rr[1]); }
    return v;
}
__device__ __forceinline__ float wave_scan_sum(float v) {
    v += dppf<0x111, 0xf>(0.f, v); v += dppf<0x112, 0xf>(0.f, v); v += dppf<0x114, 0xf>(0.f, v); v += dppf<0x118, 0xf>(0.f, v);
    v += dppf<0x142, 0xa>(0.f, v); v += dppf<0x143, 0xc>(0.f, v); return v;
}
__device__ __forceinline__ float wave_scan_max(float v) {
    const float NEG = -__builtin_inff();
    v = fmaxf(v, dppf<0x111, 0xf>(NEG, v)); v = fmaxf(v, dppf<0x112, 0xf>(NEG, v)); v = fmaxf(v, dppf<0x114, 0xf>(NEG, v)); v = fmaxf(v, dppf<0x118, 0xf>(NEG, v));
    v = fmaxf(v, dppf<0x142, 0xa>(NEG, v)); v = fmaxf(v, dppf<0x143, 0xc>(NEG, v)); return v;
}

struct CvtJob { const float* W; bf16* Bt; const float* gain; int Nsrc, K, k0, srccol0, dstrow0, rope; };
constexpr int IT_IN = 32 * 256, IT_SQ = 32 * 32, IT_UP = 32 * 176, IT_DN = 88 * 32, IT_LAYER = IT_IN + 3 * IT_SQ + IT_UP + IT_DN, IT_TOTAL = DEPTH * IT_LAYER;
__device__ __forceinline__ void cvt_decode(const Frame& F, int it, CvtJob& j) {
    const int l = it / IT_LAYER; int r = it - l * IT_LAYER; j.rope = 0; j.gain = nullptr;
    if (r < IT_IN) { const int nb = r >> 5, kt = r & 31, n0 = nb * 64;
        j.W = inp(F, I_W_IN) + (size_t)l * DM * NIN; j.Bt = (bf16*)(F.ws + WS_WIN + (size_t)l * SZ_WIN); j.Nsrc = NIN; j.K = DM; j.k0 = kt * 64; j.gain = inp(F, I_NORM_MIX) + (size_t)l * DM;
        j.srccol0 = n0 < GATE_COL ? n0 : n0 + 16; j.dstrow0 = n0; j.rope = (n0 >= 6144 && n0 < 10240 && (n0 & 127) == 0) ? 1 : 0; return; }
    r -= IT_IN;
    if (r < 3 * IT_SQ) { const int w = r / IT_SQ; r -= w * IT_SQ; const int nb = r >> 5, kt = r & 31;
        j.W = (w == 0 ? inp(F, I_W_BM) : (w == 1 ? inp(F, I_W_BD) : inp(F, I_W_O))) + (size_t)l * DM * DM;
        j.Bt = (bf16*)(F.ws + (w == 0 ? WS_WBM : (w == 1 ? WS_WBD : WS_WO)) + (size_t)l * SZ_WSQ); j.Nsrc = DM; j.K = DM; j.k0 = kt * 64; j.srccol0 = nb * 64; j.dstrow0 = nb * 64; return; }
    r -= 3 * IT_SQ;
    if (r < IT_UP) { const int nb = r >> 5, kt = r & 31, n0 = nb * 64, pn = n0 >> 8, w = n0 & 255;
        j.W = inp(F, I_W_UP) + (size_t)l * DM * NUP; j.Bt = (bf16*)(F.ws + WS_WUP + (size_t)l * SZ_WUP); j.Nsrc = NUP; j.K = DM; j.k0 = kt * 64; j.gain = inp(F, I_NORM_FFN) + (size_t)l * DM;
        j.srccol0 = (w < 128) ? pn * 128 + w : DFF + pn * 128 + (w - 128); j.dstrow0 = n0; return; }
    r -= IT_UP;
    { const int nb = r / 88, kt = r - nb * 88;
      j.W = inp(F, I_W_DOWN) + (size_t)l * DFF * DM; j.Bt = (bf16*)(F.ws + WS_WDN + (size_t)l * SZ_WDN); j.Nsrc = DM; j.K = DFF; j.k0 = kt * 64; j.srccol0 = nb * 64; j.dstrow0 = nb * 64; }
}
__device__ __forceinline__ void cvt_load(const CvtJob& j, int lane, f32x4 (&v)[16], float (&gn)[16]) {
    const float* p = j.W + (size_t)(j.k0 + (lane >> 4)) * j.Nsrc + j.srccol0 + (lane & 15) * 4;
#pragma unroll
    for (int i = 0; i < 16; ++i) v[i] = *(const f32x4*)(p + (size_t)(4 * i) * j.Nsrc);
#pragma unroll
    for (int i = 0; i < 16; ++i) gn[i] = j.gain ? j.gain[j.k0 + (lane >> 4) + 4 * i] : 1.0f;
}
__device__ __forceinline__ void cvt_store(const CvtJob& j, int lane, const f32x4 (&v)[16], const float (&gn)[16], LAS float* scr) {
#pragma unroll
    for (int i = 0; i < 16; ++i) { const int r = (lane >> 4) + 4 * i, n = (lane & 15) * 4; *(LAS f32x4*)(scr + r * 64 + (n ^ ((i >> 1) << 2))) = v[i] * gn[i]; }
    LDS_WAIT(); asm volatile("" ::: "memory");
    const int c = lane & 7;
#pragma unroll
    for (int i = 0; i < 8; ++i) { const int n = (lane >> 3) + 8 * i; const LAS float* s = scr + (8 * c) * 64 + (n ^ (c << 2));
        v4u o; o.x = pk2(s[0 * 64], s[1 * 64]); o.y = pk2(s[2 * 64], s[3 * 64]); o.z = pk2(s[4 * 64], s[5 * 64]); o.w = pk2(s[6 * 64], s[7 * 64]);
        int nd = n; if (j.rope && n < 32) nd = (n < 16) ? 2 * n : 2 * (n - 16) + 1;
        *(v4u*)(j.Bt + (size_t)(j.dstrow0 + nd) * j.K + j.k0 + 8 * c) = o; }
    LDS_WAIT(); asm volatile("" ::: "memory");
}
__device__ __forceinline__ void sincos_d(double ang, float& s, float& c) {
    const double TWO_PI = 6.283185307179586476925286766559; const double k = rint(ang / TWO_PI); const double r = ang - k * TWO_PI; const double r2 = r * r;
    double ts = 1.0, tc = 1.0, ss = 1.0, cc = 1.0;
#pragma unroll
    for (int i = 1; i <= 16; ++i) { tc = -tc * r2 / (double)((2 * i - 1) * (2 * i)); ts = -ts * r2 / (double)((2 * i) * (2 * i + 1)); cc += tc; ss += ts; }
    s = (float)(ss * r); c = (float)cc;
}
__device__ __forceinline__ void cvt_run(Frame& F, int it0, int n, int w, int nw) {
    LAS float* scr = (LAS float*)(F.lds + F.wave * 16384);
    const int per = (n + nw - 1) / nw; int it = it0 + w * per; const int it1 = (it + per < it0 + n) ? it + per : it0 + n;
    CvtJob j0, j1; f32x4 v0[16], v1[16]; float g0[16], g1[16];
    if (it < it1) { cvt_decode(F, it, j0); cvt_load(j0, F.lane, v0, g0); }
    for (; it < it1; it += 2) {
        if (it + 1 < it1) { cvt_decode(F, it + 1, j1); cvt_load(j1, F.lane, v1, g1); }
        cvt_store(j0, F.lane, v0, g0, scr);
        if (it + 1 >= it1) break;
        if (it + 2 < it1) { cvt_decode(F, it + 2, j0); cvt_load(j0, F.lane, v0, g0); }
        cvt_store(j1, F.lane, v1, g1, scr);
    }
}
__device__ __forceinline__ void p0_prologue(Frame& F) {
    const int gw = F.bid * NWAVES + F.wave, NGW = F.G * NWAVES;
    cvt_run(F, 0, IT_LAYER, gw, NGW);
    const int gt = F.bid * 512 + F.tid, NGT = F.G * 512;
    { float* bg = (float*)(F.ws + WS_BIASG);
      for (int i = gt; i < DEPTH * NING; i += NGT) { const int l = i >> 14, n = i & (NING - 1); int src = n < GATE_COL ? n : n + 16;
          if (n >= 6144 && n < 10240 && (n & 127) < 32) { const int p = n & 127, dim = (p & 1) ? 16 + (p >> 1) : (p >> 1); src = (n & ~127) + dim + 16; }
          bg[i] = inp(F, I_B_IN)[(size_t)l * NIN + src]; } }
    { float* rp = (float*)(F.ws + WS_ROPE);
      for (int i = gt; i < SEQ * 16; i += NGT) { const int pos = i >> 4, k = i & 15; const double inv = exp2(-(double)k * (18.931568569324174 / 16.0));
          float s, c; sincos_d((double)pos * inv, s, c); rp[pos * 32 + k] = c; rp[pos * 32 + 16 + k] = s; } }
    { float* hdst = (float*)(F.ws + WS_H); bf16* xn = (bf16*)(F.ws + WS_XN); float* rb = (float*)(F.ws + WS_ROWSS_B); const float* x = inp(F, I_X);
      for (int row = gw; row < MTOK; row += NGW) { const f32x4* xr = (const f32x4*)(x + (size_t)row * DM) + F.lane; f32x4* hr = (f32x4*)(hdst + (size_t)row * DM) + F.lane; v2u* o8 = (v2u*)(xn + (size_t)row * DM) + F.lane; float ss = 0.f;
          f32x4 xv8[8];
#pragma unroll
          for (int j = 0; j < 8; ++j) xv8[j] = xr[64 * j];
#pragma unroll
          for (int j = 0; j < 8; ++j) { const f32x4 v = xv8[j]; hr[64 * j] = v; ss += (v.x * v.x + v.y * v.y) + (v.z * v.z + v.w * v.w); v2u w; w.x = pk2(v.x, v.y); w.y = pk2(v.z, v.w); o8[64 * j] = w; }
          ss = wave_sum(ss); if (F.lane == 0) rb[row] = ss; } }
}

__device__ __forceinline__ void gates_step(Frame& F, int l, gu32* cnt) {
    const float* wl = inp(F, I_W_IN) + (size_t)l * DM * NIN; const float* bl = inp(F, I_B_IN) + (size_t)l * NIN; const float* gain = inp(F, I_NORM_MIX) + (size_t)l * DM;
    const bf16* hb = (const bf16*)(F.ws + WS_XN); const float* rowss = (const float*)(F.ws + WS_ROWSS_B); float* gates = (float*)(F.ws + WS_GATES);
    LAS float* WT = (LAS float*)F.lds;
    for (int k = F.tid; k < DM; k += 512) { const f32x4* src = (const f32x4*)(wl + (size_t)k * NIN + GATE_COL); const float g = gain[k];
#pragma unroll
        for (int q = 0; q < 4; ++q) { const f32x4 a = src[q] * g; WT[(4 * q + 0) * DM + k] = a.x; WT[(4 * q + 1) * DM + k] = a.y; WT[(4 * q + 2) * DM + k] = a.z; WT[(4 * q + 3) * DM + k] = a.w; } }
    __syncthreads();
    const int gw = F.bid * NWAVES + F.wave, NGW = F.G * NWAVES;
    const float bgl = bl[GATE_COL + (F.lane & 15)];
    for (int rp = gw; rp < MTOK / 2; rp += NGW) {
        f32x4 xv[2][4][2];
#pragma unroll
        for (int r = 0; r < 2; ++r)
#pragma unroll
            for (int j = 0; j < 4; ++j) { const v4u w = *((const v4u*)(hb + (size_t)(2 * rp + r) * DM) + 64 * j + F.lane);
                xv[r][j][0] = (f32x4){pg8::bf_lo(w.x), pg8::bf_hi(w.x), pg8::bf_lo(w.y), pg8::bf_hi(w.y)}; xv[r][j][1] = (f32x4){pg8::bf_lo(w.z), pg8::bf_hi(w.z), pg8::bf_lo(w.w), pg8::bf_hi(w.w)}; }
        const float rs0 = 1.0f / sqrtf(rowss[2 * rp] * (1.0f / DM) + EPS), rs1 = 1.0f / sqrtf(rowss[2 * rp + 1] * (1.0f / DM) + EPS);
        float my0 = 0.f, my1 = 0.f;
#pragma unroll
        for (int c = 0; c < 16; ++c) { float a0 = 0.f, a1 = 0.f;
#pragma unroll
            for (int j = 0; j < 4; ++j)
#pragma unroll
                for (int hh = 0; hh < 2; ++hh) { const f32x4 w = *(const LAS f32x4*)(WT + c * DM + 512 * j + 8 * F.lane + 4 * hh);
                    a0 += (xv[0][j][hh].x * w.x + xv[0][j][hh].y * w.y) + (xv[0][j][hh].z * w.z + xv[0][j][hh].w * w.w);
                    a1 += (xv[1][j][hh].x * w.x + xv[1][j][hh].y * w.y) + (xv[1][j][hh].z * w.z + xv[1][j][hh].w * w.w); }
            const float s0 = wave_sum(a0), s1 = wave_sum(a1);
            if (F.lane == c) { my0 = s0; my1 = s1; }
            __builtin_amdgcn_sched_barrier(0); }
        if (F.lane < 16) { __hip_atomic_store(gates + (size_t)(2 * rp) * 16 + F.lane, my0 * rs0 + bgl, RLX_AGENT); __hip_atomic_store(gates + (size_t)(2 * rp + 1) * 16 + F.lane, my1 * rs1 + bgl, RLX_AGENT); }
    }
    VM_WAIT(); __syncthreads();
    if (F.tid == 0) __hip_atomic_fetch_add(cnt, 1u, RLX_AGENT);
}
__device__ __forceinline__ void gates_wait(Frame& F, gu32* cnt) {
    if (threadIdx.x == 0) { unsigned sp = 0; gu32* tmo = (gu32*)(F.ws + WS_CTL) + CW_TMO;
        while (__hip_atomic_load(cnt, RLX_AGENT) < (unsigned)F.G) { __builtin_amdgcn_s_sleep(2); if (++sp > (1u << 22)) { __hip_atomic_store(tmo, 1u, RLX_AGENT); break; } }
        __builtin_amdgcn_fence(__ATOMIC_ACQUIRE, "agent"); VM_WAIT(); }
    __syncthreads();
}

__device__ __forceinline__ float logsigmoidf_(float x) { return fminf(x, 0.f) - log1pf(__expf(-fabsf(x))); }
__device__ __forceinline__ void mlstm_prep(Frame& F, int b, int hh) {
    const float* gates = (const float*)(F.ws + WS_GATES);
    float* a2 = (float*)(F.ldsg + ab::A2_OFF); float* M2 = (float*)(F.ldsg + ab::M2_OFF); float* e2 = (float*)(F.ldsg + ab::E2_OFF); float* sc = (float*)(F.ldsg + ab::SCAN_OFF);
    int tid_ = F.tid; asm volatile("" : "+v"(tid_));
    const int lane_ = tid_ & 63;
    float lf[4], ig[4];
#pragma unroll
    for (int e = 0; e < 4; ++e) { const size_t idx = (size_t)(b * SEQ + 4 * tid_ + e) * 16; ig[e] = gates[idx + hh]; lf[e] = logsigmoidf_(gates[idx + 8 + hh]); }
    float c[4]; c[0] = lf[0]; c[1] = c[0] + lf[1]; c[2] = c[1] + lf[2]; c[3] = c[2] + lf[3];
    const float incl = wave_scan_sum(c[3]);
    if (lane_ == 63) sc[F.wave] = incl;
    __syncthreads();
    float wp = 0.f;
    for (int w = 0; w < F.wave; ++w) wp += sc[w];
    const float base = wp + incl - c[3];
    float Bv[4], av[4], mx[4];
#pragma unroll
    for (int e = 0; e < 4; ++e) { Bv[e] = base + c[e]; av[e] = ig[e] - Bv[e]; }
    mx[0] = av[0]; mx[1] = fmaxf(mx[0], av[1]); mx[2] = fmaxf(mx[1], av[2]); mx[3] = fmaxf(mx[2], av[3]);
    const float im = wave_scan_max(mx[3]);
    if (lane_ == 63) sc[16 + F.wave] = im;
    const float ex = dppf<0x138, 0xf>(-__builtin_inff(), im);
    __syncthreads();
    float wm = -__builtin_inff();
    for (int w = 0; w < F.wave; ++w) wm = fmaxf(wm, sc[16 + w]);
    const float pre = fmaxf(wm, ex);
    const float L2E = 1.4426950408889634f;
#pragma unroll
    for (int e = 0; e < 4; ++e) { const float M = fmaxf(pre, mx[e]); const int t = 4 * tid_ + e; a2[t] = av[e] * L2E; M2[t] = M * L2E; e2[t] = -(Bv[e] + M) * L2E; }
    __syncthreads();
}
__device__ __forceinline__ ab::BlockRef att_ref(Frame& F, int qt) {
    const int q = qt >> 8, t = qt & 255, hv = 16 * q + (t & 15), qb = 7 - (t >> 4), vh = hv & 1, c = (hv >> 1) & 1, hh = (hv >> 2) & 7, b = hv >> 5;
    ab::BlockRef r;
    r.Q = (const bf16*)(F.ws + WS_AQ) + (size_t)(b * SEQ + qb * 256) * 2048 + hh * 256 + c * 128;
    r.K = (const bf16*)(F.ws + WS_AK) + (size_t)(b * SEQ) * 2048 + hh * 256 + c * 128;
    r.V = (const bf16*)(F.ws + WS_AV) + (size_t)(b * SEQ) * 2048 + hh * 256 + vh * 128;
    r.O = (float*)((bf16*)(F.ws + WS_OATT) + (size_t)(b * SEQ + qb * 256) * 4096 + hh * 512 + c * 256 + vh * 128);
    r.P0 = qb * 256; r.Cst = nullptr; r.nst = nullptr; return r;
}
__device__ __forceinline__ ab::BlockRef mls_ref(Frame& F, int t) {
    const int bh = t >> 4, qb = (t >> 1) & 7, vh = t & 1, hh = bh & 7, b = bh >> 3;
    ab::BlockRef r;
    r.Q = (const bf16*)(F.ws + WS_MQ) + (size_t)(b * SEQ + qb * 256) * 1024 + hh * 128;
    r.K = (const bf16*)(F.ws + WS_MK) + (size_t)(b * SEQ) * 1024 + hh * 128;
    r.V = (const bf16*)(F.ws + WS_MV) + (size_t)(b * SEQ) * 2048 + hh * 256 + vh * 128;
    r.O = (float*)((bf16*)(F.ws + WS_HRAW) + (size_t)(b * SEQ + qb * 256) * 2048 + hh * 256 + vh * 128);
    r.P0 = qb * 256;
    r.Cst = qb ? (const bf16*)(F.ws + WS_CST) + ((size_t)(bh * 7 + qb - 1) * 128) * 256 + vh * 128 : nullptr;
    r.nst = qb ? (const float*)(F.ws + WS_NST) + (size_t)(bh * 7 + qb - 1) * 128 : nullptr;
    return r;
}
__device__ __forceinline__ ab::bf16x8 scale8(ab::bf16x8 v, float w) {
    ab::u32x4 q = *reinterpret_cast<ab::u32x4*>(&v); ab::u32x4 o;
    o.x = ab::cvtpk(__uint_as_float(q.x << 16) * w, __uint_as_float(q.x & 0xffff0000u) * w); o.y = ab::cvtpk(__uint_as_float(q.y << 16) * w, __uint_as_float(q.y & 0xffff0000u) * w);
    o.z = ab::cvtpk(__uint_as_float(q.z << 16) * w, __uint_as_float(q.z & 0xffff0000u) * w); o.w = ab::cvtpk(__uint_as_float(q.w << 16) * w, __uint_as_float(q.w & 0xffff0000u) * w);
    return *reinterpret_cast<ab::bf16x8*>(&o);
}
__device__ __forceinline__ float sum8(ab::bf16x8 v) {
    const ab::u32x4 q = *reinterpret_cast<const ab::u32x4*>(&v);
    return ((__uint_as_float(q.x << 16) + __uint_as_float(q.x & 0xffff0000u)) + (__uint_as_float(q.y << 16) + __uint_as_float(q.y & 0xffff0000u)))
         + ((__uint_as_float(q.z << 16) + __uint_as_float(q.z & 0xffff0000u)) + (__uint_as_float(q.w << 16) + __uint_as_float(q.w & 0xffff0000u)));
}
__device__ __forceinline__ void mls_scan(Frame& F, int bh, const int tid) {
    using namespace ab;
    char* lds = (char*)F.ldsg; const int b = bh >> 3, hh = bh & 7;
    const float* a2 = (const float*)(lds + A2_OFF); const float* M2 = (const float*)(lds + M2_OFF);
    const int wid = __builtin_amdgcn_readfirstlane(tid >> 6), lane = tid & 63, r32 = lane & 31, hi = lane >> 5, dgrp = wid & 3, vh = wid >> 2;
    const int sr = tid >> 4, sc = (tid & 15) * 8, vst0 = v_st(sr, sc), vst1 = v_st(32 + sr, sc);
    const bf16* Kp = (const bf16*)(F.ws + WS_MK) + (size_t)(b * SEQ) * 1024 + hh * 128;
    const bf16* Vp = (const bf16*)(F.ws + WS_MV) + (size_t)(b * SEQ) * 2048 + hh * 256;
    bf16* Cst = (bf16*)(F.ws + WS_CST) + (size_t)(bh * 7) * 128 * 256; float* nst = (float*)(F.ws + WS_NST) + (size_t)(bh * 7) * 128;
    const unsigned lok = (unsigned)((lane >> 4) * 1024 + sc), lov = (unsigned)((lane >> 4) * 2048 + sc);
    f32x16 C[4] = {}; float nacc = 0.f;
    const int vbA = (int)(uintptr_t)lds + v_rd_base(lane) + dgrp * 512;
    const int vbB = (int)(uintptr_t)lds + v_rd_base(lane) + 16384 * (1 + vh);
    bf16x8 ka[4], kb[4], va[4], vb[4], vc[4], vd[4];
#define SC_LOAD(i, s0) do { const bf16* kp_ = Kp + (size_t)((s0) + wid * 4) * 1024; const bf16* vp_ = Vp + (size_t)((s0) + wid * 4) * 2048; \
        ka[i] = load8(kp_ + lok); kb[i] = load8(kp_ + 32 * 1024 + lok); va[i] = load8(vp_ + lov); vb[i] = load8(vp_ + 32 * 2048 + lov); vc[i] = load8(vp_ + 128 + lov); vd[i] = load8(vp_ + 32 * 2048 + 128 + lov); } while (0)
#define SC_TRRD(dst, base, off) asm volatile("ds_read_b64_tr_b16 %0, %1 offset:%2" : "=&v"(dst) : "v"(base), "i"(off) : "memory")
#define SC_D0(d0) do { s16x4 l0, l1, l2, l3, h0, h1, h2, h3; constexpr int b_ = (d0) * 512; \
            SC_TRRD(l0, vbB, b_); SC_TRRD(h0, vbB, b_ + 2048); SC_TRRD(l1, vbB, b_ + 4096); SC_TRRD(h1, vbB, b_ + 6144); SC_TRRD(l2, vbB, b_ + 8192); SC_TRRD(h2, vbB, b_ + 10240); SC_TRRD(l3, vbB, b_ + 12288); SC_TRRD(h3, vbB, b_ + 14336); \
            asm volatile("s_waitcnt lgkmcnt(0)" ::: "memory"); SBAR(); \
            C[d0] = __builtin_amdgcn_mfma_f32_32x32x16_bf16(A0, (bf16x8){l0[0], l0[1], l0[2], l0[3], h0[0], h0[1], h0[2], h0[3]}, C[d0], 0, 0, 0); \
            C[d0] = __builtin_amdgcn_mfma_f32_32x32x16_bf16(A1, (bf16x8){l1[0], l1[1], l1[2], l1[3], h1[0], h1[1], h1[2], h1[3]}, C[d0], 0, 0, 0); \
            C[d0] = __builtin_amdgcn_mfma_f32_32x32x16_bf16(A2, (bf16x8){l2[0], l2[1], l2[2], l2[3], h2[0], h2[1], h2[2], h2[3]}, C[d0], 0, 0, 0); \
            C[d0] = __builtin_amdgcn_mfma_f32_32x32x16_bf16(A3, (bf16x8){l3[0], l3[1], l3[2], l3[3], h3[0], h3[1], h3[2], h3[3]}, C[d0], 0, 0, 0); } while (0)
#pragma unroll
    for (int i = 0; i < 4; ++i) SC_LOAD(i, 64 * i);
    for (int j = 0; j < 7; ++j) {
        const float mNew = M2[256 * (j + 1) - 1];
        if (j > 0) { const float dec = __builtin_amdgcn_exp2f(M2[256 * j - 1] - mNew);
#pragma unroll
            for (int d_ = 0; d_ < 4; ++d_)
#pragma unroll
                for (int r = 0; r < 16; ++r) C[d_][r] *= dec;
            nacc *= dec; }
#pragma unroll
        for (int tt = 0; tt < 4; ++tt) {
            const int s0 = 256 * j + 64 * tt;
            const float w0 = __builtin_amdgcn_exp2f(a2[s0 + sr] - mNew), w1 = __builtin_amdgcn_exp2f(a2[s0 + 32 + sr] - mNew);
            if (j < 6) { asm volatile("s_waitcnt vmcnt(18)" ::: "memory"); } else { asm volatile("s_waitcnt vmcnt(0)" ::: "memory"); }
            const bf16x8 ks0 = scale8(ka[tt], w0), ks1 = scale8(kb[tt], w1);
            __syncthreads();
            *(bf16x8*)(lds + vst0) = ks0; *(bf16x8*)(lds + vst1) = ks1;
            *(bf16x8*)(lds + 16384 + vst0) = va[tt]; *(bf16x8*)(lds + 16384 + vst1) = vb[tt]; *(bf16x8*)(lds + 32768 + vst0) = vc[tt]; *(bf16x8*)(lds + 32768 + vst1) = vd[tt];
            SBAR();
            if (j < 6) SC_LOAD(tt, s0 + 256);
            __syncthreads();
            s16x4 al0, ah0, al1, ah1, al2, ah2, al3, ah3;
            SC_TRRD(al0, vbA, 0); SC_TRRD(ah0, vbA, 2048); SC_TRRD(al1, vbA, 4096); SC_TRRD(ah1, vbA, 6144); SC_TRRD(al2, vbA, 8192); SC_TRRD(ah2, vbA, 10240); SC_TRRD(al3, vbA, 12288); SC_TRRD(ah3, vbA, 14336);
            asm volatile("s_waitcnt lgkmcnt(0)" ::: "memory"); SBAR();
            const bf16x8 A0 = (bf16x8){al0[0], al0[1], al0[2], al0[3], ah0[0], ah0[1], ah0[2], ah0[3]}, A1 = (bf16x8){al1[0], al1[1], al1[2], al1[3], ah1[0], ah1[1], ah1[2], ah1[3]};
            const bf16x8 A2 = (bf16x8){al2[0], al2[1], al2[2], al2[3], ah2[0], ah2[1], ah2[2], ah2[3]}, A3 = (bf16x8){al3[0], al3[1], al3[2], al3[3], ah3[0], ah3[1], ah3[2], ah3[3]};
            if (vh == 0) nacc += (sum8(A0) + sum8(A1)) + (sum8(A2) + sum8(A3));
            SC_D0(0); SC_D0(1); SC_D0(2); SC_D0(3);
        }
        { float nt = nacc; auto rr = __builtin_amdgcn_permlane32_swap(__float_as_uint(nt), __float_as_uint(nt), false, false); nt = __uint_as_float(rr[0]) + __uint_as_float(rr[1]);
          if (vh == 0 && hi == 0) nst[j * 128 + 32 * dgrp + r32] = nt; }
        bf16* Cj = Cst + ((size_t)j * 128 + 32 * dgrp) * 256 + 128 * vh; const unsigned loc = (unsigned)(4 * hi * 256 + r32);
#pragma unroll
        for (int r = 0; r < 16; ++r) { bf16* Cr = Cj + (size_t)((r & 3) + 8 * (r >> 2)) * 256;
#pragma unroll
            for (int d0 = 0; d0 < 4; ++d0) { const float v = C[d0][r]; const float nb = dppf<0xB1, 0xf>(0.f, v);
                if ((r32 & 1) == 0) *(unsigned*)(Cr + d0 * 32 + loc) = cvtpk(v, nb); } }
    }
#undef SC_LOAD
#undef SC_TRRD
#undef SC_D0
}
__device__ __forceinline__ void wait_word_ge(Frame& F, gu32* w, unsigned need) {
    if (threadIdx.x == 0) { unsigned sp = 0; gu32* tmo = (gu32*)(F.ws + WS_CTL) + CW_TMO;
        while (__hip_atomic_load(w, RLX_AGENT) < need) { __builtin_amdgcn_s_sleep(2); if (++sp > (1u << 22)) { __hip_atomic_store(tmo, 1u, RLX_AGENT); break; } }
        __builtin_amdgcn_fence(__ATOMIC_ACQUIRE, "agent"); VM_WAIT(); }
    __syncthreads();
}
__device__ __forceinline__ void mix_phase(Frame& F, int l, int rep) {
    char* lds = (char*)F.ldsg;
    constexpr int NMLS = 512, NSCAN = 32, NCVT = 128;
    gu32* ctl = (gu32*)(F.ws + WS_CTL);
    gu32* gcnt = ctl + CW_GCNT + 64 * (l + 4 * rep); gu32* sflag = ctl + CW_SFLAG + 64 * ((l + 4 * rep) * 32); gu32* tick = ctl + CW_TICK + 64 * (l + 4 * rep);
    gates_step(F, l, gcnt);
    if (l + 1 < DEPTH && rep == 0 && F.bid >= NSCAN && F.bid < NSCAN + NCVT) {
        cvt_run(F, (l + 1) * IT_LAYER, IT_LAYER, (F.bid - NSCAN) * NWAVES + F.wave, NCVT * NWAVES);
        VM_WAIT(); __syncthreads();
    }
    if (F.bid < NSCAN) {
        gates_wait(F, gcnt);
        int tid_s = threadIdx.x; asm volatile("" : "+v"(tid_s));
        mlstm_prep(F, F.bid >> 3, F.bid & 7);
        mls_scan(F, F.bid, tid_s);
        VM_WAIT(); __syncthreads();
        if (threadIdx.x == 0) { __builtin_amdgcn_fence(__ATOMIC_RELEASE, "agent"); VM_WAIT(); __hip_atomic_store(sflag + 64 * F.bid, 1u, RLX_AGENT); }
        __syncthreads();
    }
#ifndef NO_ATT
    { volatile LAS unsigned* tw = (volatile LAS unsigned*)(F.lds + MISC_OFF) + 16; gu32* atick = ctl + CW_ATICK + 64 * (8 * (l + 4 * rep));
      const int q0 = (int)(xb_xcc_id() & 7u); int qdone = 0;
#define TAKE_ATT(dst) do { if (threadIdx.x == 0) { int r_ = -1; for (int i_ = 0; i_ < 8; ++i_) { const int q_ = (q0 + i_) & 7; if (qdone & (1 << q_)) continue;               \
            const unsigned t_ = __hip_atomic_fetch_add(atick + 64 * q_, 1u, RLX_AGENT); if (t_ < 128u) { r_ = (q_ << 8) | (int)t_; break; } qdone |= 1 << q_; } tw[0] = (unsigned)r_; } \
        PP_BAR(); dst = __builtin_amdgcn_readfirstlane((int)tw[0]); PP_BAR(); } while (0)
      int qt; TAKE_ATT(qt);
      if (qt >= 0) {
          ab::BlockRef cur = att_ref(F, qt); ab::Seam S;
          int tid_a = threadIdx.x; asm volatile("" : "+v"(tid_a));
          ab::prime2<0, 2048, 2048, 2048>(cur, lds, S, tid_a);
          for (;;) {
              int qn; TAKE_ATT(qn);
              const bool last = qn < 0;
              const ab::BlockRef nxt = last ? cur : att_ref(F, qn);
              ab::block2<0, 2048, 2048, 2048, 4096>(cur, nxt, lds, S, tid_a);
              if (last) break;
              cur = nxt;
          }
          ab::pp_realign(tid_a);
      }
#undef TAKE_ATT
    }
#endif
    VM_WAIT(); __syncthreads();
#ifndef NO_MLS
    gates_wait(F, gcnt);
    { volatile LAS unsigned* tw = (volatile LAS unsigned*)(F.lds + MISC_OFF) + 16;
#define TAKE_TICKET(dst) do { if (threadIdx.x == 0) tw[0] = __hip_atomic_fetch_add(tick, 1u, RLX_AGENT); __syncthreads(); dst = __builtin_amdgcn_readfirstlane((int)tw[0]); __syncthreads(); } while (0)
      for (;;) {
          int t2; TAKE_TICKET(t2);
          if (t2 >= NMLS / 2) break;
          int tid_m = threadIdx.x; asm volatile("" : "+v"(tid_m));
          const int bh = t2 >> 3;
          mlstm_prep(F, bh >> 3, bh & 7); wait_word_ge(F, sflag + 64 * bh, 1u);
          const ab::BlockRef c0 = mls_ref(F, 2 * t2), c1 = mls_ref(F, 2 * t2 + 1); ab::Seam S;
          ab::prime2<1, 1024, 1024, 2048>(c0, lds, S, tid_m);
          ab::block2<1, 1024, 1024, 2048, 2048>(c0, c1, lds, S, tid_m);
          ab::block2<1, 1024, 1024, 2048, 2048>(c1, c1, lds, S, tid_m);
          ab::pp_realign(tid_m);
          VM_WAIT(); __syncthreads();
      }
#undef TAKE_TICKET
    }
    VM_WAIT(); __syncthreads();
#endif
}

__device__ __forceinline__ void fin_phase(Frame& F, int l) {
    const float* lq = inp(F, I_LAM_QK) + (size_t)l * 512;
    const float s1 = wave_sum(lq[F.lane] * lq[128 + F.lane] + lq[64 + F.lane] * lq[192 + F.lane]);
    const float s2 = wave_sum(lq[256 + F.lane] * lq[384 + F.lane] + lq[320 + F.lane] * lq[448 + F.lane]);
    const float lam_init = l == 0 ? 0.2f : (l == 1 ? 0.3555090675909693f : (l == 2 ? 0.4707130183435842f : 0.5560582041556406f));
    const float lam = expf(s1) - expf(s2) + lam_init, post = 1.0f - lam_init;
    const bf16* hraw = (const bf16*)(F.ws + WS_HRAW); const bf16* oat = (const bf16*)(F.ws + WS_OATT); const bf16* smo = (const bf16*)(F.ws + WS_SMO);
    bf16* hmn = (bf16*)(F.ws + WS_HMN); bf16* han = (bf16*)(F.ws + WS_HAN);
    { float* rowss = (float*)(F.ws + WS_ROWSS); float* rowsb = (float*)(F.ws + WS_ROWSS_B); for (int i = F.bid * 512 + F.tid; i < MTOK; i += F.G * 512) { rowss[i] = 0.f; rowsb[i] = 0.f; } }
    const int gw = F.bid * NWAVES + F.wave, NGW = F.G * NWAVES;
    const float* mg = inp(F, I_M_NORM) + (size_t)l * 2048; const float* ag = inp(F, I_A_NORM) + (size_t)l * 2048;
    f32x4 mgv[8], agv[8];
#pragma unroll
    for (int hh = 0; hh < 8; ++hh) { mgv[hh] = *(const f32x4*)(mg + hh * 256 + 4 * F.lane); agv[hh] = *(const f32x4*)(ag + hh * 256 + 4 * F.lane); }
    for (int row = gw; row < MTOK; row += NGW) {
        f32x4 hv[8], o0[8], o1[8]; v2u sw[8];
#pragma unroll
        for (int hh = 0; hh < 8; ++hh) { const v2u a = *(const v2u*)(hraw + (size_t)row * 2048 + hh * 256 + 4 * F.lane); hv[hh] = (f32x4){pg8::bf_lo(a.x), pg8::bf_hi(a.x), pg8::bf_lo(a.y), pg8::bf_hi(a.y)}; sw[hh] = *(const v2u*)(smo + (size_t)row * 2048 + hh * 256 + 4 * F.lane); }
#pragma unroll
        for (int hh = 0; hh < 8; ++hh) { const v2u a = *(const v2u*)(oat + (size_t)row * 4096 + hh * 512 + 4 * F.lane), c = *(const v2u*)(oat + (size_t)row * 4096 + hh * 512 + 256 + 4 * F.lane);
            o0[hh] = (f32x4){pg8::bf_lo(a.x), pg8::bf_hi(a.x), pg8::bf_lo(a.y), pg8::bf_hi(a.y)}; o1[hh] = (f32x4){pg8::bf_lo(c.x), pg8::bf_hi(c.x), pg8::bf_lo(c.y), pg8::bf_hi(c.y)}; }
#pragma unroll
        for (int hh = 0; hh < 8; ++hh) { const int col = hh * 256 + 4 * F.lane; const f32x4 v = hv[hh];
            const float rs = 1.0f / sqrtf(wave_sum((v.x * v.x + v.y * v.y) + (v.z * v.z + v.w * v.w)) * (1.0f / 256.0f) + EPS);
            const f32x4 g = mgv[hh]; const f32x4 sg = (f32x4){pg8::bf_lo(sw[hh].x), pg8::bf_hi(sw[hh].x), pg8::bf_lo(sw[hh].y), pg8::bf_hi(sw[hh].y)};
            const f32x4 o = v * rs * g * sg; v2u w; w.x = pk2(o.x, o.y); w.y = pk2(o.z, o.w); *(v2u*)(hmn + (size_t)row * 2048 + col) = w; }
#pragma unroll
        for (int hh = 0; hh < 8; ++hh) { const int col = hh * 256 + 4 * F.lane; const f32x4 v = o0[hh] - o1[hh] * lam;
            const float rs = 1.0f / sqrtf(wave_sum((v.x * v.x + v.y * v.y) + (v.z * v.z + v.w * v.w)) * (1.0f / 256.0f) + EPS);
            const f32x4 g = agv[hh];
            const f32x4 o = v * rs * g * post; v2u w; w.x = pk2(o.x, o.y); w.y = pk2(o.z, o.w); *(v2u*)(han + (size_t)row * 2048 + col) = w; }
    }
}

__device__ __forceinline__ void conv_fixup_panel(Frame& F, int l, int pm) {
    const float* fxc = (const float*)(F.ws + WS_FXC); const float* fxv = (const float*)(F.ws + WS_FXV); const float* fxg = (const float*)(F.ws + WS_FXG); bf16* u = (bf16*)(F.ws + WS_U);
    const float* cw = inp(F, I_CONV_W) + (size_t)l * 3 * DFF;
    constexpr int NI = 2 * 2 * (DFF / 4) / 512;
    static_assert(2 * 2 * (DFF / 4) == NI * 512, "fix-up item count");
#pragma unroll
    for (int i0 = 0; i0 < NI; i0 += 4) {
        f32x4 cp[4], vv[4], ga[4], gb[4], wa[4], wb[4]; int blkv[4], colv[4], rhov[4];
#pragma unroll
        for (int k = 0; k < 4; ++k) if (i0 + k < NI) { const int i = F.tid + (i0 + k) * 512, c4 = i % (DFF / 4), rr = i / (DFF / 4), rho = rr & 1, blk = pm * 2 + (rr >> 1), col = c4 * 4, pb = (blk & 15) ? blk - 1 : blk;
            blkv[k] = blk; colv[k] = col; rhov[k] = rho;
            cp[k] = *(const f32x4*)(fxc + ((size_t)blk * 2 + rho) * DFF + col); vv[k] = *(const f32x4*)(fxv + ((size_t)blk * 2 + rho) * DFF + col);
            ga[k] = *(const f32x4*)(fxg + ((size_t)pb * 2 + 1) * DFF + col); gb[k] = *(const f32x4*)(fxg + ((size_t)pb * 2) * DFF + col);
            wa[k] = *(const f32x4*)(cw + col); wb[k] = *(const f32x4*)(cw + DFF + col); }
#pragma unroll
        for (int k = 0; k < 4; ++k) if (i0 + k < NI) {
            if ((blkv[k] & 15) == 0) continue;
            const f32x4 cv = rhov[k] == 0 ? cp[k] + wb[k] * ga[k] + wa[k] * gb[k] : cp[k] + wa[k] * ga[k];
            f32x4 o;
#pragma unroll
            for (int j = 0; j < 4; ++j) o[j] = cv[j] * pg8::sigmoidf_fast(cv[j]) * vv[k][j];
            v2u w; w.x = pk2(o[0], o[1]); w.y = pk2(o[2], o[3]);
            *(v2u*)(u + ((size_t)blkv[k] * 128 + rhov[k]) * DFF + colv[k]) = w; }
    }
}

__device__ __forceinline__ void out_phase(Frame& F) {
    const float* h = (const float*)(F.ws + WS_H); const float* gf = inp(F, I_NORM_FINAL); float* out = (float*)inp(F, I_OUT);
    const int gw = F.bid * NWAVES + F.wave, NGW = F.G * NWAVES;
    f32x4 gv[8];
#pragma unroll
    for (int j = 0; j < 8; ++j) gv[j] = *((const f32x4*)gf + 64 * j + F.lane);
    for (int row = gw; row < MTOK; row += NGW) { const f32x4* xr = (const f32x4*)(h + (size_t)row * DM) + F.lane; f32x4 xv[8]; float ss = 0.f;
#pragma unroll
        for (int j = 0; j < 8; ++j) { xv[j] = xr[64 * j]; ss += (xv[j].x * xv[j].x + xv[j].y * xv[j].y) + (xv[j].z * xv[j].z + xv[j].w * xv[j].w); }
        const float rs = 1.0f / sqrtf(wave_sum(ss) * (1.0f / DM) + EPS); f32x4* o = (f32x4*)(out + (size_t)row * DM) + F.lane;
#pragma unroll
        for (int j = 0; j < 8; ++j) o[64 * j] = xv[j] * rs * gv[j]; }
}

__device__ __forceinline__ int nrep_opaque(int n) { asm volatile("" : "+s"(n)); return n; }
struct Args { const float* in[16]; float* out; unsigned char* ws; int ph_lo, ph_hi, li, pad; };
__global__ void __launch_bounds__(NWAVES * 64, 2) fwd(Args args) {
    extern __shared__ __attribute__((aligned(16))) unsigned char lds[];
    Frame F;
    F.lds = (LAS unsigned char*)lds; F.ldsg = lds;
    F.tid = threadIdx.x; F.lane = F.tid & 63; F.wave = __builtin_amdgcn_readfirstlane(F.tid >> 6);
    F.G = gridDim.x; F.bid = blockIdx.x; F.vcu = (F.G % 8 == 0) ? (F.bid % 8) * (F.G / 8) + F.bid / 8 : F.bid;
    F.ws = args.ws;
    volatile LAS unsigned* MISC = (volatile LAS unsigned*)(F.lds + MISC_OFF);
    for (int u = F.tid; u < 64; u += NWAVES * 64) MISC[u] = 0u;
    if (F.tid < I_NPTR) { const unsigned long long p = (F.tid == I_OUT) ? (unsigned long long)args.out : (unsigned long long)args.in[F.tid & 15];
        ((LAS unsigned*)(F.lds + PTAB_OFF))[2 * F.tid] = (unsigned)p; ((LAS unsigned*)(F.lds + PTAB_OFF))[2 * F.tid + 1] = (unsigned)(p >> 32); }
    __syncthreads();
    gu32* ctl = (gu32*)(F.ws + WS_CTL);
    XcdBarrier bar = xcd_barrier_post((unsigned*)(ctl + CW_BAR) + args.li * XCD_BAR_WORDS, MISC + 8);
    const int lo = args.ph_lo, hi = args.ph_hi;
#ifndef PH_MASK
#define PH_MASK 0xFFFF
#endif
#define EN(j) ((PH_MASK >> (j)) & 1)
#ifndef PROBE_REP
#define PROBE_REP 0
#endif
#define NREP(j) nrep_opaque(1 + ((PROBE_REP >> (j)) & 1))
#define IN(k) (lo <= (k) && (k) < hi)
#define LAUNDER() do { unsigned long long z_ = 0ull; asm volatile("" : "+s"(z_), "+s"(F.vcu), "+s"(F.bid), "+s"(F.G)); F.ws = args.ws + z_; F.tid = threadIdx.x; asm volatile("" : "+v"(F.tid)); F.lane = F.tid & 63; } while (0)
#define SEAM(k) do { if (IN(k) && IN((k) + 1)) xcd_barrier(bar); } while (0)
    if (EN(12) && IN(0)) { for (int rep_ = 0; rep_ < NREP(12); ++rep_) { LAUNDER(); p0_prologue(F); } SEAM(0); }
    for (int l = 0; l < DEPTH; ++l) {
        const int pb = 1 + l * NPH_L;
        bf16* XN = (bf16*)(F.ws + WS_XN);
        if (EN(0) && IN(pb + 0)) { for (int rep_ = 0; rep_ < NREP(0); ++rep_) { LAUNDER();
            pg8::Gemm g{XN, (const bf16*)(F.ws + WS_WIN + (size_t)l * SZ_WIN), MTOK, NING, DM, nullptr, nullptr}; pg8::StaticOrder S; S.init(MTOK, NING, F.G, F.bid);
            pg8::EpiInProj E{(bf16*)(F.ws + WS_MQ), (bf16*)(F.ws + WS_MK), (bf16*)(F.ws + WS_MV), (bf16*)(F.ws + WS_SMO), (bf16*)(F.ws + WS_AQ), (bf16*)(F.ws + WS_AK), (bf16*)(F.ws + WS_AV), (bf16*)(F.ws + WS_SG),
                             (const float*)(F.ws + WS_BIASG) + (size_t)l * NING, (const float*)(F.ws + WS_ROPE), (const float*)(F.ws + WS_ROWSS_B)};
            pg8::gemm_phase<pg8::EpiInProj, pg8::StaticOrder, true, true>(F.lds, g, S, E, F.tid);
            } SEAM(pb + 0); }
        if (EN(1) && IN(pb + 1)) { for (int rep_ = 0; rep_ < NREP(1); ++rep_) { LAUNDER(); mix_phase(F, l, rep_); } SEAM(pb + 1); }
        if (EN(2) && IN(pb + 2)) { for (int rep_ = 0; rep_ < NREP(2); ++rep_) { LAUNDER(); fin_phase(F, l); } SEAM(pb + 2); }
        if (EN(3) && IN(pb + 3)) { for (int rep_ = 0; rep_ < NREP(3); ++rep_) { LAUNDER();
            pg8::Gemm g{(const bf16*)(F.ws + WS_HMN), (const bf16*)(F.ws + WS_WBM + (size_t)l * SZ_WSQ), MTOK, DM, DM, (const bf16*)(F.ws + WS_HAN), (const bf16*)(F.ws + WS_WBD + (size_t)l * SZ_WSQ)};
            pg8::PairOrder S; S.init(MTOK, DM, F.G, F.bid);
            pg8::EpiMerge E{(bf16*)(F.ws + WS_Y), (const bf16*)(F.ws + WS_SG)};
            pg8::gemm_phase<pg8::EpiMerge, pg8::PairOrder, true, true>(F.lds, g, S, E, F.tid);
            } SEAM(pb + 3); }
        if (EN(4) && IN(pb + 4)) { for (int rep_ = 0; rep_ < NREP(4); ++rep_) { LAUNDER();
            pg8::Gemm g{(const bf16*)(F.ws + WS_Y), (const bf16*)(F.ws + WS_WO + (size_t)l * SZ_WSQ), MTOK, DM, DM, nullptr, nullptr}; pg8::StaticOrder S; S.init(MTOK, DM, F.G, F.bid);
            if (rep_ == 0) { pg8::EpiRes<true> E{(float*)(F.ws + WS_H), DM, XN, (float*)(F.ws + WS_ROWSS)};
            pg8::gemm_phase<pg8::EpiRes<true>, pg8::StaticOrder, false, true>(F.lds, g, S, E, F.tid); }
            else { pg8::EpiRes<false> E{(float*)(F.ws + WS_P), DM, nullptr, nullptr};
            pg8::gemm_phase<pg8::EpiRes<false>, pg8::StaticOrder, false, true>(F.lds, g, S, E, F.tid); }
            } SEAM(pb + 4); }
        if (EN(5) && IN(pb + 5)) { for (int rep_ = 0; rep_ < NREP(5); ++rep_) { LAUNDER();
            pg8::Gemm g{XN, (const bf16*)(F.ws + WS_WUP + (size_t)l * SZ_WUP), MTOK, NUP, DM, nullptr, nullptr}; pg8::StaticOrder S; S.init(MTOK, NUP, F.G, F.bid);
            pg8::EpiUpConv E{(bf16*)(F.ws + WS_U), DFF, (const float*)(F.ws + WS_ROWSS), inp(F, I_CONV_W) + (size_t)l * 3 * DFF, inp(F, I_CONV_B) + (size_t)l * DFF,
                             (float*)(F.ws + WS_FXC), (float*)(F.ws + WS_FXV), (float*)(F.ws + WS_FXG)};
            pg8::gemm_phase<pg8::EpiUpConv, pg8::StaticOrder, true, true, true>(F.lds, g, S, E, F.tid);
            } SEAM(pb + 5); }
        if (EN(6) && IN(pb + 6)) { for (int rep_ = 0; rep_ < NREP(6); ++rep_) { LAUNDER();
            pg8::Gemm g{(const bf16*)(F.ws + WS_U), (const bf16*)(F.ws + WS_WDN + (size_t)l * SZ_WDN), MTOK, DM, DFF, nullptr, nullptr}; pg8::StaticOrder S; S.init(MTOK, DM, F.G, F.bid);
            { pg8::Unit fu; for (int i = 0; S.next(i, fu); ++i) conv_fixup_panel(F, l, fu.pm); VM_WAIT(); __syncthreads(); }
            if (rep_ == 0) { pg8::EpiRes<true> E{(float*)(F.ws + WS_H), DM, XN, (float*)(F.ws + WS_ROWSS_B)};
            pg8::gemm_phase<pg8::EpiRes<true>, pg8::StaticOrder, false, true>(F.lds, g, S, E, F.tid); }
            else { pg8::EpiRes<false> E{(float*)(F.ws + WS_P), DM, nullptr, nullptr};
            pg8::gemm_phase<pg8::EpiRes<false>, pg8::StaticOrder, false, true>(F.lds, g, S, E, F.tid); }
            } SEAM(pb + 6); }
    }
    if (EN(11) && IN(NPHASE - 1)) { LAUNDER(); out_phase(F); }
#undef IN
#undef SEAM
}

extern "C" void kernel_launch(void* const* d_in, const int* in_sizes, int n_in, void* d_out, int out_size, void* d_ws, size_t ws_size, hipStream_t stream) {
    static int grid = 0;
    if (grid == 0) {
        if (n_in != 16 || in_sizes[0] != MTOK * DM || out_size != MTOK * DM || ws_size < WS_END) {
            fprintf(stderr, "kernel_launch: unexpected shapes (n_in %d, in0 %d, out %d, ws %zu, need %zu)\n", n_in, n_in > 0 ? in_sizes[0] : -1, out_size, ws_size, (size_t)WS_END); grid = -1; return; }
        int dev = 0, cus = 0, per_cu = 0;
        if (hipGetDevice(&dev) != hipSuccess || hipDeviceGetAttribute(&cus, hipDeviceAttributeMultiprocessorCount, dev) != hipSuccess) { grid = -1; return; }
        if (hipFuncSetAttribute((const void*)fwd, hipFuncAttributeMaxDynamicSharedMemorySize, LDS_BYTES) != hipSuccess) { fprintf(stderr, "kernel_launch: hipFuncSetAttribute failed\n"); grid = -1; return; }
        if (hipOccupancyMaxActiveBlocksPerMultiprocessor(&per_cu, (const void*)fwd, NWAVES * 64, LDS_BYTES) != hipSuccess || per_cu < 1)
            fprintf(stderr, "kernel_launch: note: occupancy query reports %d workgroups per CU\n", per_cu);
        (void)hipGetLastError();
        grid = cus;
    }
    if (grid < 0) return;
    if (hipMemsetAsync((char*)d_ws + WS_CTL, 0, CTL_ZERO_BYTES, stream) != hipSuccess) return;
    Args a{};
    for (int i = 0; i < 16; ++i) a.in[i] = (const float*)d_in[i];
    a.out = (float*)d_out; a.ws = (unsigned char*)d_ws;
#if MK_SPLIT
    for (int p = 0; p < NPHASE; ++p) { a.ph_lo = p; a.ph_hi = p + 1; a.li = p; hipLaunchKernelGGL(fwd, dim3(grid), dim3(NWAVES * 64), LDS_BYTES, stream, a); }
#else
    a.ph_lo = 0; a.ph_hi = NPHASE; a.li = 0;
    hipLaunchKernelGGL(fwd, dim3(grid), dim3(NWAVES * 64), LDS_BYTES, stream, a);
#endif
    const hipError_t le = hipPeekAtLastError();
    if (le != hipSuccess) fprintf(stderr, "kernel_launch: launch failed: %s\n", hipGetErrorName(le));
}
```

```cpp
#include <hip/hip_runtime.h>
#include <cstdio>
#include <cstdint>

#ifndef MK_SPLIT
#define MK_SPLIT 0
#endif

namespace pg8 {
#define PG8_LAS __attribute__((address_space(3)))
typedef unsigned short bf16_t;
typedef short bf16x8 __attribute__((ext_vector_type(8)));
typedef float f32x4 __attribute__((ext_vector_type(4)));
typedef float f32x2 __attribute__((ext_vector_type(2)));
typedef unsigned u32x4 __attribute__((ext_vector_type(4)));
typedef unsigned u32x2 __attribute__((ext_vector_type(2)));
constexpr int BM = 256, BK = 64, HALF = 128, HTB = HALF * BK * 2, STAGE_BYTES = 8 * HTB, NXCD = 8, WGM = 8;

__host__ __device__ __forceinline__ int lds_byte(int r, int c) { const int st = (r >> 4) * 2 + (c >> 5), rr = r & 15, cc = c & 31, ob = rr * 64 + cc * 2; return st * 1024 + (ob ^ (((ob >> 9) & 1) << 5)); }
__host__ __device__ __forceinline__ void stage_rc(int b, int& R, int& C) { const int st = b / 1024, sb = b % 1024, swz = sb ^ (((sb >> 9) & 1) << 5); R = (st >> 1) * 16 + swz / 64; C = (st & 1) * 32 + (swz % 64) / 2; }
__host__ __device__ __forceinline__ int perm32(int rho) { const int n = rho >> 4, i = rho & 15; return 8 * (i >> 2) + 4 * n + (i & 3); }

struct Unit { int pm, pn, sel; };
struct Gemm { const bf16_t* A; const bf16_t* Bt; int M, N, K; const bf16_t* A1; const bf16_t* Bt1; };

struct StaticOrder {
    int nM, nN, nwg, G, c;
    __host__ __device__ __forceinline__ void init(int M, int N, int G_, int c_) { nM = M / BM; nN = N / BM; nwg = nM * nN; G = G_; c = c_; }
    __host__ __device__ __forceinline__ bool next(int i, Unit& u) const {
        const long L = (long)i * G + c; if (L >= nwg) return false;
        int wgid = (int)L; { const int q = nwg / NXCD, r = nwg % NXCD, xcd = wgid % NXCD, off = wgid / NXCD; wgid = (xcd < r ? xcd * (q + 1) : r * (q + 1) + (xcd - r) * q) + off; }
        const int nig = WGM * nN, gid = wgid / nig, fm = gid * WGM, gsz = (nM - fm) < WGM ? (nM - fm) : WGM;
        u.pm = fm + ((wgid % nig) % gsz); u.pn = (wgid % nig) / gsz; u.sel = 0; return true;
    }
    __device__ __forceinline__ void a_ready(const Unit&) const {}
    __device__ __forceinline__ void done(const Unit&) const {}
};
struct PairOrder : StaticOrder {
    __host__ __device__ __forceinline__ bool next(int i, Unit& u) const { if (!StaticOrder::next(i >> 1, u)) return false; u.sel = i & 1; return true; }
};

__device__ __forceinline__ unsigned cvt_pk_bf16(float lo, float hi) { unsigned r; asm volatile("v_cvt_pk_bf16_f32 %0, %1, %2" : "=v"(r) : "v"(lo), "v"(hi)); return r; }
__device__ __forceinline__ float bf_lo(unsigned w) { return __uint_as_float(w << 16); }
__device__ __forceinline__ float bf_hi(unsigned w) { return __uint_as_float(w & 0xffff0000u); }
__device__ __forceinline__ float sigmoidf_fast(float x) { return __builtin_amdgcn_rcpf(1.0f + __builtin_amdgcn_exp2f(-1.4426950408889634f * x)); }

struct EpiInProj {
    static constexpr bool PERM = true, AFTER_DRAIN = false, CHAIN = false;
    bf16_t *mq, *mk, *mv, *smo, *aq, *ak, *av, *sg; const float* bias; const float* rope; const float* rowss;
    __device__ __forceinline__ void operator()(const f32x4 (&acc)[2][2][4][2], const Unit& u, int wr, int wc, int fr, int fq) const {
        const int pn = u.pn; bf16_t* base; int ldc, colt, kind = 0; float sc = 1.f;
        if (pn < 4) { base = mq; ldc = 1024; colt = pn * 256; }
        else if (pn < 8) { base = mk; ldc = 1024; colt = (pn - 4) * 256; sc = 0.08838834764831845f; }
        else if (pn < 16) { base = mv; ldc = 2048; colt = (pn - 8) * 256; }
        else if (pn < 24) { base = smo; ldc = 2048; colt = (pn - 16) * 256; kind = 2; }
        else if (pn < 32) { base = aq; ldc = 2048; colt = (pn - 24) * 256; kind = 1; }
        else if (pn < 40) { base = ak; ldc = 2048; colt = (pn - 32) * 256; kind = 1; }
        else if (pn < 48) { base = av; ldc = 2048; colt = (pn - 40) * 256; }
        else { base = sg; ldc = 4096; colt = (pn - 48) * 256; kind = 2; }
        const int row0 = u.pm * BM + wr * 64 + fr, col0 = colt + wc * 32 + 8 * fq, bcol0 = pn * BM + wc * 32 + 8 * fq;
        f32x4 bv[2][2];
#pragma unroll
        for (int bj = 0; bj < 2; ++bj)
#pragma unroll
            for (int n = 0; n < 2; ++n) bv[bj][n] = *(const f32x4*)(bias + bcol0 + bj * HALF + 4 * n);
        const bool dorope = (kind == 1) && (wc == 0);
        float rsv[2][4];
#pragma unroll
        for (int ai = 0; ai < 2; ++ai)
#pragma unroll
            for (int m = 0; m < 4; ++m) rsv[ai][m] = rowss[row0 + ai * HALF + m * 16];
#pragma unroll
        for (int ai = 0; ai < 2; ++ai) {
            f32x4 cvv[4], svv[4];
#pragma unroll
            for (int m = 0; m < 4; ++m) { cvv[m] = (f32x4){1.f, 1.f, 1.f, 1.f}; svv[m] = (f32x4){0.f, 0.f, 0.f, 0.f}; }
            if (dorope) {
#pragma unroll
                for (int m = 0; m < 4; ++m) { const float* cs = rope + (size_t)((row0 + ai * HALF + m * 16) & 2047) * 32 + 4 * fq; cvv[m] = *(const f32x4*)cs; svv[m] = *(const f32x4*)(cs + 16); } }
#pragma unroll
            for (int m = 0; m < 4; ++m) { const int row = row0 + ai * HALF + m * 16; bf16_t* rowp = base + (size_t)row * ldc + col0;
                const float rs = 1.0f / sqrtf(rsv[ai][m] * (1.0f / 2048.0f) + 1e-6f);
                const f32x4 cv = cvv[m], sv = svv[m];
#pragma unroll
                for (int bj = 0; bj < 2; ++bj) { f32x4 v0 = (acc[ai][bj][m][0] * rs + bv[bj][0]) * sc, v1 = (acc[ai][bj][m][1] * rs + bv[bj][1]) * sc;
                    if (dorope) { f32x4 r0, r1;
                        r0[0] = v0[0] * cv[0] - v0[1] * sv[0]; r0[1] = v0[1] * cv[0] + v0[0] * sv[0]; r0[2] = v0[2] * cv[1] - v0[3] * sv[1]; r0[3] = v0[3] * cv[1] + v0[2] * sv[1];
                        r1[0] = v1[0] * cv[2] - v1[1] * sv[2]; r1[1] = v1[1] * cv[2] + v1[0] * sv[2]; r1[2] = v1[2] * cv[3] - v1[3] * sv[3]; r1[3] = v1[3] * cv[3] + v1[2] * sv[3];
                        v0 = r0; v1 = r1; }
                    if (kind == 2) {
#pragma unroll
                        for (int j = 0; j < 4; ++j) { v0[j] = sigmoidf_fast(v0[j]); v1[j] = sigmoidf_fast(v1[j]); } }
                    u32x4 w; w.x = cvt_pk_bf16(v0[0], v0[1]); w.y = cvt_pk_bf16(v0[2], v0[3]); w.z = cvt_pk_bf16(v1[0], v1[1]); w.w = cvt_pk_bf16(v1[2], v1[3]);
                    *(u32x4*)(rowp + bj * HALF) = w; } } }
    }
};
template <int CTRL> __device__ __forceinline__ f32x4 dpp4(const f32x4 v) { f32x4 r;
#pragma unroll
    for (int j = 0; j < 4; ++j) r[j] = __uint_as_float(__builtin_amdgcn_update_dpp(0u, __float_as_uint(v[j]), CTRL, 0xf, 0xf, false));
    return r; }
struct EpiUpConv {
    static constexpr bool PERM = true, AFTER_DRAIN = false, CHAIN = false;
    bf16_t* u; int ldc; const float* rowss; const float* cw; const float* cb; float *fxc, *fxv, *fxg;
    __device__ __forceinline__ void operator()(const f32x4 (&acc)[2][2][4][2], const Unit& un, int wr, int wc, int fr, int fq) const {
        const int col0 = un.pn * HALF + wc * 32 + 8 * fq, blk = un.pm * 2 + wr, rowb = blk * 128 + fr;
        f32x4 w0[2], w1[2], w2[2], bb[2];
#pragma unroll
        for (int n = 0; n < 2; ++n) { w0[n] = *(const f32x4*)(cw + col0 + 4 * n); w1[n] = *(const f32x4*)(cw + ldc + col0 + 4 * n); w2[n] = *(const f32x4*)(cw + 2 * ldc + col0 + 4 * n); bb[n] = *(const f32x4*)(cb + col0 + 4 * n); }
        f32x4 p1[2], p2[2];
        p1[0] = p1[1] = p2[0] = p2[1] = (f32x4){0.f, 0.f, 0.f, 0.f};
        float rsv[8];
#pragma unroll
        for (int q = 0; q < 8; ++q) rsv[q] = rowss[rowb + 16 * q];
#pragma unroll
        for (int q = 0; q < 8; ++q) { const int ai = q >> 2, m = q & 3, row = rowb + 16 * q;
            const float rs = 1.0f / sqrtf(rsv[q] * (1.0f / 2048.0f) + 1e-6f);
            u32x4 w;
#pragma unroll
            for (int n = 0; n < 2; ++n) { const f32x4 g = acc[ai][0][m][n] * rs, v = acc[ai][1][m][n] * rs;
                const f32x4 r1 = dpp4<0x121>(g), r2 = dpp4<0x122>(g);
                f32x4 g1, g2;
#pragma unroll
                for (int j = 0; j < 4; ++j) { g1[j] = fr >= 1 ? r1[j] : p1[n][j]; g2[j] = fr >= 2 ? r2[j] : p2[n][j]; }
                p1[n] = r1; p2[n] = r2;
                const f32x4 cv = w0[n] * g2 + w1[n] * g1 + w2[n] * g + bb[n];
                f32x4 o;
#pragma unroll
                for (int j = 0; j < 4; ++j) o[j] = cv[j] * sigmoidf_fast(cv[j]) * v[j];
                if (n == 0) { w.x = cvt_pk_bf16(o[0], o[1]); w.y = cvt_pk_bf16(o[2], o[3]); } else { w.z = cvt_pk_bf16(o[0], o[1]); w.w = cvt_pk_bf16(o[2], o[3]); }
                if (q == 0 && fr < 2) { *(f32x4*)(fxc + ((size_t)blk * 2 + fr) * ldc + col0 + 4 * n) = cv; *(f32x4*)(fxv + ((size_t)blk * 2 + fr) * ldc + col0 + 4 * n) = v; }
                if (q == 7 && fr >= 14) *(f32x4*)(fxg + ((size_t)blk * 2 + (fr - 14)) * ldc + col0 + 4 * n) = g; }
            *(u32x4*)(u + (size_t)row * ldc + col0) = w; }
    }
};
struct EpiMerge {
    static constexpr bool PERM = false, AFTER_DRAIN = false, CHAIN = true;
    bf16_t* y; const bf16_t* sg;
    __device__ __forceinline__ void mid(f32x4 (&acc)[2][2][4][2], const Unit& u, int wr, int wc, int fr, int fq) const {
        const int row0 = u.pm * BM + wr * 64 + fr, col0 = u.pn * BM + wc * 32 + 4 * fq;
#pragma unroll
        for (int ai = 0; ai < 2; ++ai)
#pragma unroll
            for (int m = 0; m < 4; ++m) { const int row = row0 + ai * HALF + m * 16;
                u32x2 gm[2][2], gd[2][2];
#pragma unroll
                for (int bj = 0; bj < 2; ++bj)
#pragma unroll
                    for (int n = 0; n < 2; ++n) { const int col = col0 + bj * HALF + n * 16; gm[bj][n] = *(const u32x2*)(sg + (size_t)row * 4096 + col); gd[bj][n] = *(const u32x2*)(sg + (size_t)row * 4096 + 2048 + col); }
#pragma unroll
                for (int bj = 0; bj < 2; ++bj)
#pragma unroll
                    for (int n = 0; n < 2; ++n) { const u32x2 a = gm[bj][n], d = gd[bj][n];
                        const f32x4 num = (f32x4){bf_lo(a.x), bf_hi(a.x), bf_lo(a.y), bf_hi(a.y)}, den = (f32x4){bf_lo(d.x), bf_hi(d.x), bf_lo(d.y), bf_hi(d.y)};
#pragma unroll
                        for (int j = 0; j < 4; ++j) acc[ai][bj][m][n][j] *= num[j] * __builtin_amdgcn_rcpf(fmaxf(den[j], 1e-30f)); } }
    }
    __device__ __forceinline__ void operator()(const f32x4 (&acc)[2][2][4][2], const Unit& u, int wr, int wc, int fr, int fq) const {
        const int row0 = u.pm * BM + wr * 64 + fr, col0 = u.pn * BM + wc * 32 + 4 * fq;
#pragma unroll
        for (int ai = 0; ai < 2; ++ai)
#pragma unroll
            for (int mp = 0; mp < 2; ++mp) {
                u32x2 gw[2][2][2];
#pragma unroll
                for (int mm = 0; mm < 2; ++mm)
#pragma unroll
                    for (int bj = 0; bj < 2; ++bj)
#pragma unroll
                        for (int n = 0; n < 2; ++n) gw[mm][bj][n] = *(const u32x2*)(sg + (size_t)(row0 + ai * HALF + (2 * mp + mm) * 16) * 4096 + 2048 + col0 + bj * HALF + n * 16);
#pragma unroll
                for (int mm = 0; mm < 2; ++mm)
#pragma unroll
                    for (int bj = 0; bj < 2; ++bj)
#pragma unroll
                        for (int n = 0; n < 2; ++n) { const int m = 2 * mp + mm, row = row0 + ai * HALF + m * 16, col = col0 + bj * HALF + n * 16;
                            const u32x2 g2 = gw[mm][bj][n]; f32x4 g = (f32x4){bf_lo(g2.x), bf_hi(g2.x), bf_lo(g2.y), bf_hi(g2.y)};
#pragma unroll
                            for (int j = 0; j < 4; ++j) g[j] = fmaxf(g[j], 1e-30f);
                            const f32x4 v = acc[ai][bj][m][n] * g;
                            u32x2 w; w.x = cvt_pk_bf16(v[0], v[1]); w.y = cvt_pk_bf16(v[2], v[3]); *(u32x2*)(y + (size_t)row * 2048 + col) = w; }
                asm volatile("" ::: "memory"); }
    }
};
template <bool STATS> struct EpiRes {
    static constexpr bool PERM = false, AFTER_DRAIN = false, CHAIN = false;
    float* h; int ldc; bf16_t* hb; float* rowss;
    __device__ __forceinline__ void operator()(const f32x4 (&acc)[2][2][4][2], const Unit& u, int wr, int wc, int fr, int fq) const {
        const int row0 = u.pm * BM + wr * 64 + fr, col0 = u.pn * BM + wc * 32 + 4 * fq;
#pragma unroll
        for (int ai = 0; ai < 2; ++ai)
#pragma unroll
            for (int mp = 0; mp < 2; ++mp) {
                f32x4 hv[2][2][2];
#pragma unroll
                for (int mm = 0; mm < 2; ++mm)
#pragma unroll
                    for (int bj = 0; bj < 2; ++bj)
#pragma unroll
                        for (int n = 0; n < 2; ++n) hv[mm][bj][n] = *(const f32x4*)(h + (size_t)(row0 + ai * HALF + (2 * mp + mm) * 16) * ldc + col0 + bj * HALF + n * 16);
#pragma unroll
                for (int mm = 0; mm < 2; ++mm) { const int m = 2 * mp + mm, row = row0 + ai * HALF + m * 16; float* rowp = h + (size_t)row * ldc + col0; float ss = 0.f;
#pragma unroll
                    for (int bj = 0; bj < 2; ++bj)
#pragma unroll
                        for (int n = 0; n < 2; ++n) { const f32x4 v = hv[mm][bj][n] + acc[ai][bj][m][n]; *(f32x4*)(rowp + bj * HALF + n * 16) = v;
                            if (STATS) { ss += (v[0] * v[0] + v[1] * v[1]) + (v[2] * v[2] + v[3] * v[3]); u32x2 w; w.x = cvt_pk_bf16(v[0], v[1]); w.y = cvt_pk_bf16(v[2], v[3]);
                                *(u32x2*)(hb + (size_t)row * ldc + col0 + bj * HALF + n * 16) = w; } }
                    if (STATS) {
                        { auto rr = __builtin_amdgcn_permlane16_swap(__float_as_uint(ss), __float_as_uint(ss), false, false); ss = __uint_as_float(rr[0]) + __uint_as_float(rr[1]); }
                        { auto rr = __builtin_amdgcn_permlane32_swap(__float_as_uint(ss), __float_as_uint(ss), false, false); ss = __uint_as_float(rr[0]) + __uint_as_float(rr[1]); }
                        if (fq == 0) __hip_atomic_fetch_add(rowss + row, ss, __ATOMIC_RELAXED, __HIP_MEMORY_SCOPE_AGENT); } }
                asm volatile("" ::: "memory"); }
    }
};

template <class Epi, class Sched, bool ALIGN_EPI = false, bool SP2 = false, bool APERM = false>
__device__ __forceinline__ void gemm_phase(PG8_LAS unsigned char* lds, const Gemm g, const Sched& S, const Epi& E, const int tid) {
    const int wid = __builtin_amdgcn_readfirstlane(tid >> 6), lane = tid & 63, wr = wid >> 2, wc = wid & 3, fr = lane & 15, fq = lane >> 4;
    const int K = g.K, nt = K / BK;
    unsigned voffA[2], voffB[2];
#pragma unroll
    for (int i = 0; i < 2; ++i) { int R, C; stage_rc(tid * 16 + i * 8192, R, C); const int Rb = Epi::PERM ? ((R & ~31) + perm32(R & 31)) : R;
        const int Ra = APERM ? ((R >> 6) * 128 + (R & 63)) : R;
        voffA[i] = (unsigned)(Ra * K + C) * 2u; voffB[i] = (unsigned)(Rb * K + C) * 2u; }
    const size_t kstep = (size_t)(BK * 2);
    const size_t hstep = (size_t)HALF * K * 2;
    const size_t hstepA = APERM ? (size_t)64 * K * 2 : hstep;
    const size_t tstep = 2 * hstep;
    const unsigned ldsw = (unsigned)wid * 1024u;
    const int aoff = lds_byte(wr * 64 + fr, fq * 8), boff = lds_byte(wc * 32 + fr, fq * 8);
#define PG8_SA(b, h) (((b) * 2 + (h)) * HTB)
#define PG8_SB(b, h) ((4 + (b) * 2 + (h)) * HTB)
#define PG8_STAGE(bufoff, gbase, voff) do { _Pragma("unroll") for (int _i = 0; _i < 2; ++_i) \
        __builtin_amdgcn_global_load_lds((const unsigned*)((const char*)(gbase) + (voff)[_i]), (PG8_LAS unsigned*)(lds + (bufoff) + ldsw + _i * 8192), 16, 0, 0); } while (0)
#define PG8_LDA(dst, b, h) do { _Pragma("unroll") for (int m = 0; m < 4; ++m) _Pragma("unroll") for (int k = 0; k < 2; ++k) dst[m][k] = *(const PG8_LAS bf16x8*)(lds + PG8_SA(b, h) + aoff + m * 2048 + k * 1024); } while (0)
#define PG8_LDB(dst, b, h) do { _Pragma("unroll") for (int n = 0; n < 2; ++n) _Pragma("unroll") for (int k = 0; k < 2; ++k) dst[n][k] = *(const PG8_LAS bf16x8*)(lds + PG8_SB(b, h) + boff + n * 2048 + k * 1024); } while (0)
#define PG8_MMA(ai, bj, At, Bt) do { __builtin_amdgcn_s_setprio(1); _Pragma("unroll") for (int m = 0; m < 4; ++m) _Pragma("unroll") for (int n = 0; n < 2; ++n) _Pragma("unroll") for (int k = 0; k < 2; ++k) \
        acc[ai][bj][m][n] = __builtin_amdgcn_mfma_f32_16x16x32_bf16(Bt[n][k], At[m][k], acc[ai][bj][m][n], 0, 0, 0); __builtin_amdgcn_s_setprio(0); } while (0)
#define PG8_WAIT_V(n) asm volatile("s_waitcnt vmcnt(" #n ")" ::: "memory")
#define PG8_WAIT_L(n) asm volatile("s_waitcnt lgkmcnt(" #n ")" ::: "memory")
#define PG8_BAR __builtin_amdgcn_s_barrier()
#define PG8_SCHED __builtin_amdgcn_sched_barrier(0)
    Unit cur, nxt; int ui = 0;
    if (!S.next(0, cur)) return;
    f32x4 acc[2][2][4][2];
#pragma unroll
    for (int a = 0; a < 2; ++a)
#pragma unroll
        for (int b = 0; b < 2; ++b)
#pragma unroll
            for (int m = 0; m < 4; ++m)
#pragma unroll
                for (int n = 0; n < 2; ++n) acc[a][b][m][n] = (f32x4){0.f, 0.f, 0.f, 0.f};
    bf16x8 At[4][2], B0[2][2], B1[2][2];
    const char* cA = (const char*)(cur.sel ? g.A1 : g.A) + (size_t)cur.pm * tstep; const char* cB = (const char*)(cur.sel ? g.Bt1 : g.Bt) + (size_t)cur.pn * tstep;
    S.a_ready(cur);
    if constexpr (SP2) {
        PG8_STAGE(PG8_SB(0, 0), cB, voffB); PG8_STAGE(PG8_SB(0, 1), cB + hstep, voffB); PG8_STAGE(PG8_SA(0, 0), cA, voffA); PG8_STAGE(PG8_SA(0, 1), cA + hstepA, voffA);
        if (wr == 1) PG8_BAR;
        PG8_WAIT_V(2); PG8_BAR;
        PG8_STAGE(PG8_SB(1, 0), cB + kstep, voffB); PG8_STAGE(PG8_SA(1, 0), cA + kstep, voffA); PG8_STAGE(PG8_SB(1, 1), cB + hstep + kstep, voffB);
        PG8_WAIT_V(6); PG8_BAR;
    } else {
        PG8_STAGE(PG8_SB(0, 0), cB, voffB); PG8_STAGE(PG8_SA(0, 0), cA, voffA); PG8_STAGE(PG8_SB(0, 1), cB + hstep, voffB); PG8_STAGE(PG8_SA(0, 1), cA + hstepA, voffA);
        if (wr == 1) PG8_BAR;
        PG8_WAIT_V(4); PG8_BAR;
        PG8_STAGE(PG8_SB(1, 0), cB + kstep, voffB); PG8_STAGE(PG8_SA(1, 0), cA + kstep, voffA); PG8_STAGE(PG8_SB(1, 1), cB + hstep + kstep, voffB);
        PG8_WAIT_V(6); PG8_BAR;
    }
    for (;;) {
        const bool has_next = S.next(ui + 1, nxt);
        const char* nA = has_next ? (const char*)(nxt.sel ? g.A1 : g.A) + (size_t)nxt.pm * tstep : cA; const char* nB = has_next ? (const char*)(nxt.sel ? g.Bt1 : g.Bt) + (size_t)nxt.pn * tstep : cB;
        for (int t = 0; t < nt; t += 2) {
            const bool last = (t == nt - 2);
            const char* a1 = cA + (size_t)(t + 1) * kstep;
            const char* a2 = last ? nA : cA + (size_t)(t + 2) * kstep; const char* b2 = last ? nB : cB + (size_t)(t + 2) * kstep;
            const char* a3 = a2 + kstep; const char* b3 = b2 + kstep;
            if (last && has_next) S.a_ready(nxt);
            if constexpr (SP2) {
            PG8_LDB(B0, 0, 0); PG8_LDB(B1, 0, 1); PG8_SCHED; PG8_LDA(At, 0, 0); PG8_STAGE(PG8_SA(1, 1), a1 + hstepA, voffA);
            PG8_WAIT_V(8); PG8_WAIT_L(0); PG8_BAR; PG8_MMA(0, 0, At, B0); PG8_MMA(0, 1, At, B1); PG8_BAR; PG8_SCHED;
            PG8_LDA(At, 0, 1); PG8_STAGE(PG8_SB(0, 0), b2, voffB); PG8_STAGE(PG8_SB(0, 1), b2 + hstep, voffB); PG8_STAGE(PG8_SA(0, 0), a2, voffA);
            PG8_WAIT_V(8); PG8_WAIT_L(0); PG8_BAR; PG8_MMA(1, 0, At, B0); PG8_MMA(1, 1, At, B1); PG8_BAR; PG8_SCHED;
            PG8_LDB(B0, 1, 0); PG8_LDB(B1, 1, 1); PG8_SCHED; PG8_LDA(At, 1, 0); PG8_STAGE(PG8_SA(0, 1), a2 + hstepA, voffA);
            PG8_WAIT_V(8); PG8_WAIT_L(0); PG8_BAR; PG8_MMA(0, 0, At, B0); PG8_MMA(0, 1, At, B1); PG8_BAR; PG8_SCHED;
            PG8_LDA(At, 1, 1); PG8_STAGE(PG8_SB(1, 0), b3, voffB); PG8_STAGE(PG8_SB(1, 1), b3 + hstep, voffB); PG8_STAGE(PG8_SA(1, 0), a3, voffA);
            PG8_WAIT_V(8); PG8_WAIT_L(0); PG8_BAR; PG8_MMA(1, 0, At, B0); PG8_MMA(1, 1, At, B1); PG8_BAR; PG8_SCHED;
            } else {
            PG8_LDB(B0, 0, 0); PG8_SCHED; PG8_LDA(At, 0, 0); PG8_STAGE(PG8_SA(1, 1), a1 + hstepA, voffA);
            PG8_WAIT_L(8); PG8_BAR; PG8_WAIT_L(0); PG8_MMA(0, 0, At, B0); PG8_BAR; PG8_SCHED;
            PG8_LDB(B1, 0, 1); PG8_STAGE(PG8_SB(0, 0), b2, voffB);
            PG8_BAR; PG8_WAIT_L(0); PG8_MMA(0, 1, At, B1); PG8_BAR;
            PG8_LDA(At, 0, 1); PG8_STAGE(PG8_SA(0, 0), a2, voffA);
            PG8_BAR; PG8_WAIT_L(0); PG8_MMA(1, 0, At, B0); PG8_BAR; PG8_SCHED;
            PG8_STAGE(PG8_SB(0, 1), b2 + hstep, voffB);
            PG8_WAIT_V(6); PG8_BAR; PG8_MMA(1, 1, At, B1); PG8_BAR;
            PG8_LDB(B0, 1, 0); PG8_SCHED; PG8_LDA(At, 1, 0); PG8_STAGE(PG8_SA(0, 1), a2 + hstepA, voffA);
            PG8_WAIT_L(8); PG8_BAR; PG8_WAIT_L(0); PG8_MMA(0, 0, At, B0); PG8_BAR; PG8_SCHED;
            PG8_LDB(B1, 1, 1); PG8_STAGE(PG8_SB(1, 0), b3, voffB);
            PG8_BAR; PG8_WAIT_L(0); PG8_MMA(0, 1, At, B1); PG8_BAR;
            PG8_LDA(At, 1, 1); PG8_STAGE(PG8_SA(1, 0), a3, voffA);
            PG8_BAR; PG8_WAIT_L(0); PG8_MMA(1, 0, At, B0); PG8_BAR; PG8_SCHED;
            PG8_STAGE(PG8_SB(1, 1), b3 + hstep, voffB);
            PG8_WAIT_V(6); PG8_BAR; PG8_MMA(1, 1, At, B1); PG8_BAR;
            }
        }
        if constexpr (ALIGN_EPI) { if (wr == 0) PG8_BAR; }
        bool chained = false;
        if constexpr (Epi::CHAIN) { if (cur.sel == 0) { E.mid(acc, cur, wr, wc, fr, fq); chained = true; } }
        if (!chained) { E(acc, cur, wr, wc, fr, fq); S.done(cur); }
        if (!has_next) break;
        if (!chained) {
#pragma unroll
        for (int a = 0; a < 2; ++a)
#pragma unroll
            for (int b = 0; b < 2; ++b)
#pragma unroll
                for (int m = 0; m < 4; ++m)
#pragma unroll
                    for (int n = 0; n < 2; ++n) acc[a][b][m][n] = (f32x4){0.f, 0.f, 0.f, 0.f};
        }
        cur = nxt; cA = nA; cB = nB; ++ui;
        if constexpr (ALIGN_EPI) { if (wr == 1) PG8_BAR; }
    }
    PG8_WAIT_V(0);
    if constexpr (!ALIGN_EPI) { if (wr == 0) PG8_BAR; }
    PG8_BAR;
#undef PG8_SA
#undef PG8_SB
#undef PG8_STAGE
#undef PG8_LDA
#undef PG8_LDB
#undef PG8_MMA
#undef PG8_WAIT_V
#undef PG8_WAIT_L
#undef PG8_BAR
#undef PG8_SCHED
}
}

namespace ab {
typedef unsigned short bf16;
typedef short bf16x8 __attribute__((ext_vector_type(8)));
typedef short s16x4 __attribute__((ext_vector_type(4)));
typedef float f32x16 __attribute__((ext_vector_type(16)));
typedef float f32x4 __attribute__((ext_vector_type(4)));
typedef unsigned u32x4 __attribute__((ext_vector_type(4)));
constexpr int D = 128, NW = 8, QBLK = 32, KVBLK = 64, QB = NW * QBLK;
constexpr int SHM_V = KVBLK * D * 2, SHM_K = KVBLK * D * 2;
constexpr int BODY_LDS = 2 * SHM_V + 2 * SHM_K + NW * 64 * 4;
constexpr int A2_OFF = BODY_LDS, M2_OFF = A2_OFF + 8192, E2_OFF = M2_OFF + 8192, SCAN_OFF = E2_OFF + 8192, LDS_NEED = SCAN_OFF + 256;
constexpr float SCALE = 0.08838834764831845f, THR = 8.f;
#define KSWZ(row, colB) ((row) * 256 + ((colB) ^ (((row) & 7) << 4)))
#define SBAR() __builtin_amdgcn_sched_barrier(0)
__device__ __forceinline__ int v_st(int k, int c) { const int kk = (k & ~0xC) | ((k & 4) << 1) | ((k & 8) >> 1); return ((kk >> 3) * 4 + (c >> 5)) * 512 + ((kk & 7) * 32 + (c & 31)) * 2; }
__device__ __forceinline__ int v_rd_base(int lane) { return ((lane & 3) << 3) | (((lane >> 2) & 3) << 6) | (((lane >> 4) & 1) << 5) | (((lane >> 5) & 1) << 8); }
constexpr int v_rd_off(int d0, int ks, int half) { return d0 * 512 + ks * 4096 + half * 2048; }
__device__ __forceinline__ int crow(int r, int hi) { return (r & 3) + 8 * (r >> 2) + 4 * hi; }
__device__ __forceinline__ unsigned cvtpk(float lo, float hi) { unsigned r; asm volatile("v_cvt_pk_bf16_f32 %0, %1, %2" : "=v"(r) : "v"(lo), "v"(hi)); return r; }
__device__ __forceinline__ bf16x8 load8(const bf16* p) { return *reinterpret_cast<const bf16x8*>(p); }
template <int MODE> __device__ __forceinline__ void mask_tile(f32x16& p0, f32x16& p1, int dq) {
    const float NEG = MODE == 0 ? -__builtin_inff() : 0.f;
#pragma unroll
    for (int r = 0; r < 16; ++r) { const int c = (r & 3) + 8 * (r >> 2);
        if (dq - c < 0) p0[r] = NEG;
        if (dq - c - 32 < 0) p1[r] = NEG; }
}
__device__ __forceinline__ void partialSM(f32x16& p0, f32x16& p1, float& m_reg, float& mn, float& alpha) {
    float pmax = p0[0];
#pragma unroll
    for (int r = 1; r < 16; ++r) pmax = fmaxf(pmax, p0[r]);
#pragma unroll
    for (int r = 0; r < 16; ++r) pmax = fmaxf(pmax, p1[r]);
    { auto rr = __builtin_amdgcn_permlane32_swap(__float_as_uint(pmax), __float_as_uint(pmax), false, false);
      pmax = fmaxf(__uint_as_float(rr[0]), __uint_as_float(rr[1])); }
    constexpr float C2 = 1.4426950408889634f * SCALE;
    if (__builtin_expect(__all((pmax - m_reg) * SCALE <= THR), 1)) { mn = m_reg; alpha = 1.f; }
    else { mn = fmaxf(m_reg, pmax); alpha = __builtin_amdgcn_exp2f((m_reg - mn) * C2); m_reg = mn; }
    const float mnL = -mn * C2;
#pragma unroll
    for (int r = 0; r < 16; ++r) p0[r] = fmaf(p0[r], C2, mnL);
#pragma unroll
    for (int r = 0; r < 16; ++r) p1[r] = fmaf(p1[r], C2, mnL);
#pragma unroll
    for (int r = 0; r < 16; ++r) p0[r] = __builtin_amdgcn_exp2f(p0[r]);
}
__device__ __forceinline__ void partialM(f32x16& p0, f32x16& p1, const float* a2k, float M2t, int hi) {
#pragma unroll
    for (int g = 0; g < 4; ++g) { const f32x4 a = *(const f32x4*)(a2k + 8 * g + 4 * hi);
#pragma unroll
        for (int j = 0; j < 4; ++j) p0[4 * g + j] *= __builtin_amdgcn_exp2f(fminf(a[j] - M2t, 0.f)); }
    SBAR();
#pragma unroll
    for (int g = 0; g < 4; ++g) { const f32x4 b = *(const f32x4*)(a2k + 32 + 8 * g + 4 * hi);
#pragma unroll
        for (int j = 0; j < 4; ++j) p1[4 * g + j] *= __builtin_amdgcn_exp2f(fminf(b[j] - M2t, 0.f)); }
}
#define AB_PK4(P, B_, OUT) do { unsigned a0 = cvtpk(P[B_+0], P[B_+1]), a1 = cvtpk(P[B_+2], P[B_+3]);                          \
        unsigned b0 = cvtpk(P[B_+4], P[B_+5]), b1 = cvtpk(P[B_+6], P[B_+7]);                                             \
        auto r0 = __builtin_amdgcn_permlane32_swap(a0, b0, false, false); auto r1 = __builtin_amdgcn_permlane32_swap(a1, b1, false, false); \
        u32x4 w = {r0[0], r1[0], r0[1], r1[1]}; OUT = *reinterpret_cast<bf16x8*>(&w); } while (0)
template <int MODE> __device__ __forceinline__ void finishSM(f32x16& p0, f32x16& p1, float alpha, float& l_reg, bf16x8& pa0, bf16x8& pa1, bf16x8& pa2, bf16x8& pa3) {
    if (MODE == 0) {
#pragma unroll
        for (int r = 0; r < 16; ++r) p1[r] = __builtin_amdgcn_exp2f(p1[r]); }
    float ps = 0;
#pragma unroll
    for (int r = 0; r < 16; ++r) ps += p0[r];
#pragma unroll
    for (int r = 0; r < 16; ++r) ps += p1[r];
    { auto rr = __builtin_amdgcn_permlane32_swap(__float_as_uint(ps), __float_as_uint(ps), false, false);
      ps = __uint_as_float(rr[0]) + __uint_as_float(rr[1]); }
    l_reg = l_reg * alpha + ps;
    AB_PK4(p0, 0, pa0); AB_PK4(p0, 8, pa1); AB_PK4(p1, 0, pa2); AB_PK4(p1, 8, pa3);
}
template <int KB>
__device__ __forceinline__ void qkt(f32x16& p0, f32x16& p1, const char* K_lds, int r32, int hi, const bf16x8* qr) {
    p0 = f32x16{}; p1 = f32x16{};
    const char* kb[4];
#pragma unroll
    for (int dd = 0; dd < 4; ++dd) kb[dd] = K_lds + KB * SHM_K + KSWZ(r32, (dd * 16 + hi * 8) * 2);
#pragma unroll
    for (int d0 = 0; d0 < 8; ++d0) { const char* a = kb[d0 & 3] + (d0 >> 2) * 128;
        bf16x8 b0 = *reinterpret_cast<const bf16x8*>(a);
        bf16x8 b1 = *reinterpret_cast<const bf16x8*>(a + 32 * 256);
        p0 = __builtin_amdgcn_mfma_f32_32x32x16_bf16(b0, qr[d0], p0, 0, 0, 0);
        p1 = __builtin_amdgcn_mfma_f32_32x32x16_bf16(b1, qr[d0], p1, 0, 0, 0); }
}
template <int VB>
__device__ __forceinline__ void pv_tile(f32x16* o, int vb0, bf16x8 pa0, bf16x8 pa1, bf16x8 pa2, bf16x8 pa3) {
#define TRRD(dst, off) asm volatile("ds_read_b64_tr_b16 %0, %1 offset:%2" : "=&v"(dst) : "v"(vb0), "i"(off) : "memory")
#define PV_D0(d0) do { s16x4 l0, l1, l2, l3, h0, h1, h2, h3; constexpr int b_ = VB * SHM_V + v_rd_off(d0, 0, 0); \
        TRRD(l0, b_); TRRD(h0, b_ + 2048); TRRD(l1, b_ + 4096); TRRD(h1, b_ + 6144); TRRD(l2, b_ + 8192); TRRD(h2, b_ + 10240); TRRD(l3, b_ + 12288); TRRD(h3, b_ + 14336); \
        asm volatile("s_waitcnt lgkmcnt(0)" ::: "memory"); SBAR();   \
        o[d0] = __builtin_amdgcn_mfma_f32_32x32x16_bf16(pa0, (bf16x8){l0[0], l0[1], l0[2], l0[3], h0[0], h0[1], h0[2], h0[3]}, o[d0], 0, 0, 0);   \
        o[d0] = __builtin_amdgcn_mfma_f32_32x32x16_bf16(pa1, (bf16x8){l1[0], l1[1], l1[2], l1[3], h1[0], h1[1], h1[2], h1[3]}, o[d0], 0, 0, 0);   \
        o[d0] = __builtin_amdgcn_mfma_f32_32x32x16_bf16(pa2, (bf16x8){l2[0], l2[1], l2[2], l2[3], h2[0], h2[1], h2[2], h2[3]}, o[d0], 0, 0, 0);   \
        o[d0] = __builtin_amdgcn_mfma_f32_32x32x16_bf16(pa3, (bf16x8){l3[0], l3[1], l3[2], l3[3], h3[0], h3[1], h3[2], h3[3]}, o[d0], 0, 0, 0); } while (0)
    PV_D0(0); PV_D0(1); PV_D0(2); PV_D0(3);
#undef PV_D0
#undef TRRD
}
template <int KB>
__device__ __forceinline__ void qkt2(f32x16& p0, f32x16& p1, const char* K_lds, int r32, int hi, const bf16x8* qr) {
    p0 = f32x16{}; p1 = f32x16{};
    int ka[4];
#pragma unroll
    for (int dd = 0; dd < 4; ++dd) ka[dd] = (int)(uintptr_t)K_lds + KB * SHM_K + KSWZ(r32, (dd * 16 + hi * 8) * 2);
#define KRD(dst, addr, off) asm volatile("ds_read_b128 %0, %1 offset:%2" : "=&v"(dst) : "v"(addr), "i"(off) : "memory")
#define QK_RD(X, Y, b) do { KRD(X[0], ka[(2 * (b)) & 3], ((2 * (b)) >> 2) * 128); KRD(Y[0], ka[(2 * (b)) & 3], ((2 * (b)) >> 2) * 128 + 32 * 256); \
        KRD(X[1], ka[(2 * (b) + 1) & 3], ((2 * (b) + 1) >> 2) * 128); KRD(Y[1], ka[(2 * (b) + 1) & 3], ((2 * (b) + 1) >> 2) * 128 + 32 * 256); } while (0)
#define QK_MM(X, Y, b) do { p0 = __builtin_amdgcn_mfma_f32_32x32x16_bf16(X[0], qr[2 * (b)], p0, 0, 0, 0); p1 = __builtin_amdgcn_mfma_f32_32x32x16_bf16(Y[0], qr[2 * (b)], p1, 0, 0, 0); \
        p0 = __builtin_amdgcn_mfma_f32_32x32x16_bf16(X[1], qr[2 * (b) + 1], p0, 0, 0, 0); p1 = __builtin_amdgcn_mfma_f32_32x32x16_bf16(Y[1], qr[2 * (b) + 1], p1, 0, 0, 0); } while (0)
    bf16x8 xa[2], ya[2], xb[2], yb[2];
    QK_RD(xa, ya, 0); QK_RD(xb, yb, 1);
    asm volatile("s_waitcnt lgkmcnt(4)" ::: "memory"); SBAR(); QK_MM(xa, ya, 0); SBAR(); QK_RD(xa, ya, 2);
    asm volatile("s_waitcnt lgkmcnt(4)" ::: "memory"); SBAR(); QK_MM(xb, yb, 1); SBAR(); QK_RD(xb, yb, 3);
    asm volatile("s_waitcnt lgkmcnt(4)" ::: "memory"); SBAR(); QK_MM(xa, ya, 2); SBAR();
    asm volatile("s_waitcnt lgkmcnt(0)" ::: "memory"); SBAR(); QK_MM(xb, yb, 3);
#undef QK_MM
#undef QK_RD
#undef KRD
}
template <int VB, bool PF>
__device__ __forceinline__ void pv_tile2(f32x16* o, int vb0, bf16x8 pa0, bf16x8 pa1, bf16x8 pa2, bf16x8 pa3) {
#define TRRD(dst, off) asm volatile("ds_read_b64_tr_b16 %0, %1 offset:%2" : "=&v"(dst) : "v"(vb0), "i"(off) : "memory")
#define PV_RD(L, H, ks) do { constexpr int b_ = VB * SHM_V + (ks) * 4096; TRRD(L[0], b_); TRRD(H[0], b_ + 2048); TRRD(L[1], b_ + 512); TRRD(H[1], b_ + 512 + 2048); \
        TRRD(L[2], b_ + 1024); TRRD(H[2], b_ + 1024 + 2048); TRRD(L[3], b_ + 1536); TRRD(H[3], b_ + 1536 + 2048); } while (0)
#define PV_MM(L, H, PA) do { _Pragma("unroll") for (int d0 = 0; d0 < 4; ++d0) \
        o[d0] = __builtin_amdgcn_mfma_f32_32x32x16_bf16(PA, (bf16x8){L[d0][0], L[d0][1], L[d0][2], L[d0][3], H[d0][0], H[d0][1], H[d0][2], H[d0][3]}, o[d0], 0, 0, 0); } while (0)
    s16x4 la[4], ha[4];
    if constexpr (PF) {
        s16x4 lb[4], hb[4];
        PV_RD(la, ha, 0); PV_RD(lb, hb, 1);
        asm volatile("s_waitcnt lgkmcnt(8)" ::: "memory"); SBAR(); PV_MM(la, ha, pa0); SBAR();
        PV_RD(la, ha, 2);
        asm volatile("s_waitcnt lgkmcnt(8)" ::: "memory"); SBAR(); PV_MM(lb, hb, pa1); SBAR();
        PV_RD(lb, hb, 3);
        asm volatile("s_waitcnt lgkmcnt(8)" ::: "memory"); SBAR(); PV_MM(la, ha, pa2); SBAR();
        asm volatile("s_waitcnt lgkmcnt(0)" ::: "memory"); SBAR(); PV_MM(lb, hb, pa3);
    } else {
        PV_RD(la, ha, 0); asm volatile("s_waitcnt lgkmcnt(0)" ::: "memory"); SBAR(); PV_MM(la, ha, pa0); SBAR();
        PV_RD(la, ha, 1); asm volatile("s_waitcnt lgkmcnt(0)" ::: "memory"); SBAR(); PV_MM(la, ha, pa1); SBAR();
        PV_RD(la, ha, 2); asm volatile("s_waitcnt lgkmcnt(0)" ::: "memory"); SBAR(); PV_MM(la, ha, pa2); SBAR();
        PV_RD(la, ha, 3); asm volatile("s_waitcnt lgkmcnt(0)" ::: "memory"); SBAR(); PV_MM(la, ha, pa3);
    }
#undef PV_MM
#undef PV_RD
#undef TRRD
}
struct BlockRef { const bf16* Q; const bf16* K; const bf16* V; float* O; int P0; const bf16* Cst; const float* nst; };
struct Seam { bf16x8 qr[8]; bf16x8 st_v0, st_v1, st_k0, st_k1; bf16x8 sb_v0, sb_v1, sb_k0, sb_k1; };
#define VMW() asm volatile("s_waitcnt vmcnt(0)" ::: "memory")
#define VMWN(n) asm volatile("s_waitcnt vmcnt(%0)" :: "i"(n) : "memory")
#define SLOAD_H(Kp, Vp, k0) do { const bf16* vb_ = (Vp) + (size_t)((k0) + wid * 4) * VP; const bf16* kb_ = (Kp) + (size_t)((k0) + wid * 4) * KP;    \
                         S.st_v0 = load8(vb_ + lov); S.st_v1 = load8(vb_ + 32 * VP + lov); S.st_k0 = load8(kb_ + lok); S.st_k1 = load8(kb_ + 32 * KP + lok); } while (0)
#define SWRITE_HK(bf) do { *(bf16x8*)(K_lds + (bf) * SHM_K + kws) = S.st_k0; *(bf16x8*)(K_lds + (bf) * SHM_K + kws + 32 * 256) = S.st_k1; } while (0)
#define SWRITE_HV(bf) do { *(bf16x8*)(V_lds + (bf) * SHM_V + vst0) = S.st_v0; *(bf16x8*)(V_lds + (bf) * SHM_V + vst1) = S.st_v1; } while (0)
#define SWRITE_H(bf) do { SWRITE_HV(bf); SWRITE_HK(bf); } while (0)
template <int QP, int KP, int VP>
__device__ __forceinline__ void prime(const BlockRef& cur, char* lds, Seam& S, const int tid, const int k0) {
    const int wid = __builtin_amdgcn_readfirstlane(tid >> 6), lane = tid & 63, r32 = lane & 31, hi = lane >> 5;
    const int sr = tid >> 4, sc = (tid & 15) * 8, kws = KSWZ(sr, sc * 2); char* K_lds = lds + 2 * SHM_V;
    const unsigned lov = (unsigned)((lane >> 4) * VP + sc), lok = (unsigned)((lane >> 4) * KP + sc), loq = (unsigned)(r32 * QP + hi * 8);
    { const bf16* qb_ = cur.Q + (size_t)(wid * QBLK) * QP;
#pragma unroll
      for (int d0 = 0; d0 < 8; ++d0) S.qr[d0] = load8(qb_ + d0 * 16 + loq); }
    SLOAD_H(cur.K, cur.V, k0); VMW(); SWRITE_HK(0);
    __syncthreads();
}
template <int MODE, int QP, int KP, int VP, int OP>
__device__ __forceinline__ void block(const BlockRef& cur, const BlockRef& nxt, char* lds, Seam& S, const int tid) {
    const int wid = __builtin_amdgcn_readfirstlane(tid >> 6), lane = tid & 63, r32 = lane & 31, hi = lane >> 5;
    const int T0 = (MODE == 1) ? cur.P0 / KVBLK : 0;
    int NT = (MODE == 1) ? QB / KVBLK : cur.P0 / KVBLK + QB / KVBLK;
    if (MODE == 1) asm volatile("" : "+s"(NT));
    const int qlo = cur.P0 + wid * QBLK, qm = qlo + r32 - 4 * hi;
    char* V_lds = lds; char* K_lds = lds + 2 * SHM_V;
    float* ws = (float*)(lds + 2 * SHM_V + 2 * SHM_K) + wid * 64; float* li_l = ws, * al_l = ws + 32;
    const float* a2 = (const float*)(lds + A2_OFF);
    float M2t = 0.f;
    if (MODE == 1) M2t = ((const float*)(lds + M2_OFF))[qlo + r32];
    float m_reg = -1e30f, l_reg = 0; f32x16 o[4] = {};
    const int sr = tid >> 4, sc = (tid & 15) * 8, vst0 = v_st(sr, sc), vst1 = v_st(32 + sr, sc), kws = KSWZ(sr, sc * 2);
    const int vb0 = (int)(uintptr_t)V_lds + v_rd_base(lane);
    const unsigned lov = (unsigned)((lane >> 4) * VP + sc), lok = (unsigned)((lane >> 4) * KP + sc), loq = (unsigned)(r32 * QP + hi * 8), loo = (unsigned)(4 * hi * OP + r32);
    const bf16* Kh = cur.K; const bf16* Vh = cur.V;
#define RESC(a) do { if (MODE == 0) { if (__any((a) < 1.f)) { if (hi == 0) al_l[r32] = (a); asm volatile("s_waitcnt lgkmcnt(0)" ::: "memory");              \
                     for (int d_ = 0; d_ < 4; ++d_) for (int r = 0; r < 16; ++r) o[d_][r] *= al_l[crow(r, hi)]; } } } while (0)
#define KBASE(t) ((T0 + (t)) * KVBLK)
#define MASKT(P0_, P1_, t) do { const int kb_ = KBASE(t); if (kb_ + KVBLK - 1 > qlo) mask_tile<MODE>(P0_, P1_, qm - kb_); } while (0)
#define PARTIAL(P0_, P1_, mnX, alX, t) do { if (MODE == 0) partialSM(P0_, P1_, m_reg, mnX, alX); else { alX = 1.f; partialM(P0_, P1_, a2 + KBASE(t), M2t, hi); } } while (0)
    constexpr int NQL = 8;
#define SEAM_K0() do { VMWN(NQL); SWRITE_HK(0); SBAR(); } while (0)
    f32x16 pA0, pA1, pB0, pB1; float mnA, mnB, alA, alB; bf16x8 pa0, pa1, pa2, pa3;
    if (MODE == 1 && cur.Cst != nullptr) {
        const bf16* Cp = cur.Cst + (size_t)(wid * 4) * 256; const unsigned loc = (unsigned)((lane >> 4) * 256 + sc);
        const bf16x8 c0 = load8(Cp + loc), c1 = load8(Cp + 32 * 256 + loc), c2 = load8(Cp + 64 * 256 + loc), c3 = load8(Cp + 96 * 256 + loc);
        float dn = 0.f;
#pragma unroll
        for (int d0 = 0; d0 < 8; ++d0) { const f32x4 n0 = *(const f32x4*)(cur.nst + 16 * d0 + 8 * hi), n1 = *(const f32x4*)(cur.nst + 16 * d0 + 8 * hi + 4);
            const u32x4 qw = *reinterpret_cast<const u32x4*>(&S.qr[d0]);
            dn += __uint_as_float(qw.x << 16) * n0[0] + __uint_as_float(qw.x & 0xffff0000u) * n0[1] + __uint_as_float(qw.y << 16) * n0[2] + __uint_as_float(qw.y & 0xffff0000u) * n0[3];
            dn += __uint_as_float(qw.z << 16) * n1[0] + __uint_as_float(qw.z & 0xffff0000u) * n1[1] + __uint_as_float(qw.w << 16) * n1[2] + __uint_as_float(qw.w & 0xffff0000u) * n1[3]; }
        { auto rr = __builtin_amdgcn_permlane32_swap(__float_as_uint(dn), __float_as_uint(dn), false, false); dn = __uint_as_float(rr[0]) + __uint_as_float(rr[1]); }
        VMW();
        *(bf16x8*)(V_lds + vst0) = c0; *(bf16x8*)(V_lds + vst1) = c1; *(bf16x8*)(V_lds + SHM_V + vst0) = c2; *(bf16x8*)(V_lds + SHM_V + vst1) = c3;
        __syncthreads();
        pv_tile<0>(o, vb0, S.qr[0], S.qr[1], S.qr[2], S.qr[3]); pv_tile<1>(o, vb0, S.qr[4], S.qr[5], S.qr[6], S.qr[7]);
        const float st = __builtin_amdgcn_exp2f(((const float*)(lds + M2_OFF))[cur.P0 - 1] - M2t);
        l_reg = st * dn;
        if (hi == 0) al_l[r32] = st;
        asm volatile("s_waitcnt lgkmcnt(0)" ::: "memory");
#pragma unroll
        for (int d_ = 0; d_ < 4; ++d_)
#pragma unroll
            for (int r = 0; r < 16; ++r) o[d_][r] *= al_l[crow(r, hi)];
        __syncthreads();
    }
    SWRITE_HV(0); SBAR();
    if (NT > 1) { SLOAD_H(Kh, Vh, KBASE(1)); }
    SBAR(); qkt<0>(pA0, pA1, K_lds, r32, hi, S.qr);
    MASKT(pA0, pA1, 0); PARTIAL(pA0, pA1, mnA, alA, 0);
    if (NT > 1) { VMW(); SWRITE_H(1); }
    __syncthreads();
#define HALF_STEP(PX0, PX1, mnX, alX, PY0, PY1, alY, t, KB, VB, SB) do {                                                      \
        SBAR(); qkt<KB>(PX0, PX1, K_lds, r32, hi, S.qr);                                             \
        finishSM<MODE>(PY0, PY1, alY, l_reg, pa0, pa1, pa2, pa3); SBAR();                                                           \
        if ((t) + 1 < NT) { SLOAD_H(Kh, Vh, KBASE((t) + 1)); SBAR(); }                                               \
        pv_tile<VB>(o, vb0, pa0, pa1, pa2, pa3); MASKT(PX0, PX1, (t)); PARTIAL(PX0, PX1, mnX, alX, (t));                                        \
        __syncthreads();                                                                                                      \
        if ((t) + 1 < NT) { VMW(); SWRITE_H(SB); }                                                                          \
        RESC(alX); __syncthreads(); } while (0)
    for (int t = 1; t + 1 < NT; t += 2) {
        HALF_STEP(pB0, pB1, mnB, alB, pA0, pA1, alA, t, 1, 0, 0);
        HALF_STEP(pA0, pA1, mnA, alA, pB0, pB1, alB, t + 1, 0, 1, 1);
    }
    const bool even = (NT & 1) == 0;
    if (even) { SBAR(); qkt<1>(pB0, pB1, K_lds, r32, hi, S.qr); SBAR(); }
    SLOAD_H(nxt.K, nxt.V, (MODE == 1) ? nxt.P0 : 0); SBAR();
    { const bf16* qb_ = nxt.Q + (size_t)(wid * QBLK) * QP;
#pragma unroll
      for (int d0 = 0; d0 < 8; ++d0) S.qr[d0] = load8(qb_ + d0 * 16 + loq); }
    SBAR();
    finishSM<MODE>(pA0, pA1, alA, l_reg, pa0, pa1, pa2, pa3); SBAR();
    pv_tile<0>(o, vb0, pa0, pa1, pa2, pa3);
    if (even) { MASKT(pB0, pB1, NT - 1); PARTIAL(pB0, pB1, mnB, alB, NT - 1); __syncthreads(); RESC(alB);
        finishSM<MODE>(pB0, pB1, alB, l_reg, pa0, pa1, pa2, pa3); SBAR(); pv_tile<1>(o, vb0, pa0, pa1, pa2, pa3); }
    SBAR(); SEAM_K0();
    if (hi == 0) li_l[r32] = (MODE == 0) ? l_reg : fmaxf(fabsf(l_reg), __builtin_amdgcn_exp2f(((const float*)(lds + E2_OFF))[qlo + r32]));
    asm volatile("s_waitcnt lgkmcnt(0)" ::: "memory");
    float rli[16];
#pragma unroll
    for (int r = 0; r < 16; ++r) rli[r] = __builtin_amdgcn_rcpf(li_l[crow(r, hi)]);
    float* Ow = cur.O + (size_t)(wid * QBLK) * OP;
#pragma unroll
    for (int r = 0; r < 16; ++r) { float* Or = Ow + (size_t)((r & 3) + 8 * (r >> 2)) * OP;
#pragma unroll
        for (int d0 = 0; d0 < 4; ++d0) Or[d0 * 32 + loo] = o[d0][r] * rli[r]; }
    __syncthreads();
#undef RESC
#undef KBASE
#undef MASKT
#undef PARTIAL
#undef SEAM_K0
#undef HALF_STEP
}

#define PP_BAR() do { asm volatile("s_waitcnt lgkmcnt(0)" ::: "memory"); __builtin_amdgcn_s_barrier(); asm volatile("" ::: "memory"); SBAR(); } while (0)
constexpr int SB_OFF = 98304;
static_assert(LDS_NEED <= SB_OFF && SB_OFF + 2 * SHM_V <= 131072, "lds map");
template <int MODE, int QP, int KP, int VP>
__device__ __forceinline__ void prime2(const BlockRef& cur, char* lds, Seam& S, const int tid) {
    const int wid = __builtin_amdgcn_readfirstlane(tid >> 6), lane = tid & 63, r32 = lane & 31, hi = lane >> 5;
    const int sr = tid >> 4, sc = (tid & 15) * 8, kws = KSWZ(sr, sc * 2); char* K_lds = lds + 2 * SHM_V;
    const unsigned lov = (unsigned)((lane >> 4) * VP + sc), lok = (unsigned)((lane >> 4) * KP + sc), loq = (unsigned)(r32 * QP + hi * 8);
    const int k0 = (MODE == 1) ? cur.P0 : 0;
    { const bf16* qb_ = cur.Q + (size_t)(wid * QBLK) * QP;
#pragma unroll
      for (int d0 = 0; d0 < 8; ++d0) S.qr[d0] = load8(qb_ + d0 * 16 + loq); }
    { const bf16* kb_ = cur.K + (size_t)(k0 + wid * 4) * KP; S.st_k0 = load8(kb_ + lok); S.st_k1 = load8(kb_ + 32 * KP + lok); }
    *(bf16x8*)(K_lds + kws) = S.st_k0; *(bf16x8*)(K_lds + kws + 32 * 256) = S.st_k1;
    SBAR();
    { const bf16* kb_ = cur.K + (size_t)(k0 + KVBLK + wid * 4) * KP; const bf16* vb_ = cur.V + (size_t)(k0 + wid * 4) * VP;
      S.st_k0 = load8(kb_ + lok); S.st_k1 = load8(kb_ + 32 * KP + lok); S.st_v0 = load8(vb_ + lov); S.st_v1 = load8(vb_ + 32 * VP + lov);
      if (MODE == 0) { S.sb_k0 = load8(kb_ + (size_t)KVBLK * KP + lok); S.sb_k1 = load8(kb_ + (size_t)(KVBLK + 32) * KP + lok); S.sb_v0 = load8(vb_ + (size_t)KVBLK * VP + lov); S.sb_v1 = load8(vb_ + (size_t)(KVBLK + 32) * VP + lov); } }
    PP_BAR();
    if (wid >= 4) PP_BAR();
}
__device__ __forceinline__ void pp_realign(const int tid) { if (__builtin_amdgcn_readfirstlane(tid >> 6) < 4) PP_BAR(); }
template <int MODE, int QP, int KP, int VP, int OP>
__device__ __forceinline__ void block2(const BlockRef& cur, const BlockRef& nxt, char* lds, Seam& S, const int tid) {
    const int wid = __builtin_amdgcn_readfirstlane(tid >> 6), lane = tid & 63, r32 = lane & 31, hi = lane >> 5;
    const int T0 = (MODE == 1) ? cur.P0 / KVBLK : 0, T0n = (MODE == 1) ? nxt.P0 / KVBLK : 0;
    int NT = (MODE == 1) ? QB / KVBLK : cur.P0 / KVBLK + QB / KVBLK;
    if (MODE == 1) asm volatile("" : "+s"(NT));
    const int qlo = cur.P0 + wid * QBLK, qm = qlo + r32 - 4 * hi;
    char* V_lds = lds; char* K_lds = lds + 2 * SHM_V;
    float* ws = (float*)(lds + 2 * SHM_V + 2 * SHM_K) + wid * 64; float* li_l = ws, * al_l = ws + 32;
    const float* a2 = (const float*)(lds + A2_OFF);
    float M2t = 0.f;
    if (MODE == 1) M2t = ((const float*)(lds + M2_OFF))[qlo + r32];
    float m_reg = -1e30f, l_reg = 0; f32x16 o[4] = {};
    const int sr = tid >> 4, sc = (tid & 15) * 8, vst0 = v_st(sr, sc), vst1 = v_st(32 + sr, sc), kws = KSWZ(sr, sc * 2);
    const int vb0 = (int)(uintptr_t)V_lds + v_rd_base(lane);
    const unsigned lov = (unsigned)((lane >> 4) * VP + sc), lok = (unsigned)((lane >> 4) * KP + sc), loq = (unsigned)(r32 * QP + hi * 8), loo = (unsigned)(4 * hi * OP + r32);
#define KBASE2(t) ((T0 + (t)) * KVBLK)
#define LOADKV(K0, K1, V0, V1, kt, vt) do { const bool kn_ = (kt) >= NT, vn_ = (vt) >= NT;                                                            \
        const bf16* kb_ = (kn_ ? nxt.K : cur.K) + (size_t)(((kn_ ? T0n - NT : T0) + (kt)) * KVBLK + wid * 4) * KP;                                   \
        const bf16* vb_ = (vn_ ? nxt.V : cur.V) + (size_t)(((vn_ ? T0n - NT : T0) + (vt)) * KVBLK + wid * 4) * VP;                                   \
        K0 = load8(kb_ + lok); K1 = load8(kb_ + 32 * KP + lok); V0 = load8(vb_ + lov); V1 = load8(vb_ + 32 * VP + lov); } while (0)
#define WRITEKV(K0, K1, V0, V1, kbuf, vbuf) do { *(bf16x8*)(K_lds + (kbuf) * SHM_K + kws) = K0; *(bf16x8*)(K_lds + (kbuf) * SHM_K + kws + 32 * 256) = K1;    \
        *(bf16x8*)(V_lds + (vbuf) * SHM_V + vst0) = V0; *(bf16x8*)(V_lds + (vbuf) * SHM_V + vst1) = V1; } while (0)
#define WRITE_A(kbuf, vbuf) WRITEKV(S.st_k0, S.st_k1, S.st_v0, S.st_v1, kbuf, vbuf)
#define WRITE_B(kbuf, vbuf) WRITEKV(S.sb_k0, S.sb_k1, S.sb_v0, S.sb_v1, kbuf, vbuf)
#define LOAD_A(kt, vt) LOADKV(S.st_k0, S.st_k1, S.st_v0, S.st_v1, kt, vt)
#define LOAD_B(kt, vt) LOADKV(S.sb_k0, S.sb_k1, S.sb_v0, S.sb_v1, kt, vt)
    f32x16 p0, p1; float mn, al; bf16x8 pa0, pa1, pa2, pa3;
#define VV_STAGE(t) do { { const int kb_ = KBASE2(t); if (kb_ + KVBLK - 1 > qlo) mask_tile<MODE>(p0, p1, qm - kb_); }                                 \
        if (MODE == 0) { partialSM(p0, p1, m_reg, mn, al);                                                                                             \
            if (__any(al < 1.f)) { if (hi == 0) al_l[r32] = al; asm volatile("s_waitcnt lgkmcnt(0)" ::: "memory");                                     \
                _Pragma("unroll") for (int d_ = 0; d_ < 4; ++d_) _Pragma("unroll") for (int r = 0; r < 16; ++r) o[d_][r] *= al_l[crow(r, hi)]; } }                  \
        else { al = 1.f; partialM(p0, p1, a2 + KBASE2(t), M2t, hi); }                                                                                  \
        finishSM<MODE>(p0, p1, al, l_reg, pa0, pa1, pa2, pa3); } while (0)
    if (MODE == 1 && cur.Cst != nullptr) {
        const bf16* Cp = cur.Cst + (size_t)(wid * 4) * 256; const unsigned loc = (unsigned)((lane >> 4) * 256 + sc);
        const bf16x8 c0 = load8(Cp + loc), c1 = load8(Cp + 32 * 256 + loc), c2 = load8(Cp + 64 * 256 + loc), c3 = load8(Cp + 96 * 256 + loc);
        *(bf16x8*)(lds + SB_OFF + vst0) = c0; *(bf16x8*)(lds + SB_OFF + vst1) = c1; *(bf16x8*)(lds + SB_OFF + SHM_V + vst0) = c2; *(bf16x8*)(lds + SB_OFF + SHM_V + vst1) = c3;
        PP_BAR();
        float dn = 0.f;
#pragma unroll
        for (int d0 = 0; d0 < 8; ++d0) { const f32x4 n0 = *(const f32x4*)(cur.nst + 16 * d0 + 8 * hi), n1 = *(const f32x4*)(cur.nst + 16 * d0 + 8 * hi + 4);
            const u32x4 qw = *reinterpret_cast<const u32x4*>(&S.qr[d0]);
            dn += __uint_as_float(qw.x << 16) * n0[0] + __uint_as_float(qw.x & 0xffff0000u) * n0[1] + __uint_as_float(qw.y << 16) * n0[2] + __uint_as_float(qw.y & 0xffff0000u) * n0[3];
            dn += __uint_as_float(qw.z << 16) * n1[0] + __uint_as_float(qw.z & 0xffff0000u) * n1[1] + __uint_as_float(qw.w << 16) * n1[2] + __uint_as_float(qw.w & 0xffff0000u) * n1[3]; }
        { auto rr = __builtin_amdgcn_permlane32_swap(__float_as_uint(dn), __float_as_uint(dn), false, false); dn = __uint_as_float(rr[0]) + __uint_as_float(rr[1]); }
        PP_BAR();
        pv_tile2<0, MODE == 0>(o, vb0 + SB_OFF, S.qr[0], S.qr[1], S.qr[2], S.qr[3]); pv_tile2<1, MODE == 0>(o, vb0 + SB_OFF, S.qr[4], S.qr[5], S.qr[6], S.qr[7]);
        const float st = __builtin_amdgcn_exp2f(((const float*)(lds + M2_OFF))[cur.P0 - 1] - M2t);
        l_reg = st * dn;
        if (hi == 0) al_l[r32] = st;
        asm volatile("s_waitcnt lgkmcnt(0)" ::: "memory");
#pragma unroll
        for (int d_ = 0; d_ < 4; ++d_)
#pragma unroll
            for (int r = 0; r < 16; ++r) o[d_][r] *= al_l[crow(r, hi)];
        PP_BAR();
    }
    for (int t = 0; t < NT; t += 2) {
        WRITE_A(1, 0); SBAR(); if (MODE == 0) LOAD_A(t + 3, t + 2); else LOAD_A(t + 2, t + 1); SBAR();
        if (t > 0) pv_tile2<1, MODE == 0>(o, vb0, pa0, pa1, pa2, pa3);
        qkt2<0>(p0, p1, K_lds, r32, hi, S.qr);
        PP_BAR();
        VV_STAGE(t);
        PP_BAR();
        if (MODE == 0) { WRITE_B(0, 1); SBAR(); LOAD_B(t + 4, t + 3); } else { WRITE_A(0, 1); SBAR(); LOAD_A(t + 3, t + 2); } SBAR();
        pv_tile2<0, MODE == 0>(o, vb0, pa0, pa1, pa2, pa3);
        qkt2<1>(p0, p1, K_lds, r32, hi, S.qr);
        PP_BAR();
        VV_STAGE(t + 1);
        PP_BAR();
    }
    { const bf16* qb_ = nxt.Q + (size_t)(wid * QBLK) * QP;
#pragma unroll
      for (int d0 = 0; d0 < 8; ++d0) S.qr[d0] = load8(qb_ + d0 * 16 + loq); }
    SBAR();
    pv_tile2<1, MODE == 0>(o, vb0, pa0, pa1, pa2, pa3);
    PP_BAR();
    if (hi == 0) li_l[r32] = (MODE == 0) ? l_reg : fmaxf(fabsf(l_reg), __builtin_amdgcn_exp2f(((const float*)(lds + E2_OFF))[qlo + r32]));
    asm volatile("s_waitcnt lgkmcnt(0)" ::: "memory");
    float rli[16];
#pragma unroll
    for (int r = 0; r < 16; ++r) rli[r] = __builtin_amdgcn_rcpf(li_l[crow(r, hi)]);
    { bf16* Ow = (bf16*)cur.O + (size_t)(wid * QBLK) * OP;
#pragma unroll
      for (int r = 0; r < 16; ++r) { bf16* Or = Ow + (size_t)((r & 3) + 8 * (r >> 2)) * OP;
#pragma unroll
          for (int d0 = 0; d0 < 4; ++d0) { const float v = o[d0][r] * rli[r];
              const float nb = __uint_as_float(__builtin_amdgcn_update_dpp(0u, __float_as_uint(v), 0xB1, 0xf, 0xf, false));
              if ((r32 & 1) == 0) *(unsigned*)(Or + d0 * 32 + loo) = cvtpk(v, nb); } } }
    PP_BAR();
#undef KBASE2
#undef LOADKV
#undef WRITEKV
#undef WRITE_A
#undef WRITE_B
#undef LOAD_A
#undef LOAD_B
#undef VV_STAGE
}
#undef VMW
#undef VMWN
#undef SLOAD_H
#undef SWRITE_HK
#undef SWRITE_HV
#undef SWRITE_H
}

constexpr int NWAVES = 8;
constexpr int BATCH = 4, SEQ = 2048, DM = 2048, DEPTH = 4, MTOK = BATCH * SEQ;
constexpr int NIN = 16400, NING = 16384, GATE_COL = 6144, DFF = 5632, NUP = 2 * DFF;
constexpr float EPS = 1e-6f;
constexpr int NPH_L = 7, NPHASE = 2 + DEPTH * NPH_L;
constexpr size_t MiB = 1u << 20;
constexpr size_t WS_CTL = 0, CTL_ZERO_BYTES = 1 * MiB;
constexpr size_t WS_ROPE = 1 * MiB;
constexpr size_t WS_BIASG = WS_ROPE + 512 * 1024;
constexpr size_t WS_GATES = 2 * MiB;
constexpr size_t WS_ROWSS_B = 3 * MiB - 64 * 1024;
constexpr size_t WS_ROWSS = 3 * MiB;
constexpr size_t WS_WIN = 4 * MiB, SZ_WIN = 64 * MiB;
constexpr size_t WS_WBM = WS_WIN + 4 * SZ_WIN, SZ_WSQ = 8 * MiB;
constexpr size_t WS_WBD = WS_WBM + 4 * SZ_WSQ, WS_WO = WS_WBD + 4 * SZ_WSQ;
constexpr size_t WS_WUP = WS_WO + 4 * SZ_WSQ, SZ_WUP = 44 * MiB;
constexpr size_t WS_WDN = WS_WUP + 4 * SZ_WUP, SZ_WDN = 22 * MiB;
constexpr size_t WS_H = WS_WDN + 4 * SZ_WDN;
constexpr size_t WS_XN = WS_H + 64 * MiB;
constexpr size_t WS_MQ = WS_XN + 32 * MiB, WS_MK = WS_MQ + 16 * MiB, WS_MV = WS_MK + 16 * MiB, WS_SMO = WS_MV + 32 * MiB;
constexpr size_t WS_AQ = WS_SMO + 32 * MiB, WS_AK = WS_AQ + 32 * MiB, WS_AV = WS_AK + 32 * MiB, WS_SG = WS_AV + 32 * MiB;
constexpr size_t WS_OATT = WS_SG + 64 * MiB;
constexpr size_t WS_HRAW = WS_OATT + 128 * MiB;
constexpr size_t WS_HMN = WS_HRAW + 64 * MiB, WS_HAN = WS_HMN + 32 * MiB;
constexpr size_t WS_P = WS_HAN + 32 * MiB;
constexpr size_t WS_Y = WS_P + 64 * MiB;
constexpr size_t WS_FXC = WS_Y + 32 * MiB, WS_FXV = WS_FXC + 3 * MiB, WS_FXG = WS_FXV + 3 * MiB;
constexpr size_t WS_U = WS_FXG + 3 * MiB;
constexpr size_t WS_CST = WS_U + 88 * MiB;
constexpr size_t WS_NST = WS_CST + 16 * MiB;
constexpr size_t WS_END = WS_NST + 1 * MiB;
constexpr int CW_TMO = 0, CW_CODE = 1, CW_BAR = 4096, CW_GCNT = 200000, CW_SFLAG = 210000, CW_TICK = 240000, CW_ATICK = 250000;
constexpr int LDS_BYTES = 131072 + 2048, MISC_OFF = 131072;
static_assert(ab::LDS_NEED <= 131072, "lds");

#define GAS __attribute__((address_space(1)))
#define LAS __attribute__((address_space(3)))
typedef unsigned short bf16;
typedef unsigned v4u __attribute__((ext_vector_type(4)));
typedef unsigned v2u __attribute__((ext_vector_type(2)));
typedef float f32x4 __attribute__((ext_vector_type(4)));
typedef GAS unsigned gu32;
#define RLX_AGENT __ATOMIC_RELAXED, __HIP_MEMORY_SCOPE_AGENT
#define LDS_WAIT() asm volatile("s_waitcnt lgkmcnt(0)" ::: "memory")
#define VM_WAIT() asm volatile("s_waitcnt vmcnt(0)" ::: "memory")
__device__ __forceinline__ unsigned pk2(float lo, float hi) { return pg8::cvt_pk_bf16(lo, hi); }

#define XB_TMO      128
#define XB_XCNT(j)  (256  + 64 * (j))
#define XB_XSUB(j)  (1280 + 64 * (j))
#define XB_XGEN(j)  (2304 + 64 * (j))
#define XB_TOP      3328
#define XB_TOPGEN   3392
#define XCD_BAR_WORDS 3456
#define XB_SPIN_CAP (1u << 18)
__device__ __forceinline__ unsigned xb_ld(unsigned* p)              { return __hip_atomic_load(p, __ATOMIC_RELAXED, __HIP_MEMORY_SCOPE_AGENT); }
__device__ __forceinline__ unsigned xb_add(unsigned* p, unsigned v) { return __hip_atomic_fetch_add(p, v, __ATOMIC_RELAXED, __HIP_MEMORY_SCOPE_AGENT); }
__device__ __forceinline__ unsigned xb_xcc_id() { return (unsigned)__builtin_amdgcn_s_getreg((3 << 11) | 20) & 0xFu; }
#define XB_SPIN(cond, bar) do { unsigned _sp = 0; while (cond) { __builtin_amdgcn_s_sleep(1); \
    if ((++_sp & 255u) == 0u) { if (xb_ld(&(bar)[XB_TMO])) break; if (_sp > XB_SPIN_CAP) { atomicAdd(&(bar)[XB_TMO], 1u); break; } } } } while (0)
struct XcdBarrier { unsigned* bar; unsigned x; volatile LAS unsigned* st; };
__device__ __forceinline__ XcdBarrier xcd_barrier_post(unsigned* bar, volatile LAS unsigned* st) {
    XcdBarrier b; b.bar = bar; b.x = xb_xcc_id(); b.st = st;
    if (threadIdx.x == 0) (void)xb_add(&bar[XB_XCNT(b.x)], 1u);
    return b;
}
__device__ __forceinline__ void xcd_barrier_complete(unsigned* bar, unsigned x, unsigned& nloc, unsigned& nx) {
    const unsigned G = gridDim.x * gridDim.y * gridDim.z;
    unsigned sum, cnt, mine, sp = 0u;
    for (;;) {
        sum = 0u; cnt = 0u; mine = 0u;
#pragma unroll
        for (unsigned j = 0; j < 16; ++j) { const unsigned c = xb_ld(&bar[XB_XCNT(j)]); sum += c; cnt += (c > 0u) ? 1u : 0u; mine = (j == x) ? c : mine; }
        if (sum == G) break;
        __builtin_amdgcn_s_sleep(1);
        if ((++sp & 255u) == 0u) { if (xb_ld(&bar[XB_TMO])) break; if (sp > XB_SPIN_CAP) { atomicAdd(&bar[XB_TMO], 1u); break; } }
    }
    nloc = mine > 0u ? mine : 1u; nx = cnt > 0u ? cnt : 1u;
}
__device__ __forceinline__ void xcd_barrier(const XcdBarrier& b) {
    asm volatile("s_waitcnt vmcnt(0)" ::: "memory");
    __syncthreads();
    if (threadIdx.x == 0) {
        unsigned* bar = b.bar;
        __builtin_amdgcn_s_waitcnt(0);
        unsigned nloc = b.st[0], nx = b.st[1];
        if (nloc == 0u) { xcd_barrier_complete(bar, b.x, nloc, nx); b.st[0] = nloc; b.st[1] = nx; }
        const unsigned old = xb_add(&bar[XB_XSUB(b.x)], 1u);
        const unsigned gen = old / nloc;
        if (old + 1u == (gen + 1u) * nloc) {
            __builtin_amdgcn_fence(__ATOMIC_RELEASE, "agent");
            asm volatile("s_waitcnt vmcnt(0)" ::: "memory");
            const unsigned og = xb_add(&bar[XB_TOP], 1u);
            const unsigned tg = og / nx;
            if (og + 1u == (tg + 1u) * nx) xb_add(&bar[XB_TOPGEN], 1u);
            else XB_SPIN(xb_ld(&bar[XB_TOPGEN]) == tg, bar);
            __builtin_amdgcn_fence(__ATOMIC_ACQUIRE, "agent");
            xb_add(&bar[XB_XGEN(b.x)], 1u);
            asm volatile("s_waitcnt vmcnt(0)" ::: "memory");
        } else {
            XB_SPIN(xb_ld(&bar[XB_XGEN(b.x)]) == gen, bar);
            __builtin_amdgcn_fence(__ATOMIC_ACQUIRE, "agent");
            asm volatile("s_waitcnt vmcnt(0)" ::: "memory");
        }
    }
    __syncthreads();
}

struct Frame {
    LAS unsigned char* lds; unsigned char* ldsg;
    int tid, lane, wave, bid, vcu, G;
    unsigned char* ws;
};
enum { I_X = 0, I_NORM_MIX, I_W_IN, I_B_IN, I_M_NORM, I_A_NORM, I_LAM_QK, I_W_BM, I_W_BD, I_W_O, I_NORM_FFN, I_W_UP, I_CONV_W, I_CONV_B, I_W_DOWN, I_NORM_FINAL, I_OUT, I_NPTR };
constexpr int PTAB_OFF = 131072 + 256;
__device__ __forceinline__ const float* inp(const Frame& F, int i) {
    const LAS unsigned* t = (const LAS unsigned*)(F.lds + PTAB_OFF) + 2 * i;
    const unsigned lo = __builtin_amdgcn_readfirstlane(t[0]), hi = __builtin_amdgcn_readfirstlane(t[1]);
    return (const float*)(const GAS float*)(((unsigned long long)hi << 32) | lo);
}
template <int CTRL, int RM> __device__ __forceinline__ float dppf(float old, float src) {
    return __uint_as_float(__builtin_amdgcn_update_dpp(__float_as_uint(old), __float_as_uint(src), CTRL, RM, 0xf, false)); }
__device__ __forceinline__ float wave_sum(float v) {
    v += dppf<0xB1, 0xf>(0.f, v); v += dppf<0x4E, 0xf>(0.f, v); v += dppf<0x141, 0xf>(0.f, v); v += dppf<0x140, 0xf>(0.f, v);
    { auto rr = __builtin_amdgcn_permlane16_swap(__float_as_uint(v), __float_as_uint(v), false, false); v = __uint_as_float(rr[0]) + __uint_as_float(rr[1]); }
    { auto rr = __builtin_amdgcn_permlane32_swap(__float_as_uint(v), __float_as_uint(v), false, false); v = __uint_as_float(rr[0]) + __uint_as_float(rr[1]); }
    return v;
}
__device__ __forceinline__ float wave_scan_sum(float v) {
    v += dppf<0x111, 0xf>(0.f, v); v += dppf<0x112, 0xf>(0.f, v); v += dppf<0x114, 0xf>(0.f, v); v += dppf<0x118, 0xf>(0.f, v);
    v += dppf<0x142, 0xa>(0.f, v); v += dppf<0x143, 0xc>(0.f, v); return v;
}
__device__ __forceinline__ float wave_scan_max(float v) {
    const float NEG = -__builtin_inff();
    v = fmaxf(v, dppf<0x111, 0xf>(NEG, v)); v = fmaxf(v, dppf<0x112, 0xf>(NEG, v)); v = fmaxf(v, dppf<0x114, 0xf>(NEG, v)); v = fmaxf(v, dppf<0x118, 0xf>(NEG, v));
    v = fmaxf(v, dppf<0x142, 0xa>(NEG, v)); v = fmaxf(v, dppf<0x143, 0xc>(NEG, v)); return v;
}

struct CvtJob { const float* W; bf16* Bt; const float* gain; int Nsrc, K, k0, srccol0, dstrow0, rope; };
constexpr int IT_IN = 32 * 256, IT_SQ = 32 * 32, IT_UP = 32 * 176, IT_DN = 88 * 32, IT_LAYER = IT_IN + 3 * IT_SQ + IT_UP + IT_DN, IT_TOTAL = DEPTH * IT_LAYER, IT_A = IT_IN + 3 * IT_SQ;
__host__ __device__ __forceinline__ int tail_idle(int G) { const int nu = (MTOK / 256) * (NUP / 256), rounds = (nu + G - 1) / G, busy = nu - (rounds - 1) * G; const int idle = G - busy; return idle >= 64 ? idle : 0; }
__device__ __forceinline__ void cvt_decode(const Frame& F, int it, CvtJob& j) {
    const int l = it / IT_LAYER; int r = it - l * IT_LAYER; j.rope = 0; j.gain = nullptr;
    if (r < IT_IN) { const int nb = r >> 5, kt = r & 31, n0 = nb * 64;
        j.W = inp(F, I_W_IN) + (size_t)l * DM * NIN; j.Bt = (bf16*)(F.ws + WS_WIN + (size_t)l * SZ_WIN); j.Nsrc = NIN; j.K = DM; j.k0 = kt * 64; j.gain = inp(F, I_NORM_MIX) + (size_t)l * DM;
        j.srccol0 = n0 < GATE_COL ? n0 : n0 + 16; j.dstrow0 = n0; j.rope = (n0 >= 6144 && n0 < 10240 && (n0 & 127) == 0) ? 1 : 0; return; }
    r -= IT_IN;
    if (r < 3 * IT_SQ) { const int w = r / IT_SQ; r -= w * IT_SQ; const int nb = r >> 5, kt = r & 31;
        j.W = (w == 0 ? inp(F, I_W_BM) : (w == 1 ? inp(F, I_W_BD) : inp(F, I_W_O))) + (size_t)l * DM * DM;
        j.Bt = (bf16*)(F.ws + (w == 0 ? WS_WBM : (w == 1 ? WS_WBD : WS_WO)) + (size_t)l * SZ_WSQ); j.Nsrc = DM; j.K = DM; j.k0 = kt * 64; j.srccol0 = nb * 64; j.dstrow0 = nb * 64; return; }
    r -= 3 * IT_SQ;
    if (r < IT_UP) { const int nb = r >> 5, kt = r & 31, n0 = nb * 64, pn = n0 >> 8, w = n0 & 255;
        j.W = inp(F, I_W_UP) + (size_t)l * DM * NUP; j.Bt = (bf16*)(F.ws + WS_WUP + (size_t)l * SZ_WUP); j.Nsrc = NUP; j.K = DM; j.k0 = kt * 64; j.gain = inp(F, I_NORM_FFN) + (size_t)l * DM;
        j.srccol0 = (w < 128) ? pn * 128 + w : DFF + pn * 128 + (w - 128); j.dstrow0 = n0; return; }
    r -= IT_UP;
    { const int nb = r / 88, kt = r - nb * 88;
      j.W = inp(F, I_W_DOWN) + (size_t)l * DFF * DM; j.Bt = (bf16*)(F.ws + WS_WDN + (size_t)l * SZ_WDN); j.Nsrc = DM; j.K = DFF; j.k0 = kt * 64; j.srccol0 = nb * 64; j.dstrow0 = nb * 64; }
}
__device__ __forceinline__ void cvt_load(const CvtJob& j, int lane, f32x4 (&v)[16], float (&gn)[16]) {
    const float* p = j.W + (size_t)(j.k0 + (lane >> 4)) * j.Nsrc + j.srccol0 + (lane & 15) * 4;
#pragma unroll
    for (int i = 0; i < 16; ++i) v[i] = *(const f32x4*)(p + (size_t)(4 * i) * j.Nsrc);
#pragma unroll
    for (int i = 0; i < 16; ++i) gn[i] = j.gain ? j.gain[j.k0 + (lane >> 4) + 4 * i] : 1.0f;
}
__device__ __forceinline__ void cvt_store(const CvtJob& j, int lane, const f32x4 (&v)[16], const float (&gn)[16], LAS float* scr) {
#pragma unroll
    for (int i = 0; i < 16; ++i) { const int r = (lane >> 4) + 4 * i, n = (lane & 15) * 4; *(LAS f32x4*)(scr + r * 64 + (n ^ ((i >> 1) << 2))) = v[i] * gn[i]; }
    LDS_WAIT(); asm volatile("" ::: "memory");
    const int c = lane & 7;
#pragma unroll
    for (int i = 0; i < 8; ++i) { const int n = (lane >> 3) + 8 * i; const LAS float* s = scr + (8 * c) * 64 + (n ^ (c << 2));
        v4u o; o.x = pk2(s[0 * 64], s[1 * 64]); o.y = pk2(s[2 * 64], s[3 * 64]); o.z = pk2(s[4 * 64], s[5 * 64]); o.w = pk2(s[6 * 64], s[7 * 64]);
        int nd = n; if (j.rope && n < 32) nd = (n < 16) ? 2 * n : 2 * (n - 16) + 1;
        *(v4u*)(j.Bt + (size_t)(j.dstrow0 + nd) * j.K + j.k0 + 8 * c) = o; }
    LDS_WAIT(); asm volatile("" ::: "memory");
}
__device__ __forceinline__ void sincos_d(double ang, float& s, float& c) {
    const double TWO_PI = 6.283185307179586476925286766559; const double k = rint(ang / TWO_PI); const double r = ang - k * TWO_PI; const double r2 = r * r;
    double ts = 1.0, tc = 1.0, ss = 1.0, cc = 1.0;
#pragma unroll
    for (int i = 1; i <= 16; ++i) { tc = -tc * r2 / (double)((2 * i - 1) * (2 * i)); ts = -ts * r2 / (double)((2 * i) * (2 * i + 1)); cc += tc; ss += ts; }
    s = (float)(ss * r); c = (float)cc;
}
__device__ __forceinline__ void cvt_run(Frame& F, int it0, int n, int w, int nw) {
    LAS float* scr = (LAS float*)(F.lds + F.wave * 16384);
    const int per = (n + nw - 1) / nw; int it = it0 + w * per; const int it1 = (it + per < it0 + n) ? it + per : it0 + n;
    CvtJob j0, j1; f32x4 v0[16], v1[16]; float g0[16], g1[16];
    if (it < it1) { cvt_decode(F, it, j0); cvt_load(j0, F.lane, v0, g0); }
    for (; it < it1; it += 2) {
        if (it + 1 < it1) { cvt_decode(F, it + 1, j1); cvt_load(j1, F.lane, v1, g1); }
        cvt_store(j0, F.lane, v0, g0, scr);
        if (it + 1 >= it1) break;
        if (it + 2 < it1) { cvt_decode(F, it + 2, j0); cvt_load(j0, F.lane, v0, g0); }
        cvt_store(j1, F.lane, v1, g1, scr);
    }
}
__device__ __forceinline__ void p0_prologue(Frame& F) {
    const int gw = F.bid * NWAVES + F.wave, NGW = F.G * NWAVES;
    cvt_run(F, 0, tail_idle(F.G) ? IT_A : IT_LAYER, gw, NGW);
    const int gt = F.bid * 512 + F.tid, NGT = F.G * 512;
    { float* bg = (float*)(F.ws + WS_BIASG);
      for (int i = gt; i < DEPTH * NING; i += NGT) { const int l = i >> 14, n = i & (NING - 1); int src = n < GATE_COL ? n : n + 16;
          if (n >= 6144 && n < 10240 && (n & 127) < 32) { const int p = n & 127, dim = (p & 1) ? 16 + (p >> 1) : (p >> 1); src = (n & ~127) + dim + 16; }
          bg[i] = inp(F, I_B_IN)[(size_t)l * NIN + src]; } }
    { float* rp = (float*)(F.ws + WS_ROPE);
      for (int i = gt; i < SEQ * 16; i += NGT) { const int pos = i >> 4, k = i & 15; const double inv = exp2(-(double)k * (18.931568569324174 / 16.0));
          float s, c; sincos_d((double)pos * inv, s, c); rp[pos * 32 + k] = c; rp[pos * 32 + 16 + k] = s; } }
    { float* hdst = (float*)(F.ws + WS_H); bf16* xn = (bf16*)(F.ws + WS_XN); float* rb = (float*)(F.ws + WS_ROWSS_B); const float* x = inp(F, I_X);
      for (int row = gw; row < MTOK; row += NGW) { const f32x4* xr = (const f32x4*)(x + (size_t)row * DM) + F.lane; f32x4* hr = (f32x4*)(hdst + (size_t)row * DM) + F.lane; v2u* o8 = (v2u*)(xn + (size_t)row * DM) + F.lane; float ss = 0.f;
          f32x4 xv8[8];
#pragma unroll
          for (int j = 0; j < 8; ++j) xv8[j] = xr[64 * j];
#pragma unroll
          for (int j = 0; j < 8; ++j) { const f32x4 v = xv8[j]; hr[64 * j] = v; ss += (v.x * v.x + v.y * v.y) + (v.z * v.z + v.w * v.w); v2u w; w.x = pk2(v.x, v.y); w.y = pk2(v.z, v.w); o8[64 * j] = w; }
          ss = wave_sum(ss); if (F.lane == 0) rb[row] = ss; } }
}

__device__ __forceinline__ void gates_step(Frame& F, int l, gu32* cnt) {
    const float* wl = inp(F, I_W_IN) + (size_t)l * DM * NIN; const float* bl = inp(F, I_B_IN) + (size_t)l * NIN; const float* gain = inp(F, I_NORM_MIX) + (size_t)l * DM;
    const bf16* hb = (const bf16*)(F.ws + WS_XN); const float* rowss = (const float*)(F.ws + WS_ROWSS_B); float* gates = (float*)(F.ws + WS_GATES);
    LAS float* WT = (LAS float*)F.lds;
    for (int k = F.tid; k < DM; k += 512) { const f32x4* src = (const f32x4*)(wl + (size_t)k * NIN + GATE_COL); const float g = gain[k];
#pragma unroll
        for (int q = 0; q < 4; ++q) { const f32x4 a = src[q] * g; WT[(4 * q + 0) * DM + k] = a.x; WT[(4 * q + 1) * DM + k] = a.y; WT[(4 * q + 2) * DM + k] = a.z; WT[(4 * q + 3) * DM + k] = a.w; } }
    __syncthreads();
    const int gw = F.bid * NWAVES + F.wave, NGW = F.G * NWAVES;
    const float bgl = bl[GATE_COL + (F.lane & 15)];
    for (int rp = gw; rp < MTOK / 2; rp += NGW) {
        f32x4 xv[2][4][2];
#pragma unroll
        for (int r = 0; r < 2; ++r)
#pragma unroll
            for (int j = 0; j < 4; ++j) { const v4u w = *((const v4u*)(hb + (size_t)(2 * rp + r) * DM) + 64 * j + F.lane);
                xv[r][j][0] = (f32x4){pg8::bf_lo(w.x), pg8::bf_hi(w.x), pg8::bf_lo(w.y), pg8::bf_hi(w.y)}; xv[r][j][1] = (f32x4){pg8::bf_lo(w.z), pg8::bf_hi(w.z), pg8::bf_lo(w.w), pg8::bf_hi(w.w)}; }
        const float rs0 = 1.0f / sqrtf(rowss[2 * rp] * (1.0f / DM) + EPS), rs1 = 1.0f / sqrtf(rowss[2 * rp + 1] * (1.0f / DM) + EPS);
        float my0 = 0.f, my1 = 0.f;
#pragma unroll
        for (int c = 0; c < 16; ++c) { float a0 = 0.f, a1 = 0.f;
#pragma unroll
            for (int j = 0; j < 4; ++j)
#pragma unroll
                for (int hh = 0; hh < 2; ++hh) { const f32x4 w = *(const LAS f32x4*)(WT + c * DM + 512 * j + 8 * F.lane + 4 * hh);
                    a0 += (xv[0][j][hh].x * w.x + xv[0][j][hh].y * w.y) + (xv[0][j][hh].z * w.z + xv[0][j][hh].w * w.w);
                    a1 += (xv[1][j][hh].x * w.x + xv[1][j][hh].y * w.y) + (xv[1][j][hh].z * w.z + xv[1][j][hh].w * w.w); }
            const float s0 = wave_sum(a0), s1 = wave_sum(a1);
            if (F.lane == c) { my0 = s0; my1 = s1; }
            __builtin_amdgcn_sched_barrier(0); }
        if (F.lane < 16) { __hip_atomic_store(gates + (size_t)(2 * rp) * 16 + F.lane, my0 * rs0 + bgl, RLX_AGENT); __hip_atomic_store(gates + (size_t)(2 * rp + 1) * 16 + F.lane, my1 * rs1 + bgl, RLX_AGENT); }
    }
    VM_WAIT(); __syncthreads();
    if (F.tid == 0) __hip_atomic_fetch_add(cnt, 1u, RLX_AGENT);
}
__device__ __forceinline__ void gates_wait(Frame& F, gu32* cnt) {
    if (threadIdx.x == 0) { unsigned sp = 0; gu32* tmo = (gu32*)(F.ws + WS_CTL) + CW_TMO;
        while (__hip_atomic_load(cnt, RLX_AGENT) < (unsigned)F.G) { __builtin_amdgcn_s_sleep(2); if (++sp > (1u << 22)) { __hip_atomic_store(tmo, 1u, RLX_AGENT); break; } }
        __builtin_amdgcn_fence(__ATOMIC_ACQUIRE, "agent"); VM_WAIT(); }
    __syncthreads();
}

__device__ __forceinline__ float logsigmoidf_(float x) { return fminf(x, 0.f) - log1pf(__expf(-fabsf(x))); }
__device__ __forceinline__ void mlstm_prep(Frame& F, int b, int hh) {
    const float* gates = (const float*)(F.ws + WS_GATES);
    float* a2 = (float*)(F.ldsg + ab::A2_OFF); float* M2 = (float*)(F.ldsg + ab::M2_OFF); float* e2 = (float*)(F.ldsg + ab::E2_OFF); float* sc = (float*)(F.ldsg + ab::SCAN_OFF);
    int tid_ = F.tid; asm volatile("" : "+v"(tid_));
    const int lane_ = tid_ & 63;
    float lf[4], ig[4];
#pragma unroll
    for (int e = 0; e < 4; ++e) { const size_t idx = (size_t)(b * SEQ + 4 * tid_ + e) * 16; ig[e] = gates[idx + hh]; lf[e] = logsigmoidf_(gates[idx + 8 + hh]); }
    float c[4]; c[0] = lf[0]; c[1] = c[0] + lf[1]; c[2] = c[1] + lf[2]; c[3] = c[2] + lf[3];
    const float incl = wave_scan_sum(c[3]);
    if (lane_ == 63) sc[F.wave] = incl;
    __syncthreads();
    float wp = 0.f;
    for (int w = 0; w < F.wave; ++w) wp += sc[w];
    const float base = wp + incl - c[3];
    float Bv[4], av[4], mx[4];
#pragma unroll
    for (int e = 0; e < 4; ++e) { Bv[e] = base + c[e]; av[e] = ig[e] - Bv[e]; }
    mx[0] = av[0]; mx[1] = fmaxf(mx[0], av[1]); mx[2] = fmaxf(mx[1], av[2]); mx[3] = fmaxf(mx[2], av[3]);
    const float im = wave_scan_max(mx[3]);
    if (lane_ == 63) sc[16 + F.wave] = im;
    const float ex = dppf<0x138, 0xf>(-__builtin_inff(), im);
    __syncthreads();
    float wm = -__builtin_inff();
    for (int w = 0; w < F.wave; ++w) wm = fmaxf(wm, sc[16 + w]);
    const float pre = fmaxf(wm, ex);
    const float L2E = 1.4426950408889634f;
#pragma unroll
    for (int e = 0; e < 4; ++e) { const float M = fmaxf(pre, mx[e]); const int t = 4 * tid_ + e; a2[t] = av[e] * L2E; M2[t] = M * L2E; e2[t] = -(Bv[e] + M) * L2E; }
    __syncthreads();
}
__device__ __forceinline__ ab::BlockRef att_ref(Frame& F, int qt) {
    const int q = qt >> 8, t = qt & 255, hv = 16 * q + (t & 15), qb = 7 - (t >> 4), vh = hv & 1, c = (hv >> 1) & 1, hh = (hv >> 2) & 7, b = hv >> 5;
    ab::BlockRef r;
    r.Q = (const bf16*)(F.ws + WS_AQ) + (size_t)(b * SEQ + qb * 256) * 2048 + hh * 256 + c * 128;
    r.K = (const bf16*)(F.ws + WS_AK) + (size_t)(b * SEQ) * 2048 + hh * 256 + c * 128;
    r.V = (const bf16*)(F.ws + WS_AV) + (size_t)(b * SEQ) * 2048 + hh * 256 + vh * 128;
    r.O = (float*)((bf16*)(F.ws + WS_OATT) + (size_t)(b * SEQ + qb * 256) * 4096 + hh * 512 + c * 256 + vh * 128);
    r.P0 = qb * 256; r.Cst = nullptr; r.nst = nullptr; return r;
}
__device__ __forceinline__ ab::BlockRef mls_ref(Frame& F, int t) {
    const int bh = t >> 4, qb = (t >> 1) & 7, vh = t & 1, hh = bh & 7, b = bh >> 3;
    ab::BlockRef r;
    r.Q = (const bf16*)(F.ws + WS_MQ) + (size_t)(b * SEQ + qb * 256) * 1024 + hh * 128;
    r.K = (const bf16*)(F.ws + WS_MK) + (size_t)(b * SEQ) * 1024 + hh * 128;
    r.V = (const bf16*)(F.ws + WS_MV) + (size_t)(b * SEQ) * 2048 + hh * 256 + vh * 128;
    r.O = (float*)((bf16*)(F.ws + WS_HRAW) + (size_t)(b * SEQ + qb * 256) * 2048 + hh * 256 + vh * 128);
    r.P0 = qb * 256;
    r.Cst = qb ? (const bf16*)(F.ws + WS_CST) + ((size_t)(bh * 7 + qb - 1) * 128) * 256 + vh * 128 : nullptr;
    r.nst = qb ? (const float*)(F.ws + WS_NST) + (size_t)(bh * 7 + qb - 1) * 128 : nullptr;
    return r;
}
__device__ __forceinline__ ab::bf16x8 scale8(ab::bf16x8 v, float w) {
    ab::u32x4 q = *reinterpret_cast<ab::u32x4*>(&v); ab::u32x4 o;
    o.x = ab::cvtpk(__uint_as_float(q.x << 16) * w, __uint_as_float(q.x & 0xffff0000u) * w); o.y = ab::cvtpk(__uint_as_float(q.y << 16) * w, __uint_as_float(q.y & 0xffff0000u) * w);
    o.z = ab::cvtpk(__uint_as_float(q.z << 16) * w, __uint_as_float(q.z & 0xffff0000u) * w); o.w = ab::cvtpk(__uint_as_float(q.w << 16) * w, __uint_as_float(q.w & 0xffff0000u) * w);
    return *reinterpret_cast<ab::bf16x8*>(&o);
}
__device__ __forceinline__ float sum8(ab::bf16x8 v) {
    const ab::u32x4 q = *reinterpret_cast<const ab::u32x4*>(&v);
    return ((__uint_as_float(q.x << 16) + __uint_as_float(q.x & 0xffff0000u)) + (__uint_as_float(q.y << 16) + __uint_as_float(q.y & 0xffff0000u)))
         + ((__uint_as_float(q.z << 16) + __uint_as_float(q.z & 0xffff0000u)) + (__uint_as_float(q.w << 16) + __uint_as_float(q.w & 0xffff0000u)));
}
__device__ __forceinline__ void mls_scan(Frame& F, int bh, const int tid) {
    using namespace ab;
    char* lds = (char*)F.ldsg; const int b = bh >> 3, hh = bh & 7;
    const float* a2 = (const float*)(lds + A2_OFF); const float* M2 = (const float*)(lds + M2_OFF);
    const int wid = __builtin_amdgcn_readfirstlane(tid >> 6), lane = tid & 63, r32 = lane & 31, hi = lane >> 5, dgrp = wid & 3, vh = wid >> 2;
    const int sr = tid >> 4, sc = (tid & 15) * 8, vst0 = v_st(sr, sc), vst1 = v_st(32 + sr, sc);
    const bf16* Kp = (const bf16*)(F.ws + WS_MK) + (size_t)(b * SEQ) * 1024 + hh * 128;
    const bf16* Vp = (const bf16*)(F.ws + WS_MV) + (size_t)(b * SEQ) * 2048 + hh * 256;
    bf16* Cst = (bf16*)(F.ws + WS_CST) + (size_t)(bh * 7) * 128 * 256; float* nst = (float*)(F.ws + WS_NST) + (size_t)(bh * 7) * 128;
    const unsigned lok = (unsigned)((lane >> 4) * 1024 + sc), lov = (unsigned)((lane >> 4) * 2048 + sc);
    f32x16 C[4] = {}; float nacc = 0.f;
    const int vbA = (int)(uintptr_t)lds + v_rd_base(lane) + dgrp * 512;
    const int vbB = (int)(uintptr_t)lds + v_rd_base(lane) + 16384 * (1 + vh);
    bf16x8 ka[4], kb[4], va[4], vb[4], vc[4], vd[4];
#define SC_LOAD(i, s0) do { const bf16* kp_ = Kp + (size_t)((s0) + wid * 4) * 1024; const bf16* vp_ = Vp + (size_t)((s0) + wid * 4) * 2048; \
        ka[i] = load8(kp_ + lok); kb[i] = load8(kp_ + 32 * 1024 + lok); va[i] = load8(vp_ + lov); vb[i] = load8(vp_ + 32 * 2048 + lov); vc[i] = load8(vp_ + 128 + lov); vd[i] = load8(vp_ + 32 * 2048 + 128 + lov); } while (0)
#define SC_TRRD(dst, base, off) asm volatile("ds_read_b64_tr_b16 %0, %1 offset:%2" : "=&v"(dst) : "v"(base), "i"(off) : "memory")
#define SC_D0(d0) do { s16x4 l0, l1, l2, l3, h0, h1, h2, h3; constexpr int b_ = (d0) * 512; \
            SC_TRRD(l0, vbB, b_); SC_TRRD(h0, vbB, b_ + 2048); SC_TRRD(l1, vbB, b_ + 4096); SC_TRRD(h1, vbB, b_ + 6144); SC_TRRD(l2, vbB, b_ + 8192); SC_TRRD(h2, vbB, b_ + 10240); SC_TRRD(l3, vbB, b_ + 12288); SC_TRRD(h3, vbB, b_ + 14336); \
            asm volatile("s_waitcnt lgkmcnt(0)" ::: "memory"); SBAR(); \
            C[d0] = __builtin_amdgcn_mfma_f32_32x32x16_bf16(A0, (bf16x8){l0[0], l0[1], l0[2], l0[3], h0[0], h0[1], h0[2], h0[3]}, C[d0], 0, 0, 0); \
            C[d0] = __builtin_amdgcn_mfma_f32_32x32x16_bf16(A1, (bf16x8){l1[0], l1[1], l1[2], l1[3], h1[0], h1[1], h1[2], h1[3]}, C[d0], 0, 0, 0); \
            C[d0] = __builtin_amdgcn_mfma_f32_32x32x16_bf16(A2, (bf16x8){l2[0], l2[1], l2[2], l2[3], h2[0], h2[1], h2[2], h2[3]}, C[d0], 0, 0, 0); \
            C[d0] = __builtin_amdgcn_mfma_f32_32x32x16_bf16(A3, (bf16x8){l3[0], l3[1], l3[2], l3[3], h3[0], h3[1], h3[2], h3[3]}, C[d0], 0, 0, 0); } while (0)
#pragma unroll
    for (int i = 0; i < 4; ++i) SC_LOAD(i, 64 * i);
    for (int j = 0; j < 7; ++j) {
        const float mNew = M2[256 * (j + 1) - 1];
        if (j > 0) { const float dec = __builtin_amdgcn_exp2f(M2[256 * j - 1] - mNew);
#pragma unroll
            for (int d_ = 0; d_ < 4; ++d_)
#pragma unroll
                for (int r = 0; r < 16; ++r) C[d_][r] *= dec;
            nacc *= dec; }
#pragma unroll
        for (int tt = 0; tt < 4; ++tt) {
            const int s0 = 256 * j + 64 * tt;
            const float w0 = __builtin_amdgcn_exp2f(a2[s0 + sr] - mNew), w1 = __builtin_amdgcn_exp2f(a2[s0 + 32 + sr] - mNew);
            if (j < 6) { asm volatile("s_waitcnt vmcnt(18)" ::: "memory"); } else { asm volatile("s_waitcnt vmcnt(0)" ::: "memory"); }
            const bf16x8 ks0 = scale8(ka[tt], w0), ks1 = scale8(kb[tt], w1);
            __syncthreads();
            *(bf16x8*)(lds + vst0) = ks0; *(bf16x8*)(lds + vst1) = ks1;
            *(bf16x8*)(lds + 16384 + vst0) = va[tt]; *(bf16x8*)(lds + 16384 + vst1) = vb[tt]; *(bf16x8*)(lds + 32768 + vst0) = vc[tt]; *(bf16x8*)(lds + 32768 + vst1) = vd[tt];
            SBAR();
            if (j < 6) SC_LOAD(tt, s0 + 256);
            __syncthreads();
            s16x4 al0, ah0, al1, ah1, al2, ah2, al3, ah3;
            SC_TRRD(al0, vbA, 0); SC_TRRD(ah0, vbA, 2048); SC_TRRD(al1, vbA, 4096); SC_TRRD(ah1, vbA, 6144); SC_TRRD(al2, vbA, 8192); SC_TRRD(ah2, vbA, 10240); SC_TRRD(al3, vbA, 12288); SC_TRRD(ah3, vbA, 14336);
            asm volatile("s_waitcnt lgkmcnt(0)" ::: "memory"); SBAR();
            const bf16x8 A0 = (bf16x8){al0[0], al0[1], al0[2], al0[3], ah0[0], ah0[1], ah0[2], ah0[3]}, A1 = (bf16x8){al1[0], al1[1], al1[2], al1[3], ah1[0], ah1[1], ah1[2], ah1[3]};
            const bf16x8 A2 = (bf16x8){al2[0], al2[1], al2[2], al2[3], ah2[0], ah2[1], ah2[2], ah2[3]}, A3 = (bf16x8){al3[0], al3[1], al3[2], al3[3], ah3[0], ah3[1], ah3[2], ah3[3]};
            if (vh == 0) nacc += (sum8(A0) + sum8(A1)) + (sum8(A2) + sum8(A3));
            SC_D0(0); SC_D0(1); SC_D0(2); SC_D0(3);
        }
        { float nt = nacc; auto rr = __builtin_amdgcn_permlane32_swap(__float_as_uint(nt), __float_as_uint(nt), false, false); nt = __uint_as_float(rr[0]) + __uint_as_float(rr[1]);
          if (vh == 0 && hi == 0) nst[j * 128 + 32 * dgrp + r32] = nt; }
        bf16* Cj = Cst + ((size_t)j * 128 + 32 * dgrp) * 256 + 128 * vh; const unsigned loc = (unsigned)(4 * hi * 256 + r32);
#pragma unroll
        for (int r = 0; r < 16; ++r) { bf16* Cr = Cj + (size_t)((r & 3) + 8 * (r >> 2)) * 256;
#pragma unroll
            for (int d0 = 0; d0 < 4; ++d0) { const float v = C[d0][r]; const float nb = dppf<0xB1, 0xf>(0.f, v);
                if ((r32 & 1) == 0) *(unsigned*)(Cr + d0 * 32 + loc) = cvtpk(v, nb); } }
    }
#undef SC_LOAD
#undef SC_TRRD
#undef SC_D0
}
__device__ __forceinline__ void wait_word_ge(Frame& F, gu32* w, unsigned need) {
    if (threadIdx.x == 0) { unsigned sp = 0; gu32* tmo = (gu32*)(F.ws + WS_CTL) + CW_TMO;
        while (__hip_atomic_load(w, RLX_AGENT) < need) { __builtin_amdgcn_s_sleep(2); if (++sp > (1u << 22)) { __hip_atomic_store(tmo, 1u, RLX_AGENT); break; } }
        __builtin_amdgcn_fence(__ATOMIC_ACQUIRE, "agent"); VM_WAIT(); }
    __syncthreads();
}
__device__ __forceinline__ void mix_phase(Frame& F, int l, int rep) {
    char* lds = (char*)F.ldsg;
    constexpr int NMLS = 512, NSCAN = 32, NCVT = 64, NCVT1 = 32;
    gu32* ctl = (gu32*)(F.ws + WS_CTL);
    gu32* gcnt = ctl + CW_GCNT + 64 * (l + 4 * rep); gu32* sflag = ctl + CW_SFLAG + 64 * ((l + 4 * rep) * 32); gu32* tick = ctl + CW_TICK + 64 * (l + 4 * rep);
    gates_step(F, l, gcnt);
    { const bool tl = tail_idle(F.G) != 0; const int ncvt = (!tl || l == 0) ? NCVT : NCVT1;
      if (l + 1 < DEPTH && rep == 0 && F.bid >= NSCAN && F.bid < NSCAN + ncvt) {
        const int c0 = !tl ? (l + 1) * IT_LAYER : (l == 0 ? IT_A : (l + 1) * IT_LAYER), cn = !tl ? IT_LAYER : (l == 0 ? IT_LAYER : IT_A);
        cvt_run(F, c0, cn, (F.bid - NSCAN) * NWAVES + F.wave, ncvt * NWAVES);
        VM_WAIT(); __syncthreads();
      } }
    if (F.bid < NSCAN) {
        gates_wait(F, gcnt);
        int tid_s = threadIdx.x; asm volatile("" : "+v"(tid_s));
        mlstm_prep(F, F.bid >> 3, F.bid & 7);
        mls_scan(F, F.bid, tid_s);
        VM_WAIT(); __syncthreads();
        if (threadIdx.x == 0) { __builtin_amdgcn_fence(__ATOMIC_RELEASE, "agent"); VM_WAIT(); __hip_atomic_store(sflag + 64 * F.bid, 1u, RLX_AGENT); }
        __syncthreads();
    }
#ifndef NO_ATT
    { volatile LAS unsigned* tw = (volatile LAS unsigned*)(F.lds + MISC_OFF) + 16; gu32* atick = ctl + CW_ATICK + 64 * (8 * (l + 4 * rep));
      const int q0 = (int)(xb_xcc_id() & 7u); int qdone = 0;
#define TAKE_ATT(dst) do { if (threadIdx.x == 0) { int r_ = -1; for (int i_ = 0; i_ < 8; ++i_) { const int q_ = (q0 + i_) & 7; if (qdone & (1 << q_)) continue;               \
            const unsigned t_ = __hip_atomic_fetch_add(atick + 64 * q_, 1u, RLX_AGENT); if (t_ < 128u) { r_ = (q_ << 8) | (int)t_; break; } qdone |= 1 << q_; } tw[0] = (unsigned)r_; } \
        PP_BAR(); dst = __builtin_amdgcn_readfirstlane((int)tw[0]); PP_BAR(); } while (0)
      int qt; TAKE_ATT(qt);
      if (qt >= 0) {
          ab::BlockRef cur = att_ref(F, qt); ab::Seam S;
          int tid_a = threadIdx.x; asm volatile("" : "+v"(tid_a));
          ab::prime2<0, 2048, 2048, 2048>(cur, lds, S, tid_a);
          for (;;) {
              int qn; TAKE_ATT(qn);
              const bool last = qn < 0;
              const ab::BlockRef nxt = last ? cur : att_ref(F, qn);
              ab::block2<0, 2048, 2048, 2048, 4096>(cur, nxt, lds, S, tid_a);
              if (last) break;
              cur = nxt;
          }
          ab::pp_realign(tid_a);
      }
#undef TAKE_ATT
    }
#endif
    VM_WAIT(); __syncthreads();
#ifndef NO_MLS
    gates_wait(F, gcnt);
    { volatile LAS unsigned* tw = (volatile LAS unsigned*)(F.lds + MISC_OFF) + 16;
#define TAKE_TICKET(dst) do { if (threadIdx.x == 0) tw[0] = __hip_atomic_fetch_add(tick, 1u, RLX_AGENT); __syncthreads(); dst = __builtin_amdgcn_readfirstlane((int)tw[0]); __syncthreads(); } while (0)
      for (;;) {
          int t2; TAKE_TICKET(t2);
          if (t2 >= NMLS / 2) break;
          int tid_m = threadIdx.x; asm volatile("" : "+v"(tid_m));
          const int bh = t2 >> 3;
          mlstm_prep(F, bh >> 3, bh & 7); wait_word_ge(F, sflag + 64 * bh, 1u);
          const ab::BlockRef c0 = mls_ref(F, 2 * t2), c1 = mls_ref(F, 2 * t2 + 1); ab::Seam S;
          ab::prime2<1, 1024, 1024, 2048>(c0, lds, S, tid_m);
          ab::block2<1, 1024, 1024, 2048, 2048>(c0, c1, lds, S, tid_m);
          ab::block2<1, 1024, 1024, 2048, 2048>(c1, c1, lds, S, tid_m);
          ab::pp_realign(tid_m);
          VM_WAIT(); __syncthreads();
      }
#undef TAKE_TICKET
    }
    VM_WAIT(); __syncthreads();
#endif
}

__device__ __forceinline__ void fin_phase(Frame& F, int l) {
    const float* lq = inp(F, I_LAM_QK) + (size_t)l * 512;
    const float s1 = wave_sum(lq[F.lane] * lq[128 + F.lane] + lq[64 + F.lane] * lq[192 + F.lane]);
    const float s2 = wave_sum(lq[256 + F.lane] * lq[384 + F.lane] + lq[320 + F.lane] * lq[448 + F.lane]);
    const float lam_init = l == 0 ? 0.2f : (l == 1 ? 0.3555090675909693f : (l == 2 ? 0.4707130183435842f : 0.5560582041556406f));
    const float lam = expf(s1) - expf(s2) + lam_init, post = 1.0f - lam_init;
    const bf16* hraw = (const bf16*)(F.ws + WS_HRAW); const bf16* oat = (const bf16*)(F.ws + WS_OATT); const bf16* smo = (const bf16*)(F.ws + WS_SMO);
    bf16* hmn = (bf16*)(F.ws + WS_HMN); bf16* han = (bf16*)(F.ws + WS_HAN);
    { float* rowss = (float*)(F.ws + WS_ROWSS); float* rowsb = (float*)(F.ws + WS_ROWSS_B); for (int i = F.bid * 512 + F.tid; i < MTOK; i += F.G * 512) { rowss[i] = 0.f; rowsb[i] = 0.f; } }
    const int gw = F.bid * NWAVES + F.wave, NGW = F.G * NWAVES;
    const float* mg = inp(F, I_M_NORM) + (size_t)l * 2048; const float* ag = inp(F, I_A_NORM) + (size_t)l * 2048;
    f32x4 mgv[8], agv[8];
#pragma unroll
    for (int hh = 0; hh < 8; ++hh) { mgv[hh] = *(const f32x4*)(mg + hh * 256 + 4 * F.lane); agv[hh] = *(const f32x4*)(ag + hh * 256 + 4 * F.lane); }
    for (int row = gw; row < MTOK; row += NGW) {
        f32x4 hv[8], o0[8], o1[8]; v2u sw[8];
#pragma unroll
        for (int hh = 0; hh < 8; ++hh) { const v2u a = *(const v2u*)(hraw + (size_t)row * 2048 + hh * 256 + 4 * F.lane); hv[hh] = (f32x4){pg8::bf_lo(a.x), pg8::bf_hi(a.x), pg8::bf_lo(a.y), pg8::bf_hi(a.y)}; sw[hh] = *(const v2u*)(smo + (size_t)row * 2048 + hh * 256 + 4 * F.lane); }
#pragma unroll
        for (int hh = 0; hh < 8; ++hh) { const v2u a = *(const v2u*)(oat + (size_t)row * 4096 + hh * 512 + 4 * F.lane), c = *(const v2u*)(oat + (size_t)row * 4096 + hh * 512 + 256 + 4 * F.lane);
            o0[hh] = (f32x4){pg8::bf_lo(a.x), pg8::bf_hi(a.x), pg8::bf_lo(a.y), pg8::bf_hi(a.y)}; o1[hh] = (f32x4){pg8::bf_lo(c.x), pg8::bf_hi(c.x), pg8::bf_lo(c.y), pg8::bf_hi(c.y)}; }
#pragma unroll
        for (int hh = 0; hh < 8; ++hh) { const int col = hh * 256 + 4 * F.lane; const f32x4 v = hv[hh];
            const float rs = 1.0f / sqrtf(wave_sum((v.x * v.x + v.y * v.y) + (v.z * v.z + v.w * v.w)) * (1.0f / 256.0f) + EPS);
            const f32x4 g = mgv[hh]; const f32x4 sg = (f32x4){pg8::bf_lo(sw[hh].x), pg8::bf_hi(sw[hh].x), pg8::bf_lo(sw[hh].y), pg8::bf_hi(sw[hh].y)};
            const f32x4 o = v * rs * g * sg; v2u w; w.x = pk2(o.x, o.y); w.y = pk2(o.z, o.w); *(v2u*)(hmn + (size_t)row * 2048 + col) = w; }
#pragma unroll
        for (int hh = 0; hh < 8; ++hh) { const int col = hh * 256 + 4 * F.lane; const f32x4 v = o0[hh] - o1[hh] * lam;
            const float rs = 1.0f / sqrtf(wave_sum((v.x * v.x + v.y * v.y) + (v.z * v.z + v.w * v.w)) * (1.0f / 256.0f) + EPS);
            const f32x4 g = agv[hh];
            const f32x4 o = v * rs * g * post; v2u w; w.x = pk2(o.x, o.y); w.y = pk2(o.z, o.w); *(v2u*)(han + (size_t)row * 2048 + col) = w; }
    }
}

__device__ __forceinline__ void conv_fixup_panel(Frame& F, int l, int pm) {
    const float* fxc = (const float*)(F.ws + WS_FXC); const float* fxv = (const float*)(F.ws + WS_FXV); const float* fxg = (const float*)(F.ws + WS_FXG); bf16* u = (bf16*)(F.ws + WS_U);
    const float* cw = inp(F, I_CONV_W) + (size_t)l * 3 * DFF;
    constexpr int NI = 2 * 2 * (DFF / 4) / 512;
    static_assert(2 * 2 * (DFF / 4) == NI * 512, "fix-up item count");
#pragma unroll
    for (int i0 = 0; i0 < NI; i0 += 4) {
        f32x4 cp[4], vv[4], ga[4], gb[4], wa[4], wb[4]; int blkv[4], colv[4], rhov[4];
#pragma unroll
        for (int k = 0; k < 4; ++k) if (i0 + k < NI) { const int i = F.tid + (i0 + k) * 512, c4 = i % (DFF / 4), rr = i / (DFF / 4), rho = rr & 1, blk = pm * 2 + (rr >> 1), col = c4 * 4, pb = (blk & 15) ? blk - 1 : blk;
            blkv[k] = blk; colv[k] = col; rhov[k] = rho;
            cp[k] = *(const f32x4*)(fxc + ((size_t)blk * 2 + rho) * DFF + col); vv[k] = *(const f32x4*)(fxv + ((size_t)blk * 2 + rho) * DFF + col);
            ga[k] = *(const f32x4*)(fxg + ((size_t)pb * 2 + 1) * DFF + col); gb[k] = *(const f32x4*)(fxg + ((size_t)pb * 2) * DFF + col);
            wa[k] = *(const f32x4*)(cw + col); wb[k] = *(const f32x4*)(cw + DFF + col); }
#pragma unroll
        for (int k = 0; k < 4; ++k) if (i0 + k < NI) {
            if ((blkv[k] & 15) == 0) continue;
            const f32x4 cv = rhov[k] == 0 ? cp[k] + wb[k] * ga[k] + wa[k] * gb[k] : cp[k] + wa[k] * ga[k];
            f32x4 o;
#pragma unroll
            for (int j = 0; j < 4; ++j) o[j] = cv[j] * pg8::sigmoidf_fast(cv[j]) * vv[k][j];
            v2u w; w.x = pk2(o[0], o[1]); w.y = pk2(o[2], o[3]);
            *(v2u*)(u + ((size_t)blkv[k] * 128 + rhov[k]) * DFF + colv[k]) = w; }
    }
}

__device__ __forceinline__ void out_phase(Frame& F) {
    const float* h = (const float*)(F.ws + WS_H); const float* gf = inp(F, I_NORM_FINAL); float* out = (float*)inp(F, I_OUT);
    const int gw = F.bid * NWAVES + F.wave, NGW = F.G * NWAVES;
    f32x4 gv[8];
#pragma unroll
    for (int j = 0; j < 8; ++j) gv[j] = *((const f32x4*)gf + 64 * j + F.lane);
    for (int row = gw; row < MTOK; row += NGW) { const f32x4* xr = (const f32x4*)(h + (size_t)row * DM) + F.lane; f32x4 xv[8]; float ss = 0.f;
#pragma unroll
        for (int j = 0; j < 8; ++j) { xv[j] = xr[64 * j]; ss += (xv[j].x * xv[j].x + xv[j].y * xv[j].y) + (xv[j].z * xv[j].z + xv[j].w * xv[j].w); }
        const float rs = 1.0f / sqrtf(wave_sum(ss) * (1.0f / DM) + EPS); f32x4* o = (f32x4*)(out + (size_t)row * DM) + F.lane;
#pragma unroll
        for (int j = 0; j < 8; ++j) o[64 * j] = xv[j] * rs * gv[j]; }
}

__device__ __forceinline__ int nrep_opaque(int n) { asm volatile("" : "+s"(n)); return n; }
struct Args { const float* in[16]; float* out; unsigned char* ws; int ph_lo, ph_hi, li, pad; };
__global__ void __launch_bounds__(NWAVES * 64, 2) fwd(Args args) {
    extern __shared__ __attribute__((aligned(16))) unsigned char lds[];
    Frame F;
    F.lds = (LAS unsigned char*)lds; F.ldsg = lds;
    F.tid = threadIdx.x; F.lane = F.tid & 63; F.wave = __builtin_amdgcn_readfirstlane(F.tid >> 6);
    F.G = gridDim.x; F.bid = blockIdx.x; F.vcu = (F.G % 8 == 0) ? (F.bid % 8) * (F.G / 8) + F.bid / 8 : F.bid;
    F.ws = args.ws;
    volatile LAS unsigned* MISC = (volatile LAS unsigned*)(F.lds + MISC_OFF);
    for (int u = F.tid; u < 64; u += NWAVES * 64) MISC[u] = 0u;
    if (F.tid < I_NPTR) { const unsigned long long p = (F.tid == I_OUT) ? (unsigned long long)args.out : (unsigned long long)args.in[F.tid & 15];
        ((LAS unsigned*)(F.lds + PTAB_OFF))[2 * F.tid] = (unsigned)p; ((LAS unsigned*)(F.lds + PTAB_OFF))[2 * F.tid + 1] = (unsigned)(p >> 32); }
    __syncthreads();
    gu32* ctl = (gu32*)(F.ws + WS_CTL);
    XcdBarrier bar = xcd_barrier_post((unsigned*)(ctl + CW_BAR) + args.li * XCD_BAR_WORDS, MISC + 8);
    const int lo = args.ph_lo, hi = args.ph_hi;
#ifndef PH_MASK
#define PH_MASK 0xFFFF
#endif
#define EN(j) ((PH_MASK >> (j)) & 1)
#ifndef PROBE_REP
#define PROBE_REP 0
#endif
#define NREP(j) nrep_opaque(1 + ((PROBE_REP >> (j)) & 1))
#define IN(k) (lo <= (k) && (k) < hi)
#define LAUNDER() do { unsigned long long z_ = 0ull; asm volatile("" : "+s"(z_), "+s"(F.vcu), "+s"(F.bid), "+s"(F.G)); F.ws = args.ws + z_; F.tid = threadIdx.x; asm volatile("" : "+v"(F.tid)); F.lane = F.tid & 63; } while (0)
#define SEAM(k) do { if (IN(k) && IN((k) + 1)) xcd_barrier(bar); } while (0)
    if (EN(12) && IN(0)) { for (int rep_ = 0; rep_ < NREP(12); ++rep_) { LAUNDER(); p0_prologue(F); } SEAM(0); }
    for (int l = 0; l < DEPTH; ++l) {
        const int pb = 1 + l * NPH_L;
        bf16* XN = (bf16*)(F.ws + WS_XN);
        if (EN(0) && IN(pb + 0)) { for (int rep_ = 0; rep_ < NREP(0); ++rep_) { LAUNDER();
            pg8::Gemm g{XN, (const bf16*)(F.ws + WS_WIN + (size_t)l * SZ_WIN), MTOK, NING, DM, nullptr, nullptr}; pg8::StaticOrder S; S.init(MTOK, NING, F.G, F.bid);
            pg8::EpiInProj E{(bf16*)(F.ws + WS_MQ), (bf16*)(F.ws + WS_MK), (bf16*)(F.ws + WS_MV), (bf16*)(F.ws + WS_SMO), (bf16*)(F.ws + WS_AQ), (bf16*)(F.ws + WS_AK), (bf16*)(F.ws + WS_AV), (bf16*)(F.ws + WS_SG),
                             (const float*)(F.ws + WS_BIASG) + (size_t)l * NING, (const float*)(F.ws + WS_ROPE), (const float*)(F.ws + WS_ROWSS_B)};
            pg8::gemm_phase<pg8::EpiInProj, pg8::StaticOrder, true, true>(F.lds, g, S, E, F.tid);
            } SEAM(pb + 0); }
        if (EN(1) && IN(pb + 1)) { for (int rep_ = 0; rep_ < NREP(1); ++rep_) { LAUNDER(); mix_phase(F, l, rep_); } SEAM(pb + 1); }
        if (EN(2) && IN(pb + 2)) { for (int rep_ = 0; rep_ < NREP(2); ++rep_) { LAUNDER(); fin_phase(F, l); } SEAM(pb + 2); }
        if (EN(3) && IN(pb + 3)) { for (int rep_ = 0; rep_ < NREP(3); ++rep_) { LAUNDER();
            pg8::Gemm g{(const bf16*)(F.ws + WS_HMN), (const bf16*)(F.ws + WS_WBM + (size_t)l * SZ_WSQ), MTOK, DM, DM, (const bf16*)(F.ws + WS_HAN), (const bf16*)(F.ws + WS_WBD + (size_t)l * SZ_WSQ)};
            pg8::PairOrder S; S.init(MTOK, DM, F.G, F.bid);
            pg8::EpiMerge E{(bf16*)(F.ws + WS_Y), (const bf16*)(F.ws + WS_SG)};
            pg8::gemm_phase<pg8::EpiMerge, pg8::PairOrder, true, true>(F.lds, g, S, E, F.tid);
            } SEAM(pb + 3); }
        if (EN(4) && IN(pb + 4)) { for (int rep_ = 0; rep_ < NREP(4); ++rep_) { LAUNDER();
            pg8::Gemm g{(const bf16*)(F.ws + WS_Y), (const bf16*)(F.ws + WS_WO + (size_t)l * SZ_WSQ), MTOK, DM, DM, nullptr, nullptr}; pg8::StaticOrder S; S.init(MTOK, DM, F.G, F.bid);
            if (rep_ == 0) { pg8::EpiRes<true> E{(float*)(F.ws + WS_H), DM, XN, (float*)(F.ws + WS_ROWSS)};
            pg8::gemm_phase<pg8::EpiRes<true>, pg8::StaticOrder, false, true>(F.lds, g, S, E, F.tid); }
            else { pg8::EpiRes<false> E{(float*)(F.ws + WS_P), DM, nullptr, nullptr};
            pg8::gemm_phase<pg8::EpiRes<false>, pg8::StaticOrder, false, true>(F.lds, g, S, E, F.tid); }
            } SEAM(pb + 4); }
        if (EN(5) && IN(pb + 5)) { for (int rep_ = 0; rep_ < NREP(5); ++rep_) { LAUNDER();
            pg8::Gemm g{XN, (const bf16*)(F.ws + WS_WUP + (size_t)l * SZ_WUP), MTOK, NUP, DM, nullptr, nullptr}; pg8::StaticOrder S; S.init(MTOK, NUP, F.G, F.bid);
            pg8::EpiUpConv E{(bf16*)(F.ws + WS_U), DFF, (const float*)(F.ws + WS_ROWSS), inp(F, I_CONV_W) + (size_t)l * 3 * DFF, inp(F, I_CONV_B) + (size_t)l * DFF,
                             (float*)(F.ws + WS_FXC), (float*)(F.ws + WS_FXV), (float*)(F.ws + WS_FXG)};
            pg8::gemm_phase<pg8::EpiUpConv, pg8::StaticOrder, true, true, true>(F.lds, g, S, E, F.tid);
            { const int idle = tail_idle(F.G);
              if (idle && l + 1 < DEPTH && rep_ == 0 && F.bid >= F.G - idle) { VM_WAIT(); __syncthreads();
                  cvt_run(F, (l + 1) * IT_LAYER + IT_A, IT_LAYER - IT_A, (F.bid - (F.G - idle)) * NWAVES + F.wave, idle * NWAVES); VM_WAIT(); } }
            } SEAM(pb + 5); }
        if (EN(6) && IN(pb + 6)) { for (int rep_ = 0; rep_ < NREP(6); ++rep_) { LAUNDER();
            pg8::Gemm g{(const bf16*)(F.ws + WS_U), (const bf16*)(F.ws + WS_WDN + (size_t)l * SZ_WDN), MTOK, DM, DFF, nullptr, nullptr}; pg8::StaticOrder S; S.init(MTOK, DM, F.G, F.bid);
            { pg8::Unit fu; for (int i = 0; S.next(i, fu); ++i) conv_fixup_panel(F, l, fu.pm); VM_WAIT(); __syncthreads(); }
            if (rep_ == 0) { pg8::EpiRes<true> E{(float*)(F.ws + WS_H), DM, XN, (float*)(F.ws + WS_ROWSS_B)};
            pg8::gemm_phase<pg8::EpiRes<true>, pg8::StaticOrder, false, true>(F.lds, g, S, E, F.tid); }
            else { pg8::EpiRes<false> E{(float*)(F.ws + WS_P), DM, nullptr, nullptr};
            pg8::gemm_phase<pg8::EpiRes<false>, pg8::StaticOrder, false, true>(F.lds, g, S, E, F.tid); }
            } SEAM(pb + 6); }
    }
    if (EN(11) && IN(NPHASE - 1)) { LAUNDER(); out_phase(F); }
#undef IN
#undef SEAM
}

extern "C" void kernel_launch(void* const* d_in, const int* in_sizes, int n_in, void* d_out, int out_size, void* d_ws, size_t ws_size, hipStream_t stream) {
    static int grid = 0;
    if (grid == 0) {
        if (n_in != 16 || in_sizes[0] != MTOK * DM || out_size != MTOK * DM || ws_size < WS_END) {
            fprintf(stderr, "kernel_launch: unexpected shapes (n_in %d, in0 %d, out %d, ws %zu, need %zu)\n", n_in, n_in > 0 ? in_sizes[0] : -1, out_size, ws_size, (size_t)WS_END); grid = -1; return; }
        int dev = 0, cus = 0, per_cu = 0;
        if (hipGetDevice(&dev) != hipSuccess || hipDeviceGetAttribute(&cus, hipDeviceAttributeMultiprocessorCount, dev) != hipSuccess) { grid = -1; return; }
        if (hipFuncSetAttribute((const void*)fwd, hipFuncAttributeMaxDynamicSharedMemorySize, LDS_BYTES) != hipSuccess) { fprintf(stderr, "kernel_launch: hipFuncSetAttribute failed\n"); grid = -1; return; }
        if (hipOccupancyMaxActiveBlocksPerMultiprocessor(&per_cu, (const void*)fwd, NWAVES * 64, LDS_BYTES) != hipSuccess || per_cu < 1)
            fprintf(stderr, "kernel_launch: note: occupancy query reports %d workgroups per CU\n", per_cu);
        (void)hipGetLastError();
        grid = cus;
    }
    if (grid < 0) return;
    if (hipMemsetAsync((char*)d_ws + WS_CTL, 0, CTL_ZERO_BYTES, stream) != hipSuccess) return;
    Args a{};
    for (int i = 0; i < 16; ++i) a.in[i] = (const float*)d_in[i];
    a.out = (float*)d_out; a.ws = (unsigned char*)d_ws;
#if MK_SPLIT
    for (int p = 0; p < NPHASE; ++p) { a.ph_lo = p; a.ph_hi = p + 1; a.li = p; hipLaunchKernelGGL(fwd, dim3(grid), dim3(NWAVES * 64), LDS_BYTES, stream, a); }
#else
    a.ph_lo = 0; a.ph_hi = NPHASE; a.li = 0;
    hipLaunchKernelGGL(fwd, dim3(grid), dim3(NWAVES * 64), LDS_BYTES, stream, a);
#endif
    const hipError_t le = hipPeekAtLastError();
    if (le != hipSuccess) fprintf(stderr, "kernel_launch: launch failed: %s\n", hipGetErrorName(le));
}
```

```cpp
#include <hip/hip_runtime.h>
#include <cstdio>
#include <cstdint>

#ifndef MK_SPLIT
#define MK_SPLIT 0
#endif

namespace pg8 {
#define PG8_LAS __attribute__((address_space(3)))
typedef unsigned short bf16_t;
typedef short bf16x8 __attribute__((ext_vector_type(8)));
typedef float f32x4 __attribute__((ext_vector_type(4)));
typedef float f32x2 __attribute__((ext_vector_type(2)));
typedef unsigned u32x4 __attribute__((ext_vector_type(4)));
typedef unsigned u32x2 __attribute__((ext_vector_type(2)));
constexpr int BM = 256, BK = 64, HALF = 128, HTB = HALF * BK * 2, STAGE_BYTES = 8 * HTB, NXCD = 8, WGM = 8;

__host__ __device__ __forceinline__ int lds_byte(int r, int c) { const int st = (r >> 4) * 2 + (c >> 5), rr = r & 15, cc = c & 31, ob = rr * 64 + cc * 2; return st * 1024 + (ob ^ (((ob >> 9) & 1) << 5)); }
__host__ __device__ __forceinline__ void stage_rc(int b, int& R, int& C) { const int st = b / 1024, sb = b % 1024, swz = sb ^ (((sb >> 9) & 1) << 5); R = (st >> 1) * 16 + swz / 64; C = (st & 1) * 32 + (swz % 64) / 2; }
__host__ __device__ __forceinline__ int perm32(int rho) { const int n = rho >> 4, i = rho & 15; return 8 * (i >> 2) + 4 * n + (i & 3); }

struct Unit { int pm, pn, sel; };
struct Gemm { const bf16_t* A; const bf16_t* Bt; int M, N, K; const bf16_t* A1; const bf16_t* Bt1; };

struct StaticOrder {
    int nM, nN, nwg, G, c;
    __host__ __device__ __forceinline__ void init(int M, int N, int G_, int c_) { nM = M / BM; nN = N / BM; nwg = nM * nN; G = G_; c = c_; }
    __host__ __device__ __forceinline__ bool next(int i, Unit& u) const {
        const long L = (long)i * G + c; if (L >= nwg) return false;
        int wgid = (int)L; { const int q = nwg / NXCD, r = nwg % NXCD, xcd = wgid % NXCD, off = wgid / NXCD; wgid = (xcd < r ? xcd * (q + 1) : r * (q + 1) + (xcd - r) * q) + off; }
        const int nig = WGM * nN, gid = wgid / nig, fm = gid * WGM, gsz = (nM - fm) < WGM ? (nM - fm) : WGM;
        u.pm = fm + ((wgid % nig) % gsz); u.pn = (wgid % nig) / gsz; u.sel = 0; return true;
    }
    __device__ __forceinline__ void a_ready(const Unit&) const {}
    __device__ __forceinline__ void done(const Unit&) const {}
};
struct PairOrder : StaticOrder {
    __host__ __device__ __forceinline__ bool next(int i, Unit& u) const { if (!StaticOrder::next(i >> 1, u)) return false; u.sel = i & 1; return true; }
};

__device__ __forceinline__ unsigned cvt_pk_bf16(float lo, float hi) { unsigned r; asm volatile("v_cvt_pk_bf16_f32 %0, %1, %2" : "=v"(r) : "v"(lo), "v"(hi)); return r; }
__device__ __forceinline__ float bf_lo(unsigned w) { return __uint_as_float(w << 16); }
__device__ __forceinline__ float bf_hi(unsigned w) { return __uint_as_float(w & 0xffff0000u); }
__device__ __forceinline__ float sigmoidf_fast(float x) { return __builtin_amdgcn_rcpf(1.0f + __builtin_amdgcn_exp2f(-1.4426950408889634f * x)); }

struct EpiInProj {
    static constexpr bool PERM = true, AFTER_DRAIN = false, CHAIN = false;
    bf16_t *mq, *mk, *mv, *smo, *aq, *ak, *av, *sg; const float* bias; const float* rope; const float* rowss;
    __device__ __forceinline__ void operator()(const f32x4 (&acc)[2][2][4][2], const Unit& u, int wr, int wc, int fr, int fq) const {
        const int pn = u.pn; bf16_t* base; int ldc, colt, kind = 0; float sc = 1.f;
        if (pn < 4) { base = mq; ldc = 1024; colt = pn * 256; }
        else if (pn < 8) { base = mk; ldc = 1024; colt = (pn - 4) * 256; sc = 0.08838834764831845f; }
        else if (pn < 16) { base = mv; ldc = 2048; colt = (pn - 8) * 256; }
        else if (pn < 24) { base = smo; ldc = 2048; colt = (pn - 16) * 256; kind = 2; }
        else if (pn < 32) { base = aq; ldc = 2048; colt = (pn - 24) * 256; kind = 1; }
        else if (pn < 40) { base = ak; ldc = 2048; colt = (pn - 32) * 256; kind = 1; }
        else if (pn < 48) { base = av; ldc = 2048; colt = (pn - 40) * 256; }
        else { base = sg; ldc = 4096; colt = (pn - 48) * 256; kind = 2; }
        const int row0 = u.pm * BM + wr * 64 + fr, col0 = colt + wc * 32 + 8 * fq, bcol0 = pn * BM + wc * 32 + 8 * fq;
        f32x4 bv[2][2];
#pragma unroll
        for (int bj = 0; bj < 2; ++bj)
#pragma unroll
            for (int n = 0; n < 2; ++n) bv[bj][n] = *(const f32x4*)(bias + bcol0 + bj * HALF + 4 * n);
        const bool dorope = (kind == 1) && (wc == 0);
        float rsv[2][4];
#pragma unroll
        for (int ai = 0; ai < 2; ++ai)
#pragma unroll
            for (int m = 0; m < 4; ++m) rsv[ai][m] = rowss[row0 + ai * HALF + m * 16];
#pragma unroll
        for (int ai = 0; ai < 2; ++ai) {
            f32x4 cvv[4], svv[4];
#pragma unroll
            for (int m = 0; m < 4; ++m) { cvv[m] = (f32x4){1.f, 1.f, 1.f, 1.f}; svv[m] = (f32x4){0.f, 0.f, 0.f, 0.f}; }
            if (dorope) {
#pragma unroll
                for (int m = 0; m < 4; ++m) { const float* cs = rope + (size_t)((row0 + ai * HALF + m * 16) & 2047) * 32 + 4 * fq; cvv[m] = *(const f32x4*)cs; svv[m] = *(const f32x4*)(cs + 16); } }
#pragma unroll
            for (int m = 0; m < 4; ++m) { const int row = row0 + ai * HALF + m * 16; bf16_t* rowp = base + (size_t)row * ldc + col0;
                const float rs = 1.0f / sqrtf(rsv[ai][m] * (1.0f / 2048.0f) + 1e-6f);
                const f32x4 cv = cvv[m], sv = svv[m];
#pragma unroll
                for (int bj = 0; bj < 2; ++bj) { f32x4 v0 = (acc[ai][bj][m][0] * rs + bv[bj][0]) * sc, v1 = (acc[ai][bj][m][1] * rs + bv[bj][1]) * sc;
                    if (dorope) { f32x4 r0, r1;
                        r0[0] = v0[0] * cv[0] - v0[1] * sv[0]; r0[1] = v0[1] * cv[0] + v0[0] * sv[0]; r0[2] = v0[2] * cv[1] - v0[3] * sv[1]; r0[3] = v0[3] * cv[1] + v0[2] * sv[1];
                        r1[0] = v1[0] * cv[2] - v1[1] * sv[2]; r1[1] = v1[1] * cv[2] + v1[0] * sv[2]; r1[2] = v1[2] * cv[3] - v1[3] * sv[3]; r1[3] = v1[3] * cv[3] + v1[2] * sv[3];
                        v0 = r0; v1 = r1; }
                    if (kind == 2) {
#pragma unroll
                        for (int j = 0; j < 4; ++j) { v0[j] = sigmoidf_fast(v0[j]); v1[j] = sigmoidf_fast(v1[j]); } }
                    u32x4 w; w.x = cvt_pk_bf16(v0[0], v0[1]); w.y = cvt_pk_bf16(v0[2], v0[3]); w.z = cvt_pk_bf16(v1[0], v1[1]); w.w = cvt_pk_bf16(v1[2], v1[3]);
                    *(u32x4*)(rowp + bj * HALF) = w; } } }
    }
};
template <int CTRL> __device__ __forceinline__ f32x4 dpp4(const f32x4 v) { f32x4 r;
#pragma unroll
    for (int j = 0; j < 4; ++j) r[j] = __uint_as_float(__builtin_amdgcn_update_dpp(0u, __float_as_uint(v[j]), CTRL, 0xf, 0xf, false));
    return r; }
struct EpiUpConv {
    static constexpr bool PERM = true, AFTER_DRAIN = false, CHAIN = false;
    bf16_t* u; int ldc; const float* rowss; const float* cw; const float* cb; float *fxc, *fxv, *fxg;
    __device__ __forceinline__ void operator()(const f32x4 (&acc)[2][2][4][2], const Unit& un, int wr, int wc, int fr, int fq) const {
        const int col0 = un.pn * HALF + wc * 32 + 8 * fq, blk = un.pm * 2 + wr, rowb = blk * 128 + fr;
        f32x4 w0[2], w1[2], w2[2], bb[2];
#pragma unroll
        for (int n = 0; n < 2; ++n) { w0[n] = *(const f32x4*)(cw + col0 + 4 * n); w1[n] = *(const f32x4*)(cw + ldc + col0 + 4 * n); w2[n] = *(const f32x4*)(cw + 2 * ldc + col0 + 4 * n); bb[n] = *(const f32x4*)(cb + col0 + 4 * n); }
        f32x4 p1[2], p2[2];
        p1[0] = p1[1] = p2[0] = p2[1] = (f32x4){0.f, 0.f, 0.f, 0.f};
        float rsv[8];
#pragma unroll
        for (int q = 0; q < 8; ++q) rsv[q] = rowss[rowb + 16 * q];
#pragma unroll
        for (int q = 0; q < 8; ++q) { const int ai = q >> 2, m = q & 3, row = rowb + 16 * q;
            const float rs = 1.0f / sqrtf(rsv[q] * (1.0f / 2048.0f) + 1e-6f);
            u32x4 w;
#pragma unroll
            for (int n = 0; n < 2; ++n) { const f32x4 g = acc[ai][0][m][n] * rs, v = acc[ai][1][m][n] * rs;
                const f32x4 r1 = dpp4<0x121>(g), r2 = dpp4<0x122>(g);
                f32x4 g1, g2;
#pragma unroll
                for (int j = 0; j < 4; ++j) { g1[j] = fr >= 1 ? r1[j] : p1[n][j]; g2[j] = fr >= 2 ? r2[j] : p2[n][j]; }
                p1[n] = r1; p2[n] = r2;
                const f32x4 cv = w0[n] * g2 + w1[n] * g1 + w2[n] * g + bb[n];
                f32x4 o;
#pragma unroll
                for (int j = 0; j < 4; ++j) o[j] = cv[j] * sigmoidf_fast(cv[j]) * v[j];
                if (n == 0) { w.x = cvt_pk_bf16(o[0], o[1]); w.y = cvt_pk_bf16(o[2], o[3]); } else { w.z = cvt_pk_bf16(o[0], o[1]); w.w = cvt_pk_bf16(o[2], o[3]); }
                if (q == 0 && fr < 2) { *(f32x4*)(fxc + ((size_t)blk * 2 + fr) * ldc + col0 + 4 * n) = cv; *(f32x4*)(fxv + ((size_t)blk * 2 + fr) * ldc + col0 + 4 * n) = v; }
                if (q == 7 && fr >= 14) *(f32x4*)(fxg + ((size_t)blk * 2 + (fr - 14)) * ldc + col0 + 4 * n) = g; }
            *(u32x4*)(u + (size_t)row * ldc + col0) = w; }
    }
};
struct EpiMerge {
    static constexpr bool PERM = false, AFTER_DRAIN = false, CHAIN = true;
    bf16_t* y; const bf16_t* sg;
    __device__ __forceinline__ void mid(f32x4 (&acc)[2][2][4][2], const Unit& u, int wr, int wc, int fr, int fq) const {
        const int row0 = u.pm * BM + wr * 64 + fr, col0 = u.pn * BM + wc * 32 + 4 * fq;
#pragma unroll
        for (int ai = 0; ai < 2; ++ai)
#pragma unroll
            for (int m = 0; m < 4; ++m) { const int row = row0 + ai * HALF + m * 16;
                u32x2 gm[2][2], gd[2][2];
#pragma unroll
                for (int bj = 0; bj < 2; ++bj)
#pragma unroll
                    for (int n = 0; n < 2; ++n) { const int col = col0 + bj * HALF + n * 16; gm[bj][n] = *(const u32x2*)(sg + (size_t)row * 4096 + col); gd[bj][n] = *(const u32x2*)(sg + (size_t)row * 4096 + 2048 + col); }
#pragma unroll
                for (int bj = 0; bj < 2; ++bj)
#pragma unroll
                    for (int n = 0; n < 2; ++n) { const u32x2 a = gm[bj][n], d = gd[bj][n];
                        const f32x4 num = (f32x4){bf_lo(a.x), bf_hi(a.x), bf_lo(a.y), bf_hi(a.y)}, den = (f32x4){bf_lo(d.x), bf_hi(d.x), bf_lo(d.y), bf_hi(d.y)};
#pragma unroll
                        for (int j = 0; j < 4; ++j) acc[ai][bj][m][n][j] *= num[j] * __builtin_amdgcn_rcpf(fmaxf(den[j], 1e-30f)); } }
    }
    __device__ __forceinline__ void operator()(const f32x4 (&acc)[2][2][4][2], const Unit& u, int wr, int wc, int fr, int fq) const {
        const int row0 = u.pm * BM + wr * 64 + fr, col0 = u.pn * BM + wc * 32 + 4 * fq;
#pragma unroll
        for (int ai = 0; ai < 2; ++ai)
#pragma unroll
            for (int mp = 0; mp < 2; ++mp) {
                u32x2 gw[2][2][2];
#pragma unroll
                for (int mm = 0; mm < 2; ++mm)
#pragma unroll
                    for (int bj = 0; bj < 2; ++bj)
#pragma unroll
                        for (int n = 0; n < 2; ++n) gw[mm][bj][n] = *(const u32x2*)(sg + (size_t)(row0 + ai * HALF + (2 * mp + mm) * 16) * 4096 + 2048 + col0 + bj * HALF + n * 16);
#pragma unroll
                for (int mm = 0; mm < 2; ++mm)
#pragma unroll
                    for (int bj = 0; bj < 2; ++bj)
#pragma unroll
                        for (int n = 0; n < 2; ++n) { const int m = 2 * mp + mm, row = row0 + ai * HALF + m * 16, col = col0 + bj * HALF + n * 16;
                            const u32x2 g2 = gw[mm][bj][n]; f32x4 g = (f32x4){bf_lo(g2.x), bf_hi(g2.x), bf_lo(g2.y), bf_hi(g2.y)};
#pragma unroll
                            for (int j = 0; j < 4; ++j) g[j] = fmaxf(g[j], 1e-30f);
                            const f32x4 v = acc[ai][bj][m][n] * g;
                            u32x2 w; w.x = cvt_pk_bf16(v[0], v[1]); w.y = cvt_pk_bf16(v[2], v[3]); *(u32x2*)(y + (size_t)row * 2048 + col) = w; }
                asm volatile("" ::: "memory"); }
    }
};
template <bool STATS> struct EpiRes {
    static constexpr bool PERM = false, AFTER_DRAIN = false, CHAIN = false;
    float* h; int ldc; bf16_t* hb; float* rowss;
    __device__ __forceinline__ void operator()(const f32x4 (&acc)[2][2][4][2], const Unit& u, int wr, int wc, int fr, int fq) const {
        const int row0 = u.pm * BM + wr * 64 + fr, col0 = u.pn * BM + wc * 32 + 4 * fq;
#pragma unroll
        for (int ai = 0; ai < 2; ++ai)
#pragma unroll
            for (int mp = 0; mp < 2; ++mp) {
                f32x4 hv[2][2][2];
#pragma unroll
                for (int mm = 0; mm < 2; ++mm)
#pragma unroll
                    for (int bj = 0; bj < 2; ++bj)
#pragma unroll
                        for (int n = 0; n < 2; ++n) hv[mm][bj][n] = *(const f32x4*)(h + (size_t)(row0 + ai * HALF + (2 * mp + mm) * 16) * ldc + col0 + bj * HALF + n * 16);
#pragma unroll
                for (int mm = 0; mm < 2; ++mm) { const int m = 2 * mp + mm, row = row0 + ai * HALF + m * 16; float* rowp = h + (size_t)row * ldc + col0; float ss = 0.f;
#pragma unroll
                    for (int bj = 0; bj < 2; ++bj)
#pragma unroll
                        for (int n = 0; n < 2; ++n) { const f32x4 v = hv[mm][bj][n] + acc[ai][bj][m][n]; *(f32x4*)(rowp + bj * HALF + n * 16) = v;
                            if (STATS) { ss += (v[0] * v[0] + v[1] * v[1]) + (v[2] * v[2] + v[3] * v[3]); u32x2 w; w.x = cvt_pk_bf16(v[0], v[1]); w.y = cvt_pk_bf16(v[2], v[3]);
                                *(u32x2*)(hb + (size_t)row * ldc + col0 + bj * HALF + n * 16) = w; } }
                    if (STATS) {
                        { auto rr = __builtin_amdgcn_permlane16_swap(__float_as_uint(ss), __float_as_uint(ss), false, false); ss = __uint_as_float(rr[0]) + __uint_as_float(rr[1]); }
                        { auto rr = __builtin_amdgcn_permlane32_swap(__float_as_uint(ss), __float_as_uint(ss), false, false); ss = __uint_as_float(rr[0]) + __uint_as_float(rr[1]); }
                        if (fq == 0) __hip_atomic_fetch_add(rowss + row, ss, __ATOMIC_RELAXED, __HIP_MEMORY_SCOPE_AGENT); } }
                asm volatile("" ::: "memory"); }
    }
};

template <class Epi, class Sched, bool ALIGN_EPI = false, bool SP2 = false, bool APERM = false>
__device__ __forceinline__ void gemm_phase(PG8_LAS unsigned char* lds, const Gemm g, const Sched& S, const Epi& E, const int tid) {
    const int wid = __builtin_amdgcn_readfirstlane(tid >> 6), lane = tid & 63, wr = wid >> 2, wc = wid & 3, fr = lane & 15, fq = lane >> 4;
    const int K = g.K, nt = K / BK;
    unsigned voffA[2], voffB[2];
#pragma unroll
    for (int i = 0; i < 2; ++i) { int R, C; stage_rc(tid * 16 + i * 8192, R, C); const int Rb = Epi::PERM ? ((R & ~31) + perm32(R & 31)) : R;
        const int Ra = APERM ? ((R >> 6) * 128 + (R & 63)) : R;
        voffA[i] = (unsigned)(Ra * K + C) * 2u; voffB[i] = (unsigned)(Rb * K + C) * 2u; }
    const size_t kstep = (size_t)(BK * 2);
    const size_t hstep = (size_t)HALF * K * 2;
    const size_t hstepA = APERM ? (size_t)64 * K * 2 : hstep;
    const size_t tstep = 2 * hstep;
    const unsigned ldsw = (unsigned)wid * 1024u;
    const int aoff = lds_byte(wr * 64 + fr, fq * 8), boff = lds_byte(wc * 32 + fr, fq * 8);
#define PG8_SA(b, h) (((b) * 2 + (h)) * HTB)
#define PG8_SB(b, h) ((4 + (b) * 2 + (h)) * HTB)
#define PG8_STAGE(bufoff, gbase, voff) do { _Pragma("unroll") for (int _i = 0; _i < 2; ++_i) \
        __builtin_amdgcn_global_load_lds((const unsigned*)((const char*)(gbase) + (voff)[_i]), (PG8_LAS unsigned*)(lds + (bufoff) + ldsw + _i * 8192), 16, 0, 0); } while (0)
#define PG8_LDA(dst, b, h) do { _Pragma("unroll") for (int m = 0; m < 4; ++m) _Pragma("unroll") for (int k = 0; k < 2; ++k) dst[m][k] = *(const PG8_LAS bf16x8*)(lds + PG8_SA(b, h) + aoff + m * 2048 + k * 1024); } while (0)
#define PG8_LDB(dst, b, h) do { _Pragma("unroll") for (int n = 0; n < 2; ++n) _Pragma("unroll") for (int k = 0; k < 2; ++k) dst[n][k] = *(const PG8_LAS bf16x8*)(lds + PG8_SB(b, h) + boff + n * 2048 + k * 1024); } while (0)
#define PG8_MMA(ai, bj, At, Bt) do { __builtin_amdgcn_s_setprio(1); _Pragma("unroll") for (int m = 0; m < 4; ++m) _Pragma("unroll") for (int n = 0; n < 2; ++n) _Pragma("unroll") for (int k = 0; k < 2; ++k) \
        acc[ai][bj][m][n] = __builtin_amdgcn_mfma_f32_16x16x32_bf16(Bt[n][k], At[m][k], acc[ai][bj][m][n], 0, 0, 0); __builtin_amdgcn_s_setprio(0); } while (0)
#define PG8_WAIT_V(n) asm volatile("s_waitcnt vmcnt(" #n ")" ::: "memory")
#define PG8_WAIT_L(n) asm volatile("s_waitcnt lgkmcnt(" #n ")" ::: "memory")
#define PG8_BAR __builtin_amdgcn_s_barrier()
#define PG8_SCHED __builtin_amdgcn_sched_barrier(0)
    Unit cur, nxt; int ui = 0;
    if (!S.next(0, cur)) return;
    f32x4 acc[2][2][4][2];
#pragma unroll
    for (int a = 0; a < 2; ++a)
#pragma unroll
        for (int b = 0; b < 2; ++b)
#pragma unroll
            for (int m = 0; m < 4; ++m)
#pragma unroll
                for (int n = 0; n < 2; ++n) acc[a][b][m][n] = (f32x4){0.f, 0.f, 0.f, 0.f};
    bf16x8 At[4][2], B0[2][2], B1[2][2];
    const char* cA = (const char*)(cur.sel ? g.A1 : g.A) + (size_t)cur.pm * tstep; const char* cB = (const char*)(cur.sel ? g.Bt1 : g.Bt) + (size_t)cur.pn * tstep;
    S.a_ready(cur);
    if constexpr (SP2) {
        PG8_STAGE(PG8_SB(0, 0), cB, voffB); PG8_STAGE(PG8_SB(0, 1), cB + hstep, voffB); PG8_STAGE(PG8_SA(0, 0), cA, voffA); PG8_STAGE(PG8_SA(0, 1), cA + hstepA, voffA);
        if (wr == 1) PG8_BAR;
        PG8_WAIT_V(2); PG8_BAR;
        PG8_STAGE(PG8_SB(1, 0), cB + kstep, voffB); PG8_STAGE(PG8_SA(1, 0), cA + kstep, voffA); PG8_STAGE(PG8_SB(1, 1), cB + hstep + kstep, voffB);
        PG8_WAIT_V(6); PG8_BAR;
    } else {
        PG8_STAGE(PG8_SB(0, 0), cB, voffB); PG8_STAGE(PG8_SA(0, 0), cA, voffA); PG8_STAGE(PG8_SB(0, 1), cB + hstep, voffB); PG8_STAGE(PG8_SA(0, 1), cA + hstepA, voffA);
        if (wr == 1) PG8_BAR;
        PG8_WAIT_V(4); PG8_BAR;
        PG8_STAGE(PG8_SB(1, 0), cB + kstep, voffB); PG8_STAGE(PG8_SA(1, 0), cA + kstep, voffA); PG8_STAGE(PG8_SB(1, 1), cB + hstep + kstep, voffB);
        PG8_WAIT_V(6); PG8_BAR;
    }
    for (;;) {
        const bool has_next = S.next(ui + 1, nxt);
        const char* nA = has_next ? (const char*)(nxt.sel ? g.A1 : g.A) + (size_t)nxt.pm * tstep : cA; const char* nB = has_next ? (const char*)(nxt.sel ? g.Bt1 : g.Bt) + (size_t)nxt.pn * tstep : cB;
        for (int t = 0; t < nt; t += 2) {
            const bool last = (t == nt - 2);
            const char* a1 = cA + (size_t)(t + 1) * kstep;
            const char* a2 = last ? nA : cA + (size_t)(t + 2) * kstep; const char* b2 = last ? nB : cB + (size_t)(t + 2) * kstep;
            const char* a3 = a2 + kstep; const char* b3 = b2 + kstep;
            if (last && has_next) S.a_ready(nxt);
            if constexpr (SP2) {
            PG8_LDB(B0, 0, 0); PG8_LDB(B1, 0, 1); PG8_SCHED; PG8_LDA(At, 0, 0); PG8_STAGE(PG8_SA(1, 1), a1 + hstepA, voffA);
            PG8_WAIT_V(8); PG8_WAIT_L(0); PG8_BAR; PG8_MMA(0, 0, At, B0); PG8_MMA(0, 1, At, B1); PG8_BAR; PG8_SCHED;
            PG8_LDA(At, 0, 1); PG8_STAGE(PG8_SB(0, 0), b2, voffB); PG8_STAGE(PG8_SB(0, 1), b2 + hstep, voffB); PG8_STAGE(PG8_SA(0, 0), a2, voffA);
            PG8_WAIT_V(8); PG8_WAIT_L(0); PG8_BAR; PG8_MMA(1, 0, At, B0); PG8_MMA(1, 1, At, B1); PG8_BAR; PG8_SCHED;
            PG8_LDB(B0, 1, 0); PG8_LDB(B1, 1, 1); PG8_SCHED; PG8_LDA(At, 1, 0); PG8_STAGE(PG8_SA(0, 1), a2 + hstepA, voffA);
            PG8_WAIT_V(8); PG8_WAIT_L(0); PG8_BAR; PG8_MMA(0, 0, At, B0); PG8_MMA(0, 1, At, B1); PG8_BAR; PG8_SCHED;
            PG8_LDA(At, 1, 1); PG8_STAGE(PG8_SB(1, 0), b3, voffB); PG8_STAGE(PG8_SB(1, 1), b3 + hstep, voffB); PG8_STAGE(PG8_SA(1, 0), a3, voffA);
            PG8_WAIT_V(8); PG8_WAIT_L(0); PG8_BAR; PG8_MMA(1, 0, At, B0); PG8_MMA(1, 1, At, B1); PG8_BAR; PG8_SCHED;
            } else {
            PG8_LDB(B0, 0, 0); PG8_SCHED; PG8_LDA(At, 0, 0); PG8_STAGE(PG8_SA(1, 1), a1 + hstepA, voffA);
            PG8_WAIT_L(8); PG8_BAR; PG8_WAIT_L(0); PG8_MMA(0, 0, At, B0); PG8_BAR; PG8_SCHED;
            PG8_LDB(B1, 0, 1); PG8_STAGE(PG8_SB(0, 0), b2, voffB);
            PG8_BAR; PG8_WAIT_L(0); PG8_MMA(0, 1, At, B1); PG8_BAR;
            PG8_LDA(At, 0, 1); PG8_STAGE(PG8_SA(0, 0), a2, voffA);
            PG8_BAR; PG8_WAIT_L(0); PG8_MMA(1, 0, At, B0); PG8_BAR; PG8_SCHED;
            PG8_STAGE(PG8_SB(0, 1), b2 + hstep, voffB);
            PG8_WAIT_V(6); PG8_BAR; PG8_MMA(1, 1, At, B1); PG8_BAR;
            PG8_LDB(B0, 1, 0); PG8_SCHED; PG8_LDA(At, 1, 0); PG8_STAGE(PG8_SA(0, 1), a2 + hstepA, voffA);
            PG8_WAIT_L(8); PG8_BAR; PG8_WAIT_L(0); PG8_MMA(0, 0, At, B0); PG8_BAR; PG8_SCHED;
            PG8_LDB(B1, 1, 1); PG8_STAGE(PG8_SB(1, 0), b3, voffB);
            PG8_BAR; PG8_WAIT_L(0); PG8_MMA(0, 1, At, B1); PG8_BAR;
            PG8_LDA(At, 1, 1); PG8_STAGE(PG8_SA(1, 0), a3, voffA);
            PG8_BAR; PG8_WAIT_L(0); PG8_MMA(1, 0, At, B0); PG8_BAR; PG8_SCHED;
            PG8_STAGE(PG8_SB(1, 1), b3 + hstep, voffB);
            PG8_WAIT_V(6); PG8_BAR; PG8_MMA(1, 1, At, B1); PG8_BAR;
            }
        }
        if constexpr (ALIGN_EPI) { if (wr == 0) PG8_BAR; }
        bool chained = false;
        if constexpr (Epi::CHAIN) { if (cur.sel == 0) { E.mid(acc, cur, wr, wc, fr, fq); chained = true; } }
        if (!chained) { E(acc, cur, wr, wc, fr, fq); S.done(cur); }
        if (!has_next) break;
        if (!chained) {
#pragma unroll
        for (int a = 0; a < 2; ++a)
#pragma unroll
            for (int b = 0; b < 2; ++b)
#pragma unroll
                for (int m = 0; m < 4; ++m)
#pragma unroll
                    for (int n = 0; n < 2; ++n) acc[a][b][m][n] = (f32x4){0.f, 0.f, 0.f, 0.f};
        }
        cur = nxt; cA = nA; cB = nB; ++ui;
        if constexpr (ALIGN_EPI) { if (wr == 1) PG8_BAR; }
    }
    PG8_WAIT_V(0);
    if constexpr (!ALIGN_EPI) { if (wr == 0) PG8_BAR; }
    PG8_BAR;
#undef PG8_SA
#undef PG8_SB
#undef PG8_STAGE
#undef PG8_LDA
#undef PG8_LDB
#undef PG8_MMA
#undef PG8_WAIT_V
#undef PG8_WAIT_L
#undef PG8_BAR
#undef PG8_SCHED
}
}

namespace ab {
typedef unsigned short bf16;
typedef short bf16x8 __attribute__((ext_vector_type(8)));
typedef short s16x4 __attribute__((ext_vector_type(4)));
typedef float f32x16 __attribute__((ext_vector_type(16)));
typedef float f32x4 __attribute__((ext_vector_type(4)));
typedef unsigned u32x4 __attribute__((ext_vector_type(4)));
constexpr int D = 128, NW = 8, QBLK = 32, KVBLK = 64, QB = NW * QBLK;
constexpr int SHM_V = KVBLK * D * 2, SHM_K = KVBLK * D * 2;
constexpr int BODY_LDS = 2 * SHM_V + 2 * SHM_K + NW * 64 * 4;
constexpr int A2_OFF = BODY_LDS, M2_OFF = A2_OFF + 8192, E2_OFF = M2_OFF + 8192, SCAN_OFF = E2_OFF + 8192, LDS_NEED = SCAN_OFF + 256;
constexpr float SCALE = 0.08838834764831845f, THR = 8.f;
#define KSWZ(row, colB) ((row) * 256 + ((colB) ^ (((row) & 7) << 4)))
#define SBAR() __builtin_amdgcn_sched_barrier(0)
__device__ __forceinline__ int v_st(int k, int c) { const int kk = (k & ~0xC) | ((k & 4) << 1) | ((k & 8) >> 1); return ((kk >> 3) * 4 + (c >> 5)) * 512 + ((kk & 7) * 32 + (c & 31)) * 2; }
__device__ __forceinline__ int v_rd_base(int lane) { return ((lane & 3) << 3) | (((lane >> 2) & 3) << 6) | (((lane >> 4) & 1) << 5) | (((lane >> 5) & 1) << 8); }
constexpr int v_rd_off(int d0, int ks, int half) { return d0 * 512 + ks * 4096 + half * 2048; }
__device__ __forceinline__ int crow(int r, int hi) { return (r & 3) + 8 * (r >> 2) + 4 * hi; }
__device__ __forceinline__ unsigned cvtpk(float lo, float hi) { unsigned r; asm volatile("v_cvt_pk_bf16_f32 %0, %1, %2" : "=v"(r) : "v"(lo), "v"(hi)); return r; }
__device__ __forceinline__ bf16x8 load8(const bf16* p) { return *reinterpret_cast<const bf16x8*>(p); }
template <int MODE> __device__ __forceinline__ void mask_tile(f32x16& p0, f32x16& p1, int dq) {
    const float NEG = MODE == 0 ? -__builtin_inff() : 0.f;
#pragma unroll
    for (int r = 0; r < 16; ++r) { const int c = (r & 3) + 8 * (r >> 2);
        if (dq - c < 0) p0[r] = NEG;
        if (dq - c - 32 < 0) p1[r] = NEG; }
}
__device__ __forceinline__ void partialSM(f32x16& p0, f32x16& p1, float& m_reg, float& mn, float& alpha) {
    float pmax = p0[0];
#pragma unroll
    for (int r = 1; r < 16; ++r) pmax = fmaxf(pmax, p0[r]);
#pragma unroll
    for (int r = 0; r < 16; ++r) pmax = fmaxf(pmax, p1[r]);
    { auto rr = __builtin_amdgcn_permlane32_swap(__float_as_uint(pmax), __float_as_uint(pmax), false, false);
      pmax = fmaxf(__uint_as_float(rr[0]), __uint_as_float(rr[1])); }
    constexpr float C2 = 1.4426950408889634f * SCALE;
    if (__builtin_expect(__all((pmax - m_reg) * SCALE <= THR), 1)) { mn = m_reg; alpha = 1.f; }
    else { mn = fmaxf(m_reg, pmax); alpha = __builtin_amdgcn_exp2f((m_reg - mn) * C2); m_reg = mn; }
    const float mnL = -mn * C2;
#pragma unroll
    for (int r = 0; r < 16; ++r) p0[r] = fmaf(p0[r], C2, mnL);
#pragma unroll
    for (int r = 0; r < 16; ++r) p1[r] = fmaf(p1[r], C2, mnL);
#pragma unroll
    for (int r = 0; r < 16; ++r) p0[r] = __builtin_amdgcn_exp2f(p0[r]);
}
__device__ __forceinline__ void partialM(f32x16& p0, f32x16& p1, const float* a2k, float M2t, int hi) {
#pragma unroll
    for (int g = 0; g < 4; ++g) { const f32x4 a = *(const f32x4*)(a2k + 8 * g + 4 * hi);
#pragma unroll
        for (int j = 0; j < 4; ++j) p0[4 * g + j] *= __builtin_amdgcn_exp2f(fminf(a[j] - M2t, 0.f)); }
    SBAR();
#pragma unroll
    for (int g = 0; g < 4; ++g) { const f32x4 b = *(const f32x4*)(a2k + 32 + 8 * g + 4 * hi);
#pragma unroll
        for (int j = 0; j < 4; ++j) p1[4 * g + j] *= __builtin_amdgcn_exp2f(fminf(b[j] - M2t, 0.f)); }
}
#define AB_PK4(P, B_, OUT) do { unsigned a0 = cvtpk(P[B_+0], P[B_+1]), a1 = cvtpk(P[B_+2], P[B_+3]);                          \
        unsigned b0 = cvtpk(P[B_+4], P[B_+5]), b1 = cvtpk(P[B_+6], P[B_+7]);                                             \
        auto r0 = __builtin_amdgcn_permlane32_swap(a0, b0, false, false); auto r1 = __builtin_amdgcn_permlane32_swap(a1, b1, false, false); \
        u32x4 w = {r0[0], r1[0], r0[1], r1[1]}; OUT = *reinterpret_cast<bf16x8*>(&w); } while (0)
template <int MODE> __device__ __forceinline__ void finishSM(f32x16& p0, f32x16& p1, float alpha, float& l_reg, bf16x8& pa0, bf16x8& pa1, bf16x8& pa2, bf16x8& pa3) {
    if (MODE == 0) {
#pragma unroll
        for (int r = 0; r < 16; ++r) p1[r] = __builtin_amdgcn_exp2f(p1[r]); }
    float ps = 0;
#pragma unroll
    for (int r = 0; r < 16; ++r) ps += p0[r];
#pragma unroll
    for (int r = 0; r < 16; ++r) ps += p1[r];
    { auto rr = __builtin_amdgcn_permlane32_swap(__float_as_uint(ps), __float_as_uint(ps), false, false);
      ps = __uint_as_float(rr[0]) + __uint_as_float(rr[1]); }
    l_reg = l_reg * alpha + ps;
    AB_PK4(p0, 0, pa0); AB_PK4(p0, 8, pa1); AB_PK4(p1, 0, pa2); AB_PK4(p1, 8, pa3);
}
template <int KB>
__device__ __forceinline__ void qkt(f32x16& p0, f32x16& p1, const char* K_lds, int r32, int hi, const bf16x8* qr) {
    p0 = f32x16{}; p1 = f32x16{};
    const char* kb[4];
#pragma unroll
    for (int dd = 0; dd < 4; ++dd) kb[dd] = K_lds + KB * SHM_K + KSWZ(r32, (dd * 16 + hi * 8) * 2);
#pragma unroll
    for (int d0 = 0; d0 < 8; ++d0) { const char* a = kb[d0 & 3] + (d0 >> 2) * 128;
        bf16x8 b0 = *reinterpret_cast<const bf16x8*>(a);
        bf16x8 b1 = *reinterpret_cast<const bf16x8*>(a + 32 * 256);
        p0 = __builtin_amdgcn_mfma_f32_32x32x16_bf16(b0, qr[d0], p0, 0, 0, 0);
        p1 = __builtin_amdgcn_mfma_f32_32x32x16_bf16(b1, qr[d0], p1, 0, 0, 0); }
}
template <int VB>
__device__ __forceinline__ void pv_tile(f32x16* o, int vb0, bf16x8 pa0, bf16x8 pa1, bf16x8 pa2, bf16x8 pa3) {
#define TRRD(dst, off) asm volatile("ds_read_b64_tr_b16 %0, %1 offset:%2" : "=&v"(dst) : "v"(vb0), "i"(off) : "memory")
#define PV_D0(d0) do { s16x4 l0, l1, l2, l3, h0, h1, h2, h3; constexpr int b_ = VB * SHM_V + v_rd_off(d0, 0, 0); \
        TRRD(l0, b_); TRRD(h0, b_ + 2048); TRRD(l1, b_ + 4096); TRRD(h1, b_ + 6144); TRRD(l2, b_ + 8192); TRRD(h2, b_ + 10240); TRRD(l3, b_ + 12288); TRRD(h3, b_ + 14336); \
        asm volatile("s_waitcnt lgkmcnt(0)" ::: "memory"); SBAR();   \
        o[d0] = __builtin_amdgcn_mfma_f32_32x32x16_bf16(pa0, (bf16x8){l0[0], l0[1], l0[2], l0[3], h0[0], h0[1], h0[2], h0[3]}, o[d0], 0, 0, 0);   \
        o[d0] = __builtin_amdgcn_mfma_f32_32x32x16_bf16(pa1, (bf16x8){l1[0], l1[1], l1[2], l1[3], h1[0], h1[1], h1[2], h1[3]}, o[d0], 0, 0, 0);   \
        o[d0] = __builtin_amdgcn_mfma_f32_32x32x16_bf16(pa2, (bf16x8){l2[0], l2[1], l2[2], l2[3], h2[0], h2[1], h2[2], h2[3]}, o[d0], 0, 0, 0);   \
        o[d0] = __builtin_amdgcn_mfma_f32_32x32x16_bf16(pa3, (bf16x8){l3[0], l3[1], l3[2], l3[3], h3[0], h3[1], h3[2], h3[3]}, o[d0], 0, 0, 0); } while (0)
    PV_D0(0); PV_D0(1); PV_D0(2); PV_D0(3);
#undef PV_D0
#undef TRRD
}
template <int KB>
__device__ __forceinline__ void qkt2(f32x16& p0, f32x16& p1, const char* K_lds, int r32, int hi, const bf16x8* qr) {
    p0 = f32x16{}; p1 = f32x16{};
    int ka[4];
#pragma unroll
    for (int dd = 0; dd < 4; ++dd) ka[dd] = (int)(uintptr_t)K_lds + KB * SHM_K + KSWZ(r32, (dd * 16 + hi * 8) * 2);
#define KRD(dst, addr, off) asm volatile("ds_read_b128 %0, %1 offset:%2" : "=&v"(dst) : "v"(addr), "i"(off) : "memory")
#define QK_RD(X, Y, b) do { KRD(X[0], ka[(2 * (b)) & 3], ((2 * (b)) >> 2) * 128); KRD(Y[0], ka[(2 * (b)) & 3], ((2 * (b)) >> 2) * 128 + 32 * 256); \
        KRD(X[1], ka[(2 * (b) + 1) & 3], ((2 * (b) + 1) >> 2) * 128); KRD(Y[1], ka[(2 * (b) + 1) & 3], ((2 * (b) + 1) >> 2) * 128 + 32 * 256); } while (0)
#define QK_MM(X, Y, b) do { p0 = __builtin_amdgcn_mfma_f32_32x32x16_bf16(X[0], qr[2 * (b)], p0, 0, 0, 0); p1 = __builtin_amdgcn_mfma_f32_32x32x16_bf16(Y[0], qr[2 * (b)], p1, 0, 0, 0); \
        p0 = __builtin_amdgcn_mfma_f32_32x32x16_bf16(X[1], qr[2 * (b) + 1], p0, 0, 0, 0); p1 = __builtin_amdgcn_mfma_f32_32x32x16_bf16(Y[1], qr[2 * (b) + 1], p1, 0, 0, 0); } while (0)
    bf16x8 xa[2], ya[2], xb[2], yb[2];
    QK_RD(xa, ya, 0); QK_RD(xb, yb, 1);
    asm volatile("s_waitcnt lgkmcnt(4)" ::: "memory"); SBAR(); QK_MM(xa, ya, 0); SBAR(); QK_RD(xa, ya, 2);
    asm volatile("s_waitcnt lgkmcnt(4)" ::: "memory"); SBAR(); QK_MM(xb, yb, 1); SBAR(); QK_RD(xb, yb, 3);
    asm volatile("s_waitcnt lgkmcnt(4)" ::: "memory"); SBAR(); QK_MM(xa, ya, 2); SBAR();
    asm volatile("s_waitcnt lgkmcnt(0)" ::: "memory"); SBAR(); QK_MM(xb, yb, 3);
#undef QK_MM
#undef QK_RD
#undef KRD
}
template <int VB, bool PF>
__device__ __forceinline__ void pv_tile2(f32x16* o, int vb0, bf16x8 pa0, bf16x8 pa1, bf16x8 pa2, bf16x8 pa3) {
#define TRRD(dst, off) asm volatile("ds_read_b64_tr_b16 %0, %1 offset:%2" : "=&v"(dst) : "v"(vb0), "i"(off) : "memory")
#define PV_RD(L, H, ks) do { constexpr int b_ = VB * SHM_V + (ks) * 4096; TRRD(L[0], b_); TRRD(H[0], b_ + 2048); TRRD(L[1], b_ + 512); TRRD(H[1], b_ + 512 + 2048); \
        TRRD(L[2], b_ + 1024); TRRD(H[2], b_ + 1024 + 2048); TRRD(L[3], b_ + 1536); TRRD(H[3], b_ + 1536 + 2048); } while (0)
#define PV_MM(L, H, PA) do { _Pragma("unroll") for (int d0 = 0; d0 < 4; ++d0) \
        o[d0] = __builtin_amdgcn_mfma_f32_32x32x16_bf16(PA, (bf16x8){L[d0][0], L[d0][1], L[d0][2], L[d0][3], H[d0][0], H[d0][1], H[d0][2], H[d0][3]}, o[d0], 0, 0, 0); } while (0)
    s16x4 la[4], ha[4];
    if constexpr (PF) {
        s16x4 lb[4], hb[4];
        PV_RD(la, ha, 0); PV_RD(lb, hb, 1);
        asm volatile("s_waitcnt lgkmcnt(8)" ::: "memory"); SBAR(); PV_MM(la, ha, pa0); SBAR();
        PV_RD(la, ha, 2);
        asm volatile("s_waitcnt lgkmcnt(8)" ::: "memory"); SBAR(); PV_MM(lb, hb, pa1); SBAR();
        PV_RD(lb, hb, 3);
        asm volatile("s_waitcnt lgkmcnt(8)" ::: "memory"); SBAR(); PV_MM(la, ha, pa2); SBAR();
        asm volatile("s_waitcnt lgkmcnt(0)" ::: "memory"); SBAR(); PV_MM(lb, hb, pa3);
    } else {
        PV_RD(la, ha, 0); asm volatile("s_waitcnt lgkmcnt(0)" ::: "memory"); SBAR(); PV_MM(la, ha, pa0); SBAR();
        PV_RD(la, ha, 1); asm volatile("s_waitcnt lgkmcnt(0)" ::: "memory"); SBAR(); PV_MM(la, ha, pa1); SBAR();
        PV_RD(la, ha, 2); asm volatile("s_waitcnt lgkmcnt(0)" ::: "memory"); SBAR(); PV_MM(la, ha, pa2); SBAR();
        PV_RD(la, ha, 3); asm volatile("s_waitcnt lgkmcnt(0)" ::: "memory"); SBAR(); PV_MM(la, ha, pa3);
    }
#undef PV_MM
#undef PV_RD
#undef TRRD
}
struct BlockRef { const bf16* Q; const bf16* K; const bf16* V; float* O; int P0; const bf16* Cst; const float* nst; };
struct Seam { bf16x8 qr[8]; bf16x8 st_v0, st_v1, st_k0, st_k1; bf16x8 sb_v0, sb_v1, sb_k0, sb_k1; };
#define VMW() asm volatile("s_waitcnt vmcnt(0)" ::: "memory")
#define VMWN(n) asm volatile("s_waitcnt vmcnt(%0)" :: "i"(n) : "memory")
#define SLOAD_H(Kp, Vp, k0) do { const bf16* vb_ = (Vp) + (size_t)((k0) + wid * 4) * VP; const bf16* kb_ = (Kp) + (size_t)((k0) + wid * 4) * KP;    \
                         S.st_v0 = load8(vb_ + lov); S.st_v1 = load8(vb_ + 32 * VP + lov); S.st_k0 = load8(kb_ + lok); S.st_k1 = load8(kb_ + 32 * KP + lok); } while (0)
#define SWRITE_HK(bf) do { *(bf16x8*)(K_lds + (bf) * SHM_K + kws) = S.st_k0; *(bf16x8*)(K_lds + (bf) * SHM_K + kws + 32 * 256) = S.st_k1; } while (0)
#define SWRITE_HV(bf) do { *(bf16x8*)(V_lds + (bf) * SHM_V + vst0) = S.st_v0; *(bf16x8*)(V_lds + (bf) * SHM_V + vst1) = S.st_v1; } while (0)
#define SWRITE_H(bf) do { SWRITE_HV(bf); SWRITE_HK(bf); } while (0)
template <int QP, int KP, int VP>
__device__ __forceinline__ void prime(const BlockRef& cur, char* lds, Seam& S, const int tid, const int k0) {
    const int wid = __builtin_amdgcn_readfirstlane(tid >> 6), lane = tid & 63, r32 = lane & 31, hi = lane >> 5;
    const int sr = tid >> 4, sc = (tid & 15) * 8, kws = KSWZ(sr, sc * 2); char* K_lds = lds + 2 * SHM_V;
    const unsigned lov = (unsigned)((lane >> 4) * VP + sc), lok = (unsigned)((lane >> 4) * KP + sc), loq = (unsigned)(r32 * QP + hi * 8);
    { const bf16* qb_ = cur.Q + (size_t)(wid * QBLK) * QP;
#pragma unroll
      for (int d0 = 0; d0 < 8; ++d0) S.qr[d0] = load8(qb_ + d0 * 16 + loq); }
    SLOAD_H(cur.K, cur.V, k0); VMW(); SWRITE_HK(0);
    __syncthreads();
}
template <int MODE, int QP, int KP, int VP, int OP>
__device__ __forceinline__ void block(const BlockRef& cur, const BlockRef& nxt, char* lds, Seam& S, const int tid) {
    const int wid = __builtin_amdgcn_readfirstlane(tid >> 6), lane = tid & 63, r32 = lane & 31, hi = lane >> 5;
    const int T0 = (MODE == 1) ? cur.P0 / KVBLK : 0;
    int NT = (MODE == 1) ? QB / KVBLK : cur.P0 / KVBLK + QB / KVBLK;
    if (MODE == 1) asm volatile("" : "+s"(NT));
    const int qlo = cur.P0 + wid * QBLK, qm = qlo + r32 - 4 * hi;
    char* V_lds = lds; char* K_lds = lds + 2 * SHM_V;
    float* ws = (float*)(lds + 2 * SHM_V + 2 * SHM_K) + wid * 64; float* li_l = ws, * al_l = ws + 32;
    const float* a2 = (const float*)(lds + A2_OFF);
    float M2t = 0.f;
    if (MODE == 1) M2t = ((const float*)(lds + M2_OFF))[qlo + r32];
    float m_reg = -1e30f, l_reg = 0; f32x16 o[4] = {};
    const int sr = tid >> 4, sc = (tid & 15) * 8, vst0 = v_st(sr, sc), vst1 = v_st(32 + sr, sc), kws = KSWZ(sr, sc * 2);
    const int vb0 = (int)(uintptr_t)V_lds + v_rd_base(lane);
    const unsigned lov = (unsigned)((lane >> 4) * VP + sc), lok = (unsigned)((lane >> 4) * KP + sc), loq = (unsigned)(r32 * QP + hi * 8), loo = (unsigned)(4 * hi * OP + r32);
    const bf16* Kh = cur.K; const bf16* Vh = cur.V;
#define RESC(a) do { if (MODE == 0) { if (__any((a) < 1.f)) { if (hi == 0) al_l[r32] = (a); asm volatile("s_waitcnt lgkmcnt(0)" ::: "memory");              \
                     for (int d_ = 0; d_ < 4; ++d_) for (int r = 0; r < 16; ++r) o[d_][r] *= al_l[crow(r, hi)]; } } } while (0)
#define KBASE(t) ((T0 + (t)) * KVBLK)
#define MASKT(P0_, P1_, t) do { const int kb_ = KBASE(t); if (kb_ + KVBLK - 1 > qlo) mask_tile<MODE>(P0_, P1_, qm - kb_); } while (0)
#define PARTIAL(P0_, P1_, mnX, alX, t) do { if (MODE == 0) partialSM(P0_, P1_, m_reg, mnX, alX); else { alX = 1.f; partialM(P0_, P1_, a2 + KBASE(t), M2t, hi); } } while (0)
    constexpr int NQL = 8;
#define SEAM_K0() do { VMWN(NQL); SWRITE_HK(0); SBAR(); } while (0)
    f32x16 pA0, pA1, pB0, pB1; float mnA, mnB, alA, alB; bf16x8 pa0, pa1, pa2, pa3;
    if (MODE == 1 && cur.Cst != nullptr) {
        const bf16* Cp = cur.Cst + (size_t)(wid * 4) * 256; const unsigned loc = (unsigned)((lane >> 4) * 256 + sc);
        const bf16x8 c0 = load8(Cp + loc), c1 = load8(Cp + 32 * 256 + loc), c2 = load8(Cp + 64 * 256 + loc), c3 = load8(Cp + 96 * 256 + loc);
        float dn = 0.f;
#pragma unroll
        for (int d0 = 0; d0 < 8; ++d0) { const f32x4 n0 = *(const f32x4*)(cur.nst + 16 * d0 + 8 * hi), n1 = *(const f32x4*)(cur.nst + 16 * d0 + 8 * hi + 4);
            const u32x4 qw = *reinterpret_cast<const u32x4*>(&S.qr[d0]);
            dn += __uint_as_float(qw.x << 16) * n0[0] + __uint_as_float(qw.x & 0xffff0000u) * n0[1] + __uint_as_float(qw.y << 16) * n0[2] + __uint_as_float(qw.y & 0xffff0000u) * n0[3];
            dn += __uint_as_float(qw.z << 16) * n1[0] + __uint_as_float(qw.z & 0xffff0000u) * n1[1] + __uint_as_float(qw.w << 16) * n1[2] + __uint_as_float(qw.w & 0xffff0000u) * n1[3]; }
        { auto rr = __builtin_amdgcn_permlane32_swap(__float_as_uint(dn), __float_as_uint(dn), false, false); dn = __uint_as_float(rr[0]) + __uint_as_float(rr[1]); }
        VMW();
        *(bf16x8*)(V_lds + vst0) = c0; *(bf16x8*)(V_lds + vst1) = c1; *(bf16x8*)(V_lds + SHM_V + vst0) = c2; *(bf16x8*)(V_lds + SHM_V + vst1) = c3;
        __syncthreads();
        pv_tile<0>(o, vb0, S.qr[0], S.qr[1], S.qr[2], S.qr[3]); pv_tile<1>(o, vb0, S.qr[4], S.qr[5], S.qr[6], S.qr[7]);
        const float st = __builtin_amdgcn_exp2f(((const float*)(lds + M2_OFF))[cur.P0 - 1] - M2t);
        l_reg = st * dn;
        if (hi == 0) al_l[r32] = st;
        asm volatile("s_waitcnt lgkmcnt(0)" ::: "memory");
#pragma unroll
        for (int d_ = 0; d_ < 4; ++d_)
#pragma unroll
            for (int r = 0; r < 16; ++r) o[d_][r] *= al_l[crow(r, hi)];
        __syncthreads();
    }
    SWRITE_HV(0); SBAR();
    if (NT > 1) { SLOAD_H(Kh, Vh, KBASE(1)); }
    SBAR(); qkt<0>(pA0, pA1, K_lds, r32, hi, S.qr);
    MASKT(pA0, pA1, 0); PARTIAL(pA0, pA1, mnA, alA, 0);
    if (NT > 1) { VMW(); SWRITE_H(1); }
    __syncthreads();
#define HALF_STEP(PX0, PX1, mnX, alX, PY0, PY1, alY, t, KB, VB, SB) do {                                                      \
        SBAR(); qkt<KB>(PX0, PX1, K_lds, r32, hi, S.qr);                                             \
        finishSM<MODE>(PY0, PY1, alY, l_reg, pa0, pa1, pa2, pa3); SBAR();                                                           \
        if ((t) + 1 < NT) { SLOAD_H(Kh, Vh, KBASE((t) + 1)); SBAR(); }                                               \
        pv_tile<VB>(o, vb0, pa0, pa1, pa2, pa3); MASKT(PX0, PX1, (t)); PARTIAL(PX0, PX1, mnX, alX, (t));                                        \
        __syncthreads();                                                                                                      \
        if ((t) + 1 < NT) { VMW(); SWRITE_H(SB); }                                                                          \
        RESC(alX); __syncthreads(); } while (0)
    for (int t = 1; t + 1 < NT; t += 2) {
        HALF_STEP(pB0, pB1, mnB, alB, pA0, pA1, alA, t, 1, 0, 0);
        HALF_STEP(pA0, pA1, mnA, alA, pB0, pB1, alB, t + 1, 0, 1, 1);
    }
    const bool even = (NT & 1) == 0;
    if (even) { SBAR(); qkt<1>(pB0, pB1, K_lds, r32, hi, S.qr); SBAR(); }
    SLOAD_H(nxt.K, nxt.V, (MODE == 1) ? nxt.P0 : 0); SBAR();
    { const bf16* qb_ = nxt.Q + (size_t)(wid * QBLK) * QP;
#pragma unroll
      for (int d0 = 0; d0 < 8; ++d0) S.qr[d0] = load8(qb_ + d0 * 16 + loq); }
    SBAR();
    finishSM<MODE>(pA0, pA1, alA, l_reg, pa0, pa1, pa2, pa3); SBAR();
    pv_tile<0>(o, vb0, pa0, pa1, pa2, pa3);
    if (even) { MASKT(pB0, pB1, NT - 1); PARTIAL(pB0, pB1, mnB, alB, NT - 1); __syncthreads(); RESC(alB);
        finishSM<MODE>(pB0, pB1, alB, l_reg, pa0, pa1, pa2, pa3); SBAR(); pv_tile<1>(o, vb0, pa0, pa1, pa2, pa3); }
    SBAR(); SEAM_K0();
    if (hi == 0) li_l[r32] = (MODE == 0) ? l_reg : fmaxf(fabsf(l_reg), __builtin_amdgcn_exp2f(((const float*)(lds + E2_OFF))[qlo + r32]));
    asm volatile("s_waitcnt lgkmcnt(0)" ::: "memory");
    float rli[16];
#pragma unroll
    for (int r = 0; r < 16; ++r) rli[r] = __builtin_amdgcn_rcpf(li_l[crow(r, hi)]);
    float* Ow = cur.O + (size_t)(wid * QBLK) * OP;
#pragma unroll
    for (int r = 0; r < 16; ++r) { float* Or = Ow + (size_t)((r & 3) + 8 * (r >> 2)) * OP;
#pragma unroll
        for (int d0 = 0; d0 < 4; ++d0) Or[d0 * 32 + loo] = o[d0][r] * rli[r]; }
    __syncthreads();
#undef RESC
#undef KBASE
#undef MASKT
#undef PARTIAL
#undef SEAM_K0
#undef HALF_STEP
}

#define PP_BAR() do { asm volatile("s_waitcnt lgkmcnt(0)" ::: "memory"); __builtin_amdgcn_s_barrier(); asm volatile("" ::: "memory"); SBAR(); } while (0)
constexpr int SB_OFF = 98304;
static_assert(LDS_NEED <= SB_OFF && SB_OFF + 2 * SHM_V <= 131072, "lds map");
template <int MODE, int QP, int KP, int VP>
__device__ __forceinline__ void prime2(const BlockRef& cur, char* lds, Seam& S, const int tid) {
    const int wid = __builtin_amdgcn_readfirstlane(tid >> 6), lane = tid & 63, r32 = lane & 31, hi = lane >> 5;
    const int sr = tid >> 4, sc = (tid & 15) * 8, kws = KSWZ(sr, sc * 2); char* K_lds = lds + 2 * SHM_V;
    const unsigned lov = (unsigned)((lane >> 4) * VP + sc), lok = (unsigned)((lane >> 4) * KP + sc), loq = (unsigned)(r32 * QP + hi * 8);
    const int k0 = (MODE == 1) ? cur.P0 : 0;
    { const bf16* qb_ = cur.Q + (size_t)(wid * QBLK) * QP;
#pragma unroll
      for (int d0 = 0; d0 < 8; ++d0) S.qr[d0] = load8(qb_ + d0 * 16 + loq); }
    { const bf16* kb_ = cur.K + (size_t)(k0 + wid * 4) * KP; S.st_k0 = load8(kb_ + lok); S.st_k1 = load8(kb_ + 32 * KP + lok); }
    *(bf16x8*)(K_lds + kws) = S.st_k0; *(bf16x8*)(K_lds + kws + 32 * 256) = S.st_k1;
    SBAR();
    { const bf16* kb_ = cur.K + (size_t)(k0 + KVBLK + wid * 4) * KP; const bf16* vb_ = cur.V + (size_t)(k0 + wid * 4) * VP;
      S.st_k0 = load8(kb_ + lok); S.st_k1 = load8(kb_ + 32 * KP + lok); S.st_v0 = load8(vb_ + lov); S.st_v1 = load8(vb_ + 32 * VP + lov);
      if (MODE == 0) { S.sb_k0 = load8(kb_ + (size_t)KVBLK * KP + lok); S.sb_k1 = load8(kb_ + (size_t)(KVBLK + 32) * KP + lok); S.sb_v0 = load8(vb_ + (size_t)KVBLK * VP + lov); S.sb_v1 = load8(vb_ + (size_t)(KVBLK + 32) * VP + lov); } }
    PP_BAR();
    if (wid >= 4) PP_BAR();
}
__device__ __forceinline__ void pp_realign(const int tid) { if (__builtin_amdgcn_readfirstlane(tid >> 6) < 4) PP_BAR(); }
template <int MODE, int QP, int KP, int VP, int OP>
__device__ __forceinline__ void block2(const BlockRef& cur, const BlockRef& nxt, char* lds, Seam& S, const int tid) {
    const int wid = __builtin_amdgcn_readfirstlane(tid >> 6), lane = tid & 63, r32 = lane & 31, hi = lane >> 5;
    const int T0 = (MODE == 1) ? cur.P0 / KVBLK : 0, T0n = (MODE == 1) ? nxt.P0 / KVBLK : 0;
    int NT = (MODE == 1) ? QB / KVBLK : cur.P0 / KVBLK + QB / KVBLK;
    if (MODE == 1) asm volatile("" : "+s"(NT));
    const int qlo = cur.P0 + wid * QBLK, qm = qlo + r32 - 4 * hi;
    char* V_lds = lds; char* K_lds = lds + 2 * SHM_V;
    float* ws = (float*)(lds + 2 * SHM_V + 2 * SHM_K) + wid * 64; float* li_l = ws, * al_l = ws + 32;
    const float* a2 = (const float*)(lds + A2_OFF);
    float M2t = 0.f;
    if (MODE == 1) M2t = ((const float*)(lds + M2_OFF))[qlo + r32];
    float m_reg = -1e30f, l_reg = 0; f32x16 o[4] = {};
    const int sr = tid >> 4, sc = (tid & 15) * 8, vst0 = v_st(sr, sc), vst1 = v_st(32 + sr, sc), kws = KSWZ(sr, sc * 2);
    const int vb0 = (int)(uintptr_t)V_lds + v_rd_base(lane);
    const unsigned lov = (unsigned)((lane >> 4) * VP + sc), lok = (unsigned)((lane >> 4) * KP + sc), loq = (unsigned)(r32 * QP + hi * 8), loo = (unsigned)(4 * hi * OP + r32);
#define KBASE2(t) ((T0 + (t)) * KVBLK)
#define LOADKV(K0, K1, V0, V1, kt, vt) do { const bool kn_ = (kt) >= NT, vn_ = (vt) >= NT;                                                            \
        const bf16* kb_ = (kn_ ? nxt.K : cur.K) + (size_t)(((kn_ ? T0n - NT : T0) + (kt)) * KVBLK + wid * 4) * KP;                                   \
        const bf16* vb_ = (vn_ ? nxt.V : cur.V) + (size_t)(((vn_ ? T0n - NT : T0) + (vt)) * KVBLK + wid * 4) * VP;                                   \
        K0 = load8(kb_ + lok); K1 = load8(kb_ + 32 * KP + lok); V0 = load8(vb_ + lov); V1 = load8(vb_ + 32 * VP + lov); } while (0)
#define WRITEKV(K0, K1, V0, V1, kbuf, vbuf) do { *(bf16x8*)(K_lds + (kbuf) * SHM_K + kws) = K0; *(bf16x8*)(K_lds + (kbuf) * SHM_K + kws + 32 * 256) = K1;    \
        *(bf16x8*)(V_lds + (vbuf) * SHM_V + vst0) = V0; *(bf16x8*)(V_lds + (vbuf) * SHM_V + vst1) = V1; } while (0)
#define WRITE_A(kbuf, vbuf) WRITEKV(S.st_k0, S.st_k1, S.st_v0, S.st_v1, kbuf, vbuf)
#define WRITE_B(kbuf, vbuf) WRITEKV(S.sb_k0, S.sb_k1, S.sb_v0, S.sb_v1, kbuf, vbuf)
#define LOAD_A(kt, vt) LOADKV(S.st_k0, S.st_k1, S.st_v0, S.st_v1, kt, vt)
#define LOAD_B(kt, vt) LOADKV(S.sb_k0, S.sb_k1, S.sb_v0, S.sb_v1, kt, vt)
    f32x16 p0, p1; float mn, al; bf16x8 pa0, pa1, pa2, pa3;
#define VV_STAGE(t) do { { const int kb_ = KBASE2(t); if (kb_ + KVBLK - 1 > qlo) mask_tile<MODE>(p0, p1, qm - kb_); }                                 \
        if (MODE == 0) { partialSM(p0, p1, m_reg, mn, al);                                                                                             \
            if (__any(al < 1.f)) { if (hi == 0) al_l[r32] = al; asm volatile("s_waitcnt lgkmcnt(0)" ::: "memory");                                     \
                _Pragma("unroll") for (int d_ = 0; d_ < 4; ++d_) _Pragma("unroll") for (int r = 0; r < 16; ++r) o[d_][r] *= al_l[crow(r, hi)]; } }                  \
        else { al = 1.f; partialM(p0, p1, a2 + KBASE2(t), M2t, hi); }                                                                                  \
        finishSM<MODE>(p0, p1, al, l_reg, pa0, pa1, pa2, pa3); } while (0)
    if (MODE == 1 && cur.Cst != nullptr) {
        const bf16* Cp = cur.Cst + (size_t)(wid * 4) * 256; const unsigned loc = (unsigned)((lane >> 4) * 256 + sc);
        const bf16x8 c0 = load8(Cp + loc), c1 = load8(Cp + 32 * 256 + loc), c2 = load8(Cp + 64 * 256 + loc), c3 = load8(Cp + 96 * 256 + loc);
        *(bf16x8*)(lds + SB_OFF + vst0) = c0; *(bf16x8*)(lds + SB_OFF + vst1) = c1; *(bf16x8*)(lds + SB_OFF + SHM_V + vst0) = c2; *(bf16x8*)(lds + SB_OFF + SHM_V + vst1) = c3;
        PP_BAR();
        float dn = 0.f;
#pragma unroll
        for (int d0 = 0; d0 < 8; ++d0) { const f32x4 n0 = *(const f32x4*)(cur.nst + 16 * d0 + 8 * hi), n1 = *(const f32x4*)(cur.nst + 16 * d0 + 8 * hi + 4);
            const u32x4 qw = *reinterpret_cast<const u32x4*>(&S.qr[d0]);
            dn += __uint_as_float(qw.x << 16) * n0[0] + __uint_as_float(qw.x & 0xffff0000u) * n0[1] + __uint_as_float(qw.y << 16) * n0[2] + __uint_as_float(qw.y & 0xffff0000u) * n0[3];
            dn += __uint_as_float(qw.z << 16) * n1[0] + __uint_as_float(qw.z & 0xffff0000u) * n1[1] + __uint_as_float(qw.w << 16) * n1[2] + __uint_as_float(qw.w & 0xffff0000u) * n1[3]; }
        { auto rr = __builtin_amdgcn_permlane32_swap(__float_as_uint(dn), __float_as_uint(dn), false, false); dn = __uint_as_float(rr[0]) + __uint_as_float(rr[1]); }
        PP_BAR();
        pv_tile2<0, MODE == 0>(o, vb0 + SB_OFF, S.qr[0], S.qr[1], S.qr[2], S.qr[3]); pv_tile2<1, MODE == 0>(o, vb0 + SB_OFF, S.qr[4], S.qr[5], S.qr[6], S.qr[7]);
        const float st = __builtin_amdgcn_exp2f(((const float*)(lds + M2_OFF))[cur.P0 - 1] - M2t);
        l_reg = st * dn;
        if (hi == 0) al_l[r32] = st;
        asm volatile("s_waitcnt lgkmcnt(0)" ::: "memory");
#pragma unroll
        for (int d_ = 0; d_ < 4; ++d_)
#pragma unroll
            for (int r = 0; r < 16; ++r) o[d_][r] *= al_l[crow(r, hi)];
        PP_BAR();
    }
    for (int t = 0; t < NT; t += 2) {
        WRITE_A(1, 0); SBAR(); if (MODE == 0) LOAD_A(t + 3, t + 2); else LOAD_A(t + 2, t + 1); SBAR();
        if (t > 0) pv_tile2<1, MODE == 0>(o, vb0, pa0, pa1, pa2, pa3);
        qkt2<0>(p0, p1, K_lds, r32, hi, S.qr);
        PP_BAR();
        VV_STAGE(t);
        PP_BAR();
        if (MODE == 0) { WRITE_B(0, 1); SBAR(); LOAD_B(t + 4, t + 3); } else { WRITE_A(0, 1); SBAR(); LOAD_A(t + 3, t + 2); } SBAR();
        pv_tile2<0, MODE == 0>(o, vb0, pa0, pa1, pa2, pa3);
        qkt2<1>(p0, p1, K_lds, r32, hi, S.qr);
        PP_BAR();
        VV_STAGE(t + 1);
        PP_BAR();
    }
    { const bf16* qb_ = nxt.Q + (size_t)(wid * QBLK) * QP;
#pragma unroll
      for (int d0 = 0; d0 < 8; ++d0) S.qr[d0] = load8(qb_ + d0 * 16 + loq); }
    SBAR();
    pv_tile2<1, MODE == 0>(o, vb0, pa0, pa1, pa2, pa3);
    PP_BAR();
    if (hi == 0) li_l[r32] = (MODE == 0) ? l_reg : fmaxf(fabsf(l_reg), __builtin_amdgcn_exp2f(((const float*)(lds + E2_OFF))[qlo + r32]));
    asm volatile("s_waitcnt lgkmcnt(0)" ::: "memory");
    float rli[16];
#pragma unroll
    for (int r = 0; r < 16; ++r) rli[r] = __builtin_amdgcn_rcpf(li_l[crow(r, hi)]);
    { bf16* Ow = (bf16*)cur.O + (size_t)(wid * QBLK) * OP;
#pragma unroll
      for (int r = 0; r < 16; ++r) { bf16* Or = Ow + (size_t)((r & 3) + 8 * (r >> 2)) * OP;
#pragma unroll
          for (int d0 = 0; d0 < 4; ++d0) { const float v = o[d0][r] * rli[r];
              const float nb = __uint_as_float(__builtin_amdgcn_update_dpp(0u, __float_as_uint(v), 0xB1, 0xf, 0xf, false));
              if ((r32 & 1) == 0) *(unsigned*)(Or + d0 * 32 + loo) = cvtpk(v, nb); } } }
    PP_BAR();
#undef KBASE2
#undef LOADKV
#undef WRITEKV
#undef WRITE_A
#undef WRITE_B
#undef LOAD_A
#undef LOAD_B
#undef VV_STAGE
}
#undef VMW
#undef VMWN
#undef SLOAD_H
#undef SWRITE_HK
#undef SWRITE_HV
#undef SWRITE_H
}

constexpr int NWAVES = 8;
constexpr int BATCH = 4, SEQ = 2048, DM = 2048, DEPTH = 4, MTOK = BATCH * SEQ;
constexpr int NIN = 16400, NING = 16384, GATE_COL = 6144, DFF = 5632, NUP = 2 * DFF;
constexpr float EPS = 1e-6f;
constexpr int NPH_L = 7, NPHASE = 2 + DEPTH * NPH_L;
constexpr size_t MiB = 1u << 20;
constexpr size_t WS_CTL = 0, CTL_ZERO_BYTES = 1 * MiB;
constexpr size_t WS_ROPE = 1 * MiB;
constexpr size_t WS_BIASG = WS_ROPE + 512 * 1024;
constexpr size_t WS_GATES = 2 * MiB;
constexpr size_t WS_ROWSS_B = 3 * MiB - 64 * 1024;
constexpr size_t WS_ROWSS = 3 * MiB;
constexpr size_t WS_WIN = 4 * MiB, SZ_WIN = 64 * MiB;
constexpr size_t WS_WBM = WS_WIN + 4 * SZ_WIN, SZ_WSQ = 8 * MiB;
constexpr size_t WS_WBD = WS_WBM + 4 * SZ_WSQ, WS_WO = WS_WBD + 4 * SZ_WSQ;
constexpr size_t WS_WUP = WS_WO + 4 * SZ_WSQ, SZ_WUP = 44 * MiB;
constexpr size_t WS_WDN = WS_WUP + 4 * SZ_WUP, SZ_WDN = 22 * MiB;
constexpr size_t WS_H = WS_WDN + 4 * SZ_WDN;
constexpr size_t WS_XN = WS_H + 64 * MiB;
constexpr size_t WS_MQ = WS_XN + 32 * MiB, WS_MK = WS_MQ + 16 * MiB, WS_MV = WS_MK + 16 * MiB, WS_SMO = WS_MV + 32 * MiB;
constexpr size_t WS_AQ = WS_SMO + 32 * MiB, WS_AK = WS_AQ + 32 * MiB, WS_AV = WS_AK + 32 * MiB, WS_SG = WS_AV + 32 * MiB;
constexpr size_t WS_OATT = WS_SG + 64 * MiB;
constexpr size_t WS_HRAW = WS_OATT + 128 * MiB;
constexpr size_t WS_HMN = WS_HRAW + 64 * MiB, WS_HAN = WS_HMN + 32 * MiB;
constexpr size_t WS_P = WS_HAN + 32 * MiB;
constexpr size_t WS_Y = WS_P + 64 * MiB;
constexpr size_t WS_FXC = WS_Y + 32 * MiB, WS_FXV = WS_FXC + 3 * MiB, WS_FXG = WS_FXV + 3 * MiB;
constexpr size_t WS_U = WS_FXG + 3 * MiB;
constexpr size_t WS_CST = WS_U + 88 * MiB;
constexpr size_t WS_NST = WS_CST + 16 * MiB;
constexpr size_t WS_END = WS_NST + 1 * MiB;
constexpr int CW_TMO = 0, CW_CODE = 1, CW_BAR = 4096, CW_GCNT = 200000, CW_SFLAG = 210000, CW_TICK = 240000, CW_ATICK = 250000;
constexpr int LDS_BYTES = 131072 + 2048, MISC_OFF = 131072;
static_assert(ab::LDS_NEED <= 131072, "lds");

#define GAS __attribute__((address_space(1)))
#define LAS __attribute__((address_space(3)))
typedef unsigned short bf16;
typedef unsigned v4u __attribute__((ext_vector_type(4)));
typedef unsigned v2u __attribute__((ext_vector_type(2)));
typedef float f32x4 __attribute__((ext_vector_type(4)));
typedef GAS unsigned gu32;
#define RLX_AGENT __ATOMIC_RELAXED, __HIP_MEMORY_SCOPE_AGENT
#define LDS_WAIT() asm volatile("s_waitcnt lgkmcnt(0)" ::: "memory")
#define VM_WAIT() asm volatile("s_waitcnt vmcnt(0)" ::: "memory")
__device__ __forceinline__ unsigned pk2(float lo, float hi) { return pg8::cvt_pk_bf16(lo, hi); }

#define XB_TMO      128
#define XB_XCNT(j)  (256  + 64 * (j))
#define XB_XSUB(j)  (1280 + 64 * (j))
#define XB_XGEN(j)  (2304 + 64 * (j))
#define XB_TOP      3328
#define XB_TOPGEN   3392
#define XCD_BAR_WORDS 3456
#define XB_SPIN_CAP (1u << 18)
__device__ __forceinline__ unsigned xb_ld(unsigned* p)              { return __hip_atomic_load(p, __ATOMIC_RELAXED, __HIP_MEMORY_SCOPE_AGENT); }
__device__ __forceinline__ unsigned xb_add(unsigned* p, unsigned v) { return __hip_atomic_fetch_add(p, v, __ATOMIC_RELAXED, __HIP_MEMORY_SCOPE_AGENT); }
__device__ __forceinline__ unsigned xb_xcc_id() { return (unsigned)__builtin_amdgcn_s_getreg((3 << 11) | 20) & 0xFu; }
#define XB_SPIN(cond, bar) do { unsigned _sp = 0; while (cond) { __builtin_amdgcn_s_sleep(1); \
    if ((++_sp & 255u) == 0u) { if (xb_ld(&(bar)[XB_TMO])) break; if (_sp > XB_SPIN_CAP) { atomicAdd(&(bar)[XB_TMO], 1u); break; } } } } while (0)
struct XcdBarrier { unsigned* bar; unsigned x; volatile LAS unsigned* st; };
__device__ __forceinline__ XcdBarrier xcd_barrier_post(unsigned* bar, volatile LAS unsigned* st) {
    XcdBarrier b; b.bar = bar; b.x = xb_xcc_id(); b.st = st;
    if (threadIdx.x == 0) (void)xb_add(&bar[XB_XCNT(b.x)], 1u);
    return b;
}
__device__ __forceinline__ void xcd_barrier_complete(unsigned* bar, unsigned x, unsigned& nloc, unsigned& nx) {
    const unsigned G = gridDim.x * gridDim.y * gridDim.z;
    unsigned sum, cnt, mine, sp = 0u;
    for (;;) {
        sum = 0u; cnt = 0u; mine = 0u;
#pragma unroll
        for (unsigned j = 0; j < 16; ++j) { const unsigned c = xb_ld(&bar[XB_XCNT(j)]); sum += c; cnt += (c > 0u) ? 1u : 0u; mine = (j == x) ? c : mine; }
        if (sum == G) break;
        __builtin_amdgcn_s_sleep(1);
        if ((++sp & 255u) == 0u) { if (xb_ld(&bar[XB_TMO])) break; if (sp > XB_SPIN_CAP) { atomicAdd(&bar[XB_TMO], 1u); break; } }
    }
    nloc = mine > 0u ? mine : 1u; nx = cnt > 0u ? cnt : 1u;
}
__device__ __forceinline__ void xcd_barrier(const XcdBarrier& b) {
    asm volatile("s_waitcnt vmcnt(0)" ::: "memory");
    __syncthreads();
    if (threadIdx.x == 0) {
        unsigned* bar = b.bar;
        __builtin_amdgcn_s_waitcnt(0);
        unsigned nloc = b.st[0], nx = b.st[1];
        if (nloc == 0u) { xcd_barrier_complete(bar, b.x, nloc, nx); b.st[0] = nloc; b.st[1] = nx; }
        const unsigned old = xb_add(&bar[XB_XSUB(b.x)], 1u);
        const unsigned gen = old / nloc;
        if (old + 1u == (gen + 1u) * nloc) {
            __builtin_amdgcn_fence(__ATOMIC_RELEASE, "agent");
            asm volatile("s_waitcnt vmcnt(0)" ::: "memory");
            const unsigned og = xb_add(&bar[XB_TOP], 1u);
            const unsigned tg = og / nx;
            if (og + 1u == (tg + 1u) * nx) xb_add(&bar[XB_TOPGEN], 1u);
            else XB_SPIN(xb_ld(&bar[XB_TOPGEN]) == tg, bar);
            __builtin_amdgcn_fence(__ATOMIC_ACQUIRE, "agent");
            xb_add(&bar[XB_XGEN(b.x)], 1u);
            asm volatile("s_waitcnt vmcnt(0)" ::: "memory");
        } else {
            XB_SPIN(xb_ld(&bar[XB_XGEN(b.x)]) == gen, bar);
            __builtin_amdgcn_fence(__ATOMIC_ACQUIRE, "agent");
            asm volatile("s_waitcnt vmcnt(0)" ::: "memory");
        }
    }
    __syncthreads();
}

struct Frame {
    LAS unsigned char* lds; unsigned char* ldsg;
    int tid, lane, wave, bid, vcu, G;
    unsigned char* ws;
};
enum { I_X = 0, I_NORM_MIX, I_W_IN, I_B_IN, I_M_NORM, I_A_NORM, I_LAM_QK, I_W_BM, I_W_BD, I_W_O, I_NORM_FFN, I_W_UP, I_CONV_W, I_CONV_B, I_W_DOWN, I_NORM_FINAL, I_OUT, I_NPTR };
constexpr int PTAB_OFF = 131072 + 256;
__device__ __forceinline__ const float* inp(const Frame& F, int i) {
    const LAS unsigned* t = (const LAS unsigned*)(F.lds + PTAB_OFF) + 2 * i;
    const unsigned lo = __builtin_amdgcn_readfirstlane(t[0]), hi = __builtin_amdgcn_readfirstlane(t[1]);
    return (const float*)(const GAS float*)(((unsigned long long)hi << 32) | lo);
}
template <int CTRL, int RM> __device__ __forceinline__ float dppf(float old, float src) {
    return __uint_as_float(__builtin_amdgcn_update_dpp(__float_as_uint(old), __float_as_uint(src), CTRL, RM, 0xf, false)); }
__device__ __forceinline__ float wave_sum(float v) {
    v += dppf<0xB1, 0xf>(0.f, v); v += dppf<0x4E, 0xf>(0.f, v); v += dppf<0x141, 0xf>(0.f, v); v += dppf<0x140, 0xf>(0.f, v);
    { auto rr = __builtin_amdgcn_permlane16_swap(__float_as_uint(v), __float_as_uint(v), false, false); v = __uint_as_float(rr[0]) + __uint_as_float(rr[1]); }
    { auto rr = __builtin_amdgcn_permlane32_swap(__float_as_uint(v), __float_as_uint(v), false, false); v = __uint_as_float(rr[0]) + __uint_as_float(rr[1]); }
    return v;
}
__device__ __forceinline__ float wave_scan_sum(float v) {
    v += dppf<0x111, 0xf>(0.f, v); v += dppf<0x112, 0xf>(0.f, v); v += dppf<0x114, 0xf>(0.f, v); v += dppf<0x118, 0xf>(0.f, v);
    v += dppf<0x142, 0xa>(0.f, v); v += dppf<0x143, 0xc>(0.f, v); return v;
}
__device__ __forceinline__ float wave_scan_max(float v) {
    const float NEG = -__builtin_inff();
    v = fmaxf(v, dppf<0x111, 0xf>(NEG, v)); v = fmaxf(v, dppf<0x112, 0xf>(NEG, v)); v = fmaxf(v, dppf<0x114, 0xf>(NEG, v)); v = fmaxf(v, dppf<0x118, 0xf>(NEG, v));
    v = fmaxf(v, dppf<0x142, 0xa>(NEG, v)); v = fmaxf(v, dppf<0x143, 0xc>(NEG, v)); return v;
}

struct CvtJob { const float* W; bf16* Bt; const float* gain; int Nsrc, K, k0, srccol0, dstrow0, rope; };
constexpr int IT_IN = 32 * 256, IT_SQ = 32 * 32, IT_UP = 32 * 176, IT_DN = 88 * 32, IT_LAYER = IT_IN + 3 * IT_SQ + IT_UP + IT_DN, IT_TOTAL = DEPTH * IT_LAYER, IT_A = IT_IN + 3 * IT_SQ;
__host__ __device__ __forceinline__ int tail_idle(int G) { const int nu = (MTOK / 256) * (NUP / 256), rounds = (nu + G - 1) / G, busy = nu - (rounds - 1) * G; const int idle = G - busy; return idle >= 64 ? idle : 0; }
__device__ __forceinline__ void cvt_decode(const Frame& F, int it, CvtJob& j) {
    const int l = it / IT_LAYER; int r = it - l * IT_LAYER; j.rope = 0; j.gain = nullptr;
    if (r < IT_IN) { const int nb = r >> 5, kt = r & 31, n0 = nb * 64;
        j.W = inp(F, I_W_IN) + (size_t)l * DM * NIN; j.Bt = (bf16*)(F.ws + WS_WIN + (size_t)l * SZ_WIN); j.Nsrc = NIN; j.K = DM; j.k0 = kt * 64; j.gain = inp(F, I_NORM_MIX) + (size_t)l * DM;
        j.srccol0 = n0 < GATE_COL ? n0 : n0 + 16; j.dstrow0 = n0; j.rope = (n0 >= 6144 && n0 < 10240 && (n0 & 127) == 0) ? 1 : 0; return; }
    r -= IT_IN;
    if (r < 3 * IT_SQ) { const int w = r / IT_SQ; r -= w * IT_SQ; const int nb = r >> 5, kt = r & 31;
        j.W = (w == 0 ? inp(F, I_W_BM) : (w == 1 ? inp(F, I_W_BD) : inp(F, I_W_O))) + (size_t)l * DM * DM;
        j.Bt = (bf16*)(F.ws + (w == 0 ? WS_WBM : (w == 1 ? WS_WBD : WS_WO)) + (size_t)l * SZ_WSQ); j.Nsrc = DM; j.K = DM; j.k0 = kt * 64; j.srccol0 = nb * 64; j.dstrow0 = nb * 64; return; }
    r -= 3 * IT_SQ;
    if (r < IT_UP) { const int nb = r >> 5, kt = r & 31, n0 = nb * 64, pn = n0 >> 8, w = n0 & 255;
        j.W = inp(F, I_W_UP) + (size_t)l * DM * NUP; j.Bt = (bf16*)(F.ws + WS_WUP + (size_t)l * SZ_WUP); j.Nsrc = NUP; j.K = DM; j.k0 = kt * 64; j.gain = inp(F, I_NORM_FFN) + (size_t)l * DM;
        j.srccol0 = (w < 128) ? pn * 128 + w : DFF + pn * 128 + (w - 128); j.dstrow0 = n0; return; }
    r -= IT_UP;
    { const int nb = r / 88, kt = r - nb * 88;
      j.W = inp(F, I_W_DOWN) + (size_t)l * DFF * DM; j.Bt = (bf16*)(F.ws + WS_WDN + (size_t)l * SZ_WDN); j.Nsrc = DM; j.K = DFF; j.k0 = kt * 64; j.srccol0 = nb * 64; j.dstrow0 = nb * 64; }
}
__device__ __forceinline__ void cvt_load(const CvtJob& j, int lane, f32x4 (&v)[16], float (&gn)[16]) {
    const float* p = j.W + (size_t)(j.k0 + (lane >> 4)) * j.Nsrc + j.srccol0 + (lane & 15) * 4;
#pragma unroll
    for (int i = 0; i < 16; ++i) v[i] = *(const f32x4*)(p + (size_t)(4 * i) * j.Nsrc);
#pragma unroll
    for (int i = 0; i < 16; ++i) gn[i] = j.gain ? j.gain[j.k0 + (lane >> 4) + 4 * i] : 1.0f;
}
__device__ __forceinline__ void cvt_store(const CvtJob& j, int lane, const f32x4 (&v)[16], const float (&gn)[16], LAS float* scr) {
#pragma unroll
    for (int i = 0; i < 16; ++i) { const int r = (lane >> 4) + 4 * i, n = (lane & 15) * 4; *(LAS f32x4*)(scr + r * 64 + (n ^ ((i >> 1) << 2))) = v[i] * gn[i]; }
    LDS_WAIT(); asm volatile("" ::: "memory");
    const int c = lane & 7;
#pragma unroll
    for (int i = 0; i < 8; ++i) { const int n = (lane >> 3) + 8 * i; const LAS float* s = scr + (8 * c) * 64 + (n ^ (c << 2));
        v4u o; o.x = pk2(s[0 * 64], s[1 * 64]); o.y = pk2(s[2 * 64], s[3 * 64]); o.z = pk2(s[4 * 64], s[5 * 64]); o.w = pk2(s[6 * 64], s[7 * 64]);
        int nd = n; if (j.rope && n < 32) nd = (n < 16) ? 2 * n : 2 * (n - 16) + 1;
        *(v4u*)(j.Bt + (size_t)(j.dstrow0 + nd) * j.K + j.k0 + 8 * c) = o; }
    LDS_WAIT(); asm volatile("" ::: "memory");
}
__device__ __forceinline__ void sincos_d(double ang, float& s, float& c) {
    const double TWO_PI = 6.283185307179586476925286766559; const double k = rint(ang / TWO_PI); const double r = ang - k * TWO_PI; const double r2 = r * r;
    double ts = 1.0, tc = 1.0, ss = 1.0, cc = 1.0;
#pragma unroll
    for (int i = 1; i <= 16; ++i) { tc = -tc * r2 / (double)((2 * i - 1) * (2 * i)); ts = -ts * r2 / (double)((2 * i) * (2 * i + 1)); cc += tc; ss += ts; }
    s = (float)(ss * r); c = (float)cc;
}
__device__ __forceinline__ void cvt_run(Frame& F, int it0, int n, int w, int nw) {
    LAS float* scr = (LAS float*)(F.lds + F.wave * 16384);
    const int per = (n + nw - 1) / nw; int it = it0 + w * per; const int it1 = (it + per < it0 + n) ? it + per : it0 + n;
    CvtJob j0, j1; f32x4 v0[16], v1[16]; float g0[16], g1[16];
    if (it < it1) { cvt_decode(F, it, j0); cvt_load(j0, F.lane, v0, g0); }
    for (; it < it1; it += 2) {
        if (it + 1 < it1) { cvt_decode(F, it + 1, j1); cvt_load(j1, F.lane, v1, g1); }
        cvt_store(j0, F.lane, v0, g0, scr);
        if (it + 1 >= it1) break;
        if (it + 2 < it1) { cvt_decode(F, it + 2, j0); cvt_load(j0, F.lane, v0, g0); }
        cvt_store(j1, F.lane, v1, g1, scr);
    }
}
__device__ __forceinline__ void p0_prologue(Frame& F) {
    const int gw = F.bid * NWAVES + F.wave, NGW = F.G * NWAVES;
    cvt_run(F, 0, tail_idle(F.G) ? IT_A : IT_LAYER, gw, NGW);
    const int gt = F.bid * 512 + F.tid, NGT = F.G * 512;
    { float* bg = (float*)(F.ws + WS_BIASG);
      for (int i = gt; i < DEPTH * NING; i += NGT) { const int l = i >> 14, n = i & (NING - 1); int src = n < GATE_COL ? n : n + 16;
          if (n >= 6144 && n < 10240 && (n & 127) < 32) { const int p = n & 127, dim = (p & 1) ? 16 + (p >> 1) : (p >> 1); src = (n & ~127) + dim + 16; }
          bg[i] = inp(F, I_B_IN)[(size_t)l * NIN + src]; } }
    { float* rp = (float*)(F.ws + WS_ROPE);
      for (int i = gt; i < SEQ * 16; i += NGT) { const int pos = i >> 4, k = i & 15; const double inv = exp2(-(double)k * (18.931568569324174 / 16.0));
          float s, c; sincos_d((double)pos * inv, s, c); rp[pos * 32 + k] = c; rp[pos * 32 + 16 + k] = s; } }
    { float* hdst = (float*)(F.ws + WS_H); bf16* xn = (bf16*)(F.ws + WS_XN); float* rb = (float*)(F.ws + WS_ROWSS_B); const float* x = inp(F, I_X);
      for (int row = gw; row < MTOK; row += NGW) { const f32x4* xr = (const f32x4*)(x + (size_t)row * DM) + F.lane; f32x4* hr = (f32x4*)(hdst + (size_t)row * DM) + F.lane; v2u* o8 = (v2u*)(xn + (size_t)row * DM) + F.lane; float ss = 0.f;
          f32x4 xv8[8];
#pragma unroll
          for (int j = 0; j < 8; ++j) xv8[j] = xr[64 * j];
#pragma unroll
          for (int j = 0; j < 8; ++j) { const f32x4 v = xv8[j]; hr[64 * j] = v; ss += (v.x * v.x + v.y * v.y) + (v.z * v.z + v.w * v.w); v2u w; w.x = pk2(v.x, v.y); w.y = pk2(v.z, v.w); o8[64 * j] = w; }
          ss = wave_sum(ss); if (F.lane == 0) rb[row] = ss; } }
}

__device__ __forceinline__ void gates_step(Frame& F, int l, gu32* cnt) {
    const float* wl = inp(F, I_W_IN) + (size_t)l * DM * NIN; const float* bl = inp(F, I_B_IN) + (size_t)l * NIN; const float* gain = inp(F, I_NORM_MIX) + (size_t)l * DM;
    const bf16* hb = (const bf16*)(F.ws + WS_XN); const float* rowss = (const float*)(F.ws + WS_ROWSS_B); float* gates = (float*)(F.ws + WS_GATES);
    LAS float* WT = (LAS float*)F.lds;
    for (int k = F.tid; k < DM; k += 512) { const f32x4* src = (const f32x4*)(wl + (size_t)k * NIN + GATE_COL); const float g = gain[k];
#pragma unroll
        for (int q = 0; q < 4; ++q) { const f32x4 a = src[q] * g; WT[(4 * q + 0) * DM + k] = a.x; WT[(4 * q + 1) * DM + k] = a.y; WT[(4 * q + 2) * DM + k] = a.z; WT[(4 * q + 3) * DM + k] = a.w; } }
    __syncthreads();
    const int gw = F.bid * NWAVES + F.wave, NGW = F.G * NWAVES;
    const float bgl = bl[GATE_COL + (F.lane & 15)];
    for (int rp = gw; rp < MTOK / 2; rp += NGW) {
        f32x4 xv[2][4][2];
#pragma unroll
        for (int r = 0; r < 2; ++r)
#pragma unroll
            for (int j = 0; j < 4; ++j) { const v4u w = *((const v4u*)(hb + (size_t)(2 * rp + r) * DM) + 64 * j + F.lane);
                xv[r][j][0] = (f32x4){pg8::bf_lo(w.x), pg8::bf_hi(w.x), pg8::bf_lo(w.y), pg8::bf_hi(w.y)}; xv[r][j][1] = (f32x4){pg8::bf_lo(w.z), pg8::bf_hi(w.z), pg8::bf_lo(w.w), pg8::bf_hi(w.w)}; }
        const float rs0 = 1.0f / sqrtf(rowss[2 * rp] * (1.0f / DM) + EPS), rs1 = 1.0f / sqrtf(rowss[2 * rp + 1] * (1.0f / DM) + EPS);
        float my0 = 0.f, my1 = 0.f;
#pragma unroll
        for (int c = 0; c < 16; ++c) { float a0 = 0.f, a1 = 0.f;
#pragma unroll
            for (int j = 0; j < 4; ++j)
#pragma unroll
                for (int hh = 0; hh < 2; ++hh) { const f32x4 w = *(const LAS f32x4*)(WT + c * DM + 512 * j + 8 * F.lane + 4 * hh);
                    a0 += (xv[0][j][hh].x * w.x + xv[0][j][hh].y * w.y) + (xv[0][j][hh].z * w.z + xv[0][j][hh].w * w.w);
                    a1 += (xv[1][j][hh].x * w.x + xv[1][j][hh].y * w.y) + (xv[1][j][hh].z * w.z + xv[1][j][hh].w * w.w); }
            const float s0 = wave_sum(a0), s1 = wave_sum(a1);
            if (F.lane == c) { my0 = s0; my1 = s1; }
            __builtin_amdgcn_sched_barrier(0); }
        if (F.lane < 16) { __hip_atomic_store(gates + (size_t)(2 * rp) * 16 + F.lane, my0 * rs0 + bgl, RLX_AGENT); __hip_atomic_store(gates + (size_t)(2 * rp + 1) * 16 + F.lane, my1 * rs1 + bgl, RLX_AGENT); }
    }
    VM_WAIT(); __syncthreads();
    if (F.tid == 0) __hip_atomic_fetch_add(cnt, 1u, RLX_AGENT);
}
__device__ __forceinline__ void gates_wait(Frame& F, gu32* cnt) {
    if (threadIdx.x == 0) { unsigned sp = 0; gu32* tmo = (gu32*)(F.ws + WS_CTL) + CW_TMO;
        while (__hip_atomic_load(cnt, RLX_AGENT) < (unsigned)F.G) { __builtin_amdgcn_s_sleep(2); if (++sp > (1u << 22)) { __hip_atomic_store(tmo, 1u, RLX_AGENT); break; } }
        __builtin_amdgcn_fence(__ATOMIC_ACQUIRE, "agent"); VM_WAIT(); }
    __syncthreads();
}

__device__ __forceinline__ float logsigmoidf_(float x) { return fminf(x, 0.f) - log1pf(__expf(-fabsf(x))); }
__device__ __forceinline__ void mlstm_prep(Frame& F, int b, int hh) {
    const float* gates = (const float*)(F.ws + WS_GATES);
    float* a2 = (float*)(F.ldsg + ab::A2_OFF); float* M2 = (float*)(F.ldsg + ab::M2_OFF); float* e2 = (float*)(F.ldsg + ab::E2_OFF); float* sc = (float*)(F.ldsg + ab::SCAN_OFF);
    int tid_ = F.tid; asm volatile("" : "+v"(tid_));
    const int lane_ = tid_ & 63;
    float lf[4], ig[4];
#pragma unroll
    for (int e = 0; e < 4; ++e) { const size_t idx = (size_t)(b * SEQ + 4 * tid_ + e) * 16; ig[e] = gates[idx + hh]; lf[e] = logsigmoidf_(gates[idx + 8 + hh]); }
    float c[4]; c[0] = lf[0]; c[1] = c[0] + lf[1]; c[2] = c[1] + lf[2]; c[3] = c[2] + lf[3];
    const float incl = wave_scan_sum(c[3]);
    if (lane_ == 63) sc[F.wave] = incl;
    __syncthreads();
    float wp = 0.f;
    for (int w = 0; w < F.wave; ++w) wp += sc[w];
    const float base = wp + incl - c[3];
    float Bv[4], av[4], mx[4];
#pragma unroll
    for (int e = 0; e < 4; ++e) { Bv[e] = base + c[e]; av[e] = ig[e] - Bv[e]; }
    mx[0] = av[0]; mx[1] = fmaxf(mx[0], av[1]); mx[2] = fmaxf(mx[1], av[2]); mx[3] = fmaxf(mx[2], av[3]);
    const float im = wave_scan_max(mx[3]);
    if (lane_ == 63) sc[16 + F.wave] = im;
    const float ex = dppf<0x138, 0xf>(-__builtin_inff(), im);
    __syncthreads();
    float wm = -__builtin_inff();
    for (int w = 0; w < F.wave; ++w) wm = fmaxf(wm, sc[16 + w]);
    const float pre = fmaxf(wm, ex);
    const float L2E = 1.4426950408889634f;
#pragma unroll
    for (int e = 0; e < 4; ++e) { const float M = fmaxf(pre, mx[e]); const int t = 4 * tid_ + e; a2[t] = av[e] * L2E; M2[t] = M * L2E; e2[t] = -(Bv[e] + M) * L2E; }
    __syncthreads();
}
__device__ __forceinline__ ab::BlockRef att_ref(Frame& F, int qt) {
    const int q = qt >> 8, t = qt & 255, hv = 16 * q + (t & 15), qb = 7 - (t >> 4), vh = hv & 1, c = (hv >> 1) & 1, hh = (hv >> 2) & 7, b = hv >> 5;
    ab::BlockRef r;
    r.Q = (const bf16*)(F.ws + WS_AQ) + (size_t)(b * SEQ + qb * 256) * 2048 + hh * 256 + c * 128;
    r.K = (const bf16*)(F.ws + WS_AK) + (size_t)(b * SEQ) * 2048 + hh * 256 + c * 128;
    r.V = (const bf16*)(F.ws + WS_AV) + (size_t)(b * SEQ) * 2048 + hh * 256 + vh * 128;
    r.O = (float*)((bf16*)(F.ws + WS_OATT) + (size_t)(b * SEQ + qb * 256) * 4096 + hh * 512 + c * 256 + vh * 128);
    r.P0 = qb * 256; r.Cst = nullptr; r.nst = nullptr; return r;
}
__device__ __forceinline__ ab::BlockRef mls_ref(Frame& F, int t) {
    const int bh = t >> 4, qb = (t >> 1) & 7, vh = t & 1, hh = bh & 7, b = bh >> 3;
    ab::BlockRef r;
    r.Q = (const bf16*)(F.ws + WS_MQ) + (size_t)(b * SEQ + qb * 256) * 1024 + hh * 128;
    r.K = (const bf16*)(F.ws + WS_MK) + (size_t)(b * SEQ) * 1024 + hh * 128;
    r.V = (const bf16*)(F.ws + WS_MV) + (size_t)(b * SEQ) * 2048 + hh * 256 + vh * 128;
    r.O = (float*)((bf16*)(F.ws + WS_HRAW) + (size_t)(b * SEQ + qb * 256) * 2048 + hh * 256 + vh * 128);
    r.P0 = qb * 256;
    r.Cst = qb ? (const bf16*)(F.ws + WS_CST) + ((size_t)(bh * 7 + qb - 1) * 128) * 256 + vh * 128 : nullptr;
    r.nst = qb ? (const float*)(F.ws + WS_NST) + (size_t)(bh * 7 + qb - 1) * 128 : nullptr;
    return r;
}
__device__ __forceinline__ ab::bf16x8 scale8(ab::bf16x8 v, float w) {
    ab::u32x4 q = *reinterpret_cast<ab::u32x4*>(&v); ab::u32x4 o;
    o.x = ab::cvtpk(__uint_as_float(q.x << 16) * w, __uint_as_float(q.x & 0xffff0000u) * w); o.y = ab::cvtpk(__uint_as_float(q.y << 16) * w, __uint_as_float(q.y & 0xffff0000u) * w);
    o.z = ab::cvtpk(__uint_as_float(q.z << 16) * w, __uint_as_float(q.z & 0xffff0000u) * w); o.w = ab::cvtpk(__uint_as_float(q.w << 16) * w, __uint_as_float(q.w & 0xffff0000u) * w);
    return *reinterpret_cast<ab::bf16x8*>(&o);
}
__device__ __forceinline__ float sum8(ab::bf16x8 v) {
    const ab::u32x4 q = *reinterpret_cast<const ab::u32x4*>(&v);
    return ((__uint_as_float(q.x << 16) + __uint_as_float(q.x & 0xffff0000u)) + (__uint_as_float(q.y << 16) + __uint_as_float(q.y & 0xffff0000u)))
         + ((__uint_as_float(q.z << 16) + __uint_as_float(q.z & 0xffff0000u)) + (__uint_as_float(q.w << 16) + __uint_as_float(q.w & 0xffff0000u)));
}
__device__ __forceinline__ void mls_scan(Frame& F, int bh, const int tid) {
    using namespace ab;
    char* lds = (char*)F.ldsg; const int b = bh >> 3, hh = bh & 7;
    const float* a2 = (const float*)(lds + A2_OFF); const float* M2 = (const float*)(lds + M2_OFF);
    const int wid = __builtin_amdgcn_readfirstlane(tid >> 6), lane = tid & 63, r32 = lane & 31, hi = lane >> 5, dgrp = wid & 3, vh = wid >> 2;
    const int sr = tid >> 4, sc = (tid & 15) * 8, vst0 = v_st(sr, sc), vst1 = v_st(32 + sr, sc);
    const bf16* Kp = (const bf16*)(F.ws + WS_MK) + (size_t)(b * SEQ) * 1024 + hh * 128;
    const bf16* Vp = (const bf16*)(F.ws + WS_MV) + (size_t)(b * SEQ) * 2048 + hh * 256;
    bf16* Cst = (bf16*)(F.ws + WS_CST) + (size_t)(bh * 7) * 128 * 256; float* nst = (float*)(F.ws + WS_NST) + (size_t)(bh * 7) * 128;
    const unsigned lok = (unsigned)((lane >> 4) * 1024 + sc), lov = (unsigned)((lane >> 4) * 2048 + sc);
    f32x16 C[4] = {}; float nacc = 0.f;
    const int vbA = (int)(uintptr_t)lds + v_rd_base(lane) + dgrp * 512;
    const int vbB = (int)(uintptr_t)lds + v_rd_base(lane) + 16384 * (1 + vh);
    bf16x8 ka[4], kb[4], va[4], vb[4], vc[4], vd[4];
#define SC_LOAD(i, s0) do { const bf16* kp_ = Kp + (size_t)((s0) + wid * 4) * 1024; const bf16* vp_ = Vp + (size_t)((s0) + wid * 4) * 2048; \
        ka[i] = load8(kp_ + lok); kb[i] = load8(kp_ + 32 * 1024 + lok); va[i] = load8(vp_ + lov); vb[i] = load8(vp_ + 32 * 2048 + lov); vc[i] = load8(vp_ + 128 + lov); vd[i] = load8(vp_ + 32 * 2048 + 128 + lov); } while (0)
#define SC_TRRD(dst, base, off) asm volatile("ds_read_b64_tr_b16 %0, %1 offset:%2" : "=&v"(dst) : "v"(base), "i"(off) : "memory")
#define SC_D0(d0) do { s16x4 l0, l1, l2, l3, h0, h1, h2, h3; constexpr int b_ = (d0) * 512; \
            SC_TRRD(l0, vbB, b_); SC_TRRD(h0, vbB, b_ + 2048); SC_TRRD(l1, vbB, b_ + 4096); SC_TRRD(h1, vbB, b_ + 6144); SC_TRRD(l2, vbB, b_ + 8192); SC_TRRD(h2, vbB, b_ + 10240); SC_TRRD(l3, vbB, b_ + 12288); SC_TRRD(h3, vbB, b_ + 14336); \
            asm volatile("s_waitcnt lgkmcnt(0)" ::: "memory"); SBAR(); \
            C[d0] = __builtin_amdgcn_mfma_f32_32x32x16_bf16(A0, (bf16x8){l0[0], l0[1], l0[2], l0[3], h0[0], h0[1], h0[2], h0[3]}, C[d0], 0, 0, 0); \
            C[d0] = __builtin_amdgcn_mfma_f32_32x32x16_bf16(A1, (bf16x8){l1[0], l1[1], l1[2], l1[3], h1[0], h1[1], h1[2], h1[3]}, C[d0], 0, 0, 0); \
            C[d0] = __builtin_amdgcn_mfma_f32_32x32x16_bf16(A2, (bf16x8){l2[0], l2[1], l2[2], l2[3], h2[0], h2[1], h2[2], h2[3]}, C[d0], 0, 0, 0); \
            C[d0] = __builtin_amdgcn_mfma_f32_32x32x16_bf16(A3, (bf16x8){l3[0], l3[1], l3[2], l3[3], h3[0], h3[1], h3[2], h3[3]}, C[d0], 0, 0, 0); } while (0)
#pragma unroll
    for (int i = 0; i < 4; ++i) SC_LOAD(i, 64 * i);
    for (int j = 0; j < 7; ++j) {
        const float mNew = M2[256 * (j + 1) - 1];
        if (j > 0) { const float dec = __builtin_amdgcn_exp2f(M2[256 * j - 1] - mNew);
#pragma unroll
            for (int d_ = 0; d_ < 4; ++d_)
#pragma unroll
                for (int r = 0; r < 16; ++r) C[d_][r] *= dec;
            nacc *= dec; }
#pragma unroll
        for (int tt = 0; tt < 4; ++tt) {
            const int s0 = 256 * j + 64 * tt;
            const float w0 = __builtin_amdgcn_exp2f(a2[s0 + sr] - mNew), w1 = __builtin_amdgcn_exp2f(a2[s0 + 32 + sr] - mNew);
            if (j < 6) { asm volatile("s_waitcnt vmcnt(18)" ::: "memory"); } else { asm volatile("s_waitcnt vmcnt(0)" ::: "memory"); }
            const bf16x8 ks0 = scale8(ka[tt], w0), ks1 = scale8(kb[tt], w1);
            __syncthreads();
            *(bf16x8*)(lds + vst0) = ks0; *(bf16x8*)(lds + vst1) = ks1;
            *(bf16x8*)(lds + 16384 + vst0) = va[tt]; *(bf16x8*)(lds + 16384 + vst1) = vb[tt]; *(bf16x8*)(lds + 32768 + vst0) = vc[tt]; *(bf16x8*)(lds + 32768 + vst1) = vd[tt];
            SBAR();
            if (j < 6) SC_LOAD(tt, s0 + 256);
            __syncthreads();
            s16x4 al0, ah0, al1, ah1, al2, ah2, al3, ah3;
            SC_TRRD(al0, vbA, 0); SC_TRRD(ah0, vbA, 2048); SC_TRRD(al1, vbA, 4096); SC_TRRD(ah1, vbA, 6144); SC_TRRD(al2, vbA, 8192); SC_TRRD(ah2, vbA, 10240); SC_TRRD(al3, vbA, 12288); SC_TRRD(ah3, vbA, 14336);
            asm volatile("s_waitcnt lgkmcnt(0)" ::: "memory"); SBAR();
            const bf16x8 A0 = (bf16x8){al0[0], al0[1], al0[2], al0[3], ah0[0], ah0[1], ah0[2], ah0[3]}, A1 = (bf16x8){al1[0], al1[1], al1[2], al1[3], ah1[0], ah1[1], ah1[2], ah1[3]};
            const bf16x8 A2 = (bf16x8){al2[0], al2[1], al2[2], al2[3], ah2[0], ah2[1], ah2[2], ah2[3]}, A3 = (bf16x8){al3[0], al3[1], al3[2], al3[3], ah3[0], ah3[1], ah3[2], ah3[3]};
            if (vh == 0) nacc += (sum8(A0) + sum8(A1)) + (sum8(A2) + sum8(A3));
            SC_D0(0); SC_D0(1); SC_D0(2); SC_D0(3);
        }
        { float nt = nacc; auto rr = __builtin_amdgcn_permlane32_swap(__float_as_uint(nt), __float_as_uint(nt), false, false); nt = __uint_as_float(rr[0]) + __uint_as_float(rr[1]);
          if (vh == 0 && hi == 0) nst[j * 128 + 32 * dgrp + r32] = nt; }
        bf16* Cj = Cst + ((size_t)j * 128 + 32 * dgrp) * 256 + 128 * vh; const unsigned loc = (unsigned)(4 * hi * 256 + r32);
#pragma unroll
        for (int r = 0; r < 16; ++r) { bf16* Cr = Cj + (size_t)((r & 3) + 8 * (r >> 2)) * 256;
#pragma unroll
            for (int d0 = 0; d0 < 4; ++d0) { const float v = C[d0][r]; const float nb = dppf<0xB1, 0xf>(0.f, v);
                if ((r32 & 1) == 0) *(unsigned*)(Cr + d0 * 32 + loc) = cvtpk(v, nb); } }
    }
#undef SC_LOAD
#undef SC_TRRD
#undef SC_D0
}
__device__ __forceinline__ void wait_word_ge(Frame& F, gu32* w, unsigned need) {
    if (threadIdx.x == 0) { unsigned sp = 0; gu32* tmo = (gu32*)(F.ws + WS_CTL) + CW_TMO;
        while (__hip_atomic_load(w, RLX_AGENT) < need) { __builtin_amdgcn_s_sleep(2); if (++sp > (1u << 22)) { __hip_atomic_store(tmo, 1u, RLX_AGENT); break; } }
        __builtin_amdgcn_fence(__ATOMIC_ACQUIRE, "agent"); VM_WAIT(); }
    __syncthreads();
}
__device__ __forceinline__ void mix_phase(Frame& F, int l, int rep) {
    char* lds = (char*)F.ldsg;
    constexpr int NMLS = 512, NSCAN = 32, NCVT = 64, NCVT1 = 64;
    gu32* ctl = (gu32*)(F.ws + WS_CTL);
    gu32* gcnt = ctl + CW_GCNT + 64 * (l + 4 * rep); gu32* sflag = ctl + CW_SFLAG + 64 * ((l + 4 * rep) * 32); gu32* tick = ctl + CW_TICK + 64 * (l + 4 * rep);
    gates_step(F, l, gcnt);
    { const bool tl = tail_idle(F.G) != 0; const int ncvt = (!tl || l == 0) ? NCVT : NCVT1;
      if (l + 1 < DEPTH && rep == 0 && F.bid >= NSCAN && F.bid < NSCAN + ncvt) {
        const int c0 = !tl ? (l + 1) * IT_LAYER : (l == 0 ? IT_A : (l + 1) * IT_LAYER), cn = !tl ? IT_LAYER : (l == 0 ? IT_LAYER : IT_A);
        cvt_run(F, c0, cn, (F.bid - NSCAN) * NWAVES + F.wave, ncvt * NWAVES);
        VM_WAIT(); __syncthreads();
      } }
    if (F.bid < NSCAN) {
        gates_wait(F, gcnt);
        int tid_s = threadIdx.x; asm volatile("" : "+v"(tid_s));
        mlstm_prep(F, F.bid >> 3, F.bid & 7);
        mls_scan(F, F.bid, tid_s);
        VM_WAIT(); __syncthreads();
        if (threadIdx.x == 0) { __builtin_amdgcn_fence(__ATOMIC_RELEASE, "agent"); VM_WAIT(); __hip_atomic_store(sflag + 64 * F.bid, 1u, RLX_AGENT); }
        __syncthreads();
    }
#ifndef NO_ATT
    { volatile LAS unsigned* tw = (volatile LAS unsigned*)(F.lds + MISC_OFF) + 16; gu32* atick = ctl + CW_ATICK + 64 * (8 * (l + 4 * rep));
      const int q0 = (int)(xb_xcc_id() & 7u); int qdone = 0;
#define TAKE_ATT(dst) do { if (threadIdx.x == 0) { int r_ = -1; for (int i_ = 0; i_ < 8; ++i_) { const int q_ = (q0 + i_) & 7; if (qdone & (1 << q_)) continue;               \
            const unsigned t_ = __hip_atomic_fetch_add(atick + 64 * q_, 1u, RLX_AGENT); if (t_ < 128u) { r_ = (q_ << 8) | (int)t_; break; } qdone |= 1 << q_; } tw[0] = (unsigned)r_; } \
        PP_BAR(); dst = __builtin_amdgcn_readfirstlane((int)tw[0]); PP_BAR(); } while (0)
      int qt; TAKE_ATT(qt);
      if (qt >= 0) {
          ab::BlockRef cur = att_ref(F, qt); ab::Seam S;
          int tid_a = threadIdx.x; asm volatile("" : "+v"(tid_a));
          ab::prime2<0, 2048, 2048, 2048>(cur, lds, S, tid_a);
          for (;;) {
              int qn; TAKE_ATT(qn);
              const bool last = qn < 0;
              const ab::BlockRef nxt = last ? cur : att_ref(F, qn);
              ab::block2<0, 2048, 2048, 2048, 4096>(cur, nxt, lds, S, tid_a);
              if (last) break;
              cur = nxt;
          }
          ab::pp_realign(tid_a);
      }
#undef TAKE_ATT
    }
#endif
    VM_WAIT(); __syncthreads();
#ifndef NO_MLS
    gates_wait(F, gcnt);
    { volatile LAS unsigned* tw = (volatile LAS unsigned*)(F.lds + MISC_OFF) + 16;
#define TAKE_TICKET(dst) do { if (threadIdx.x == 0) tw[0] = __hip_atomic_fetch_add(tick, 1u, RLX_AGENT); __syncthreads(); dst = __builtin_amdgcn_readfirstlane((int)tw[0]); __syncthreads(); } while (0)
      for (;;) {
          int t2; TAKE_TICKET(t2);
          if (t2 >= NMLS / 2) break;
          int tid_m = threadIdx.x; asm volatile("" : "+v"(tid_m));
          const int bh = t2 >> 3;
          mlstm_prep(F, bh >> 3, bh & 7); wait_word_ge(F, sflag + 64 * bh, 1u);
          const ab::BlockRef c0 = mls_ref(F, 2 * t2), c1 = mls_ref(F, 2 * t2 + 1); ab::Seam S;
          ab::prime2<1, 1024, 1024, 2048>(c0, lds, S, tid_m);
          ab::block2<1, 1024, 1024, 2048, 2048>(c0, c1, lds, S, tid_m);
          ab::block2<1, 1024, 1024, 2048, 2048>(c1, c1, lds, S, tid_m);
          ab::pp_realign(tid_m);
          VM_WAIT(); __syncthreads();
      }
#undef TAKE_TICKET
    }
    VM_WAIT(); __syncthreads();
#endif
}

__device__ __forceinline__ void fin_phase(Frame& F, int l) {
    const float* lq = inp(F, I_LAM_QK) + (size_t)l * 512;
    const float s1 = wave_sum(lq[F.lane] * lq[128 + F.lane] + lq[64 + F.lane] * lq[192 + F.lane]);
    const float s2 = wave_sum(lq[256 + F.lane] * lq[384 + F.lane] + lq[320 + F.lane] * lq[448 + F.lane]);
    const float lam_init = l == 0 ? 0.2f : (l == 1 ? 0.3555090675909693f : (l == 2 ? 0.4707130183435842f : 0.5560582041556406f));
    const float lam = expf(s1) - expf(s2) + lam_init, post = 1.0f - lam_init;
    const bf16* hraw = (const bf16*)(F.ws + WS_HRAW); const bf16* oat = (const bf16*)(F.ws + WS_OATT); const bf16* smo = (const bf16*)(F.ws + WS_SMO);
    bf16* hmn = (bf16*)(F.ws + WS_HMN); bf16* han = (bf16*)(F.ws + WS_HAN);
    { float* rowss = (float*)(F.ws + WS_ROWSS); float* rowsb = (float*)(F.ws + WS_ROWSS_B); for (int i = F.bid * 512 + F.tid; i < MTOK; i += F.G * 512) { rowss[i] = 0.f; rowsb[i] = 0.f; } }
    const int gw = F.bid * NWAVES + F.wave, NGW = F.G * NWAVES;
    const float* mg = inp(F, I_M_NORM) + (size_t)l * 2048; const float* ag = inp(F, I_A_NORM) + (size_t)l * 2048;
    f32x4 mgv[8], agv[8];
#pragma unroll
    for (int hh = 0; hh < 8; ++hh) { mgv[hh] = *(const f32x4*)(mg + hh * 256 + 4 * F.lane); agv[hh] = *(const f32x4*)(ag + hh * 256 + 4 * F.lane); }
    for (int row = gw; row < MTOK; row += NGW) {
        f32x4 hv[8], o0[8], o1[8]; v2u sw[8];
#pragma unroll
        for (int hh = 0; hh < 8; ++hh) { const v2u a = *(const v2u*)(hraw + (size_t)row * 2048 + hh * 256 + 4 * F.lane); hv[hh] = (f32x4){pg8::bf_lo(a.x), pg8::bf_hi(a.x), pg8::bf_lo(a.y), pg8::bf_hi(a.y)}; sw[hh] = *(const v2u*)(smo + (size_t)row * 2048 + hh * 256 + 4 * F.lane); }
#pragma unroll
        for (int hh = 0; hh < 8; ++hh) { const v2u a = *(const v2u*)(oat + (size_t)row * 4096 + hh * 512 + 4 * F.lane), c = *(const v2u*)(oat + (size_t)row * 4096 + hh * 512 + 256 + 4 * F.lane);
            o0[hh] = (f32x4){pg8::bf_lo(a.x), pg8::bf_hi(a.x), pg8::bf_lo(a.y), pg8::bf_hi(a.y)}; o1[hh] = (f32x4){pg8::bf_lo(c.x), pg8::bf_hi(c.x), pg8::bf_lo(c.y), pg8::bf_hi(c.y)}; }
#pragma unroll
        for (int hh = 0; hh < 8; ++hh) { const int col = hh * 256 + 4 * F.lane; const f32x4 v = hv[hh];
            const float rs = 1.0f / sqrtf(wave_sum((v.x * v.x + v.y * v.y) + (v.z * v.z + v.w * v.w)) * (1.0f / 256.0f) + EPS);
            const f32x4 g = mgv[hh]; const f32x4 sg = (f32x4){pg8::bf_lo(sw[hh].x), pg8::bf_hi(sw[hh].x), pg8::bf_lo(sw[hh].y), pg8::bf_hi(sw[hh].y)};
            const f32x4 o = v * rs * g * sg; v2u w; w.x = pk2(o.x, o.y); w.y = pk2(o.z, o.w); *(v2u*)(hmn + (size_t)row * 2048 + col) = w; }
#pragma unroll
        for (int hh = 0; hh < 8; ++hh) { const int col = hh * 256 + 4 * F.lane; const f32x4 v = o0[hh] - o1[hh] * lam;
            const float rs = 1.0f / sqrtf(wave_sum((v.x * v.x + v.y * v.y) + (v.z * v.z + v.w * v.w)) * (1.0f / 256.0f) + EPS);
            const f32x4 g = agv[hh];
            const f32x4 o = v * rs * g * post; v2u w; w.x = pk2(o.x, o.y); w.y = pk2(o.z, o.w); *(v2u*)(han + (size_t)row * 2048 + col) = w; }
    }
}

__device__ __forceinline__ void conv_fixup_panel(Frame& F, int l, int pm) {
    const float* fxc = (const float*)(F.ws + WS_FXC); const float* fxv = (const float*)(F.ws + WS_FXV); const float* fxg = (const float*)(F.ws + WS_FXG); bf16* u = (bf16*)(F.ws + WS_U);
    const float* cw = inp(F, I_CONV_W) + (size_t)l * 3 * DFF;
    constexpr int NI = 2 * 2 * (DFF / 4) / 512;
    static_assert(2 * 2 * (DFF / 4) == NI * 512, "fix-up item count");
#pragma unroll
    for (int i0 = 0; i0 < NI; i0 += 4) {
        f32x4 cp[4], vv[4], ga[4], gb[4], wa[4], wb[4]; int blkv[4], colv[4], rhov[4];
#pragma unroll
        for (int k = 0; k < 4; ++k) if (i0 + k < NI) { const int i = F.tid + (i0 + k) * 512, c4 = i % (DFF / 4), rr = i / (DFF / 4), rho = rr & 1, blk = pm * 2 + (rr >> 1), col = c4 * 4, pb = (blk & 15) ? blk - 1 : blk;
            blkv[k] = blk; colv[k] = col; rhov[k] = rho;
            cp[k] = *(const f32x4*)(fxc + ((size_t)blk * 2 + rho) * DFF + col); vv[k] = *(const f32x4*)(fxv + ((size_t)blk * 2 + rho) * DFF + col);
            ga[k] = *(const f32x4*)(fxg + ((size_t)pb * 2 + 1) * DFF + col); gb[k] = *(const f32x4*)(fxg + ((size_t)pb * 2) * DFF + col);
            wa[k] = *(const f32x4*)(cw + col); wb[k] = *(const f32x4*)(cw + DFF + col); }
#pragma unroll
        for (int k = 0; k < 4; ++k) if (i0 + k < NI) {
            if ((blkv[k] & 15) == 0) continue;
            const f32x4 cv = rhov[k] == 0 ? cp[k] + wb[k] * ga[k] + wa[k] * gb[k] : cp[k] + wa[k] * ga[k];
            f32x4 o;
#pragma unroll
            for (int j = 0; j < 4; ++j) o[j] = cv[j] * pg8::sigmoidf_fast(cv[j]) * vv[k][j];
            v2u w; w.x = pk2(o[0], o[1]); w.y = pk2(o[2], o[3]);
            *(v2u*)(u + ((size_t)blkv[k] * 128 + rhov[k]) * DFF + colv[k]) = w; }
    }
}

__device__ __forceinline__ void out_phase(Frame& F) {
    const float* h = (const float*)(F.ws + WS_H); const float* gf = inp(F, I_NORM_FINAL); float* out = (float*)inp(F, I_OUT);
    const int gw = F.bid * NWAVES + F.wave, NGW = F.G * NWAVES;
    f32x4 gv[8];
#pragma unroll
    for (int j = 0; j < 8; ++j) gv[j] = *((const f32x4*)gf + 64 * j + F.lane);
    for (int row = gw; row < MTOK; row += NGW) { const f32x4* xr = (const f32x4*)(h + (size_t)row * DM) + F.lane; f32x4 xv[8]; float ss = 0.f;
#pragma unroll
        for (int j = 0; j < 8; ++j) { xv[j] = xr[64 * j]; ss += (xv[j].x * xv[j].x + xv[j].y * xv[j].y) + (xv[j].z * xv[j].z + xv[j].w * xv[j].w); }
        const float rs = 1.0f / sqrtf(wave_sum(ss) * (1.0f / DM) + EPS); f32x4* o = (f32x4*)(out + (size_t)row * DM) + F.lane;
#pragma unroll
        for (int j = 0; j < 8; ++j) o[64 * j] = xv[j] * rs * gv[j]; }
}

__device__ __forceinline__ int nrep_opaque(int n) { asm volatile("" : "+s"(n)); return n; }
struct Args { const float* in[16]; float* out; unsigned char* ws; int ph_lo, ph_hi, li, pad; };
__global__ void __launch_bounds__(NWAVES * 64, 2) fwd(Args args) {
    extern __shared__ __attribute__((aligned(16))) unsigned char lds[];
    Frame F;
    F.lds = (LAS unsigned char*)lds; F.ldsg = lds;
    F.tid = threadIdx.x; F.lane = F.tid & 63; F.wave = __builtin_amdgcn_readfirstlane(F.tid >> 6);
    F.G = gridDim.x; F.bid = blockIdx.x; F.vcu = (F.G % 8 == 0) ? (F.bid % 8) * (F.G / 8) + F.bid / 8 : F.bid;
    F.ws = args.ws;
    volatile LAS unsigned* MISC = (volatile LAS unsigned*)(F.lds + MISC_OFF);
    for (int u = F.tid; u < 64; u += NWAVES * 64) MISC[u] = 0u;
    if (F.tid < I_NPTR) { const unsigned long long p = (F.tid == I_OUT) ? (unsigned long long)args.out : (unsigned long long)args.in[F.tid & 15];
        ((LAS unsigned*)(F.lds + PTAB_OFF))[2 * F.tid] = (unsigned)p; ((LAS unsigned*)(F.lds + PTAB_OFF))[2 * F.tid + 1] = (unsigned)(p >> 32); }
    __syncthreads();
    gu32* ctl = (gu32*)(F.ws + WS_CTL);
    XcdBarrier bar = xcd_barrier_post((unsigned*)(ctl + CW_BAR) + args.li * XCD_BAR_WORDS, MISC + 8);
    const int lo = args.ph_lo, hi = args.ph_hi;
#ifndef PH_MASK
#define PH_MASK 0xFFFF
#endif
#define EN(j) ((PH_MASK >> (j)) & 1)
#ifndef PROBE_REP
#define PROBE_REP 0
#endif
#define NREP(j) nrep_opaque(1 + ((PROBE_REP >> (j)) & 1))
#define IN(k) (lo <= (k) && (k) < hi)
#define LAUNDER() do { unsigned long long z_ = 0ull; asm volatile("" : "+s"(z_), "+s"(F.vcu), "+s"(F.bid), "+s"(F.G)); F.ws = args.ws + z_; F.tid = threadIdx.x; asm volatile("" : "+v"(F.tid)); F.lane = F.tid & 63; } while (0)
#define SEAM(k) do { if (IN(k) && IN((k) + 1)) xcd_barrier(bar); } while (0)
    if (EN(12) && IN(0)) { for (int rep_ = 0; rep_ < NREP(12); ++rep_) { LAUNDER(); p0_prologue(F); } SEAM(0); }
    for (int l = 0; l < DEPTH; ++l) {
        const int pb = 1 + l * NPH_L;
        bf16* XN = (bf16*)(F.ws + WS_XN);
        if (EN(0) && IN(pb + 0)) { for (int rep_ = 0; rep_ < NREP(0); ++rep_) { LAUNDER();
            pg8::Gemm g{XN, (const bf16*)(F.ws + WS_WIN + (size_t)l * SZ_WIN), MTOK, NING, DM, nullptr, nullptr}; pg8::StaticOrder S; S.init(MTOK, NING, F.G, F.bid);
            pg8::EpiInProj E{(bf16*)(F.ws + WS_MQ), (bf16*)(F.ws + WS_MK), (bf16*)(F.ws + WS_MV), (bf16*)(F.ws + WS_SMO), (bf16*)(F.ws + WS_AQ), (bf16*)(F.ws + WS_AK), (bf16*)(F.ws + WS_AV), (bf16*)(F.ws + WS_SG),
                             (const float*)(F.ws + WS_BIASG) + (size_t)l * NING, (const float*)(F.ws + WS_ROPE), (const float*)(F.ws + WS_ROWSS_B)};
            pg8::gemm_phase<pg8::EpiInProj, pg8::StaticOrder, true, true>(F.lds, g, S, E, F.tid);
            } SEAM(pb + 0); }
        if (EN(1) && IN(pb + 1)) { for (int rep_ = 0; rep_ < NREP(1); ++rep_) { LAUNDER(); mix_phase(F, l, rep_); } SEAM(pb + 1); }
        if (EN(2) && IN(pb + 2)) { for (int rep_ = 0; rep_ < NREP(2); ++rep_) { LAUNDER(); fin_phase(F, l); } SEAM(pb + 2); }
        if (EN(3) && IN(pb + 3)) { for (int rep_ = 0; rep_ < NREP(3); ++rep_) { LAUNDER();
            pg8::Gemm g{(const bf16*)(F.ws + WS_HMN), (const bf16*)(F.ws + WS_WBM + (size_t)l * SZ_WSQ), MTOK, DM, DM, (const bf16*)(F.ws + WS_HAN), (const bf16*)(F.ws + WS_WBD + (size_t)l * SZ_WSQ)};
            pg8::PairOrder S; S.init(MTOK, DM, F.G, F.bid);
            pg8::EpiMerge E{(bf16*)(F.ws + WS_Y), (const bf16*)(F.ws + WS_SG)};
            pg8::gemm_phase<pg8::EpiMerge, pg8::PairOrder, true, true>(F.lds, g, S, E, F.tid);
            } SEAM(pb + 3); }
        if (EN(4) && IN(pb + 4)) { for (int rep_ = 0; rep_ < NREP(4); ++rep_) { LAUNDER();
            pg8::Gemm g{(const bf16*)(F.ws + WS_Y), (const bf16*)(F.ws + WS_WO + (size_t)l * SZ_WSQ), MTOK, DM, DM, nullptr, nullptr}; pg8::StaticOrder S; S.init(MTOK, DM, F.G, F.bid);
            if (rep_ == 0) { pg8::EpiRes<true> E{(float*)(F.ws + WS_H), DM, XN, (float*)(F.ws + WS_ROWSS)};
            pg8::gemm_phase<pg8::EpiRes<true>, pg8::StaticOrder, false, true>(F.lds, g, S, E, F.tid); }
            else { pg8::EpiRes<false> E{(float*)(F.ws + WS_P), DM, nullptr, nullptr};
            pg8::gemm_phase<pg8::EpiRes<false>, pg8::StaticOrder, false, true>(F.lds, g, S, E, F.tid); }
            } SEAM(pb + 4); }
        if (EN(5) && IN(pb + 5)) { for (int rep_ = 0; rep_ < NREP(5); ++rep_) { LAUNDER();
            pg8::Gemm g{XN, (const bf16*)(F.ws + WS_WUP + (size_t)l * SZ_WUP), MTOK, NUP, DM, nullptr, nullptr}; pg8::StaticOrder S; S.init(MTOK, NUP, F.G, F.bid);
            pg8::EpiUpConv E{(bf16*)(F.ws + WS_U), DFF, (const float*)(F.ws + WS_ROWSS), inp(F, I_CONV_W) + (size_t)l * 3 * DFF, inp(F, I_CONV_B) + (size_t)l * DFF,
                             (float*)(F.ws + WS_FXC), (float*)(F.ws + WS_FXV), (float*)(F.ws + WS_FXG)};
            pg8::gemm_phase<pg8::EpiUpConv, pg8::StaticOrder, true, true, true>(F.lds, g, S, E, F.tid);
            { const int idle = tail_idle(F.G);
              if (idle && l + 1 < DEPTH && rep_ == 0 && F.bid >= F.G - idle) { VM_WAIT(); __syncthreads();
                  cvt_run(F, (l + 1) * IT_LAYER + IT_A, IT_LAYER - IT_A, (F.bid - (F.G - idle)) * NWAVES + F.wave, idle * NWAVES); VM_WAIT(); } }
            } SEAM(pb + 5); }
        if (EN(6) && IN(pb + 6)) { for (int rep_ = 0; rep_ < NREP(6); ++rep_) { LAUNDER();
            pg8::Gemm g{(const bf16*)(F.ws + WS_U), (const bf16*)(F.ws + WS_WDN + (size_t)l * SZ_WDN), MTOK, DM, DFF, nullptr, nullptr}; pg8::StaticOrder S; S.init(MTOK, DM, F.G, F.bid);
            { pg8::Unit fu; for (int i = 0; S.next(i, fu); ++i) conv_fixup_panel(F, l, fu.pm); VM_WAIT(); __syncthreads(); }
            if (rep_ == 0) { pg8::EpiRes<true> E{(float*)(F.ws + WS_H), DM, XN, (float*)(F.ws + WS_ROWSS_B)};
            pg8::gemm_phase<pg8::EpiRes<true>, pg8::StaticOrder, false, true>(F.lds, g, S, E, F.tid); }
            else { pg8::EpiRes<false> E{(float*)(F.ws + WS_P), DM, nullptr, nullptr};
            pg8::gemm_phase<pg8::EpiRes<false>, pg8::StaticOrder, false, true>(F.lds, g, S, E, F.tid); }
            } SEAM(pb + 6); }
    }
    if (EN(11) && IN(NPHASE - 1)) { LAUNDER(); out_phase(F); }
#undef IN
#undef SEAM
}

extern "C" void kernel_launch(void* const* d_in, const int* in_sizes, int n_in, void* d_out, int out_size, void* d_ws, size_t ws_size, hipStream_t stream) {
    static int grid = 0;
    if (grid == 0) {
        if (n_in != 16 || in_sizes[0] != MTOK * DM || out_size != MTOK * DM || ws_size < WS_END) {
            fprintf(stderr, "kernel_launch: unexpected shapes (n_in %d, in0 %d, out %d, ws %zu, need %zu)\n", n_in, n_in > 0 ? in_sizes[0] : -1, out_size, ws_size, (size_t)WS_END); grid = -1; return; }
        int dev = 0, cus = 0, per_cu = 0;
        if (hipGetDevice(&dev) != hipSuccess || hipDeviceGetAttribute(&cus, hipDeviceAttributeMultiprocessorCount, dev) != hipSuccess) { grid = -1; return; }
        if (hipFuncSetAttribute((const void*)fwd, hipFuncAttributeMaxDynamicSharedMemorySize, LDS_BYTES) != hipSuccess) { fprintf(stderr, "kernel_launch: hipFuncSetAttribute failed\n"); grid = -1; return; }
        if (hipOccupancyMaxActiveBlocksPerMultiprocessor(&per_cu, (const void*)fwd, NWAVES * 64, LDS_BYTES) != hipSuccess || per_cu < 1)
            fprintf(stderr, "kernel_launch: note: occupancy query reports %d workgroups per CU\n", per_cu);
        (void)hipGetLastError();
        grid = cus;
    }
    if (grid < 0) return;
    if (hipMemsetAsync((char*)d_ws + WS_CTL, 0, CTL_ZERO_BYTES, stream) != hipSuccess) return;
    Args a{};
    for (int i = 0; i < 16; ++i) a.in[i] = (const float*)d_in[i];
    a.out = (float*)d_out; a.ws = (unsigned char*)d_ws;
#if MK_SPLIT
    for (int p = 0; p < NPHASE; ++p) { a.ph_lo = p; a.ph_hi = p + 1; a.li = p; hipLaunchKernelGGL(fwd, dim3(grid), dim3(NWAVES * 64), LDS_BYTES, stream, a); }
#else
    a.ph_lo = 0; a.ph_hi = NPHASE; a.li = 0;
    hipLaunchKernelGGL(fwd, dim3(grid), dim3(NWAVES * 64), LDS_BYTES, stream, a);
#endif
    const hipError_t le = hipPeekAtLastError();
    if (le != hipSuccess) fprintf(stderr, "kernel_launch: launch failed: %s\n", hipGetErrorName(le));
}
```

```cpp
#include <hip/hip_runtime.h>
#include <cstdio>
#include <cstdint>

#ifndef MK_SPLIT
#define MK_SPLIT 0
#define TP_MASK 0x0
#define TPS 0
#define TPS_WG 0
#endif

namespace pg8 {
#define PG8_LAS __attribute__((address_space(3)))
typedef unsigned short bf16_t;
typedef short bf16x8 __attribute__((ext_vector_type(8)));
typedef float f32x4 __attribute__((ext_vector_type(4)));
typedef float f32x2 __attribute__((ext_vector_type(2)));
typedef unsigned u32x4 __attribute__((ext_vector_type(4)));
typedef unsigned u32x2 __attribute__((ext_vector_type(2)));
constexpr int BM = 256, BK = 64, HALF = 128, HTB = HALF * BK * 2, STAGE_BYTES = 8 * HTB, NXCD = 8, WGM = 8;

__host__ __device__ __forceinline__ int lds_byte(int r, int c) { const int st = (r >> 4) * 2 + (c >> 5), rr = r & 15, cc = c & 31, ob = rr * 64 + cc * 2; return st * 1024 + (ob ^ (((ob >> 9) & 1) << 5)); }
__host__ __device__ __forceinline__ void stage_rc(int b, int& R, int& C) { const int st = b / 1024, sb = b % 1024, swz = sb ^ (((sb >> 9) & 1) << 5); R = (st >> 1) * 16 + swz / 64; C = (st & 1) * 32 + (swz % 64) / 2; }
__host__ __device__ __forceinline__ int perm32(int rho) { const int n = rho >> 4, i = rho & 15; return 8 * (i >> 2) + 4 * n + (i & 3); }

struct Unit { int pm, pn, sel; };
struct Gemm { const bf16_t* A; const bf16_t* Bt; int M, N, K; const bf16_t* A1; const bf16_t* Bt1; };

struct StaticOrder {
    int nM, nN, nwg, G, c;
    __host__ __device__ __forceinline__ void init(int M, int N, int G_, int c_) { nM = M / BM; nN = N / BM; nwg = nM * nN; G = G_; c = c_; }
    __host__ __device__ __forceinline__ bool next(int i, Unit& u) const {
        const long L = (long)i * G + c; if (L >= nwg) return false;
        int wgid = (int)L; { const int q = nwg / NXCD, r = nwg % NXCD, xcd = wgid % NXCD, off = wgid / NXCD; wgid = (xcd < r ? xcd * (q + 1) : r * (q + 1) + (xcd - r) * q) + off; }
        const int nig = WGM * nN, gid = wgid / nig, fm = gid * WGM, gsz = (nM - fm) < WGM ? (nM - fm) : WGM;
        u.pm = fm + ((wgid % nig) % gsz); u.pn = (wgid % nig) / gsz; u.sel = 0; return true;
    }
    __device__ __forceinline__ void a_ready(const Unit&) const {}
    __device__ __forceinline__ void done(const Unit&) const {}
};
struct PairOrder : StaticOrder {
    __host__ __device__ __forceinline__ bool next(int i, Unit& u) const { if (!StaticOrder::next(i >> 1, u)) return false; u.sel = i & 1; return true; }
};

__device__ __forceinline__ unsigned cvt_pk_bf16(float lo, float hi) { unsigned r; asm volatile("v_cvt_pk_bf16_f32 %0, %1, %2" : "=v"(r) : "v"(lo), "v"(hi)); return r; }
__device__ __forceinline__ float bf_lo(unsigned w) { return __uint_as_float(w << 16); }
__device__ __forceinline__ float bf_hi(unsigned w) { return __uint_as_float(w & 0xffff0000u); }
__device__ __forceinline__ float sigmoidf_fast(float x) { return __builtin_amdgcn_rcpf(1.0f + __builtin_amdgcn_exp2f(-1.4426950408889634f * x)); }
typedef unsigned long long u64_t;
__device__ __forceinline__ u64_t ss_fix(float ss) { const double d = (double)ss * 16777216.0; const unsigned hi = (unsigned)(d * (1.0 / 4294967296.0)); const unsigned lo = (unsigned)__builtin_fma(-(double)hi, 4294967296.0, d); return ((u64_t)hi << 32) | lo; }
__device__ __forceinline__ float ss_f32(u64_t v) { return (float)(__builtin_fma((double)(unsigned)(v >> 32), 4294967296.0, (double)(unsigned)v) * (1.0 / 16777216.0)); }

struct EpiInProj {
    static constexpr bool PERM = true, AFTER_DRAIN = false, CHAIN = false;
    bf16_t *mq, *mk, *mv, *smo, *aq, *ak, *av, *sg; const float* bias; const float* rope; const u64_t* rowss;
    __device__ __forceinline__ void operator()(const f32x4 (&acc)[2][2][4][2], const Unit& u, int wr, int wc, int fr, int fq) const {
        const int pn = u.pn; bf16_t* base; int ldc, colt, kind = 0; float sc = 1.f;
        if (pn < 4) { base = mq; ldc = 1024; colt = pn * 256; }
        else if (pn < 8) { base = mk; ldc = 1024; colt = (pn - 4) * 256; sc = 0.08838834764831845f; }
        else if (pn < 16) { base = mv; ldc = 2048; colt = (pn - 8) * 256; }
        else if (pn < 24) { base = smo; ldc = 2048; colt = (pn - 16) * 256; kind = 2; }
        else if (pn < 32) { base = aq; ldc = 2048; colt = (pn - 24) * 256; kind = 1; }
        else if (pn < 40) { base = ak; ldc = 2048; colt = (pn - 32) * 256; kind = 1; }
        else if (pn < 48) { base = av; ldc = 2048; colt = (pn - 40) * 256; }
        else { base = sg; ldc = 4096; colt = (pn - 48) * 256; kind = 2; }
        const int row0 = u.pm * BM + wr * 64 + fr, col0 = colt + wc * 32 + 8 * fq, bcol0 = pn * BM + wc * 32 + 8 * fq;
        f32x4 bv[2][2];
#pragma unroll
        for (int bj = 0; bj < 2; ++bj)
#pragma unroll
            for (int n = 0; n < 2; ++n) bv[bj][n] = *(const f32x4*)(bias + bcol0 + bj * HALF + 4 * n);
        const bool dorope = (kind == 1) && (wc == 0);
        u64_t rsu[2][4]; float rsv[2][4];
#pragma unroll
        for (int ai = 0; ai < 2; ++ai)
#pragma unroll
            for (int m = 0; m < 4; ++m) rsu[ai][m] = rowss[row0 + ai * HALF + m * 16];
#pragma unroll
        for (int ai = 0; ai < 2; ++ai)
#pragma unroll
            for (int m = 0; m < 4; ++m) rsv[ai][m] = ss_f32(rsu[ai][m]);
#pragma unroll
        for (int ai = 0; ai < 2; ++ai) {
            f32x4 cvv[4], svv[4];
#pragma unroll
            for (int m = 0; m < 4; ++m) { cvv[m] = (f32x4){1.f, 1.f, 1.f, 1.f}; svv[m] = (f32x4){0.f, 0.f, 0.f, 0.f}; }
            if (dorope) {
#pragma unroll
                for (int m = 0; m < 4; ++m) { const float* cs = rope + (size_t)((row0 + ai * HALF + m * 16) & 2047) * 32 + 4 * fq; cvv[m] = *(const f32x4*)cs; svv[m] = *(const f32x4*)(cs + 16); } }
#pragma unroll
            for (int m = 0; m < 4; ++m) { const int row = row0 + ai * HALF + m * 16; bf16_t* rowp = base + (size_t)row * ldc + col0;
                const float rs = 1.0f / sqrtf(rsv[ai][m] * (1.0f / 2048.0f) + 1e-6f);
                const f32x4 cv = cvv[m], sv = svv[m];
#pragma unroll
                for (int bj = 0; bj < 2; ++bj) { f32x4 v0 = (acc[ai][bj][m][0] * rs + bv[bj][0]) * sc, v1 = (acc[ai][bj][m][1] * rs + bv[bj][1]) * sc;
                    if (dorope) { f32x4 r0, r1;
                        r0[0] = v0[0] * cv[0] - v0[1] * sv[0]; r0[1] = v0[1] * cv[0] + v0[0] * sv[0]; r0[2] = v0[2] * cv[1] - v0[3] * sv[1]; r0[3] = v0[3] * cv[1] + v0[2] * sv[1];
                        r1[0] = v1[0] * cv[2] - v1[1] * sv[2]; r1[1] = v1[1] * cv[2] + v1[0] * sv[2]; r1[2] = v1[2] * cv[3] - v1[3] * sv[3]; r1[3] = v1[3] * cv[3] + v1[2] * sv[3];
                        v0 = r0; v1 = r1; }
                    if (kind == 2) {
#pragma unroll
                        for (int j = 0; j < 4; ++j) { v0[j] = sigmoidf_fast(v0[j]); v1[j] = sigmoidf_fast(v1[j]); } }
                    u32x4 w; w.x = cvt_pk_bf16(v0[0], v0[1]); w.y = cvt_pk_bf16(v0[2], v0[3]); w.z = cvt_pk_bf16(v1[0], v1[1]); w.w = cvt_pk_bf16(v1[2], v1[3]);
                    *(u32x4*)(rowp + bj * HALF) = w; } } }
    }
};
template <int CTRL> __device__ __forceinline__ f32x4 dpp4(const f32x4 v) { f32x4 r;
#pragma unroll
    for (int j = 0; j < 4; ++j) r[j] = __uint_as_float(__builtin_amdgcn_update_dpp(0u, __float_as_uint(v[j]), CTRL, 0xf, 0xf, false));
    return r; }
struct EpiUpConv {
    static constexpr bool PERM = true, AFTER_DRAIN = false, CHAIN = false;
    bf16_t* u; int ldc; const u64_t* rowss; const float* cw; const float* cb; float *fxc, *fxv, *fxg;
    __device__ __forceinline__ void operator()(const f32x4 (&acc)[2][2][4][2], const Unit& un, int wr, int wc, int fr, int fq) const {
        const int col0 = un.pn * HALF + wc * 32 + 8 * fq, blk = un.pm * 2 + wr, rowb = blk * 128 + fr;
        f32x4 w0[2], w1[2], w2[2], bb[2];
#pragma unroll
        for (int n = 0; n < 2; ++n) { w0[n] = *(const f32x4*)(cw + col0 + 4 * n); w1[n] = *(const f32x4*)(cw + ldc + col0 + 4 * n); w2[n] = *(const f32x4*)(cw + 2 * ldc + col0 + 4 * n); bb[n] = *(const f32x4*)(cb + col0 + 4 * n); }
        f32x4 p1[2], p2[2];
        p1[0] = p1[1] = p2[0] = p2[1] = (f32x4){0.f, 0.f, 0.f, 0.f};
        u64_t rsu[8]; float rsv[8];
#pragma unroll
        for (int q = 0; q < 8; ++q) rsu[q] = rowss[rowb + 16 * q];
#pragma unroll
        for (int q = 0; q < 8; ++q) rsv[q] = ss_f32(rsu[q]);
#pragma unroll
        for (int q = 0; q < 8; ++q) { const int ai = q >> 2, m = q & 3, row = rowb + 16 * q;
            const float rs = 1.0f / sqrtf(rsv[q] * (1.0f / 2048.0f) + 1e-6f);
            u32x4 w;
#pragma unroll
            for (int n = 0; n < 2; ++n) { const f32x4 g = acc[ai][0][m][n] * rs, v = acc[ai][1][m][n] * rs;
                const f32x4 r1 = dpp4<0x121>(g), r2 = dpp4<0x122>(g);
                f32x4 g1, g2;
#pragma unroll
                for (int j = 0; j < 4; ++j) { g1[j] = fr >= 1 ? r1[j] : p1[n][j]; g2[j] = fr >= 2 ? r2[j] : p2[n][j]; }
                p1[n] = r1; p2[n] = r2;
                const f32x4 cv = w0[n] * g2 + w1[n] * g1 + w2[n] * g + bb[n];
                f32x4 o;
#pragma unroll
                for (int j = 0; j < 4; ++j) o[j] = cv[j] * sigmoidf_fast(cv[j]) * v[j];
                if (n == 0) { w.x = cvt_pk_bf16(o[0], o[1]); w.y = cvt_pk_bf16(o[2], o[3]); } else { w.z = cvt_pk_bf16(o[0], o[1]); w.w = cvt_pk_bf16(o[2], o[3]); }
                if (q == 0 && fr < 2) { *(f32x4*)(fxc + ((size_t)blk * 2 + fr) * ldc + col0 + 4 * n) = cv; *(f32x4*)(fxv + ((size_t)blk * 2 + fr) * ldc + col0 + 4 * n) = v; }
                if (q == 7 && fr >= 14) *(f32x4*)(fxg + ((size_t)blk * 2 + (fr - 14)) * ldc + col0 + 4 * n) = g; }
            *(u32x4*)(u + (size_t)row * ldc + col0) = w; }
    }
};
struct EpiMerge {
    static constexpr bool PERM = false, AFTER_DRAIN = false, CHAIN = true;
    bf16_t* y; const bf16_t* sg;
    __device__ __forceinline__ void mid(f32x4 (&acc)[2][2][4][2], const Unit& u, int wr, int wc, int fr, int fq) const {
        const int row0 = u.pm * BM + wr * 64 + fr, col0 = u.pn * BM + wc * 32 + 4 * fq;
#pragma unroll
        for (int ai = 0; ai < 2; ++ai)
#pragma unroll
            for (int m = 0; m < 4; ++m) { const int row = row0 + ai * HALF + m * 16;
                u32x2 gm[2][2], gd[2][2];
#pragma unroll
                for (int bj = 0; bj < 2; ++bj)
#pragma unroll
                    for (int n = 0; n < 2; ++n) { const int col = col0 + bj * HALF + n * 16; gm[bj][n] = *(const u32x2*)(sg + (size_t)row * 4096 + col); gd[bj][n] = *(const u32x2*)(sg + (size_t)row * 4096 + 2048 + col); }
#pragma unroll
                for (int bj = 0; bj < 2; ++bj)
#pragma unroll
                    for (int n = 0; n < 2; ++n) { const u32x2 a = gm[bj][n], d = gd[bj][n];
                        const f32x4 num = (f32x4){bf_lo(a.x), bf_hi(a.x), bf_lo(a.y), bf_hi(a.y)}, den = (f32x4){bf_lo(d.x), bf_hi(d.x), bf_lo(d.y), bf_hi(d.y)};
#pragma unroll
                        for (int j = 0; j < 4; ++j) acc[ai][bj][m][n][j] *= num[j] * __builtin_amdgcn_rcpf(fmaxf(den[j], 1e-30f)); } }
    }
    __device__ __forceinline__ void operator()(const f32x4 (&acc)[2][2][4][2], const Unit& u, int wr, int wc, int fr, int fq) const {
        const int row0 = u.pm * BM + wr * 64 + fr, col0 = u.pn * BM + wc * 32 + 4 * fq;
#pragma unroll
        for (int ai = 0; ai < 2; ++ai)
#pragma unroll
            for (int mp = 0; mp < 2; ++mp) {
                u32x2 gw[2][2][2];
#pragma unroll
                for (int mm = 0; mm < 2; ++mm)
#pragma unroll
                    for (int bj = 0; bj < 2; ++bj)
#pragma unroll
                        for (int n = 0; n < 2; ++n) gw[mm][bj][n] = *(const u32x2*)(sg + (size_t)(row0 + ai * HALF + (2 * mp + mm) * 16) * 4096 + 2048 + col0 + bj * HALF + n * 16);
#pragma unroll
                for (int mm = 0; mm < 2; ++mm)
#pragma unroll
                    for (int bj = 0; bj < 2; ++bj)
#pragma unroll
                        for (int n = 0; n < 2; ++n) { const int m = 2 * mp + mm, row = row0 + ai * HALF + m * 16, col = col0 + bj * HALF + n * 16;
                            const u32x2 g2 = gw[mm][bj][n]; f32x4 g = (f32x4){bf_lo(g2.x), bf_hi(g2.x), bf_lo(g2.y), bf_hi(g2.y)};
#pragma unroll
                            for (int j = 0; j < 4; ++j) g[j] = fmaxf(g[j], 1e-30f);
                            const f32x4 v = acc[ai][bj][m][n] * g;
                            u32x2 w; w.x = cvt_pk_bf16(v[0], v[1]); w.y = cvt_pk_bf16(v[2], v[3]); *(u32x2*)(y + (size_t)row * 2048 + col) = w; }
                asm volatile("" ::: "memory"); }
    }
};
template <bool STATS> struct EpiRes {
    static constexpr bool PERM = true, AFTER_DRAIN = false, CHAIN = false;
    bf16_t* hb; int ldc; u64_t* rowss;
    __device__ __forceinline__ void operator()(const f32x4 (&acc)[2][2][4][2], const Unit& u, int wr, int wc, int fr, int fq) const {
        const int row0 = u.pm * BM + wr * 64 + fr, col0 = u.pn * BM + wc * 32 + 8 * fq;
#pragma unroll
        for (int ai = 0; ai < 2; ++ai) {
            u32x4 hv[4][2];
#pragma unroll
            for (int m = 0; m < 4; ++m)
#pragma unroll
                for (int bj = 0; bj < 2; ++bj) hv[m][bj] = *(const u32x4*)(hb + (size_t)(row0 + ai * HALF + m * 16) * ldc + col0 + bj * HALF);
#pragma unroll
            for (int m = 0; m < 4; ++m) { const int row = row0 + ai * HALF + m * 16; float ss = 0.f;
#pragma unroll
                for (int bj = 0; bj < 2; ++bj) { const u32x4 x = hv[m][bj]; const f32x4 a0 = acc[ai][bj][m][0], a1 = acc[ai][bj][m][1]; u32x4 w;
                    w.x = cvt_pk_bf16(bf_lo(x.x) + a0[0], bf_hi(x.x) + a0[1]); w.y = cvt_pk_bf16(bf_lo(x.y) + a0[2], bf_hi(x.y) + a0[3]);
                    w.z = cvt_pk_bf16(bf_lo(x.z) + a1[0], bf_hi(x.z) + a1[1]); w.w = cvt_pk_bf16(bf_lo(x.w) + a1[2], bf_hi(x.w) + a1[3]);
                    *(u32x4*)(hb + (size_t)row * ldc + col0 + bj * HALF) = w;
                    if (STATS) { ss += (bf_lo(w.x) * bf_lo(w.x) + bf_hi(w.x) * bf_hi(w.x)) + (bf_lo(w.y) * bf_lo(w.y) + bf_hi(w.y) * bf_hi(w.y));
                                 ss += (bf_lo(w.z) * bf_lo(w.z) + bf_hi(w.z) * bf_hi(w.z)) + (bf_lo(w.w) * bf_lo(w.w) + bf_hi(w.w) * bf_hi(w.w)); } }
                if (STATS) {
                    { auto rr = __builtin_amdgcn_permlane16_swap(__float_as_uint(ss), __float_as_uint(ss), false, false); ss = __uint_as_float(rr[0]) + __uint_as_float(rr[1]); }
                    { auto rr = __builtin_amdgcn_permlane32_swap(__float_as_uint(ss), __float_as_uint(ss), false, false); ss = __uint_as_float(rr[0]) + __uint_as_float(rr[1]); }
                    if (fq == 0) __hip_atomic_fetch_add(rowss + row, ss_fix(ss), __ATOMIC_RELAXED, __HIP_MEMORY_SCOPE_AGENT); } }
            asm volatile("" ::: "memory"); }
    }
};

template <class Epi, class Sched, bool ALIGN_EPI = false, bool SP2 = false, bool APERM = false>
__device__ __forceinline__ void gemm_phase(PG8_LAS unsigned char* lds, const Gemm g, const Sched& S, const Epi& E, const int tid) {
    const int wid = __builtin_amdgcn_readfirstlane(tid >> 6), lane = tid & 63, wr = wid >> 2, wc = wid & 3, fr = lane & 15, fq = lane >> 4;
    const int K = g.K, nt = K / BK;
    unsigned voffA[2], voffB[2];
#pragma unroll
    for (int i = 0; i < 2; ++i) { int R, C; stage_rc(tid * 16 + i * 8192, R, C); const int Rb = Epi::PERM ? ((R & ~31) + perm32(R & 31)) : R;
        const int Ra = APERM ? ((R >> 6) * 128 + (R & 63)) : R;
        voffA[i] = (unsigned)(Ra * K + C) * 2u; voffB[i] = (unsigned)(Rb * K + C) * 2u; }
    const size_t kstep = (size_t)(BK * 2);
    const size_t hstep = (size_t)HALF * K * 2;
    const size_t hstepA = APERM ? (size_t)64 * K * 2 : hstep;
    const size_t tstep = 2 * hstep;
    const unsigned ldsw = (unsigned)wid * 1024u;
    const int aoff = lds_byte(wr * 64 + fr, fq * 8), boff = lds_byte(wc * 32 + fr, fq * 8);
#define PG8_SA(b, h) (((b) * 2 + (h)) * HTB)
#define PG8_SB(b, h) ((4 + (b) * 2 + (h)) * HTB)
#define PG8_STAGE(bufoff, gbase, voff) do { _Pragma("unroll") for (int _i = 0; _i < 2; ++_i) \
        __builtin_amdgcn_global_load_lds((const unsigned*)((const char*)(gbase) + (voff)[_i]), (PG8_LAS unsigned*)(lds + (bufoff) + ldsw + _i * 8192), 16, 0, 0); } while (0)
#define PG8_LDA(dst, b, h) do { _Pragma("unroll") for (int m = 0; m < 4; ++m) _Pragma("unroll") for (int k = 0; k < 2; ++k) dst[m][k] = *(const PG8_LAS bf16x8*)(lds + PG8_SA(b, h) + aoff + m * 2048 + k * 1024); } while (0)
#define PG8_LDB(dst, b, h) do { _Pragma("unroll") for (int n = 0; n < 2; ++n) _Pragma("unroll") for (int k = 0; k < 2; ++k) dst[n][k] = *(const PG8_LAS bf16x8*)(lds + PG8_SB(b, h) + boff + n * 2048 + k * 1024); } while (0)
#define PG8_MMA(ai, bj, At, Bt) do { __builtin_amdgcn_s_setprio(1); _Pragma("unroll") for (int m = 0; m < 4; ++m) _Pragma("unroll") for (int n = 0; n < 2; ++n) _Pragma("unroll") for (int k = 0; k < 2; ++k) \
        acc[ai][bj][m][n] = __builtin_amdgcn_mfma_f32_16x16x32_bf16(Bt[n][k], At[m][k], acc[ai][bj][m][n], 0, 0, 0); __builtin_amdgcn_s_setprio(0); } while (0)
#define PG8_WAIT_V(n) asm volatile("s_waitcnt vmcnt(" #n ")" ::: "memory")
#define PG8_WAIT_L(n) asm volatile("s_waitcnt lgkmcnt(" #n ")" ::: "memory")
#define PG8_BAR __builtin_amdgcn_s_barrier()
#define PG8_SCHED __builtin_amdgcn_sched_barrier(0)
    Unit cur, nxt; int ui = 0;
    if (!S.next(0, cur)) return;
    f32x4 acc[2][2][4][2];
#pragma unroll
    for (int a = 0; a < 2; ++a)
#pragma unroll
        for (int b = 0; b < 2; ++b)
#pragma unroll
            for (int m = 0; m < 4; ++m)
#pragma unroll
                for (int n = 0; n < 2; ++n) acc[a][b][m][n] = (f32x4){0.f, 0.f, 0.f, 0.f};
    bf16x8 At[4][2], B0[2][2], B1[2][2];
    const char* cA = (const char*)(cur.sel ? g.A1 : g.A) + (size_t)cur.pm * tstep; const char* cB = (const char*)(cur.sel ? g.Bt1 : g.Bt) + (size_t)cur.pn * tstep;
    S.a_ready(cur);
    if constexpr (SP2) {
        PG8_STAGE(PG8_SB(0, 0), cB, voffB); PG8_STAGE(PG8_SB(0, 1), cB + hstep, voffB); PG8_STAGE(PG8_SA(0, 0), cA, voffA); PG8_STAGE(PG8_SA(0, 1), cA + hstepA, voffA);
        if (wr == 1) PG8_BAR;
        PG8_WAIT_V(2); PG8_BAR;
        PG8_STAGE(PG8_SB(1, 0), cB + kstep, voffB); PG8_STAGE(PG8_SA(1, 0), cA + kstep, voffA); PG8_STAGE(PG8_SB(1, 1), cB + hstep + kstep, voffB);
        PG8_WAIT_V(6); PG8_BAR;
    } else {
        PG8_STAGE(PG8_SB(0, 0), cB, voffB); PG8_STAGE(PG8_SA(0, 0), cA, voffA); PG8_STAGE(PG8_SB(0, 1), cB + hstep, voffB); PG8_STAGE(PG8_SA(0, 1), cA + hstepA, voffA);
        if (wr == 1) PG8_BAR;
        PG8_WAIT_V(4); PG8_BAR;
        PG8_STAGE(PG8_SB(1, 0), cB + kstep, voffB); PG8_STAGE(PG8_SA(1, 0), cA + kstep, voffA); PG8_STAGE(PG8_SB(1, 1), cB + hstep + kstep, voffB);
        PG8_WAIT_V(6); PG8_BAR;
    }
    for (;;) {
        const bool has_next = S.next(ui + 1, nxt);
        const char* nA = has_next ? (const char*)(nxt.sel ? g.A1 : g.A) + (size_t)nxt.pm * tstep : cA; const char* nB = has_next ? (const char*)(nxt.sel ? g.Bt1 : g.Bt) + (size_t)nxt.pn * tstep : cB;
        for (int t = 0; t < nt; t += 2) {
            const bool last = (t == nt - 2);
            const char* a1 = cA + (size_t)(t + 1) * kstep;
            const char* a2 = last ? nA : cA + (size_t)(t + 2) * kstep; const char* b2 = last ? nB : cB + (size_t)(t + 2) * kstep;
            const char* a3 = a2 + kstep; const char* b3 = b2 + kstep;
            if (last && has_next) S.a_ready(nxt);
            if constexpr (SP2) {
            PG8_LDB(B0, 0, 0); PG8_LDB(B1, 0, 1); PG8_SCHED; PG8_LDA(At, 0, 0); PG8_STAGE(PG8_SA(1, 1), a1 + hstepA, voffA);
            PG8_WAIT_V(8); PG8_WAIT_L(0); PG8_BAR; PG8_MMA(0, 0, At, B0); PG8_MMA(0, 1, At, B1); PG8_BAR; PG8_SCHED;
            PG8_LDA(At, 0, 1); PG8_STAGE(PG8_SB(0, 0), b2, voffB); PG8_STAGE(PG8_SB(0, 1), b2 + hstep, voffB); PG8_STAGE(PG8_SA(0, 0), a2, voffA);
            PG8_WAIT_V(8); PG8_WAIT_L(0); PG8_BAR; PG8_MMA(1, 0, At, B0); PG8_MMA(1, 1, At, B1); PG8_BAR; PG8_SCHED;
            PG8_LDB(B0, 1, 0); PG8_LDB(B1, 1, 1); PG8_SCHED; PG8_LDA(At, 1, 0); PG8_STAGE(PG8_SA(0, 1), a2 + hstepA, voffA);
            PG8_WAIT_V(8); PG8_WAIT_L(0); PG8_BAR; PG8_MMA(0, 0, At, B0); PG8_MMA(0, 1, At, B1); PG8_BAR; PG8_SCHED;
            PG8_LDA(At, 1, 1); PG8_STAGE(PG8_SB(1, 0), b3, voffB); PG8_STAGE(PG8_SB(1, 1), b3 + hstep, voffB); PG8_STAGE(PG8_SA(1, 0), a3, voffA);
            PG8_WAIT_V(8); PG8_WAIT_L(0); PG8_BAR; PG8_MMA(1, 0, At, B0); PG8_MMA(1, 1, At, B1); PG8_BAR; PG8_SCHED;
            } else {
            PG8_LDB(B0, 0, 0); PG8_SCHED; PG8_LDA(At, 0, 0); PG8_STAGE(PG8_SA(1, 1), a1 + hstepA, voffA);
            PG8_WAIT_L(8); PG8_BAR; PG8_WAIT_L(0); PG8_MMA(0, 0, At, B0); PG8_BAR; PG8_SCHED;
            PG8_LDB(B1, 0, 1); PG8_STAGE(PG8_SB(0, 0), b2, voffB);
            PG8_BAR; PG8_WAIT_L(0); PG8_MMA(0, 1, At, B1); PG8_BAR;
            PG8_LDA(At, 0, 1); PG8_STAGE(PG8_SA(0, 0), a2, voffA);
            PG8_BAR; PG8_WAIT_L(0); PG8_MMA(1, 0, At, B0); PG8_BAR; PG8_SCHED;
            PG8_STAGE(PG8_SB(0, 1), b2 + hstep, voffB);
            PG8_WAIT_V(6); PG8_BAR; PG8_MMA(1, 1, At, B1); PG8_BAR;
            PG8_LDB(B0, 1, 0); PG8_SCHED; PG8_LDA(At, 1, 0); PG8_STAGE(PG8_SA(0, 1), a2 + hstepA, voffA);
            PG8_WAIT_L(8); PG8_BAR; PG8_WAIT_L(0); PG8_MMA(0, 0, At, B0); PG8_BAR; PG8_SCHED;
            PG8_LDB(B1, 1, 1); PG8_STAGE(PG8_SB(1, 0), b3, voffB);
            PG8_BAR; PG8_WAIT_L(0); PG8_MMA(0, 1, At, B1); PG8_BAR;
            PG8_LDA(At, 1, 1); PG8_STAGE(PG8_SA(1, 0), a3, voffA);
            PG8_BAR; PG8_WAIT_L(0); PG8_MMA(1, 0, At, B0); PG8_BAR; PG8_SCHED;
            PG8_STAGE(PG8_SB(1, 1), b3 + hstep, voffB);
            PG8_WAIT_V(6); PG8_BAR; PG8_MMA(1, 1, At, B1); PG8_BAR;
            }
        }
        if constexpr (ALIGN_EPI) { if (wr == 0) PG8_BAR; }
        bool chained = false;
        if constexpr (Epi::CHAIN) { if (cur.sel == 0) { E.mid(acc, cur, wr, wc, fr, fq); chained = true; } }
        if (!chained) { E(acc, cur, wr, wc, fr, fq); S.done(cur); }
        if (!has_next) break;
        if (!chained) {
#pragma unroll
        for (int a = 0; a < 2; ++a)
#pragma unroll
            for (int b = 0; b < 2; ++b)
#pragma unroll
                for (int m = 0; m < 4; ++m)
#pragma unroll
                    for (int n = 0; n < 2; ++n) acc[a][b][m][n] = (f32x4){0.f, 0.f, 0.f, 0.f};
        }
        cur = nxt; cA = nA; cB = nB; ++ui;
        if constexpr (ALIGN_EPI) { if (wr == 1) PG8_BAR; }
    }
    PG8_WAIT_V(0);
    if constexpr (!ALIGN_EPI) { if (wr == 0) PG8_BAR; }
    PG8_BAR;
#undef PG8_SA
#undef PG8_SB
#undef PG8_STAGE
#undef PG8_LDA
#undef PG8_LDB
#undef PG8_MMA
#undef PG8_WAIT_V
#undef PG8_WAIT_L
#undef PG8_BAR
#undef PG8_SCHED
}
}

namespace ab {
typedef unsigned short bf16;
typedef short bf16x8 __attribute__((ext_vector_type(8)));
typedef short s16x4 __attribute__((ext_vector_type(4)));
typedef float f32x16 __attribute__((ext_vector_type(16)));
typedef float f32x4 __attribute__((ext_vector_type(4)));
typedef unsigned u32x4 __attribute__((ext_vector_type(4)));
constexpr int D = 128, NW = 8, QBLK = 32, KVBLK = 64, QB = NW * QBLK;
constexpr int SHM_V = KVBLK * D * 2, SHM_K = KVBLK * D * 2;
constexpr int BODY_LDS = 2 * SHM_V + 2 * SHM_K + NW * 64 * 4;
constexpr int A2_OFF = BODY_LDS, M2_OFF = A2_OFF + 8192, E2_OFF = M2_OFF + 8192, SCAN_OFF = E2_OFF + 8192, LDS_NEED = SCAN_OFF + 256;
constexpr float SCALE = 0.08838834764831845f, THR = 8.f;
#define KSWZ(row, colB) ((row) * 256 + ((colB) ^ (((row) & 7) << 4)))
#define SBAR() __builtin_amdgcn_sched_barrier(0)
__device__ __forceinline__ int v_st(int k, int c) { const int kk = (k & ~0xC) | ((k & 4) << 1) | ((k & 8) >> 1); return ((kk >> 3) * 4 + (c >> 5)) * 512 + ((kk & 7) * 32 + (c & 31)) * 2; }
__device__ __forceinline__ int v_rd_base(int lane) { return ((lane & 3) << 3) | (((lane >> 2) & 3) << 6) | (((lane >> 4) & 1) << 5) | (((lane >> 5) & 1) << 8); }
constexpr int v_rd_off(int d0, int ks, int half) { return d0 * 512 + ks * 4096 + half * 2048; }
__device__ __forceinline__ int crow(int r, int hi) { return (r & 3) + 8 * (r >> 2) + 4 * hi; }
__device__ __forceinline__ unsigned cvtpk(float lo, float hi) { unsigned r; asm volatile("v_cvt_pk_bf16_f32 %0, %1, %2" : "=v"(r) : "v"(lo), "v"(hi)); return r; }
__device__ __forceinline__ bf16x8 load8(const bf16* p) { return *reinterpret_cast<const bf16x8*>(p); }
template <int MODE> __device__ __forceinline__ void mask_tile(f32x16& p0, f32x16& p1, int dq) {
    const float NEG = MODE == 0 ? -__builtin_inff() : 0.f;
#pragma unroll
    for (int r = 0; r < 16; ++r) { const int c = (r & 3) + 8 * (r >> 2);
        if (dq - c < 0) p0[r] = NEG;
        if (dq - c - 32 < 0) p1[r] = NEG; }
}
__device__ __forceinline__ void partialSM(f32x16& p0, f32x16& p1, float& m_reg, float& mn, float& alpha) {
    float pmax = p0[0];
#pragma unroll
    for (int r = 1; r < 16; ++r) pmax = fmaxf(pmax, p0[r]);
#pragma unroll
    for (int r = 0; r < 16; ++r) pmax = fmaxf(pmax, p1[r]);
    { auto rr = __builtin_amdgcn_permlane32_swap(__float_as_uint(pmax), __float_as_uint(pmax), false, false);
      pmax = fmaxf(__uint_as_float(rr[0]), __uint_as_float(rr[1])); }
    constexpr float C2 = 1.4426950408889634f * SCALE;
    if (__builtin_expect(__all((pmax - m_reg) * SCALE <= THR), 1)) { mn = m_reg; alpha = 1.f; }
    else { mn = fmaxf(m_reg, pmax); alpha = __builtin_amdgcn_exp2f((m_reg - mn) * C2); m_reg = mn; }
    const float mnL = -mn * C2;
#pragma unroll
    for (int r = 0; r < 16; ++r) p0[r] = fmaf(p0[r], C2, mnL);
#pragma unroll
    for (int r = 0; r < 16; ++r) p1[r] = fmaf(p1[r], C2, mnL);
#pragma unroll
    for (int r = 0; r < 16; ++r) p0[r] = __builtin_amdgcn_exp2f(p0[r]);
}
__device__ __forceinline__ void partialM(f32x16& p0, f32x16& p1, const float* a2k, float M2t, int hi) {
#pragma unroll
    for (int g = 0; g < 4; ++g) { const f32x4 a = *(const f32x4*)(a2k + 8 * g + 4 * hi);
#pragma unroll
        for (int j = 0; j < 4; ++j) p0[4 * g + j] *= __builtin_amdgcn_exp2f(fminf(a[j] - M2t, 0.f)); }
    SBAR();
#pragma unroll
    for (int g = 0; g < 4; ++g) { const f32x4 b = *(const f32x4*)(a2k + 32 + 8 * g + 4 * hi);
#pragma unroll
        for (int j = 0; j < 4; ++j) p1[4 * g + j] *= __builtin_amdgcn_exp2f(fminf(b[j] - M2t, 0.f)); }
}
#define AB_PK4(P, B_, OUT) do { unsigned a0 = cvtpk(P[B_+0], P[B_+1]), a1 = cvtpk(P[B_+2], P[B_+3]);                          \
        unsigned b0 = cvtpk(P[B_+4], P[B_+5]), b1 = cvtpk(P[B_+6], P[B_+7]);                                             \
        auto r0 = __builtin_amdgcn_permlane32_swap(a0, b0, false, false); auto r1 = __builtin_amdgcn_permlane32_swap(a1, b1, false, false); \
        u32x4 w = {r0[0], r1[0], r0[1], r1[1]}; OUT = *reinterpret_cast<bf16x8*>(&w); } while (0)
template <int MODE> __device__ __forceinline__ void finishSM(f32x16& p0, f32x16& p1, float alpha, float& l_reg, bf16x8& pa0, bf16x8& pa1, bf16x8& pa2, bf16x8& pa3) {
    if (MODE == 0) {
#pragma unroll
        for (int r = 0; r < 16; ++r) p1[r] = __builtin_amdgcn_exp2f(p1[r]); }
    float ps = 0;
#pragma unroll
    for (int r = 0; r < 16; ++r) ps += p0[r];
#pragma unroll
    for (int r = 0; r < 16; ++r) ps += p1[r];
    { auto rr = __builtin_amdgcn_permlane32_swap(__float_as_uint(ps), __float_as_uint(ps), false, false);
      ps = __uint_as_float(rr[0]) + __uint_as_float(rr[1]); }
    l_reg = l_reg * alpha + ps;
    AB_PK4(p0, 0, pa0); AB_PK4(p0, 8, pa1); AB_PK4(p1, 0, pa2); AB_PK4(p1, 8, pa3);
}
template <int KB>
__device__ __forceinline__ void qkt(f32x16& p0, f32x16& p1, const char* K_lds, int r32, int hi, const bf16x8* qr) {
    p0 = f32x16{}; p1 = f32x16{};
    const char* kb[4];
#pragma unroll
    for (int dd = 0; dd < 4; ++dd) kb[dd] = K_lds + KB * SHM_K + KSWZ(r32, (dd * 16 + hi * 8) * 2);
#pragma unroll
    for (int d0 = 0; d0 < 8; ++d0) { const char* a = kb[d0 & 3] + (d0 >> 2) * 128;
        bf16x8 b0 = *reinterpret_cast<const bf16x8*>(a);
        bf16x8 b1 = *reinterpret_cast<const bf16x8*>(a + 32 * 256);
        p0 = __builtin_amdgcn_mfma_f32_32x32x16_bf16(b0, qr[d0], p0, 0, 0, 0);
        p1 = __builtin_amdgcn_mfma_f32_32x32x16_bf16(b1, qr[d0], p1, 0, 0, 0); }
}
template <int VB>
__device__ __forceinline__ void pv_tile(f32x16* o, int vb0, bf16x8 pa0, bf16x8 pa1, bf16x8 pa2, bf16x8 pa3) {
#define TRRD(dst, off) asm volatile("ds_read_b64_tr_b16 %0, %1 offset:%2" : "=&v"(dst) : "v"(vb0), "i"(off) : "memory")
#define PV_D0(d0) do { s16x4 l0, l1, l2, l3, h0, h1, h2, h3; constexpr int b_ = VB * SHM_V + v_rd_off(d0, 0, 0); \
        TRRD(l0, b_); TRRD(h0, b_ + 2048); TRRD(l1, b_ + 4096); TRRD(h1, b_ + 6144); TRRD(l2, b_ + 8192); TRRD(h2, b_ + 10240); TRRD(l3, b_ + 12288); TRRD(h3, b_ + 14336); \
        asm volatile("s_waitcnt lgkmcnt(0)" ::: "memory"); SBAR();   \
        o[d0] = __builtin_amdgcn_mfma_f32_32x32x16_bf16(pa0, (bf16x8){l0[0], l0[1], l0[2], l0[3], h0[0], h0[1], h0[2], h0[3]}, o[d0], 0, 0, 0);   \
        o[d0] = __builtin_amdgcn_mfma_f32_32x32x16_bf16(pa1, (bf16x8){l1[0], l1[1], l1[2], l1[3], h1[0], h1[1], h1[2], h1[3]}, o[d0], 0, 0, 0);   \
        o[d0] = __builtin_amdgcn_mfma_f32_32x32x16_bf16(pa2, (bf16x8){l2[0], l2[1], l2[2], l2[3], h2[0], h2[1], h2[2], h2[3]}, o[d0], 0, 0, 0);   \
        o[d0] = __builtin_amdgcn_mfma_f32_32x32x16_bf16(pa3, (bf16x8){l3[0], l3[1], l3[2], l3[3], h3[0], h3[1], h3[2], h3[3]}, o[d0], 0, 0, 0); } while (0)
    PV_D0(0); PV_D0(1); PV_D0(2); PV_D0(3);
#undef PV_D0
#undef TRRD
}
template <int KB>
__device__ __forceinline__ void qkt2(f32x16& p0, f32x16& p1, const char* K_lds, int r32, int hi, const bf16x8* qr) {
    p0 = f32x16{}; p1 = f32x16{};
    int ka[4];
#pragma unroll
    for (int dd = 0; dd < 4; ++dd) ka[dd] = (int)(uintptr_t)K_lds + KB * SHM_K + KSWZ(r32, (dd * 16 + hi * 8) * 2);
#define KRD(dst, addr, off) asm volatile("ds_read_b128 %0, %1 offset:%2" : "=&v"(dst) : "v"(addr), "i"(off) : "memory")
#define QK_RD(X, Y, b) do { KRD(X[0], ka[(2 * (b)) & 3], ((2 * (b)) >> 2) * 128); KRD(Y[0], ka[(2 * (b)) & 3], ((2 * (b)) >> 2) * 128 + 32 * 256); \
        KRD(X[1], ka[(2 * (b) + 1) & 3], ((2 * (b) + 1) >> 2) * 128); KRD(Y[1], ka[(2 * (b) + 1) & 3], ((2 * (b) + 1) >> 2) * 128 + 32 * 256); } while (0)
#define QK_MM(X, Y, b) do { p0 = __builtin_amdgcn_mfma_f32_32x32x16_bf16(X[0], qr[2 * (b)], p0, 0, 0, 0); p1 = __builtin_amdgcn_mfma_f32_32x32x16_bf16(Y[0], qr[2 * (b)], p1, 0, 0, 0); \
        p0 = __builtin_amdgcn_mfma_f32_32x32x16_bf16(X[1], qr[2 * (b) + 1], p0, 0, 0, 0); p1 = __builtin_amdgcn_mfma_f32_32x32x16_bf16(Y[1], qr[2 * (b) + 1], p1, 0, 0, 0); } while (0)
    bf16x8 xa[2], ya[2], xb[2], yb[2];
    QK_RD(xa, ya, 0); QK_RD(xb, yb, 1);
    asm volatile("s_waitcnt lgkmcnt(4)" ::: "memory"); SBAR(); QK_MM(xa, ya, 0); SBAR(); QK_RD(xa, ya, 2);
    asm volatile("s_waitcnt lgkmcnt(4)" ::: "memory"); SBAR(); QK_MM(xb, yb, 1); SBAR(); QK_RD(xb, yb, 3);
    asm volatile("s_waitcnt lgkmcnt(4)" ::: "memory"); SBAR(); QK_MM(xa, ya, 2); SBAR();
    asm volatile("s_waitcnt lgkmcnt(0)" ::: "memory"); SBAR(); QK_MM(xb, yb, 3);
#undef QK_MM
#undef QK_RD
#undef KRD
}
template <int VB, bool PF>
__device__ __forceinline__ void pv_tile2(f32x16* o, int vb0, bf16x8 pa0, bf16x8 pa1, bf16x8 pa2, bf16x8 pa3) {
#define TRRD(dst, off) asm volatile("ds_read_b64_tr_b16 %0, %1 offset:%2" : "=&v"(dst) : "v"(vb0), "i"(off) : "memory")
#define PV_RD(L, H, ks) do { constexpr int b_ = VB * SHM_V + (ks) * 4096; TRRD(L[0], b_); TRRD(H[0], b_ + 2048); TRRD(L[1], b_ + 512); TRRD(H[1], b_ + 512 + 2048); \
        TRRD(L[2], b_ + 1024); TRRD(H[2], b_ + 1024 + 2048); TRRD(L[3], b_ + 1536); TRRD(H[3], b_ + 1536 + 2048); } while (0)
#define PV_MM(L, H, PA) do { _Pragma("unroll") for (int d0 = 0; d0 < 4; ++d0) \
        o[d0] = __builtin_amdgcn_mfma_f32_32x32x16_bf16(PA, (bf16x8){L[d0][0], L[d0][1], L[d0][2], L[d0][3], H[d0][0], H[d0][1], H[d0][2], H[d0][3]}, o[d0], 0, 0, 0); } while (0)
    s16x4 la[4], ha[4];
    if constexpr (PF) {
        s16x4 lb[4], hb[4];
        PV_RD(la, ha, 0); PV_RD(lb, hb, 1);
        asm volatile("s_waitcnt lgkmcnt(8)" ::: "memory"); SBAR(); PV_MM(la, ha, pa0); SBAR();
        PV_RD(la, ha, 2);
        asm volatile("s_waitcnt lgkmcnt(8)" ::: "memory"); SBAR(); PV_MM(lb, hb, pa1); SBAR();
        PV_RD(lb, hb, 3);
        asm volatile("s_waitcnt lgkmcnt(8)" ::: "memory"); SBAR(); PV_MM(la, ha, pa2); SBAR();
        asm volatile("s_waitcnt lgkmcnt(0)" ::: "memory"); SBAR(); PV_MM(lb, hb, pa3);
    } else {
        PV_RD(la, ha, 0); asm volatile("s_waitcnt lgkmcnt(0)" ::: "memory"); SBAR(); PV_MM(la, ha, pa0); SBAR();
        PV_RD(la, ha, 1); asm volatile("s_waitcnt lgkmcnt(0)" ::: "memory"); SBAR(); PV_MM(la, ha, pa1); SBAR();
        PV_RD(la, ha, 2); asm volatile("s_waitcnt lgkmcnt(0)" ::: "memory"); SBAR(); PV_MM(la, ha, pa2); SBAR();
        PV_RD(la, ha, 3); asm volatile("s_waitcnt lgkmcnt(0)" ::: "memory"); SBAR(); PV_MM(la, ha, pa3);
    }
#undef PV_MM
#undef PV_RD
#undef TRRD
}
struct BlockRef { const bf16* Q; const bf16* K; const bf16* V; float* O; int P0; const bf16* Cst; const float* nst; };
struct Seam { bf16x8 qr[8]; bf16x8 st_v0, st_v1, st_k0, st_k1; bf16x8 sb_v0, sb_v1, sb_k0, sb_k1; };
#define VMW() asm volatile("s_waitcnt vmcnt(0)" ::: "memory")
#define VMWN(n) asm volatile("s_waitcnt vmcnt(%0)" :: "i"(n) : "memory")
#define SLOAD_H(Kp, Vp, k0) do { const bf16* vb_ = (Vp) + (size_t)((k0) + wid * 4) * VP; const bf16* kb_ = (Kp) + (size_t)((k0) + wid * 4) * KP;    \
                         S.st_v0 = load8(vb_ + lov); S.st_v1 = load8(vb_ + 32 * VP + lov); S.st_k0 = load8(kb_ + lok); S.st_k1 = load8(kb_ + 32 * KP + lok); } while (0)
#define SWRITE_HK(bf) do { *(bf16x8*)(K_lds + (bf) * SHM_K + kws) = S.st_k0; *(bf16x8*)(K_lds + (bf) * SHM_K + kws + 32 * 256) = S.st_k1; } while (0)
#define SWRITE_HV(bf) do { *(bf16x8*)(V_lds + (bf) * SHM_V + vst0) = S.st_v0; *(bf16x8*)(V_lds + (bf) * SHM_V + vst1) = S.st_v1; } while (0)
#define SWRITE_H(bf) do { SWRITE_HV(bf); SWRITE_HK(bf); } while (0)
template <int QP, int KP, int VP>
__device__ __forceinline__ void prime(const BlockRef& cur, char* lds, Seam& S, const int tid, const int k0) {
    const int wid = __builtin_amdgcn_readfirstlane(tid >> 6), lane = tid & 63, r32 = lane & 31, hi = lane >> 5;
    const int sr = tid >> 4, sc = (tid & 15) * 8, kws = KSWZ(sr, sc * 2); char* K_lds = lds + 2 * SHM_V;
    const unsigned lov = (unsigned)((lane >> 4) * VP + sc), lok = (unsigned)((lane >> 4) * KP + sc), loq = (unsigned)(r32 * QP + hi * 8);
    { const bf16* qb_ = cur.Q + (size_t)(wid * QBLK) * QP;
#pragma unroll
      for (int d0 = 0; d0 < 8; ++d0) S.qr[d0] = load8(qb_ + d0 * 16 + loq); }
    SLOAD_H(cur.K, cur.V, k0); VMW(); SWRITE_HK(0);
    __syncthreads();
}
template <int MODE, int QP, int KP, int VP, int OP>
__device__ __forceinline__ void block(const BlockRef& cur, const BlockRef& nxt, char* lds, Seam& S, const int tid) {
    const int wid = __builtin_amdgcn_readfirstlane(tid >> 6), lane = tid & 63, r32 = lane & 31, hi = lane >> 5;
    const int T0 = (MODE == 1) ? cur.P0 / KVBLK : 0;
    int NT = (MODE == 1) ? QB / KVBLK : cur.P0 / KVBLK + QB / KVBLK;
    if (MODE == 1) asm volatile("" : "+s"(NT));
    const int qlo = cur.P0 + wid * QBLK, qm = qlo + r32 - 4 * hi;
    char* V_lds = lds; char* K_lds = lds + 2 * SHM_V;
    float* ws = (float*)(lds + 2 * SHM_V + 2 * SHM_K) + wid * 64; float* li_l = ws, * al_l = ws + 32;
    const float* a2 = (const float*)(lds + A2_OFF);
    float M2t = 0.f;
    if (MODE == 1) M2t = ((const float*)(lds + M2_OFF))[qlo + r32];
    float m_reg = -1e30f, l_reg = 0; f32x16 o[4] = {};
    const int sr = tid >> 4, sc = (tid & 15) * 8, vst0 = v_st(sr, sc), vst1 = v_st(32 + sr, sc), kws = KSWZ(sr, sc * 2);
    const int vb0 = (int)(uintptr_t)V_lds + v_rd_base(lane);
    const unsigned lov = (unsigned)((lane >> 4) * VP + sc), lok = (unsigned)((lane >> 4) * KP + sc), loq = (unsigned)(r32 * QP + hi * 8), loo = (unsigned)(4 * hi * OP + r32);
    const bf16* Kh = cur.K; const bf16* Vh = cur.V;
#define RESC(a) do { if (MODE == 0) { if (__any((a) < 1.f)) { if (hi == 0) al_l[r32] = (a); asm volatile("s_waitcnt lgkmcnt(0)" ::: "memory");              \
                     for (int d_ = 0; d_ < 4; ++d_) for (int r = 0; r < 16; ++r) o[d_][r] *= al_l[crow(r, hi)]; } } } while (0)
#define KBASE(t) ((T0 + (t)) * KVBLK)
#define MASKT(P0_, P1_, t) do { const int kb_ = KBASE(t); if (kb_ + KVBLK - 1 > qlo) mask_tile<MODE>(P0_, P1_, qm - kb_); } while (0)
#define PARTIAL(P0_, P1_, mnX, alX, t) do { if (MODE == 0) partialSM(P0_, P1_, m_reg, mnX, alX); else { alX = 1.f; partialM(P0_, P1_, a2 + KBASE(t), M2t, hi); } } while (0)
    constexpr int NQL = 8;
#define SEAM_K0() do { VMWN(NQL); SWRITE_HK(0); SBAR(); } while (0)
    f32x16 pA0, pA1, pB0, pB1; float mnA, mnB, alA, alB; bf16x8 pa0, pa1, pa2, pa3;
    if (MODE == 1 && cur.Cst != nullptr) {
        const bf16* Cp = cur.Cst + (size_t)(wid * 4) * 256; const unsigned loc = (unsigned)((lane >> 4) * 256 + sc);
        const bf16x8 c0 = load8(Cp + loc), c1 = load8(Cp + 32 * 256 + loc), c2 = load8(Cp + 64 * 256 + loc), c3 = load8(Cp + 96 * 256 + loc);
        float dn = 0.f;
#pragma unroll
        for (int d0 = 0; d0 < 8; ++d0) { const f32x4 n0 = *(const f32x4*)(cur.nst + 16 * d0 + 8 * hi), n1 = *(const f32x4*)(cur.nst + 16 * d0 + 8 * hi + 4);
            const u32x4 qw = *reinterpret_cast<const u32x4*>(&S.qr[d0]);
            dn += __uint_as_float(qw.x << 16) * n0[0] + __uint_as_float(qw.x & 0xffff0000u) * n0[1] + __uint_as_float(qw.y << 16) * n0[2] + __uint_as_float(qw.y & 0xffff0000u) * n0[3];
            dn += __uint_as_float(qw.z << 16) * n1[0] + __uint_as_float(qw.z & 0xffff0000u) * n1[1] + __uint_as_float(qw.w << 16) * n1[2] + __uint_as_float(qw.w & 0xffff0000u) * n1[3]; }
        { auto rr = __builtin_amdgcn_permlane32_swap(__float_as_uint(dn), __float_as_uint(dn), false, false); dn = __uint_as_float(rr[0]) + __uint_as_float(rr[1]); }
        VMW();
        *(bf16x8*)(V_lds + vst0) = c0; *(bf16x8*)(V_lds + vst1) = c1; *(bf16x8*)(V_lds + SHM_V + vst0) = c2; *(bf16x8*)(V_lds + SHM_V + vst1) = c3;
        __syncthreads();
        pv_tile<0>(o, vb0, S.qr[0], S.qr[1], S.qr[2], S.qr[3]); pv_tile<1>(o, vb0, S.qr[4], S.qr[5], S.qr[6], S.qr[7]);
        const float st = __builtin_amdgcn_exp2f(((const float*)(lds + M2_OFF))[cur.P0 - 1] - M2t);
        l_reg = st * dn;
        if (hi == 0) al_l[r32] = st;
        asm volatile("s_waitcnt lgkmcnt(0)" ::: "memory");
#pragma unroll
        for (int d_ = 0; d_ < 4; ++d_)
#pragma unroll
            for (int r = 0; r < 16; ++r) o[d_][r] *= al_l[crow(r, hi)];
        __syncthreads();
    }
    SWRITE_HV(0); SBAR();
    if (NT > 1) { SLOAD_H(Kh, Vh, KBASE(1)); }
    SBAR(); qkt<0>(pA0, pA1, K_lds, r32, hi, S.qr);
    MASKT(pA0, pA1, 0); PARTIAL(pA0, pA1, mnA, alA, 0);
    if (NT > 1) { VMW(); SWRITE_H(1); }
    __syncthreads();
#define HALF_STEP(PX0, PX1, mnX, alX, PY0, PY1, alY, t, KB, VB, SB) do {                                                      \
        SBAR(); qkt<KB>(PX0, PX1, K_lds, r32, hi, S.qr);                                             \
        finishSM<MODE>(PY0, PY1, alY, l_reg, pa0, pa1, pa2, pa3); SBAR();                                                           \
        if ((t) + 1 < NT) { SLOAD_H(Kh, Vh, KBASE((t) + 1)); SBAR(); }                                               \
        pv_tile<VB>(o, vb0, pa0, pa1, pa2, pa3); MASKT(PX0, PX1, (t)); PARTIAL(PX0, PX1, mnX, alX, (t));                                        \
        __syncthreads();                                                                                                      \
        if ((t) + 1 < NT) { VMW(); SWRITE_H(SB); }                                                                          \
        RESC(alX); __syncthreads(); } while (0)
    for (int t = 1; t + 1 < NT; t += 2) {
        HALF_STEP(pB0, pB1, mnB, alB, pA0, pA1, alA, t, 1, 0, 0);
        HALF_STEP(pA0, pA1, mnA, alA, pB0, pB1, alB, t + 1, 0, 1, 1);
    }
    const bool even = (NT & 1) == 0;
    if (even) { SBAR(); qkt<1>(pB0, pB1, K_lds, r32, hi, S.qr); SBAR(); }
    SLOAD_H(nxt.K, nxt.V, (MODE == 1) ? nxt.P0 : 0); SBAR();
    { const bf16* qb_ = nxt.Q + (size_t)(wid * QBLK) * QP;
#pragma unroll
      for (int d0 = 0; d0 < 8; ++d0) S.qr[d0] = load8(qb_ + d0 * 16 + loq); }
    SBAR();
    finishSM<MODE>(pA0, pA1, alA, l_reg, pa0, pa1, pa2, pa3); SBAR();
    pv_tile<0>(o, vb0, pa0, pa1, pa2, pa3);
    if (even) { MASKT(pB0, pB1, NT - 1); PARTIAL(pB0, pB1, mnB, alB, NT - 1); __syncthreads(); RESC(alB);
        finishSM<MODE>(pB0, pB1, alB, l_reg, pa0, pa1, pa2, pa3); SBAR(); pv_tile<1>(o, vb0, pa0, pa1, pa2, pa3); }
    SBAR(); SEAM_K0();
    if (hi == 0) li_l[r32] = (MODE == 0) ? l_reg : fmaxf(fabsf(l_reg), __builtin_amdgcn_exp2f(((const float*)(lds + E2_OFF))[qlo + r32]));
    asm volatile("s_waitcnt lgkmcnt(0)" ::: "memory");
    float rli[16];
#pragma unroll
    for (int r = 0; r < 16; ++r) rli[r] = __builtin_amdgcn_rcpf(li_l[crow(r, hi)]);
    float* Ow = cur.O + (size_t)(wid * QBLK) * OP;
#pragma unroll
    for (int r = 0; r < 16; ++r) { float* Or = Ow + (size_t)((r & 3) + 8 * (r >> 2)) * OP;
#pragma unroll
        for (int d0 = 0; d0 < 4; ++d0) Or[d0 * 32 + loo] = o[d0][r] * rli[r]; }
    __syncthreads();
#undef RESC
#undef KBASE
#undef MASKT
#undef PARTIAL
#undef SEAM_K0
#undef HALF_STEP
}

#define PP_BAR() do { asm volatile("s_waitcnt lgkmcnt(0)" ::: "memory"); __builtin_amdgcn_s_barrier(); asm volatile("" ::: "memory"); SBAR(); } while (0)
constexpr int SB_OFF = 98304;
static_assert(LDS_NEED <= SB_OFF && SB_OFF + 2 * SHM_V <= 131072, "lds map");
template <int MODE, int QP, int KP, int VP>
__device__ __forceinline__ void prime2(const BlockRef& cur, char* lds, Seam& S, const int tid) {
    const int wid = __builtin_amdgcn_readfirstlane(tid >> 6), lane = tid & 63, r32 = lane & 31, hi = lane >> 5;
    const int sr = tid >> 4, sc = (tid & 15) * 8, kws = KSWZ(sr, sc * 2); char* K_lds = lds + 2 * SHM_V;
    const unsigned lov = (unsigned)((lane >> 4) * VP + sc), lok = (unsigned)((lane >> 4) * KP + sc), loq = (unsigned)(r32 * QP + hi * 8);
    const int k0 = (MODE == 1) ? cur.P0 : 0;
    { const bf16* qb_ = cur.Q + (size_t)(wid * QBLK) * QP;
#pragma unroll
      for (int d0 = 0; d0 < 8; ++d0) S.qr[d0] = load8(qb_ + d0 * 16 + loq); }
    { const bf16* kb_ = cur.K + (size_t)(k0 + wid * 4) * KP; S.st_k0 = load8(kb_ + lok); S.st_k1 = load8(kb_ + 32 * KP + lok); }
    *(bf16x8*)(K_lds + kws) = S.st_k0; *(bf16x8*)(K_lds + kws + 32 * 256) = S.st_k1;
    SBAR();
    { const bf16* kb_ = cur.K + (size_t)(k0 + KVBLK + wid * 4) * KP; const bf16* vb_ = cur.V + (size_t)(k0 + wid * 4) * VP;
      S.st_k0 = load8(kb_ + lok); S.st_k1 = load8(kb_ + 32 * KP + lok); S.st_v0 = load8(vb_ + lov); S.st_v1 = load8(vb_ + 32 * VP + lov);
      if (MODE == 0) { S.sb_k0 = load8(kb_ + (size_t)KVBLK * KP + lok); S.sb_k1 = load8(kb_ + (size_t)(KVBLK + 32) * KP + lok); S.sb_v0 = load8(vb_ + (size_t)KVBLK * VP + lov); S.sb_v1 = load8(vb_ + (size_t)(KVBLK + 32) * VP + lov); } }
    PP_BAR();
    if (wid >= 4) PP_BAR();
}
__device__ __forceinline__ void pp_realign(const int tid) { if (__builtin_amdgcn_readfirstlane(tid >> 6) < 4) PP_BAR(); }
template <int MODE, int QP, int KP, int VP, int OP>
__device__ __forceinline__ void block2(const BlockRef& cur, const BlockRef& nxt, char* lds, Seam& S, const int tid) {
    const int wid = __builtin_amdgcn_readfirstlane(tid >> 6), lane = tid & 63, r32 = lane & 31, hi = lane >> 5;
    const int T0 = (MODE == 1) ? cur.P0 / KVBLK : 0, T0n = (MODE == 1) ? nxt.P0 / KVBLK : 0;
    int NT = (MODE == 1) ? QB / KVBLK : cur.P0 / KVBLK + QB / KVBLK;
    if (MODE == 1) asm volatile("" : "+s"(NT));
    const int qlo = cur.P0 + wid * QBLK, qm = qlo + r32 - 4 * hi;
    char* V_lds = lds; char* K_lds = lds + 2 * SHM_V;
    float* ws = (float*)(lds + 2 * SHM_V + 2 * SHM_K) + wid * 64; float* li_l = ws, * al_l = ws + 32;
    const float* a2 = (const float*)(lds + A2_OFF);
    float M2t = 0.f;
    if (MODE == 1) M2t = ((const float*)(lds + M2_OFF))[qlo + r32];
    float m_reg = -1e30f, l_reg = 0; f32x16 o[4] = {};
    const int sr = tid >> 4, sc = (tid & 15) * 8, vst0 = v_st(sr, sc), vst1 = v_st(32 + sr, sc), kws = KSWZ(sr, sc * 2);
    const int vb0 = (int)(uintptr_t)V_lds + v_rd_base(lane);
    const unsigned lov = (unsigned)((lane >> 4) * VP + sc), lok = (unsigned)((lane >> 4) * KP + sc), loq = (unsigned)(r32 * QP + hi * 8), loo = (unsigned)(4 * hi * OP + r32);
#define KBASE2(t) ((T0 + (t)) * KVBLK)
#define LOADKV(K0, K1, V0, V1, kt, vt) do { const bool kn_ = (kt) >= NT, vn_ = (vt) >= NT;                                                            \
        const bf16* kb_ = (kn_ ? nxt.K : cur.K) + (size_t)(((kn_ ? T0n - NT : T0) + (kt)) * KVBLK + wid * 4) * KP;                                   \
        const bf16* vb_ = (vn_ ? nxt.V : cur.V) + (size_t)(((vn_ ? T0n - NT : T0) + (vt)) * KVBLK + wid * 4) * VP;                                   \
        K0 = load8(kb_ + lok); K1 = load8(kb_ + 32 * KP + lok); V0 = load8(vb_ + lov); V1 = load8(vb_ + 32 * VP + lov); } while (0)
#define WRITEKV(K0, K1, V0, V1, kbuf, vbuf) do { *(bf16x8*)(K_lds + (kbuf) * SHM_K + kws) = K0; *(bf16x8*)(K_lds + (kbuf) * SHM_K + kws + 32 * 256) = K1;    \
        *(bf16x8*)(V_lds + (vbuf) * SHM_V + vst0) = V0; *(bf16x8*)(V_lds + (vbuf) * SHM_V + vst1) = V1; } while (0)
#define WRITE_A(kbuf, vbuf) WRITEKV(S.st_k0, S.st_k1, S.st_v0, S.st_v1, kbuf, vbuf)
#define WRITE_B(kbuf, vbuf) WRITEKV(S.sb_k0, S.sb_k1, S.sb_v0, S.sb_v1, kbuf, vbuf)
#define LOAD_A(kt, vt) LOADKV(S.st_k0, S.st_k1, S.st_v0, S.st_v1, kt, vt)
#define LOAD_B(kt, vt) LOADKV(S.sb_k0, S.sb_k1, S.sb_v0, S.sb_v1, kt, vt)
    f32x16 p0, p1; float mn, al; bf16x8 pa0, pa1, pa2, pa3;
#define VV_STAGE(t) do { { const int kb_ = KBASE2(t); if (kb_ + KVBLK - 1 > qlo) mask_tile<MODE>(p0, p1, qm - kb_); }                                 \
        if (MODE == 0) { partialSM(p0, p1, m_reg, mn, al);                                                                                             \
            if (__any(al < 1.f)) { if (hi == 0) al_l[r32] = al; asm volatile("s_waitcnt lgkmcnt(0)" ::: "memory");                                     \
                _Pragma("unroll") for (int d_ = 0; d_ < 4; ++d_) _Pragma("unroll") for (int r = 0; r < 16; ++r) o[d_][r] *= al_l[crow(r, hi)]; } }                  \
        else { al = 1.f; partialM(p0, p1, a2 + KBASE2(t), M2t, hi); }                                                                                  \
        finishSM<MODE>(p0, p1, al, l_reg, pa0, pa1, pa2, pa3); } while (0)
    if (MODE == 1 && cur.Cst != nullptr) {
        const bf16* Cp = cur.Cst + (size_t)(wid * 4) * 256; const unsigned loc = (unsigned)((lane >> 4) * 256 + sc);
        const bf16x8 c0 = load8(Cp + loc), c1 = load8(Cp + 32 * 256 + loc), c2 = load8(Cp + 64 * 256 + loc), c3 = load8(Cp + 96 * 256 + loc);
        *(bf16x8*)(lds + SB_OFF + vst0) = c0; *(bf16x8*)(lds + SB_OFF + vst1) = c1; *(bf16x8*)(lds + SB_OFF + SHM_V + vst0) = c2; *(bf16x8*)(lds + SB_OFF + SHM_V + vst1) = c3;
        PP_BAR();
        float dn = 0.f;
#pragma unroll
        for (int d0 = 0; d0 < 8; ++d0) { const f32x4 n0 = *(const f32x4*)(cur.nst + 16 * d0 + 8 * hi), n1 = *(const f32x4*)(cur.nst + 16 * d0 + 8 * hi + 4);
            const u32x4 qw = *reinterpret_cast<const u32x4*>(&S.qr[d0]);
            dn += __uint_as_float(qw.x << 16) * n0[0] + __uint_as_float(qw.x & 0xffff0000u) * n0[1] + __uint_as_float(qw.y << 16) * n0[2] + __uint_as_float(qw.y & 0xffff0000u) * n0[3];
            dn += __uint_as_float(qw.z << 16) * n1[0] + __uint_as_float(qw.z & 0xffff0000u) * n1[1] + __uint_as_float(qw.w << 16) * n1[2] + __uint_as_float(qw.w & 0xffff0000u) * n1[3]; }
        { auto rr = __builtin_amdgcn_permlane32_swap(__float_as_uint(dn), __float_as_uint(dn), false, false); dn = __uint_as_float(rr[0]) + __uint_as_float(rr[1]); }
        PP_BAR();
        pv_tile2<0, MODE == 0>(o, vb0 + SB_OFF, S.qr[0], S.qr[1], S.qr[2], S.qr[3]); pv_tile2<1, MODE == 0>(o, vb0 + SB_OFF, S.qr[4], S.qr[5], S.qr[6], S.qr[7]);
        const float st = __builtin_amdgcn_exp2f(((const float*)(lds + M2_OFF))[cur.P0 - 1] - M2t);
        l_reg = st * dn;
        if (hi == 0) al_l[r32] = st;
        asm volatile("s_waitcnt lgkmcnt(0)" ::: "memory");
#pragma unroll
        for (int d_ = 0; d_ < 4; ++d_)
#pragma unroll
            for (int r = 0; r < 16; ++r) o[d_][r] *= al_l[crow(r, hi)];
        PP_BAR();
    }
    for (int t = 0; t < NT; t += 2) {
        WRITE_A(1, 0); SBAR(); if (MODE == 0) LOAD_A(t + 3, t + 2); else LOAD_A(t + 2, t + 1); SBAR();
        if (t > 0) pv_tile2<1, MODE == 0>(o, vb0, pa0, pa1, pa2, pa3);
        qkt2<0>(p0, p1, K_lds, r32, hi, S.qr);
        PP_BAR();
        VV_STAGE(t);
        PP_BAR();
        if (MODE == 0) { WRITE_B(0, 1); SBAR(); LOAD_B(t + 4, t + 3); } else { WRITE_A(0, 1); SBAR(); LOAD_A(t + 3, t + 2); } SBAR();
        pv_tile2<0, MODE == 0>(o, vb0, pa0, pa1, pa2, pa3);
        qkt2<1>(p0, p1, K_lds, r32, hi, S.qr);
        PP_BAR();
        VV_STAGE(t + 1);
        PP_BAR();
    }
    { const bf16* qb_ = nxt.Q + (size_t)(wid * QBLK) * QP;
#pragma unroll
      for (int d0 = 0; d0 < 8; ++d0) S.qr[d0] = load8(qb_ + d0 * 16 + loq); }
    SBAR();
    pv_tile2<1, MODE == 0>(o, vb0, pa0, pa1, pa2, pa3);
    PP_BAR();
    if (hi == 0) li_l[r32] = (MODE == 0) ? l_reg : fmaxf(fabsf(l_reg), __builtin_amdgcn_exp2f(((const float*)(lds + E2_OFF))[qlo + r32]));
    asm volatile("s_waitcnt lgkmcnt(0)" ::: "memory");
    float rli[16];
#pragma unroll
    for (int r = 0; r < 16; ++r) rli[r] = __builtin_amdgcn_rcpf(li_l[crow(r, hi)]);
    { bf16* Ow = (bf16*)cur.O + (size_t)(wid * QBLK) * OP;
#pragma unroll
      for (int r = 0; r < 16; ++r) { bf16* Or = Ow + (size_t)((r & 3) + 8 * (r >> 2)) * OP;
#pragma unroll
          for (int d0 = 0; d0 < 4; ++d0) { const float v = o[d0][r] * rli[r];
              const float nb = __uint_as_float(__builtin_amdgcn_update_dpp(0u, __float_as_uint(v), 0xB1, 0xf, 0xf, false));
              if ((r32 & 1) == 0) *(unsigned*)(Or + d0 * 32 + loo) = cvtpk(v, nb); } } }
    PP_BAR();
#undef KBASE2
#undef LOADKV
#undef WRITEKV
#undef WRITE_A
#undef WRITE_B
#undef LOAD_A
#undef LOAD_B
#undef VV_STAGE
}
#undef VMW
#undef VMWN
#undef SLOAD_H
#undef SWRITE_HK
#undef SWRITE_HV
#undef SWRITE_H
}

constexpr int NWAVES = 8;
constexpr int BATCH = 4, SEQ = 2048, DM = 2048, DEPTH = 4, MTOK = BATCH * SEQ;
constexpr int NIN = 16400, NING = 16384, GATE_COL = 6144, DFF = 5632, NUP = 2 * DFF;
constexpr float EPS = 1e-6f;
constexpr int NPH_L = 7, NPHASE = 2 + DEPTH * NPH_L;
constexpr size_t MiB = 1u << 20;
constexpr size_t WS_CTL = 0, CTL_ZERO_BYTES = 1 * MiB;
constexpr size_t WS_ROPE = 1 * MiB;
constexpr size_t WS_BIASG = WS_ROPE + 512 * 1024;
constexpr size_t WS_GATES = 2 * MiB;
constexpr size_t WS_ROWSS_B = 3 * MiB - 64 * 1024;
constexpr size_t WS_ROWSS = 3 * MiB;
constexpr size_t WS_WIN = 4 * MiB, SZ_WIN = 64 * MiB;
constexpr size_t WS_WBM = WS_WIN + 4 * SZ_WIN, SZ_WSQ = 8 * MiB;
constexpr size_t WS_WBD = WS_WBM + 4 * SZ_WSQ, WS_WO = WS_WBD + 4 * SZ_WSQ;
constexpr size_t WS_WUP = WS_WO + 4 * SZ_WSQ, SZ_WUP = 44 * MiB;
constexpr size_t WS_WDN = WS_WUP + 4 * SZ_WUP, SZ_WDN = 22 * MiB;
constexpr size_t WS_H = WS_WDN + 4 * SZ_WDN;
constexpr size_t WS_GWF = WS_H;
constexpr size_t WS_XN = WS_H + 64 * MiB;
constexpr size_t WS_MQ = WS_XN + 32 * MiB, WS_MK = WS_MQ + 16 * MiB, WS_MV = WS_MK + 16 * MiB, WS_SMO = WS_MV + 32 * MiB;
constexpr size_t WS_AQ = WS_SMO + 32 * MiB, WS_AK = WS_AQ + 32 * MiB, WS_AV = WS_AK + 32 * MiB, WS_SG = WS_AV + 32 * MiB;
constexpr size_t WS_OATT = WS_SG + 64 * MiB;
constexpr size_t WS_HRAW = WS_OATT + 128 * MiB;
constexpr size_t WS_HMN = WS_HRAW + 64 * MiB, WS_HAN = WS_HMN + 32 * MiB;
constexpr size_t WS_P = WS_HAN + 32 * MiB;
constexpr size_t WS_Y = WS_P + 64 * MiB;
constexpr size_t WS_FXC = WS_Y + 32 * MiB, WS_FXV = WS_FXC + 3 * MiB, WS_FXG = WS_FXV + 3 * MiB;
constexpr size_t WS_U = WS_FXG + 3 * MiB;
constexpr size_t WS_CST = WS_U + 88 * MiB;
constexpr size_t WS_NST = WS_CST + 16 * MiB;
constexpr size_t WS_END = WS_NST + 1 * MiB;
constexpr int CW_TMO = 0, CW_CODE = 1, CW_BAR = 4096, CW_GCNT = 200000, CW_SFLAG = 210000, CW_TICK = 240000, CW_ATICK = 250000, CW_ADONE = 170000;
constexpr int LDS_BYTES = 131072 + 2048, MISC_OFF = 131072;
static_assert(ab::LDS_NEED <= 131072, "lds");

#define GAS __attribute__((address_space(1)))
#define LAS __attribute__((address_space(3)))
typedef unsigned short bf16;
typedef unsigned v4u __attribute__((ext_vector_type(4)));
typedef unsigned v2u __attribute__((ext_vector_type(2)));
typedef float f32x4 __attribute__((ext_vector_type(4)));
typedef GAS unsigned gu32;
#define RLX_AGENT __ATOMIC_RELAXED, __HIP_MEMORY_SCOPE_AGENT
#define LDS_WAIT() asm volatile("s_waitcnt lgkmcnt(0)" ::: "memory")
#define VM_WAIT() asm volatile("s_waitcnt vmcnt(0)" ::: "memory")
__device__ __forceinline__ unsigned pk2(float lo, float hi) { return pg8::cvt_pk_bf16(lo, hi); }

#define XB_TMO      128
#define XB_XCNT(j)  (256  + 64 * (j))
#define XB_XSUB(j)  (1280 + 64 * (j))
#define XB_XGEN(j)  (2304 + 64 * (j))
#define XB_TOP      3328
#define XB_TOPGEN   3392
#define XCD_BAR_WORDS 3456
#define XB_SPIN_CAP (1u << 18)
__device__ __forceinline__ unsigned xb_ld(unsigned* p)              { return __hip_atomic_load(p, __ATOMIC_RELAXED, __HIP_MEMORY_SCOPE_AGENT); }
__device__ __forceinline__ unsigned xb_add(unsigned* p, unsigned v) { return __hip_atomic_fetch_add(p, v, __ATOMIC_RELAXED, __HIP_MEMORY_SCOPE_AGENT); }
__device__ __forceinline__ unsigned xb_xcc_id() { return (unsigned)__builtin_amdgcn_s_getreg((3 << 11) | 20) & 0xFu; }
#define XB_SPIN(cond, bar) do { unsigned _sp = 0; while (cond) { __builtin_amdgcn_s_sleep(1); \
    if ((++_sp & 255u) == 0u) { if (xb_ld(&(bar)[XB_TMO])) break; if (_sp > XB_SPIN_CAP) { atomicAdd(&(bar)[XB_TMO], 1u); break; } } } } while (0)
struct XcdBarrier { unsigned* bar; unsigned x; volatile LAS unsigned* st; };
__device__ __forceinline__ XcdBarrier xcd_barrier_post(unsigned* bar, volatile LAS unsigned* st) {
    XcdBarrier b; b.bar = bar; b.x = xb_xcc_id(); b.st = st;
    if (threadIdx.x == 0) (void)xb_add(&bar[XB_XCNT(b.x)], 1u);
    return b;
}
__device__ __forceinline__ void xcd_barrier_complete(unsigned* bar, unsigned x, unsigned& nloc, unsigned& nx) {
    const unsigned G = gridDim.x * gridDim.y * gridDim.z;
    unsigned sum, cnt, mine, sp = 0u;
    for (;;) {
        sum = 0u; cnt = 0u; mine = 0u;
#pragma unroll
        for (unsigned j = 0; j < 16; ++j) { const unsigned c = xb_ld(&bar[XB_XCNT(j)]); sum += c; cnt += (c > 0u) ? 1u : 0u; mine = (j == x) ? c : mine; }
        if (sum == G) break;
        __builtin_amdgcn_s_sleep(1);
        if ((++sp & 255u) == 0u) { if (xb_ld(&bar[XB_TMO])) break; if (sp > XB_SPIN_CAP) { atomicAdd(&bar[XB_TMO], 1u); break; } }
    }
    nloc = mine > 0u ? mine : 1u; nx = cnt > 0u ? cnt : 1u;
}
__device__ __forceinline__ void xcd_barrier(const XcdBarrier& b) {
    asm volatile("s_waitcnt vmcnt(0)" ::: "memory");
    __syncthreads();
    if (threadIdx.x == 0) {
        unsigned* bar = b.bar;
        __builtin_amdgcn_s_waitcnt(0);
        unsigned nloc = b.st[0], nx = b.st[1];
        if (nloc == 0u) { xcd_barrier_complete(bar, b.x, nloc, nx); b.st[0] = nloc; b.st[1] = nx; }
        const unsigned old = xb_add(&bar[XB_XSUB(b.x)], 1u);
        const unsigned gen = old / nloc;
        if (old + 1u == (gen + 1u) * nloc) {
            __builtin_amdgcn_fence(__ATOMIC_RELEASE, "agent");
            asm volatile("s_waitcnt vmcnt(0)" ::: "memory");
            const unsigned og = xb_add(&bar[XB_TOP], 1u);
            const unsigned tg = og / nx;
            if (og + 1u == (tg + 1u) * nx) xb_add(&bar[XB_TOPGEN], 1u);
            else XB_SPIN(xb_ld(&bar[XB_TOPGEN]) == tg, bar);
            __builtin_amdgcn_fence(__ATOMIC_ACQUIRE, "agent");
            xb_add(&bar[XB_XGEN(b.x)], 1u);
            asm volatile("s_waitcnt vmcnt(0)" ::: "memory");
        } else {
            XB_SPIN(xb_ld(&bar[XB_XGEN(b.x)]) == gen, bar);
            __builtin_amdgcn_fence(__ATOMIC_ACQUIRE, "agent");
            asm volatile("s_waitcnt vmcnt(0)" ::: "memory");
        }
    }
    __syncthreads();
}

#ifndef TPS
#define TPS 0
#define TPS_WG 0
#endif
#define TPS_POINT(n) do { if (TPS == (n) && F.bid == TPS_WG) F.tp += __builtin_amdgcn_s_memrealtime() - F.tp0; } while (0)
struct Frame {
    LAS unsigned char* lds; unsigned char* ldsg;
    int tid, lane, wave, bid, vcu, G;
    unsigned char* ws;
    unsigned long long tp, tp0;
};
enum { I_X = 0, I_NORM_MIX, I_W_IN, I_B_IN, I_M_NORM, I_A_NORM, I_LAM_QK, I_W_BM, I_W_BD, I_W_O, I_NORM_FFN, I_W_UP, I_CONV_W, I_CONV_B, I_W_DOWN, I_NORM_FINAL, I_OUT, I_NPTR };
constexpr int PTAB_OFF = 131072 + 256;
__device__ __forceinline__ const float* inp(const Frame& F, int i) {
    const LAS unsigned* t = (const LAS unsigned*)(F.lds + PTAB_OFF) + 2 * i;
    const unsigned lo = __builtin_amdgcn_readfirstlane(t[0]), hi = __builtin_amdgcn_readfirstlane(t[1]);
    return (const float*)(const GAS float*)(((unsigned long long)hi << 32) | lo);
}
template <int CTRL, int RM> __device__ __forceinline__ float dppf(float old, float src) {
    return __uint_as_float(__builtin_amdgcn_update_dpp(__float_as_uint(old), __float_as_uint(src), CTRL, RM, 0xf, false)); }
__device__ __forceinline__ float wave_sum(float v) {
    v += dppf<0xB1, 0xf>(0.f, v); v += dppf<0x4E, 0xf>(0.f, v); v += dppf<0x141, 0xf>(0.f, v); v += dppf<0x140, 0xf>(0.f, v);
    { auto rr = __builtin_amdgcn_permlane16_swap(__float_as_uint(v), __float_as_uint(v), false, false); v = __uint_as_float(rr[0]) + __uint_as_float(rr[1]); }
    { auto rr = __builtin_amdgcn_permlane32_swap(__float_as_uint(v), __float_as_uint(v), false, false); v = __uint_as_float(rr[0]) + __uint_as_float(rr[1]); }
    return v;
}
__device__ __forceinline__ float wave_scan_sum(float v) {
    v += dppf<0x111, 0xf>(0.f, v); v += dppf<0x112, 0xf>(0.f, v); v += dppf<0x114, 0xf>(0.f, v); v += dppf<0x118, 0xf>(0.f, v);
    v += dppf<0x142, 0xa>(0.f, v); v += dppf<0x143, 0xc>(0.f, v); return v;
}
__device__ __forceinline__ float wave_scan_max(float v) {
    const float NEG = -__builtin_inff();
    v = fmaxf(v, dppf<0x111, 0xf>(NEG, v)); v = fmaxf(v, dppf<0x112, 0xf>(NEG, v)); v = fmaxf(v, dppf<0x114, 0xf>(NEG, v)); v = fmaxf(v, dppf<0x118, 0xf>(NEG, v));
    v = fmaxf(v, dppf<0x142, 0xa>(NEG, v)); v = fmaxf(v, dppf<0x143, 0xc>(NEG, v)); return v;
}

struct CvtJob { const float* W; bf16* Bt; const float* gain; int Nsrc, K, k0, srccol0, dstrow0, rope; };
constexpr int IT_IN = 32 * 256, IT_SQ = 32 * 32, IT_UP = 32 * 176, IT_DN = 88 * 32, IT_LAYER = IT_IN + 3 * IT_SQ + IT_UP + IT_DN, IT_TOTAL = DEPTH * IT_LAYER, IT_A = IT_IN + 3 * IT_SQ;
__host__ __device__ __forceinline__ int tail_idle(int G) { const int nu = (MTOK / 256) * (NUP / 256), rounds = (nu + G - 1) / G, busy = nu - (rounds - 1) * G; const int idle = G - busy; return idle >= 64 ? idle : 0; }
__device__ __forceinline__ void cvt_decode(const Frame& F, int it, CvtJob& j) {
    const int l = it / IT_LAYER; int r = it - l * IT_LAYER; j.rope = 0; j.gain = nullptr;
    if (r < IT_IN) { const int nb = r >> 5, kt = r & 31, n0 = nb * 64;
        j.W = inp(F, I_W_IN) + (size_t)l * DM * NIN; j.Bt = (bf16*)(F.ws + WS_WIN + (size_t)l * SZ_WIN); j.Nsrc = NIN; j.K = DM; j.k0 = kt * 64; j.gain = inp(F, I_NORM_MIX) + (size_t)l * DM;
        j.srccol0 = n0 < GATE_COL ? n0 : n0 + 16; j.dstrow0 = n0; j.rope = (n0 >= 6144 && n0 < 10240 && (n0 & 127) == 0) ? 1 : 0; return; }
    r -= IT_IN;
    if (r < 3 * IT_SQ) { const int w = r / IT_SQ; r -= w * IT_SQ; const int nb = r >> 5, kt = r & 31;
        j.W = (w == 0 ? inp(F, I_W_BM) : (w == 1 ? inp(F, I_W_BD) : inp(F, I_W_O))) + (size_t)l * DM * DM;
        j.Bt = (bf16*)(F.ws + (w == 0 ? WS_WBM : (w == 1 ? WS_WBD : WS_WO)) + (size_t)l * SZ_WSQ); j.Nsrc = DM; j.K = DM; j.k0 = kt * 64; j.srccol0 = nb * 64; j.dstrow0 = nb * 64; return; }
    r -= 3 * IT_SQ;
    if (r < IT_UP) { const int nb = r >> 5, kt = r & 31, n0 = nb * 64, pn = n0 >> 8, w = n0 & 255;
        j.W = inp(F, I_W_UP) + (size_t)l * DM * NUP; j.Bt = (bf16*)(F.ws + WS_WUP + (size_t)l * SZ_WUP); j.Nsrc = NUP; j.K = DM; j.k0 = kt * 64; j.gain = inp(F, I_NORM_FFN) + (size_t)l * DM;
        j.srccol0 = (w < 128) ? pn * 128 + w : DFF + pn * 128 + (w - 128); j.dstrow0 = n0; return; }
    r -= IT_UP;
    { const int nb = r / 88, kt = r - nb * 88;
      j.W = inp(F, I_W_DOWN) + (size_t)l * DFF * DM; j.Bt = (bf16*)(F.ws + WS_WDN + (size_t)l * SZ_WDN); j.Nsrc = DM; j.K = DFF; j.k0 = kt * 64; j.srccol0 = nb * 64; j.dstrow0 = nb * 64; }
}
__device__ __forceinline__ void cvt_load(const CvtJob& j, int lane, f32x4 (&v)[16], float (&gn)[16]) {
    const float* p = j.W + (size_t)(j.k0 + (lane >> 4)) * j.Nsrc + j.srccol0 + (lane & 15) * 4;
#pragma unroll
    for (int i = 0; i < 16; ++i) v[i] = *(const f32x4*)(p + (size_t)(4 * i) * j.Nsrc);
#pragma unroll
    for (int i = 0; i < 16; ++i) gn[i] = j.gain ? j.gain[j.k0 + (lane >> 4) + 4 * i] : 1.0f;
}
__device__ __forceinline__ void cvt_store(const CvtJob& j, int lane, const f32x4 (&v)[16], const float (&gn)[16], LAS float* scr) {
#pragma unroll
    for (int i = 0; i < 16; ++i) { const int r = (lane >> 4) + 4 * i, n = (lane & 15) * 4; *(LAS f32x4*)(scr + r * 64 + (n ^ ((i >> 1) << 2))) = v[i] * gn[i]; }
    LDS_WAIT(); asm volatile("" ::: "memory");
    const int c = lane & 7;
#pragma unroll
    for (int i = 0; i < 8; ++i) { const int n = (lane >> 3) + 8 * i; const LAS float* s = scr + (8 * c) * 64 + (n ^ (c << 2));
        v4u o; o.x = pk2(s[0 * 64], s[1 * 64]); o.y = pk2(s[2 * 64], s[3 * 64]); o.z = pk2(s[4 * 64], s[5 * 64]); o.w = pk2(s[6 * 64], s[7 * 64]);
        int nd = n; if (j.rope && n < 32) nd = (n < 16) ? 2 * n : 2 * (n - 16) + 1;
        *(v4u*)(j.Bt + (size_t)(j.dstrow0 + nd) * j.K + j.k0 + 8 * c) = o; }
    LDS_WAIT(); asm volatile("" ::: "memory");
}
__device__ __forceinline__ void sincos_d(double ang, float& s, float& c) {
    const double TWO_PI = 6.283185307179586476925286766559; const double k = rint(ang / TWO_PI); const double r = ang - k * TWO_PI; const double r2 = r * r;
    double ts = 1.0, tc = 1.0, ss = 1.0, cc = 1.0;
#pragma unroll
    for (int i = 1; i <= 16; ++i) { tc = -tc * r2 / (double)((2 * i - 1) * (2 * i)); ts = -ts * r2 / (double)((2 * i) * (2 * i + 1)); cc += tc; ss += ts; }
    s = (float)(ss * r); c = (float)cc;
}
__device__ __forceinline__ void cvt_run(Frame& F, int it0, int n, int w, int nw) {
    LAS float* scr = (LAS float*)(F.lds + F.wave * 16384);
    const int per = (n + nw - 1) / nw; int it = it0 + w * per; const int it1 = (it + per < it0 + n) ? it + per : it0 + n;
    CvtJob j0, j1; f32x4 v0[16], v1[16]; float g0[16], g1[16];
    if (it < it1) { cvt_decode(F, it, j0); cvt_load(j0, F.lane, v0, g0); }
    for (; it < it1; it += 2) {
        if (it + 1 < it1) { cvt_decode(F, it + 1, j1); cvt_load(j1, F.lane, v1, g1); }
        cvt_store(j0, F.lane, v0, g0, scr);
        if (it + 1 >= it1) break;
        if (it + 2 < it1) { cvt_decode(F, it + 2, j0); cvt_load(j0, F.lane, v0, g0); }
        cvt_store(j1, F.lane, v1, g1, scr);
    }
}
__device__ __forceinline__ void p0_prologue(Frame& F) {
    const int gw = F.bid * NWAVES + F.wave, NGW = F.G * NWAVES;
    cvt_run(F, 0, tail_idle(F.G) ? IT_A : IT_LAYER, gw, NGW);
    const int gt = F.bid * 512 + F.tid, NGT = F.G * 512;
    { float* bg = (float*)(F.ws + WS_BIASG);
      for (int i = gt; i < DEPTH * NING; i += NGT) { const int l = i >> 14, n = i & (NING - 1); int src = n < GATE_COL ? n : n + 16;
          if (n >= 6144 && n < 10240 && (n & 127) < 32) { const int p = n & 127, dim = (p & 1) ? 16 + (p >> 1) : (p >> 1); src = (n & ~127) + dim + 16; }
          bg[i] = inp(F, I_B_IN)[(size_t)l * NIN + src]; } }
    { unsigned short* gwf = (unsigned short*)(F.ws + WS_GWF);
      for (int i = gt; i < DEPTH * DM * 4; i += NGT) { const int l = i >> 13, k = (i >> 2) & (DM - 1), q = i & 3;
          const f32x4 w = *(const f32x4*)(inp(F, I_W_IN) + (size_t)l * DM * NIN + (size_t)k * NIN + GATE_COL + 4 * q) * inp(F, I_NORM_MIX)[l * DM + k];
          const int ks = k >> 5, kq = (k >> 3) & 3, e = k & 7;
#pragma unroll
          for (int j = 0; j < 4; ++j) { const unsigned hi = pk2(w[j], 0.f) & 0xffffu; const unsigned lo = pk2(w[j] - __uint_as_float(hi << 16), 0.f) & 0xffffu;
              const size_t o = ((((size_t)l * 64 + ks) * 2) * 64 + 16 * kq + 4 * q + j) * 8 + e;
              gwf[o] = (unsigned short)hi; gwf[o + 64 * 8] = (unsigned short)lo; } } }
    { float* rp = (float*)(F.ws + WS_ROPE);
      for (int i = gt; i < SEQ * 16; i += NGT) { const int pos = i >> 4, k = i & 15; const double inv = exp2(-(double)k * (18.931568569324174 / 16.0));
          float s, c; sincos_d((double)pos * inv, s, c); rp[pos * 32 + k] = c; rp[pos * 32 + 16 + k] = s; } }
    { bf16* xn = (bf16*)(F.ws + WS_XN); pg8::u64_t* rb = (pg8::u64_t*)(F.ws + WS_ROWSS_B); const float* x = inp(F, I_X);
      for (int row = gw; row < MTOK; row += NGW) { const f32x4* xr = (const f32x4*)(x + (size_t)row * DM) + F.lane; v2u* o8 = (v2u*)(xn + (size_t)row * DM) + F.lane; float ss = 0.f;
          f32x4 xv8[8];
#pragma unroll
          for (int j = 0; j < 8; ++j) xv8[j] = xr[64 * j];
#pragma unroll
          for (int j = 0; j < 8; ++j) { const f32x4 v = xv8[j]; v2u w; w.x = pk2(v.x, v.y); w.y = pk2(v.z, v.w); o8[64 * j] = w;
              ss += (pg8::bf_lo(w.x) * pg8::bf_lo(w.x) + pg8::bf_hi(w.x) * pg8::bf_hi(w.x)) + (pg8::bf_lo(w.y) * pg8::bf_lo(w.y) + pg8::bf_hi(w.y) * pg8::bf_hi(w.y)); }
          ss = wave_sum(ss); if (F.lane == 0) rb[row] = pg8::ss_fix(ss); } }
}

__device__ __forceinline__ void gates_step(Frame& F, int l, gu32* cnt) {
    const float* bl = inp(F, I_B_IN) + (size_t)l * NIN;
    const bf16* hb = (const bf16*)(F.ws + WS_XN); const pg8::u64_t* rowss = (const pg8::u64_t*)(F.ws + WS_ROWSS_B); float* gates = (float*)(F.ws + WS_GATES);
    const bf16* gwf = (const bf16*)(F.ws + WS_GWF) + (size_t)l * (64 * 2 * 64 * 8);
    LAS float* RED = (LAS float*)F.lds;
    const int fr = F.lane & 15, fq = F.lane >> 4;
    const int orow = F.tid >> 4, on = F.tid & 15;
    const float bgl = bl[GATE_COL + on];
    for (int rb = F.bid; rb < MTOK / 32; rb += F.G) { const int r0 = rb * 32;
        v4u a[2][8], b[8][2];
#pragma unroll
        for (int ks = 0; ks < 8; ++ks)
#pragma unroll
            for (int t = 0; t < 2; ++t) a[t][ks] = *(const v4u*)(hb + (size_t)(r0 + 16 * t + fr) * DM + 256 * F.wave + 32 * ks + 8 * fq);
#pragma unroll
        for (int ks = 0; ks < 8; ++ks)
#pragma unroll
            for (int hl = 0; hl < 2; ++hl) b[ks][hl] = *(const v4u*)(gwf + ((size_t)((8 * F.wave + ks) * 2 + hl) * 64 + F.lane) * 8);
        const pg8::u64_t rsu = rowss[r0 + orow];
        f32x4 acc[2]; acc[0] = acc[1] = (f32x4){0.f, 0.f, 0.f, 0.f};
#pragma unroll
        for (int ks = 0; ks < 8; ++ks)
#pragma unroll
            for (int hl = 0; hl < 2; ++hl)
#pragma unroll
                for (int t = 0; t < 2; ++t) acc[t] = __builtin_amdgcn_mfma_f32_16x16x32_bf16(__builtin_bit_cast(pg8::bf16x8, a[t][ks]), __builtin_bit_cast(pg8::bf16x8, b[ks][hl]), acc[t], 0, 0, 0);
#pragma unroll
        for (int t = 0; t < 2; ++t) *(LAS f32x4*)(RED + ((F.wave * 2 + t) * 64 + F.lane) * 4) = acc[t];
        __syncthreads();
        { const int t = orow >> 4, q = (orow >> 2) & 3, r = orow & 3; float sum = 0.f;
#pragma unroll
          for (int w = 0; w < 8; ++w) sum += RED[((w * 2 + t) * 64 + 16 * q + on) * 4 + r];
          const float rs = 1.0f / sqrtf(pg8::ss_f32(rsu) * (1.0f / DM) + EPS);
          __hip_atomic_store(gates + (size_t)(r0 + orow) * 16 + on, sum * rs + bgl, RLX_AGENT); }
        __syncthreads();
    }
    VM_WAIT(); __syncthreads();
    if (F.tid == 0) __hip_atomic_fetch_add(cnt, 1u, RLX_AGENT);
}
__device__ __forceinline__ void gates_wait(Frame& F, gu32* cnt) {
    if (threadIdx.x == 0) { unsigned sp = 0; gu32* tmo = (gu32*)(F.ws + WS_CTL) + CW_TMO;
        while (__hip_atomic_load(cnt, RLX_AGENT) < (unsigned)F.G) { __builtin_amdgcn_s_sleep(2); if (++sp > (1u << 22)) { __hip_atomic_store(tmo, 1u, RLX_AGENT); break; } }
        __builtin_amdgcn_fence(__ATOMIC_ACQUIRE, "agent"); VM_WAIT(); }
    __syncthreads();
}

__device__ __forceinline__ float logsigmoidf_(float x) { return fminf(x, 0.f) - log1pf(__expf(-fabsf(x))); }
__device__ __forceinline__ void mlstm_prep(Frame& F, int b, int hh) {
    const float* gates = (const float*)(F.ws + WS_GATES);
    float* a2 = (float*)(F.ldsg + ab::A2_OFF); float* M2 = (float*)(F.ldsg + ab::M2_OFF); float* e2 = (float*)(F.ldsg + ab::E2_OFF); float* sc = (float*)(F.ldsg + ab::SCAN_OFF);
    int tid_ = F.tid; asm volatile("" : "+v"(tid_));
    const int lane_ = tid_ & 63;
    float lf[4], ig[4];
#pragma unroll
    for (int e = 0; e < 4; ++e) { const size_t idx = (size_t)(b * SEQ + 4 * tid_ + e) * 16; ig[e] = gates[idx + hh]; lf[e] = logsigmoidf_(gates[idx + 8 + hh]); }
    float c[4]; c[0] = lf[0]; c[1] = c[0] + lf[1]; c[2] = c[1] + lf[2]; c[3] = c[2] + lf[3];
    const float incl = wave_scan_sum(c[3]);
    if (lane_ == 63) sc[F.wave] = incl;
    __syncthreads();
    float wp = 0.f;
    for (int w = 0; w < F.wave; ++w) wp += sc[w];
    const float base = wp + incl - c[3];
    float Bv[4], av[4], mx[4];
#pragma unroll
    for (int e = 0; e < 4; ++e) { Bv[e] = base + c[e]; av[e] = ig[e] - Bv[e]; }
    mx[0] = av[0]; mx[1] = fmaxf(mx[0], av[1]); mx[2] = fmaxf(mx[1], av[2]); mx[3] = fmaxf(mx[2], av[3]);
    const float im = wave_scan_max(mx[3]);
    if (lane_ == 63) sc[16 + F.wave] = im;
    const float ex = dppf<0x138, 0xf>(-__builtin_inff(), im);
    __syncthreads();
    float wm = -__builtin_inff();
    for (int w = 0; w < F.wave; ++w) wm = fmaxf(wm, sc[16 + w]);
    const float pre = fmaxf(wm, ex);
    const float L2E = 1.4426950408889634f;
#pragma unroll
    for (int e = 0; e < 4; ++e) { const float M = fmaxf(pre, mx[e]); const int t = 4 * tid_ + e; a2[t] = av[e] * L2E; M2[t] = M * L2E; e2[t] = -(Bv[e] + M) * L2E; }
    __syncthreads();
}
__device__ __forceinline__ ab::BlockRef att_ref(Frame& F, int qt) {
    const int q = qt >> 8, t = qt & 255, hv = 16 * q + (t & 15), qb = 7 - (t >> 4), vh = hv & 1, c = (hv >> 1) & 1, hh = (hv >> 2) & 7, b = hv >> 5;
    ab::BlockRef r;
    r.Q = (const bf16*)(F.ws + WS_AQ) + (size_t)(b * SEQ + qb * 256) * 2048 + hh * 256 + c * 128;
    r.K = (const bf16*)(F.ws + WS_AK) + (size_t)(b * SEQ) * 2048 + hh * 256 + c * 128;
    r.V = (const bf16*)(F.ws + WS_AV) + (size_t)(b * SEQ) * 2048 + hh * 256 + vh * 128;
    r.O = (float*)((bf16*)(F.ws + WS_OATT) + (size_t)(b * SEQ + qb * 256) * 4096 + hh * 512 + c * 256 + vh * 128);
    r.P0 = qb * 256; r.Cst = nullptr; r.nst = nullptr; return r;
}
__device__ __forceinline__ ab::BlockRef mls_ref(Frame& F, int t) {
    const int bh = t >> 4, qb = (t >> 1) & 7, vh = t & 1, hh = bh & 7, b = bh >> 3;
    ab::BlockRef r;
    r.Q = (const bf16*)(F.ws + WS_MQ) + (size_t)(b * SEQ + qb * 256) * 1024 + hh * 128;
    r.K = (const bf16*)(F.ws + WS_MK) + (size_t)(b * SEQ) * 1024 + hh * 128;
    r.V = (const bf16*)(F.ws + WS_MV) + (size_t)(b * SEQ) * 2048 + hh * 256 + vh * 128;
    r.O = (float*)((bf16*)(F.ws + WS_HRAW) + (size_t)(b * SEQ + qb * 256) * 2048 + hh * 256 + vh * 128);
    r.P0 = qb * 256;
    r.Cst = qb ? (const bf16*)(F.ws + WS_CST) + ((size_t)(bh * 7 + qb - 1) * 128) * 256 + vh * 128 : nullptr;
    r.nst = qb ? (const float*)(F.ws + WS_NST) + (size_t)(bh * 7 + qb - 1) * 128 : nullptr;
    return r;
}
__device__ __forceinline__ ab::bf16x8 scale8(ab::bf16x8 v, float w) {
    ab::u32x4 q = *reinterpret_cast<ab::u32x4*>(&v); ab::u32x4 o;
    o.x = ab::cvtpk(__uint_as_float(q.x << 16) * w, __uint_as_float(q.x & 0xffff0000u) * w); o.y = ab::cvtpk(__uint_as_float(q.y << 16) * w, __uint_as_float(q.y & 0xffff0000u) * w);
    o.z = ab::cvtpk(__uint_as_float(q.z << 16) * w, __uint_as_float(q.z & 0xffff0000u) * w); o.w = ab::cvtpk(__uint_as_float(q.w << 16) * w, __uint_as_float(q.w & 0xffff0000u) * w);
    return *reinterpret_cast<ab::bf16x8*>(&o);
}
__device__ __forceinline__ float sum8(ab::bf16x8 v) {
    const ab::u32x4 q = *reinterpret_cast<const ab::u32x4*>(&v);
    return ((__uint_as_float(q.x << 16) + __uint_as_float(q.x & 0xffff0000u)) + (__uint_as_float(q.y << 16) + __uint_as_float(q.y & 0xffff0000u)))
         + ((__uint_as_float(q.z << 16) + __uint_as_float(q.z & 0xffff0000u)) + (__uint_as_float(q.w << 16) + __uint_as_float(q.w & 0xffff0000u)));
}
__device__ __forceinline__ void mls_scan(Frame& F, int bh, const int tid) {
    using namespace ab;
    char* lds = (char*)F.ldsg; const int b = bh >> 3, hh = bh & 7;
    const float* a2 = (const float*)(lds + A2_OFF); const float* M2 = (const float*)(lds + M2_OFF);
    const int wid = __builtin_amdgcn_readfirstlane(tid >> 6), lane = tid & 63, r32 = lane & 31, hi = lane >> 5, dgrp = wid & 3, vh = wid >> 2;
    const int sr = tid >> 4, sc = (tid & 15) * 8, vst0 = v_st(sr, sc), vst1 = v_st(32 + sr, sc);
    const bf16* Kp = (const bf16*)(F.ws + WS_MK) + (size_t)(b * SEQ) * 1024 + hh * 128;
    const bf16* Vp = (const bf16*)(F.ws + WS_MV) + (size_t)(b * SEQ) * 2048 + hh * 256;
    bf16* Cst = (bf16*)(F.ws + WS_CST) + (size_t)(bh * 7) * 128 * 256; float* nst = (float*)(F.ws + WS_NST) + (size_t)(bh * 7) * 128;
    const unsigned lok = (unsigned)((lane >> 4) * 1024 + sc), lov = (unsigned)((lane >> 4) * 2048 + sc);
    f32x16 C[4] = {}; float nacc = 0.f;
    const int vbA = (int)(uintptr_t)lds + v_rd_base(lane) + dgrp * 512;
    const int vbB = (int)(uintptr_t)lds + v_rd_base(lane) + 16384 * (1 + vh);
    bf16x8 ka[4], kb[4], va[4], vb[4], vc[4], vd[4];
#define SC_LOAD(i, s0) do { const bf16* kp_ = Kp + (size_t)((s0) + wid * 4) * 1024; const bf16* vp_ = Vp + (size_t)((s0) + wid * 4) * 2048; \
        ka[i] = load8(kp_ + lok); kb[i] = load8(kp_ + 32 * 1024 + lok); va[i] = load8(vp_ + lov); vb[i] = load8(vp_ + 32 * 2048 + lov); vc[i] = load8(vp_ + 128 + lov); vd[i] = load8(vp_ + 32 * 2048 + 128 + lov); } while (0)
#define SC_TRRD(dst, base, off) asm volatile("ds_read_b64_tr_b16 %0, %1 offset:%2" : "=&v"(dst) : "v"(base), "i"(off) : "memory")
#define SC_D0(d0) do { s16x4 l0, l1, l2, l3, h0, h1, h2, h3; constexpr int b_ = (d0) * 512; \
            SC_TRRD(l0, vbB, b_); SC_TRRD(h0, vbB, b_ + 2048); SC_TRRD(l1, vbB, b_ + 4096); SC_TRRD(h1, vbB, b_ + 6144); SC_TRRD(l2, vbB, b_ + 8192); SC_TRRD(h2, vbB, b_ + 10240); SC_TRRD(l3, vbB, b_ + 12288); SC_TRRD(h3, vbB, b_ + 14336); \
            asm volatile("s_waitcnt lgkmcnt(0)" ::: "memory"); SBAR(); \
            C[d0] = __builtin_amdgcn_mfma_f32_32x32x16_bf16(A0, (bf16x8){l0[0], l0[1], l0[2], l0[3], h0[0], h0[1], h0[2], h0[3]}, C[d0], 0, 0, 0); \
            C[d0] = __builtin_amdgcn_mfma_f32_32x32x16_bf16(A1, (bf16x8){l1[0], l1[1], l1[2], l1[3], h1[0], h1[1], h1[2], h1[3]}, C[d0], 0, 0, 0); \
            C[d0] = __builtin_amdgcn_mfma_f32_32x32x16_bf16(A2, (bf16x8){l2[0], l2[1], l2[2], l2[3], h2[0], h2[1], h2[2], h2[3]}, C[d0], 0, 0, 0); \
            C[d0] = __builtin_amdgcn_mfma_f32_32x32x16_bf16(A3, (bf16x8){l3[0], l3[1], l3[2], l3[3], h3[0], h3[1], h3[2], h3[3]}, C[d0], 0, 0, 0); } while (0)
#pragma unroll
    for (int i = 0; i < 4; ++i) SC_LOAD(i, 64 * i);
    for (int j = 0; j < 7; ++j) {
        const float mNew = M2[256 * (j + 1) - 1];
        if (j > 0) { const float dec = __builtin_amdgcn_exp2f(M2[256 * j - 1] - mNew);
#pragma unroll
            for (int d_ = 0; d_ < 4; ++d_)
#pragma unroll
                for (int r = 0; r < 16; ++r) C[d_][r] *= dec;
            nacc *= dec; }
#pragma unroll
        for (int tt = 0; tt < 4; ++tt) {
            const int s0 = 256 * j + 64 * tt;
            const float w0 = __builtin_amdgcn_exp2f(a2[s0 + sr] - mNew), w1 = __builtin_amdgcn_exp2f(a2[s0 + 32 + sr] - mNew);
            if (j < 6) { asm volatile("s_waitcnt vmcnt(18)" ::: "memory"); } else { asm volatile("s_waitcnt vmcnt(0)" ::: "memory"); }
            const bf16x8 ks0 = scale8(ka[tt], w0), ks1 = scale8(kb[tt], w1);
            __syncthreads();
            *(bf16x8*)(lds + vst0) = ks0; *(bf16x8*)(lds + vst1) = ks1;
            *(bf16x8*)(lds + 16384 + vst0) = va[tt]; *(bf16x8*)(lds + 16384 + vst1) = vb[tt]; *(bf16x8*)(lds + 32768 + vst0) = vc[tt]; *(bf16x8*)(lds + 32768 + vst1) = vd[tt];
            SBAR();
            if (j < 6) SC_LOAD(tt, s0 + 256);
            __syncthreads();
            s16x4 al0, ah0, al1, ah1, al2, ah2, al3, ah3;
            SC_TRRD(al0, vbA, 0); SC_TRRD(ah0, vbA, 2048); SC_TRRD(al1, vbA, 4096); SC_TRRD(ah1, vbA, 6144); SC_TRRD(al2, vbA, 8192); SC_TRRD(ah2, vbA, 10240); SC_TRRD(al3, vbA, 12288); SC_TRRD(ah3, vbA, 14336);
            asm volatile("s_waitcnt lgkmcnt(0)" ::: "memory"); SBAR();
            const bf16x8 A0 = (bf16x8){al0[0], al0[1], al0[2], al0[3], ah0[0], ah0[1], ah0[2], ah0[3]}, A1 = (bf16x8){al1[0], al1[1], al1[2], al1[3], ah1[0], ah1[1], ah1[2], ah1[3]};
            const bf16x8 A2 = (bf16x8){al2[0], al2[1], al2[2], al2[3], ah2[0], ah2[1], ah2[2], ah2[3]}, A3 = (bf16x8){al3[0], al3[1], al3[2], al3[3], ah3[0], ah3[1], ah3[2], ah3[3]};
            if (vh == 0) nacc += (sum8(A0) + sum8(A1)) + (sum8(A2) + sum8(A3));
            SC_D0(0); SC_D0(1); SC_D0(2); SC_D0(3);
        }
        { float nt = nacc; auto rr = __builtin_amdgcn_permlane32_swap(__float_as_uint(nt), __float_as_uint(nt), false, false); nt = __uint_as_float(rr[0]) + __uint_as_float(rr[1]);
          if (vh == 0 && hi == 0) nst[j * 128 + 32 * dgrp + r32] = nt; }
        bf16* Cj = Cst + ((size_t)j * 128 + 32 * dgrp) * 256 + 128 * vh; const unsigned loc = (unsigned)(4 * hi * 256 + r32);
#pragma unroll
        for (int r = 0; r < 16; ++r) { bf16* Cr = Cj + (size_t)((r & 3) + 8 * (r >> 2)) * 256;
#pragma unroll
            for (int d0 = 0; d0 < 4; ++d0) { const float v = C[d0][r]; const float nb = dppf<0xB1, 0xf>(0.f, v);
                if ((r32 & 1) == 0) *(unsigned*)(Cr + d0 * 32 + loc) = cvtpk(v, nb); } }
    }
#undef SC_LOAD
#undef SC_TRRD
#undef SC_D0
}
__device__ __forceinline__ void mls_finalise(Frame& F, int l, int bh, int qb) {
    int tid_ = threadIdx.x; asm volatile("" : "+v"(tid_)); const int lane_ = tid_ & 63;
    const int b = bh >> 3, hh = bh & 7; const bf16* hraw = (const bf16*)(F.ws + WS_HRAW); const bf16* smo = (const bf16*)(F.ws + WS_SMO); bf16* hmn = (bf16*)(F.ws + WS_HMN);
    const f32x4 g = *(const f32x4*)(inp(F, I_M_NORM) + (size_t)l * 2048 + hh * 256 + 4 * lane_);
    const size_t base = (size_t)(b * SEQ + qb * 256 + F.wave * 32) * 2048 + hh * 256 + 4 * lane_;
#pragma unroll 1
    for (int r0 = 0; r0 < 32; r0 += 16) {
        v2u hv[16], sw[16];
#pragma unroll
        for (int r = 0; r < 16; ++r) { hv[r] = *(const v2u*)(hraw + base + (size_t)(r0 + r) * 2048); sw[r] = *(const v2u*)(smo + base + (size_t)(r0 + r) * 2048); }
#pragma unroll
        for (int r = 0; r < 16; ++r) { const f32x4 x = (f32x4){pg8::bf_lo(hv[r].x), pg8::bf_hi(hv[r].x), pg8::bf_lo(hv[r].y), pg8::bf_hi(hv[r].y)};
            const float rs = 1.0f / sqrtf(wave_sum((x.x * x.x + x.y * x.y) + (x.z * x.z + x.w * x.w)) * (1.0f / 256.0f) + EPS);
            const f32x4 sg = (f32x4){pg8::bf_lo(sw[r].x), pg8::bf_hi(sw[r].x), pg8::bf_lo(sw[r].y), pg8::bf_hi(sw[r].y)};
            const f32x4 o = x * rs * g * sg; v2u w; w.x = pk2(o.x, o.y); w.y = pk2(o.z, o.w); *(v2u*)(hmn + base + (size_t)(r0 + r) * 2048) = w; }
    }
}
__device__ __forceinline__ void wait_word_ge(Frame& F, gu32* w, unsigned need) {
    if (threadIdx.x == 0) { unsigned sp = 0; gu32* tmo = (gu32*)(F.ws + WS_CTL) + CW_TMO;
        while (__hip_atomic_load(w, RLX_AGENT) < need) { __builtin_amdgcn_s_sleep(2); if (++sp > (1u << 22)) { __hip_atomic_store(tmo, 1u, RLX_AGENT); break; } }
        __builtin_amdgcn_fence(__ATOMIC_ACQUIRE, "agent"); VM_WAIT(); }
    __syncthreads();
}
__device__ __forceinline__ void fin_phase(Frame& F, int l);
__device__ __forceinline__ void mix_phase(Frame& F, int l, int rep) {
    char* lds = (char*)F.ldsg;
    constexpr int NMLS = 512, NSCAN = 32, NCVT = 64, NCVT1 = 64;
    gu32* ctl = (gu32*)(F.ws + WS_CTL);
    gu32* gcnt = ctl + CW_GCNT + 64 * (l + 4 * rep); gu32* sflag = ctl + CW_SFLAG + 64 * ((l + 4 * rep) * 32); gu32* tick = ctl + CW_TICK + 64 * (l + 4 * rep);
    if (TPS) F.tp0 = __builtin_amdgcn_s_memrealtime();
    gates_step(F, l, gcnt);
    TPS_POINT(1);
    { const bool tl = tail_idle(F.G) != 0; const int ncvt = (!tl || l == 0) ? NCVT : NCVT1;
      if (l + 1 < DEPTH && rep == 0 && F.bid >= NSCAN && F.bid < NSCAN + ncvt) {
        const int c0 = !tl ? (l + 1) * IT_LAYER : (l == 0 ? IT_A : (l + 1) * IT_LAYER), cn = !tl ? IT_LAYER : (l == 0 ? IT_LAYER : IT_A);
        cvt_run(F, c0, cn, (F.bid - NSCAN) * NWAVES + F.wave, ncvt * NWAVES);
        VM_WAIT(); __syncthreads();
      } }
    if (F.bid < NSCAN) {
        gates_wait(F, gcnt);
        int tid_s = threadIdx.x; asm volatile("" : "+v"(tid_s));
        mlstm_prep(F, F.bid >> 3, F.bid & 7);
        mls_scan(F, F.bid, tid_s);
        VM_WAIT(); __syncthreads();
        if (threadIdx.x == 0) { __builtin_amdgcn_fence(__ATOMIC_RELEASE, "agent"); VM_WAIT(); __hip_atomic_store(sflag + 64 * F.bid, 1u, RLX_AGENT); }
        __syncthreads();
        TPS_POINT(2);
    }
#ifndef NO_ATT
    { volatile LAS unsigned* tw = (volatile LAS unsigned*)(F.lds + MISC_OFF) + 16; gu32* atick = ctl + CW_ATICK + 64 * (8 * (l + 4 * rep));
      const int q0 = (int)(xb_xcc_id() & 7u); int qdone = 0;
#define TAKE_ATT(dst) do { if (threadIdx.x == 0) { int r_ = -1; for (int i_ = 0; i_ < 8; ++i_) { const int q_ = (q0 + i_) & 7; if (qdone & (1 << q_)) continue;               \
            const unsigned t_ = __hip_atomic_fetch_add(atick + 64 * q_, 1u, RLX_AGENT); if (t_ < 128u) { r_ = (q_ << 8) | (int)t_; break; } qdone |= 1 << q_; } tw[0] = (unsigned)r_; } \
        PP_BAR(); dst = __builtin_amdgcn_readfirstlane((int)tw[0]); PP_BAR(); } while (0)
      int qt; TAKE_ATT(qt);
      if (qt >= 0) {
          ab::BlockRef cur = att_ref(F, qt); ab::Seam S;
          int tid_a = threadIdx.x; asm volatile("" : "+v"(tid_a));
          ab::prime2<0, 2048, 2048, 2048>(cur, lds, S, tid_a);
          for (;;) {
              int qn; TAKE_ATT(qn);
              const bool last = qn < 0;
              const ab::BlockRef nxt = last ? cur : att_ref(F, qn);
              ab::block2<0, 2048, 2048, 2048, 4096>(cur, nxt, lds, S, tid_a);
              if (last) break;
              cur = nxt;
          }
          ab::pp_realign(tid_a);
      }
#undef TAKE_ATT
    }
#endif
    VM_WAIT(); __syncthreads();
    if (threadIdx.x == 0) { __builtin_amdgcn_fence(__ATOMIC_RELEASE, "agent"); VM_WAIT(); __hip_atomic_fetch_add((gu32*)(F.ws + WS_CTL) + CW_ADONE + 64 * (l + 4 * rep), 1u, RLX_AGENT); }
    TPS_POINT(3);
#ifndef NO_MLS
    gates_wait(F, gcnt);
    TPS_POINT(4);
    { volatile LAS unsigned* tw = (volatile LAS unsigned*)(F.lds + MISC_OFF) + 16;
#define TAKE_TICKET(dst) do { if (threadIdx.x == 0) tw[0] = __hip_atomic_fetch_add(tick, 1u, RLX_AGENT); __syncthreads(); dst = __builtin_amdgcn_readfirstlane((int)tw[0]); __syncthreads(); } while (0)
      for (;;) {
          int t2; TAKE_TICKET(t2);
          if (t2 >= NMLS / 2) break;
          int tid_m = threadIdx.x; asm volatile("" : "+v"(tid_m));
          const int bh = t2 >> 3;
          mlstm_prep(F, bh >> 3, bh & 7); wait_word_ge(F, sflag + 64 * bh, 1u);
          const ab::BlockRef c0 = mls_ref(F, 2 * t2), c1 = mls_ref(F, 2 * t2 + 1); ab::Seam S;
          ab::prime2<1, 1024, 1024, 2048>(c0, lds, S, tid_m);
          ab::block2<1, 1024, 1024, 2048, 2048>(c0, c1, lds, S, tid_m);
          ab::block2<1, 1024, 1024, 2048, 2048>(c1, c1, lds, S, tid_m);
          ab::pp_realign(tid_m);
          VM_WAIT(); __syncthreads();
          mls_finalise(F, l, bh, t2 & 7);
      }
#undef TAKE_TICKET
    }
    VM_WAIT(); __syncthreads();
#endif
    TPS_POINT(5);
}

__device__ __forceinline__ void fin_phase(Frame& F, int l) {
    int tid_ = threadIdx.x; asm volatile("" : "+v"(tid_)); const int lane_ = tid_ & 63;
    const float* lq = inp(F, I_LAM_QK) + (size_t)l * 512;
    const float s1 = wave_sum(lq[lane_] * lq[128 + lane_] + lq[64 + lane_] * lq[192 + lane_]);
    const float s2 = wave_sum(lq[256 + lane_] * lq[384 + lane_] + lq[320 + lane_] * lq[448 + lane_]);
    unsigned lib_ = l == 0 ? 0x3e4ccccdu : (l == 1 ? 0x3eb60549u : (l == 2 ? 0x3ef1014cu : 0x3f0e59d5u)); asm volatile("" : "+s"(lib_));
    const float lam_init = __uint_as_float(lib_);
    const float lam = expf(s1) - expf(s2) + lam_init, post = 1.0f - lam_init;
    const bf16* oat = (const bf16*)(F.ws + WS_OATT); bf16* han = (bf16*)(F.ws + WS_HAN);
    { pg8::u64_t* rowss = (pg8::u64_t*)(F.ws + WS_ROWSS); pg8::u64_t* rowsb = (pg8::u64_t*)(F.ws + WS_ROWSS_B); for (int i = F.bid * 512 + tid_; i < MTOK; i += F.G * 512) { rowss[i] = 0ull; rowsb[i] = 0ull; } }
    const int gw = F.bid * NWAVES + F.wave, NGW = F.G * NWAVES;
    const float* ag = inp(F, I_A_NORM) + (size_t)l * 2048;
    f32x4 agv[8];
#pragma unroll
    for (int hh = 0; hh < 8; ++hh) agv[hh] = *(const f32x4*)(ag + hh * 256 + 4 * lane_);
    for (int row = gw; row < MTOK; row += NGW) {
        v2u ra[8], rc[8]; const size_t ro = (size_t)row * 4096;
#pragma unroll
        for (int hh = 0; hh < 8; ++hh) { ra[hh] = *(const v2u*)(oat + ro + hh * 512 + 4 * lane_); rc[hh] = *(const v2u*)(oat + ro + hh * 512 + 256 + 4 * lane_); }
#pragma unroll
        for (int hh = 0; hh < 8; ++hh) { const int col = hh * 256 + 4 * lane_; const v2u a = ra[hh], c = rc[hh];
            const f32x4 v = (f32x4){pg8::bf_lo(a.x), pg8::bf_hi(a.x), pg8::bf_lo(a.y), pg8::bf_hi(a.y)} - (f32x4){pg8::bf_lo(c.x), pg8::bf_hi(c.x), pg8::bf_lo(c.y), pg8::bf_hi(c.y)} * lam;
            const float rs = 1.0f / sqrtf(wave_sum((v.x * v.x + v.y * v.y) + (v.z * v.z + v.w * v.w)) * (1.0f / 256.0f) + EPS);
            const f32x4 g = agv[hh];
            const f32x4 o = v * rs * g * post; v2u w; w.x = pk2(o.x, o.y); w.y = pk2(o.z, o.w); *(v2u*)(han + (size_t)row * 2048 + col) = w; }
    }
}

__device__ __forceinline__ void conv_fixup_panel(Frame& F, int l, int pm) {
    const float* fxc = (const float*)(F.ws + WS_FXC); const float* fxv = (const float*)(F.ws + WS_FXV); const float* fxg = (const float*)(F.ws + WS_FXG); bf16* u = (bf16*)(F.ws + WS_U);
    const float* cw = inp(F, I_CONV_W) + (size_t)l * 3 * DFF;
    constexpr int NI = 2 * 2 * (DFF / 4) / 512;
    static_assert(2 * 2 * (DFF / 4) == NI * 512, "fix-up item count");
#pragma unroll
    for (int i0 = 0; i0 < NI; i0 += 4) {
        f32x4 cp[4], vv[4], ga[4], gb[4], wa[4], wb[4]; int blkv[4], colv[4], rhov[4];
#pragma unroll
        for (int k = 0; k < 4; ++k) if (i0 + k < NI) { const int i = F.tid + (i0 + k) * 512, c4 = i % (DFF / 4), rr = i / (DFF / 4), rho = rr & 1, blk = pm * 2 + (rr >> 1), col = c4 * 4, pb = (blk & 15) ? blk - 1 : blk;
            blkv[k] = blk; colv[k] = col; rhov[k] = rho;
            cp[k] = *(const f32x4*)(fxc + ((size_t)blk * 2 + rho) * DFF + col); vv[k] = *(const f32x4*)(fxv + ((size_t)blk * 2 + rho) * DFF + col);
            ga[k] = *(const f32x4*)(fxg + ((size_t)pb * 2 + 1) * DFF + col); gb[k] = *(const f32x4*)(fxg + ((size_t)pb * 2) * DFF + col);
            wa[k] = *(const f32x4*)(cw + col); wb[k] = *(const f32x4*)(cw + DFF + col); }
#pragma unroll
        for (int k = 0; k < 4; ++k) if (i0 + k < NI) {
            if ((blkv[k] & 15) == 0) continue;
            const f32x4 cv = rhov[k] == 0 ? cp[k] + wb[k] * ga[k] + wa[k] * gb[k] : cp[k] + wa[k] * ga[k];
            f32x4 o;
#pragma unroll
            for (int j = 0; j < 4; ++j) o[j] = cv[j] * pg8::sigmoidf_fast(cv[j]) * vv[k][j];
            v2u w; w.x = pk2(o[0], o[1]); w.y = pk2(o[2], o[3]);
            *(v2u*)(u + ((size_t)blkv[k] * 128 + rhov[k]) * DFF + colv[k]) = w; }
    }
}

__device__ __forceinline__ void out_phase(Frame& F) {
    const bf16* h = (const bf16*)(F.ws + WS_XN); const float* gf = inp(F, I_NORM_FINAL); float* out = (float*)inp(F, I_OUT);
    const int gw = F.bid * NWAVES + F.wave, NGW = F.G * NWAVES;
    f32x4 gv[8];
#pragma unroll
    for (int j = 0; j < 8; ++j) gv[j] = *((const f32x4*)gf + 64 * j + F.lane);
    for (int row = gw; row < MTOK; row += NGW) { const v2u* xr = (const v2u*)(h + (size_t)row * DM) + F.lane; f32x4 xv[8]; float ss = 0.f;
#pragma unroll
        for (int j = 0; j < 8; ++j) { const v2u a = xr[64 * j]; xv[j] = (f32x4){pg8::bf_lo(a.x), pg8::bf_hi(a.x), pg8::bf_lo(a.y), pg8::bf_hi(a.y)}; ss += (xv[j].x * xv[j].x + xv[j].y * xv[j].y) + (xv[j].z * xv[j].z + xv[j].w * xv[j].w); }
        const float rs = 1.0f / sqrtf(wave_sum(ss) * (1.0f / DM) + EPS); f32x4* o = (f32x4*)(out + (size_t)row * DM) + F.lane;
#pragma unroll
        for (int j = 0; j < 8; ++j) o[64 * j] = xv[j] * rs * gv[j]; }
}

__device__ __forceinline__ int nrep_opaque(int n) { asm volatile("" : "+s"(n)); return n; }
struct Args { const float* in[16]; float* out; unsigned char* ws; int ph_lo, ph_hi, li, pad; };
__global__ void __launch_bounds__(NWAVES * 64, 2) fwd(Args args) {
    extern __shared__ __attribute__((aligned(16))) unsigned char lds[];
    Frame F;
    F.lds = (LAS unsigned char*)lds; F.ldsg = lds;
    F.tid = threadIdx.x; F.lane = F.tid & 63; F.wave = __builtin_amdgcn_readfirstlane(F.tid >> 6);
    F.G = gridDim.x; F.bid = blockIdx.x; F.vcu = (F.G % 8 == 0) ? (F.bid % 8) * (F.G / 8) + F.bid / 8 : F.bid;
    F.ws = args.ws; F.tp = 0ull; F.tp0 = 0ull;
    volatile LAS unsigned* MISC = (volatile LAS unsigned*)(F.lds + MISC_OFF);
    for (int u = F.tid; u < 64; u += NWAVES * 64) MISC[u] = 0u;
    if (F.tid < I_NPTR) { const unsigned long long p = (F.tid == I_OUT) ? (unsigned long long)args.out : (unsigned long long)args.in[F.tid & 15];
        ((LAS unsigned*)(F.lds + PTAB_OFF))[2 * F.tid] = (unsigned)p; ((LAS unsigned*)(F.lds + PTAB_OFF))[2 * F.tid + 1] = (unsigned)(p >> 32); }
    __syncthreads();
    gu32* ctl = (gu32*)(F.ws + WS_CTL);
    XcdBarrier bar = xcd_barrier_post((unsigned*)(ctl + CW_BAR) + args.li * XCD_BAR_WORDS, MISC + 8);
    const int lo = args.ph_lo, hi = args.ph_hi;
#ifndef PH_MASK
#define PH_MASK 0xFFFF
#endif
#define EN(j) ((PH_MASK >> (j)) & 1)
#ifndef PROBE_REP
#define PROBE_REP 0
#endif
#define NREP(j) nrep_opaque(1 + ((PROBE_REP >> (j)) & 1))
#define IN(k) (lo <= (k) && (k) < hi)
#define LAUNDER() do { unsigned long long z_ = 0ull; asm volatile("" : "+s"(z_), "+s"(F.vcu), "+s"(F.bid), "+s"(F.G)); F.ws = args.ws + z_; F.tid = threadIdx.x; asm volatile("" : "+v"(F.tid)); F.lane = F.tid & 63; } while (0)
#define SEAM(k) do { if (IN(k) && IN((k) + 1)) xcd_barrier(bar); } while (0)
#ifndef TP_MASK
#define TP_MASK 0
#endif
#ifndef TP_MULT
#define TP_MULT 4
#endif
    unsigned long long tp_acc = 0ull, tp0_ = 0ull; (void)tp0_;
#define TP_B(j) do { if ((TP_MASK >> (j)) & 1) tp0_ = __builtin_amdgcn_s_memrealtime(); } while (0)
#define TP_E(j) do { if ((TP_MASK >> (j)) & 1) tp_acc += __builtin_amdgcn_s_memrealtime() - tp0_; } while (0)
    if (EN(12) && IN(0)) { TP_B(12); for (int rep_ = 0; rep_ < NREP(12); ++rep_) { LAUNDER(); p0_prologue(F); } SEAM(0); TP_E(12); }
    for (int l = 0; l < DEPTH; ++l) {
        const int pb = 1 + l * NPH_L;
        bf16* XN = (bf16*)(F.ws + WS_XN);
        if (EN(0) && IN(pb + 0)) { TP_B(0); for (int rep_ = 0; rep_ < NREP(0); ++rep_) { LAUNDER();
            pg8::Gemm g{XN, (const bf16*)(F.ws + WS_WIN + (size_t)l * SZ_WIN), MTOK, NING, DM, nullptr, nullptr}; pg8::StaticOrder S; S.init(MTOK, NING, F.G, F.bid);
            pg8::EpiInProj E{(bf16*)(F.ws + WS_MQ), (bf16*)(F.ws + WS_MK), (bf16*)(F.ws + WS_MV), (bf16*)(F.ws + WS_SMO), (bf16*)(F.ws + WS_AQ), (bf16*)(F.ws + WS_AK), (bf16*)(F.ws + WS_AV), (bf16*)(F.ws + WS_SG),
                             (const float*)(F.ws + WS_BIASG) + (size_t)l * NING, (const float*)(F.ws + WS_ROPE), (const pg8::u64_t*)(F.ws + WS_ROWSS_B)};
            pg8::gemm_phase<pg8::EpiInProj, pg8::StaticOrder, true, true>(F.lds, g, S, E, F.tid);
            } SEAM(pb + 0); TP_E(0); }
        if (EN(1) && IN(pb + 1)) { TP_B(1); for (int rep_ = 0; rep_ < NREP(1); ++rep_) { LAUNDER(); mix_phase(F, l, rep_);
            LAUNDER(); wait_word_ge(F, (gu32*)(F.ws + WS_CTL) + CW_ADONE + 64 * (l + 4 * rep_), (unsigned)F.G); fin_phase(F, l); } SEAM(pb + 1); TP_E(1); }
        if (EN(3) && IN(pb + 3)) { TP_B(3); for (int rep_ = 0; rep_ < NREP(3); ++rep_) { LAUNDER();
            pg8::Gemm g{(const bf16*)(F.ws + WS_HMN), (const bf16*)(F.ws + WS_WBM + (size_t)l * SZ_WSQ), MTOK, DM, DM, (const bf16*)(F.ws + WS_HAN), (const bf16*)(F.ws + WS_WBD + (size_t)l * SZ_WSQ)};
            pg8::PairOrder S; S.init(MTOK, DM, F.G, F.bid);
            pg8::EpiMerge E{(bf16*)(F.ws + WS_Y), (const bf16*)(F.ws + WS_SG)};
            pg8::gemm_phase<pg8::EpiMerge, pg8::PairOrder, true, true>(F.lds, g, S, E, F.tid);
            } SEAM(pb + 3); TP_E(3); }
        if (EN(4) && IN(pb + 4)) { TP_B(4); for (int rep_ = 0; rep_ < NREP(4); ++rep_) { LAUNDER();
            pg8::Gemm g{(const bf16*)(F.ws + WS_Y), (const bf16*)(F.ws + WS_WO + (size_t)l * SZ_WSQ), MTOK, DM, DM, nullptr, nullptr}; pg8::StaticOrder S; S.init(MTOK, DM, F.G, F.bid);
            if (rep_ == 0) { pg8::EpiRes<true> E{XN, DM, (pg8::u64_t*)(F.ws + WS_ROWSS)};
            pg8::gemm_phase<pg8::EpiRes<true>, pg8::StaticOrder, false, true>(F.lds, g, S, E, F.tid); }
            else { pg8::EpiRes<false> E{(bf16*)(F.ws + WS_P), DM, nullptr};
            pg8::gemm_phase<pg8::EpiRes<false>, pg8::StaticOrder, false, true>(F.lds, g, S, E, F.tid); }
            } SEAM(pb + 4); TP_E(4); }
        if (EN(5) && IN(pb + 5)) { TP_B(5); for (int rep_ = 0; rep_ < NREP(5); ++rep_) { LAUNDER();
            pg8::Gemm g{XN, (const bf16*)(F.ws + WS_WUP + (size_t)l * SZ_WUP), MTOK, NUP, DM, nullptr, nullptr}; pg8::StaticOrder S; S.init(MTOK, NUP, F.G, F.bid);
            pg8::EpiUpConv E{(bf16*)(F.ws + WS_U), DFF, (const pg8::u64_t*)(F.ws + WS_ROWSS), inp(F, I_CONV_W) + (size_t)l * 3 * DFF, inp(F, I_CONV_B) + (size_t)l * DFF,
                             (float*)(F.ws + WS_FXC), (float*)(F.ws + WS_FXV), (float*)(F.ws + WS_FXG)};
            pg8::gemm_phase<pg8::EpiUpConv, pg8::StaticOrder, true, true, true>(F.lds, g, S, E, F.tid);
            { const int idle = tail_idle(F.G);
              if (idle && l + 1 < DEPTH && rep_ == 0 && F.bid >= F.G - idle) { VM_WAIT(); __syncthreads();
                  cvt_run(F, (l + 1) * IT_LAYER + IT_A, IT_LAYER - IT_A, (F.bid - (F.G - idle)) * NWAVES + F.wave, idle * NWAVES); VM_WAIT(); } }
            } SEAM(pb + 5); TP_E(5); }
        if (EN(6) && IN(pb + 6)) { TP_B(6); for (int rep_ = 0; rep_ < NREP(6); ++rep_) { LAUNDER();
            pg8::Gemm g{(const bf16*)(F.ws + WS_U), (const bf16*)(F.ws + WS_WDN + (size_t)l * SZ_WDN), MTOK, DM, DFF, nullptr, nullptr}; pg8::StaticOrder S; S.init(MTOK, DM, F.G, F.bid);
            { pg8::Unit fu; for (int i = 0; S.next(i, fu); ++i) conv_fixup_panel(F, l, fu.pm); VM_WAIT(); __syncthreads(); }
            if (rep_ == 0) { pg8::EpiRes<true> E{XN, DM, (pg8::u64_t*)(F.ws + WS_ROWSS_B)};
            pg8::gemm_phase<pg8::EpiRes<true>, pg8::StaticOrder, false, true>(F.lds, g, S, E, F.tid); }
            else { pg8::EpiRes<false> E{(bf16*)(F.ws + WS_P), DM, nullptr};
            pg8::gemm_phase<pg8::EpiRes<false>, pg8::StaticOrder, false, true>(F.lds, g, S, E, F.tid); }
            } SEAM(pb + 6); TP_E(6); }
    }
    if (EN(11) && IN(NPHASE - 1)) { TP_B(11); LAUNDER(); out_phase(F); TP_E(11); }
    if (TPS && F.bid == TPS_WG) { const unsigned long long tgt = __builtin_amdgcn_s_memrealtime() + TP_MULT * F.tp; while (__builtin_amdgcn_s_memrealtime() < tgt) __builtin_amdgcn_s_sleep(8); }
    if (TP_MASK && F.bid == 0) { const unsigned long long tgt = __builtin_amdgcn_s_memrealtime() + TP_MULT * tp_acc; while (__builtin_amdgcn_s_memrealtime() < tgt) __builtin_amdgcn_s_sleep(8); }
#undef IN
#undef SEAM
}

extern "C" void kernel_launch(void* const* d_in, const int* in_sizes, int n_in, void* d_out, int out_size, void* d_ws, size_t ws_size, hipStream_t stream) {
    static int grid = 0;
    if (grid == 0) {
        if (n_in != 16 || in_sizes[0] != MTOK * DM || out_size != MTOK * DM || ws_size < WS_END) {
            fprintf(stderr, "kernel_launch: unexpected shapes (n_in %d, in0 %d, out %d, ws %zu, need %zu)\n", n_in, n_in > 0 ? in_sizes[0] : -1, out_size, ws_size, (size_t)WS_END); grid = -1; return; }
        int dev = 0, cus = 0, per_cu = 0;
        if (hipGetDevice(&dev) != hipSuccess || hipDeviceGetAttribute(&cus, hipDeviceAttributeMultiprocessorCount, dev) != hipSuccess) { grid = -1; return; }
        if (hipFuncSetAttribute((const void*)fwd, hipFuncAttributeMaxDynamicSharedMemorySize, LDS_BYTES) != hipSuccess) { fprintf(stderr, "kernel_launch: hipFuncSetAttribute failed\n"); grid = -1; return; }
        if (hipOccupancyMaxActiveBlocksPerMultiprocessor(&per_cu, (const void*)fwd, NWAVES * 64, LDS_BYTES) != hipSuccess || per_cu < 1)
            fprintf(stderr, "kernel_launch: note: occupancy query reports %d workgroups per CU\n", per_cu);
        (void)hipGetLastError();
        grid = cus;
    }
    if (grid < 0) return;
    if (hipMemsetAsync((char*)d_ws + WS_CTL, 0, CTL_ZERO_BYTES, stream) != hipSuccess) return;
    Args a{};
    for (int i = 0; i < 16; ++i) a.in[i] = (const float*)d_in[i];
    a.out = (float*)d_out; a.ws = (unsigned char*)d_ws;
#if MK_SPLIT
    for (int p = 0; p < NPHASE; ++p) { a.ph_lo = p; a.ph_hi = p + 1; a.li = p; hipLaunchKernelGGL(fwd, dim3(grid), dim3(NWAVES * 64), LDS_BYTES, stream, a); }
#else
    a.ph_lo = 0; a.ph_hi = NPHASE; a.li = 0;
    hipLaunchKernelGGL(fwd, dim3(grid), dim3(NWAVES * 64), LDS_BYTES, stream, a);
#endif
    const hipError_t le = hipPeekAtLastError();
    if (le != hipSuccess) fprintf(stderr, "kernel_launch: launch failed: %s\n", hipGetErrorName(le));
}
```

```cpp
#include <hip/hip_runtime.h>
#include <cstdio>
#include <cstdint>

#ifndef MK_SPLIT
#define MK_SPLIT 0
#define TP_MASK 0x0
#define TPS 0
#define TPS_WG 0
#endif

namespace pg8 {
#define PG8_LAS __attribute__((address_space(3)))
typedef unsigned short bf16_t;
typedef short bf16x8 __attribute__((ext_vector_type(8)));
typedef float f32x4 __attribute__((ext_vector_type(4)));
typedef float f32x2 __attribute__((ext_vector_type(2)));
typedef unsigned u32x4 __attribute__((ext_vector_type(4)));
typedef unsigned u32x2 __attribute__((ext_vector_type(2)));
constexpr int BM = 256, BK = 64, HALF = 128, HTB = HALF * BK * 2, STAGE_BYTES = 8 * HTB, NXCD = 8, WGM = 8;

__host__ __device__ __forceinline__ int lds_byte(int r, int c) { const int st = (r >> 4) * 2 + (c >> 5), rr = r & 15, cc = c & 31, ob = rr * 64 + cc * 2; return st * 1024 + (ob ^ (((ob >> 9) & 1) << 5)); }
__host__ __device__ __forceinline__ void stage_rc(int b, int& R, int& C) { const int st = b / 1024, sb = b % 1024, swz = sb ^ (((sb >> 9) & 1) << 5); R = (st >> 1) * 16 + swz / 64; C = (st & 1) * 32 + (swz % 64) / 2; }
__host__ __device__ __forceinline__ int perm32(int rho) { const int n = rho >> 4, i = rho & 15; return 8 * (i >> 2) + 4 * n + (i & 3); }

struct Unit { int pm, pn, sel; };
struct Gemm { const bf16_t* A; const bf16_t* Bt; int M, N, K; const bf16_t* A1; const bf16_t* Bt1; };

struct StaticOrder {
    int nM, nN, nwg, G, c;
    __host__ __device__ __forceinline__ void init(int M, int N, int G_, int c_) { nM = M / BM; nN = N / BM; nwg = nM * nN; G = G_; c = c_; }
    __host__ __device__ __forceinline__ bool next(int i, Unit& u) const {
        const long L = (long)i * G + c; if (L >= nwg) return false;
        int wgid = (int)L; { const int q = nwg / NXCD, r = nwg % NXCD, xcd = wgid % NXCD, off = wgid / NXCD; wgid = (xcd < r ? xcd * (q + 1) : r * (q + 1) + (xcd - r) * q) + off; }
        const int nig = WGM * nN, gid = wgid / nig, fm = gid * WGM, gsz = (nM - fm) < WGM ? (nM - fm) : WGM;
        u.pm = fm + ((wgid % nig) % gsz); u.pn = (wgid % nig) / gsz; u.sel = 0; return true;
    }
    __device__ __forceinline__ void a_ready(const Unit&) const {}
    __device__ __forceinline__ void done(const Unit&) const {}
};
struct PairOrder : StaticOrder {
    __host__ __device__ __forceinline__ bool next(int i, Unit& u) const { if (!StaticOrder::next(i >> 1, u)) return false; u.sel = i & 1; return true; }
};

__device__ __forceinline__ unsigned cvt_pk_bf16(float lo, float hi) { unsigned r; asm volatile("v_cvt_pk_bf16_f32 %0, %1, %2" : "=v"(r) : "v"(lo), "v"(hi)); return r; }
__device__ __forceinline__ float bf_lo(unsigned w) { return __uint_as_float(w << 16); }
__device__ __forceinline__ float bf_hi(unsigned w) { return __uint_as_float(w & 0xffff0000u); }
__device__ __forceinline__ float sigmoidf_fast(float x) { return __builtin_amdgcn_rcpf(1.0f + __builtin_amdgcn_exp2f(-1.4426950408889634f * x)); }
typedef unsigned long long u64_t;
__device__ __forceinline__ u64_t ss_fix(float ss) { const double d = (double)ss * 16777216.0; const unsigned hi = (unsigned)(d * (1.0 / 4294967296.0)); const unsigned lo = (unsigned)__builtin_fma(-(double)hi, 4294967296.0, d); return ((u64_t)hi << 32) | lo; }
__device__ __forceinline__ float ss_f32(u64_t v) { return (float)(__builtin_fma((double)(unsigned)(v >> 32), 4294967296.0, (double)(unsigned)v) * (1.0 / 16777216.0)); }

struct EpiInProj {
    static constexpr bool PERM = true, AFTER_DRAIN = false, CHAIN = false;
    bf16_t *mq, *mk, *mv, *smo, *aq, *ak, *av, *sg; const float* bias; const float* rope; const u64_t* rowss;
    __device__ __forceinline__ void operator()(const f32x4 (&acc)[2][2][4][2], const Unit& u, int wr, int wc, int fr, int fq) const {
        const int pn = u.pn; bf16_t* base; int ldc, colt, kind = 0; float sc = 1.f;
        if (pn < 4) { base = mq; ldc = 1024; colt = pn * 256; }
        else if (pn < 8) { base = mk; ldc = 1024; colt = (pn - 4) * 256; sc = 0.08838834764831845f; }
        else if (pn < 16) { base = mv; ldc = 2048; colt = (pn - 8) * 256; }
        else if (pn < 24) { base = smo; ldc = 2048; colt = (pn - 16) * 256; kind = 2; }
        else if (pn < 32) { base = aq; ldc = 2048; colt = (pn - 24) * 256; kind = 1; }
        else if (pn < 40) { base = ak; ldc = 2048; colt = (pn - 32) * 256; kind = 1; }
        else if (pn < 48) { base = av; ldc = 2048; colt = (pn - 40) * 256; }
        else { base = sg; ldc = 4096; colt = (pn - 48) * 256; kind = 2; }
        const int row0 = u.pm * BM + wr * 64 + fr, col0 = colt + wc * 32 + 8 * fq, bcol0 = pn * BM + wc * 32 + 8 * fq;
        f32x4 bv[2][2];
#pragma unroll
        for (int bj = 0; bj < 2; ++bj)
#pragma unroll
            for (int n = 0; n < 2; ++n) bv[bj][n] = *(const f32x4*)(bias + bcol0 + bj * HALF + 4 * n);
        const bool dorope = (kind == 1) && (wc == 0);
        u64_t rsu[2][4]; float rsv[2][4];
#pragma unroll
        for (int ai = 0; ai < 2; ++ai)
#pragma unroll
            for (int m = 0; m < 4; ++m) rsu[ai][m] = rowss[row0 + ai * HALF + m * 16];
#pragma unroll
        for (int ai = 0; ai < 2; ++ai)
#pragma unroll
            for (int m = 0; m < 4; ++m) rsv[ai][m] = ss_f32(rsu[ai][m]);
#pragma unroll
        for (int ai = 0; ai < 2; ++ai) {
            f32x4 cvv[4], svv[4];
#pragma unroll
            for (int m = 0; m < 4; ++m) { cvv[m] = (f32x4){1.f, 1.f, 1.f, 1.f}; svv[m] = (f32x4){0.f, 0.f, 0.f, 0.f}; }
            if (dorope) {
#pragma unroll
                for (int m = 0; m < 4; ++m) { const float* cs = rope + (size_t)((row0 + ai * HALF + m * 16) & 2047) * 32 + 4 * fq; cvv[m] = *(const f32x4*)cs; svv[m] = *(const f32x4*)(cs + 16); } }
#pragma unroll
            for (int m = 0; m < 4; ++m) { const int row = row0 + ai * HALF + m * 16; bf16_t* rowp = base + (size_t)row * ldc + col0;
                const float rs = 1.0f / sqrtf(rsv[ai][m] * (1.0f / 2048.0f) + 1e-6f);
                const f32x4 cv = cvv[m], sv = svv[m];
#pragma unroll
                for (int bj = 0; bj < 2; ++bj) { f32x4 v0 = (acc[ai][bj][m][0] * rs + bv[bj][0]) * sc, v1 = (acc[ai][bj][m][1] * rs + bv[bj][1]) * sc;
                    if (dorope) { f32x4 r0, r1;
                        r0[0] = v0[0] * cv[0] - v0[1] * sv[0]; r0[1] = v0[1] * cv[0] + v0[0] * sv[0]; r0[2] = v0[2] * cv[1] - v0[3] * sv[1]; r0[3] = v0[3] * cv[1] + v0[2] * sv[1];
                        r1[0] = v1[0] * cv[2] - v1[1] * sv[2]; r1[1] = v1[1] * cv[2] + v1[0] * sv[2]; r1[2] = v1[2] * cv[3] - v1[3] * sv[3]; r1[3] = v1[3] * cv[3] + v1[2] * sv[3];
                        v0 = r0; v1 = r1; }
                    if (kind == 2) {
#pragma unroll
                        for (int j = 0; j < 4; ++j) { v0[j] = sigmoidf_fast(v0[j]); v1[j] = sigmoidf_fast(v1[j]); } }
                    u32x4 w; w.x = cvt_pk_bf16(v0[0], v0[1]); w.y = cvt_pk_bf16(v0[2], v0[3]); w.z = cvt_pk_bf16(v1[0], v1[1]); w.w = cvt_pk_bf16(v1[2], v1[3]);
                    *(u32x4*)(rowp + bj * HALF) = w; } } }
    }
};
template <int CTRL> __device__ __forceinline__ f32x4 dpp4(const f32x4 v) { f32x4 r;
#pragma unroll
    for (int j = 0; j < 4; ++j) r[j] = __uint_as_float(__builtin_amdgcn_update_dpp(0u, __float_as_uint(v[j]), CTRL, 0xf, 0xf, false));
    return r; }
struct EpiUpConv {
    static constexpr bool PERM = true, AFTER_DRAIN = false, CHAIN = false;
    bf16_t* u; int ldc; const u64_t* rowss; const float* cw; const float* cb; float *fxc, *fxv, *fxg;
    __device__ __forceinline__ void operator()(const f32x4 (&acc)[2][2][4][2], const Unit& un, int wr, int wc, int fr, int fq) const {
        const int col0 = un.pn * HALF + wc * 32 + 8 * fq, blk = un.pm * 2 + wr, rowb = blk * 128 + fr;
        f32x4 w0[2], w1[2], w2[2], bb[2];
#pragma unroll
        for (int n = 0; n < 2; ++n) { w0[n] = *(const f32x4*)(cw + col0 + 4 * n); w1[n] = *(const f32x4*)(cw + ldc + col0 + 4 * n); w2[n] = *(const f32x4*)(cw + 2 * ldc + col0 + 4 * n); bb[n] = *(const f32x4*)(cb + col0 + 4 * n); }
        f32x4 p1[2], p2[2];
        p1[0] = p1[1] = p2[0] = p2[1] = (f32x4){0.f, 0.f, 0.f, 0.f};
        u64_t rsu[8]; float rsv[8];
#pragma unroll
        for (int q = 0; q < 8; ++q) rsu[q] = rowss[rowb + 16 * q];
#pragma unroll
        for (int q = 0; q < 8; ++q) rsv[q] = ss_f32(rsu[q]);
#pragma unroll
        for (int q = 0; q < 8; ++q) { const int ai = q >> 2, m = q & 3, row = rowb + 16 * q;
            const float rs = 1.0f / sqrtf(rsv[q] * (1.0f / 2048.0f) + 1e-6f);
            u32x4 w;
#pragma unroll
            for (int n = 0; n < 2; ++n) { const f32x4 g = acc[ai][0][m][n] * rs, v = acc[ai][1][m][n] * rs;
                const f32x4 r1 = dpp4<0x121>(g), r2 = dpp4<0x122>(g);
                f32x4 g1, g2;
#pragma unroll
                for (int j = 0; j < 4; ++j) { g1[j] = fr >= 1 ? r1[j] : p1[n][j]; g2[j] = fr >= 2 ? r2[j] : p2[n][j]; }
                p1[n] = r1; p2[n] = r2;
                const f32x4 cv = w0[n] * g2 + w1[n] * g1 + w2[n] * g + bb[n];
                f32x4 o;
#pragma unroll
                for (int j = 0; j < 4; ++j) o[j] = cv[j] * sigmoidf_fast(cv[j]) * v[j];
                if (n == 0) { w.x = cvt_pk_bf16(o[0], o[1]); w.y = cvt_pk_bf16(o[2], o[3]); } else { w.z = cvt_pk_bf16(o[0], o[1]); w.w = cvt_pk_bf16(o[2], o[3]); }
                if (q == 0 && fr < 2) { *(f32x4*)(fxc + ((size_t)blk * 2 + fr) * ldc + col0 + 4 * n) = cv; *(f32x4*)(fxv + ((size_t)blk * 2 + fr) * ldc + col0 + 4 * n) = v; }
                if (q == 7 && fr >= 14) *(f32x4*)(fxg + ((size_t)blk * 2 + (fr - 14)) * ldc + col0 + 4 * n) = g; }
            *(u32x4*)(u + (size_t)row * ldc + col0) = w; }
    }
};
struct EpiMerge {
    static constexpr bool PERM = false, AFTER_DRAIN = false, CHAIN = true;
    bf16_t* y; const bf16_t* sg;
    __device__ __forceinline__ void mid(f32x4 (&acc)[2][2][4][2], const Unit& u, int wr, int wc, int fr, int fq) const {
        const int row0 = u.pm * BM + wr * 64 + fr, col0 = u.pn * BM + wc * 32 + 4 * fq;
#pragma unroll
        for (int ai = 0; ai < 2; ++ai)
#pragma unroll
            for (int m = 0; m < 4; ++m) { const int row = row0 + ai * HALF + m * 16;
                u32x2 gm[2][2], gd[2][2];
#pragma unroll
                for (int bj = 0; bj < 2; ++bj)
#pragma unroll
                    for (int n = 0; n < 2; ++n) { const int col = col0 + bj * HALF + n * 16; gm[bj][n] = *(const u32x2*)(sg + (size_t)row * 4096 + col); gd[bj][n] = *(const u32x2*)(sg + (size_t)row * 4096 + 2048 + col); }
#pragma unroll
                for (int bj = 0; bj < 2; ++bj)
#pragma unroll
                    for (int n = 0; n < 2; ++n) { const u32x2 a = gm[bj][n], d = gd[bj][n];
                        const f32x4 num = (f32x4){bf_lo(a.x), bf_hi(a.x), bf_lo(a.y), bf_hi(a.y)}, den = (f32x4){bf_lo(d.x), bf_hi(d.x), bf_lo(d.y), bf_hi(d.y)};
#pragma unroll
                        for (int j = 0; j < 4; ++j) acc[ai][bj][m][n][j] *= num[j] * __builtin_amdgcn_rcpf(fmaxf(den[j], 1e-30f)); } }
    }
    __device__ __forceinline__ void operator()(const f32x4 (&acc)[2][2][4][2], const Unit& u, int wr, int wc, int fr, int fq) const {
        const int row0 = u.pm * BM + wr * 64 + fr, col0 = u.pn * BM + wc * 32 + 4 * fq;
#pragma unroll
        for (int ai = 0; ai < 2; ++ai)
#pragma unroll
            for (int mp = 0; mp < 2; ++mp) {
                u32x2 gw[2][2][2];
#pragma unroll
                for (int mm = 0; mm < 2; ++mm)
#pragma unroll
                    for (int bj = 0; bj < 2; ++bj)
#pragma unroll
                        for (int n = 0; n < 2; ++n) gw[mm][bj][n] = *(const u32x2*)(sg + (size_t)(row0 + ai * HALF + (2 * mp + mm) * 16) * 4096 + 2048 + col0 + bj * HALF + n * 16);
#pragma unroll
                for (int mm = 0; mm < 2; ++mm)
#pragma unroll
                    for (int bj = 0; bj < 2; ++bj)
#pragma unroll
                        for (int n = 0; n < 2; ++n) { const int m = 2 * mp + mm, row = row0 + ai * HALF + m * 16, col = col0 + bj * HALF + n * 16;
                            const u32x2 g2 = gw[mm][bj][n]; f32x4 g = (f32x4){bf_lo(g2.x), bf_hi(g2.x), bf_lo(g2.y), bf_hi(g2.y)};
#pragma unroll
                            for (int j = 0; j < 4; ++j) g[j] = fmaxf(g[j], 1e-30f);
                            const f32x4 v = acc[ai][bj][m][n] * g;
                            u32x2 w; w.x = cvt_pk_bf16(v[0], v[1]); w.y = cvt_pk_bf16(v[2], v[3]); *(u32x2*)(y + (size_t)row * 2048 + col) = w; }
                asm volatile("" ::: "memory"); }
    }
};
template <bool STATS> struct EpiRes {
    static constexpr bool PERM = true, AFTER_DRAIN = false, CHAIN = false;
    bf16_t* hb; int ldc; u64_t* rowss;
    __device__ __forceinline__ void operator()(const f32x4 (&acc)[2][2][4][2], const Unit& u, int wr, int wc, int fr, int fq) const {
        const int row0 = u.pm * BM + wr * 64 + fr, col0 = u.pn * BM + wc * 32 + 8 * fq;
#pragma unroll
        for (int ai = 0; ai < 2; ++ai) {
            u32x4 hv[4][2];
#pragma unroll
            for (int m = 0; m < 4; ++m)
#pragma unroll
                for (int bj = 0; bj < 2; ++bj) hv[m][bj] = *(const u32x4*)(hb + (size_t)(row0 + ai * HALF + m * 16) * ldc + col0 + bj * HALF);
#pragma unroll
            for (int m = 0; m < 4; ++m) { const int row = row0 + ai * HALF + m * 16; float ss = 0.f;
#pragma unroll
                for (int bj = 0; bj < 2; ++bj) { const u32x4 x = hv[m][bj]; const f32x4 a0 = acc[ai][bj][m][0], a1 = acc[ai][bj][m][1]; u32x4 w;
                    w.x = cvt_pk_bf16(bf_lo(x.x) + a0[0], bf_hi(x.x) + a0[1]); w.y = cvt_pk_bf16(bf_lo(x.y) + a0[2], bf_hi(x.y) + a0[3]);
                    w.z = cvt_pk_bf16(bf_lo(x.z) + a1[0], bf_hi(x.z) + a1[1]); w.w = cvt_pk_bf16(bf_lo(x.w) + a1[2], bf_hi(x.w) + a1[3]);
                    *(u32x4*)(hb + (size_t)row * ldc + col0 + bj * HALF) = w;
                    if (STATS) { ss += (bf_lo(w.x) * bf_lo(w.x) + bf_hi(w.x) * bf_hi(w.x)) + (bf_lo(w.y) * bf_lo(w.y) + bf_hi(w.y) * bf_hi(w.y));
                                 ss += (bf_lo(w.z) * bf_lo(w.z) + bf_hi(w.z) * bf_hi(w.z)) + (bf_lo(w.w) * bf_lo(w.w) + bf_hi(w.w) * bf_hi(w.w)); } }
                if (STATS) {
                    { auto rr = __builtin_amdgcn_permlane16_swap(__float_as_uint(ss), __float_as_uint(ss), false, false); ss = __uint_as_float(rr[0]) + __uint_as_float(rr[1]); }
                    { auto rr = __builtin_amdgcn_permlane32_swap(__float_as_uint(ss), __float_as_uint(ss), false, false); ss = __uint_as_float(rr[0]) + __uint_as_float(rr[1]); }
                    if (fq == 0) __hip_atomic_fetch_add(rowss + row, ss_fix(ss), __ATOMIC_RELAXED, __HIP_MEMORY_SCOPE_AGENT); } }
            asm volatile("" ::: "memory"); }
    }
};

template <class Epi, class Sched, bool ALIGN_EPI = false, bool SP2 = false, bool APERM = false>
__device__ __forceinline__ void gemm_phase(PG8_LAS unsigned char* lds, const Gemm g, const Sched& S, const Epi& E, const int tid) {
    const int wid = __builtin_amdgcn_readfirstlane(tid >> 6), lane = tid & 63, wr = wid >> 2, wc = wid & 3, fr = lane & 15, fq = lane >> 4;
    const int K = g.K, nt = K / BK;
    unsigned voffA[2], voffB[2];
#pragma unroll
    for (int i = 0; i < 2; ++i) { int R, C; stage_rc(tid * 16 + i * 8192, R, C); const int Rb = Epi::PERM ? ((R & ~31) + perm32(R & 31)) : R;
        const int Ra = APERM ? ((R >> 6) * 128 + (R & 63)) : R;
        voffA[i] = (unsigned)(Ra * K + C) * 2u; voffB[i] = (unsigned)(Rb * K + C) * 2u; }
    const size_t kstep = (size_t)(BK * 2);
    const size_t hstep = (size_t)HALF * K * 2;
    const size_t hstepA = APERM ? (size_t)64 * K * 2 : hstep;
    const size_t tstep = 2 * hstep;
    const unsigned ldsw = (unsigned)wid * 1024u;
    const int aoff = lds_byte(wr * 64 + fr, fq * 8), boff = lds_byte(wc * 32 + fr, fq * 8);
#define PG8_SA(b, h) (((b) * 2 + (h)) * HTB)
#define PG8_SB(b, h) ((4 + (b) * 2 + (h)) * HTB)
#define PG8_STAGE(bufoff, gbase, voff) do { _Pragma("unroll") for (int _i = 0; _i < 2; ++_i) \
        __builtin_amdgcn_global_load_lds((const unsigned*)((const char*)(gbase) + (voff)[_i]), (PG8_LAS unsigned*)(lds + (bufoff) + ldsw + _i * 8192), 16, 0, 0); } while (0)
#define PG8_LDA(dst, b, h) do { _Pragma("unroll") for (int m = 0; m < 4; ++m) _Pragma("unroll") for (int k = 0; k < 2; ++k) dst[m][k] = *(const PG8_LAS bf16x8*)(lds + PG8_SA(b, h) + aoff + m * 2048 + k * 1024); } while (0)
#define PG8_LDB(dst, b, h) do { _Pragma("unroll") for (int n = 0; n < 2; ++n) _Pragma("unroll") for (int k = 0; k < 2; ++k) dst[n][k] = *(const PG8_LAS bf16x8*)(lds + PG8_SB(b, h) + boff + n * 2048 + k * 1024); } while (0)
#define PG8_MMA(ai, bj, At, Bt) do { __builtin_amdgcn_s_setprio(1); _Pragma("unroll") for (int m = 0; m < 4; ++m) _Pragma("unroll") for (int n = 0; n < 2; ++n) _Pragma("unroll") for (int k = 0; k < 2; ++k) \
        acc[ai][bj][m][n] = __builtin_amdgcn_mfma_f32_16x16x32_bf16(Bt[n][k], At[m][k], acc[ai][bj][m][n], 0, 0, 0); __builtin_amdgcn_s_setprio(0); } while (0)
#define PG8_WAIT_V(n) asm volatile("s_waitcnt vmcnt(" #n ")" ::: "memory")
#define PG8_WAIT_L(n) asm volatile("s_waitcnt lgkmcnt(" #n ")" ::: "memory")
#define PG8_BAR __builtin_amdgcn_s_barrier()
#define PG8_SCHED __builtin_amdgcn_sched_barrier(0)
    Unit cur, nxt; int ui = 0;
    if (!S.next(0, cur)) return;
    f32x4 acc[2][2][4][2];
#pragma unroll
    for (int a = 0; a < 2; ++a)
#pragma unroll
        for (int b = 0; b < 2; ++b)
#pragma unroll
            for (int m = 0; m < 4; ++m)
#pragma unroll
                for (int n = 0; n < 2; ++n) acc[a][b][m][n] = (f32x4){0.f, 0.f, 0.f, 0.f};
    bf16x8 At[4][2], B0[2][2], B1[2][2];
    const char* cA = (const char*)(cur.sel ? g.A1 : g.A) + (size_t)cur.pm * tstep; const char* cB = (const char*)(cur.sel ? g.Bt1 : g.Bt) + (size_t)cur.pn * tstep;
    S.a_ready(cur);
    if constexpr (SP2) {
        PG8_STAGE(PG8_SB(0, 0), cB, voffB); PG8_STAGE(PG8_SB(0, 1), cB + hstep, voffB); PG8_STAGE(PG8_SA(0, 0), cA, voffA); PG8_STAGE(PG8_SA(0, 1), cA + hstepA, voffA);
        if (wr == 1) PG8_BAR;
        PG8_WAIT_V(2); PG8_BAR;
        PG8_STAGE(PG8_SB(1, 0), cB + kstep, voffB); PG8_STAGE(PG8_SA(1, 0), cA + kstep, voffA); PG8_STAGE(PG8_SB(1, 1), cB + hstep + kstep, voffB);
        PG8_WAIT_V(6); PG8_BAR;
    } else {
        PG8_STAGE(PG8_SB(0, 0), cB, voffB); PG8_STAGE(PG8_SA(0, 0), cA, voffA); PG8_STAGE(PG8_SB(0, 1), cB + hstep, voffB); PG8_STAGE(PG8_SA(0, 1), cA + hstepA, voffA);
        if (wr == 1) PG8_BAR;
        PG8_WAIT_V(4); PG8_BAR;
        PG8_STAGE(PG8_SB(1, 0), cB + kstep, voffB); PG8_STAGE(PG8_SA(1, 0), cA + kstep, voffA); PG8_STAGE(PG8_SB(1, 1), cB + hstep + kstep, voffB);
        PG8_WAIT_V(6); PG8_BAR;
    }
    for (;;) {
        const bool has_next = S.next(ui + 1, nxt);
        const char* nA = has_next ? (const char*)(nxt.sel ? g.A1 : g.A) + (size_t)nxt.pm * tstep : cA; const char* nB = has_next ? (const char*)(nxt.sel ? g.Bt1 : g.Bt) + (size_t)nxt.pn * tstep : cB;
        for (int t = 0; t < nt; t += 2) {
            const bool last = (t == nt - 2);
            const char* a1 = cA + (size_t)(t + 1) * kstep;
            const char* a2 = last ? nA : cA + (size_t)(t + 2) * kstep; const char* b2 = last ? nB : cB + (size_t)(t + 2) * kstep;
            const char* a3 = a2 + kstep; const char* b3 = b2 + kstep;
            if (last && has_next) S.a_ready(nxt);
            if constexpr (SP2) {
            PG8_LDB(B0, 0, 0); PG8_LDB(B1, 0, 1); PG8_SCHED; PG8_LDA(At, 0, 0); PG8_STAGE(PG8_SA(1, 1), a1 + hstepA, voffA);
            PG8_WAIT_V(8); PG8_WAIT_L(0); PG8_BAR; PG8_MMA(0, 0, At, B0); PG8_MMA(0, 1, At, B1); PG8_BAR; PG8_SCHED;
            PG8_LDA(At, 0, 1); PG8_STAGE(PG8_SB(0, 0), b2, voffB); PG8_STAGE(PG8_SB(0, 1), b2 + hstep, voffB); PG8_STAGE(PG8_SA(0, 0), a2, voffA);
            PG8_WAIT_V(8); PG8_WAIT_L(0); PG8_BAR; PG8_MMA(1, 0, At, B0); PG8_MMA(1, 1, At, B1); PG8_BAR; PG8_SCHED;
            PG8_LDB(B0, 1, 0); PG8_LDB(B1, 1, 1); PG8_SCHED; PG8_LDA(At, 1, 0); PG8_STAGE(PG8_SA(0, 1), a2 + hstepA, voffA);
            PG8_WAIT_V(8); PG8_WAIT_L(0); PG8_BAR; PG8_MMA(0, 0, At, B0); PG8_MMA(0, 1, At, B1); PG8_BAR; PG8_SCHED;
            PG8_LDA(At, 1, 1); PG8_STAGE(PG8_SB(1, 0), b3, voffB); PG8_STAGE(PG8_SB(1, 1), b3 + hstep, voffB); PG8_STAGE(PG8_SA(1, 0), a3, voffA);
            PG8_WAIT_V(8); PG8_WAIT_L(0); PG8_BAR; PG8_MMA(1, 0, At, B0); PG8_MMA(1, 1, At, B1); PG8_BAR; PG8_SCHED;
            } else {
            PG8_LDB(B0, 0, 0); PG8_SCHED; PG8_LDA(At, 0, 0); PG8_STAGE(PG8_SA(1, 1), a1 + hstepA, voffA);
            PG8_WAIT_L(8); PG8_BAR; PG8_WAIT_L(0); PG8_MMA(0, 0, At, B0); PG8_BAR; PG8_SCHED;
            PG8_LDB(B1, 0, 1); PG8_STAGE(PG8_SB(0, 0), b2, voffB);
            PG8_BAR; PG8_WAIT_L(0); PG8_MMA(0, 1, At, B1); PG8_BAR;
            PG8_LDA(At, 0, 1); PG8_STAGE(PG8_SA(0, 0), a2, voffA);
            PG8_BAR; PG8_WAIT_L(0); PG8_MMA(1, 0, At, B0); PG8_BAR; PG8_SCHED;
            PG8_STAGE(PG8_SB(0, 1), b2 + hstep, voffB);
            PG8_WAIT_V(6); PG8_BAR; PG8_MMA(1, 1, At, B1); PG8_BAR;
            PG8_LDB(B0, 1, 0); PG8_SCHED; PG8_LDA(At, 1, 0); PG8_STAGE(PG8_SA(0, 1), a2 + hstepA, voffA);
            PG8_WAIT_L(8); PG8_BAR; PG8_WAIT_L(0); PG8_MMA(0, 0, At, B0); PG8_BAR; PG8_SCHED;
            PG8_LDB(B1, 1, 1); PG8_STAGE(PG8_SB(1, 0), b3, voffB);
            PG8_BAR; PG8_WAIT_L(0); PG8_MMA(0, 1, At, B1); PG8_BAR;
            PG8_LDA(At, 1, 1); PG8_STAGE(PG8_SA(1, 0), a3, voffA);
            PG8_BAR; PG8_WAIT_L(0); PG8_MMA(1, 0, At, B0); PG8_BAR; PG8_SCHED;
            PG8_STAGE(PG8_SB(1, 1), b3 + hstep, voffB);
            PG8_WAIT_V(6); PG8_BAR; PG8_MMA(1, 1, At, B1); PG8_BAR;
            }
        }
        if constexpr (ALIGN_EPI) { if (wr == 0) PG8_BAR; }
        bool chained = false;
        if constexpr (Epi::CHAIN) { if (cur.sel == 0) { E.mid(acc, cur, wr, wc, fr, fq); chained = true; } }
        if (!chained) { E(acc, cur, wr, wc, fr, fq); S.done(cur); }
        if (!has_next) break;
        if (!chained) {
#pragma unroll
        for (int a = 0; a < 2; ++a)
#pragma unroll
            for (int b = 0; b < 2; ++b)
#pragma unroll
                for (int m = 0; m < 4; ++m)
#pragma unroll
                    for (int n = 0; n < 2; ++n) acc[a][b][m][n] = (f32x4){0.f, 0.f, 0.f, 0.f};
        }
        cur = nxt; cA = nA; cB = nB; ++ui;
        if constexpr (ALIGN_EPI) { if (wr == 1) PG8_BAR; }
    }
    PG8_WAIT_V(0);
    if constexpr (!ALIGN_EPI) { if (wr == 0) PG8_BAR; }
    PG8_BAR;
#undef PG8_SA
#undef PG8_SB
#undef PG8_STAGE
#undef PG8_LDA
#undef PG8_LDB
#undef PG8_MMA
#undef PG8_WAIT_V
#undef PG8_WAIT_L
#undef PG8_BAR
#undef PG8_SCHED
}
}

namespace ab {
typedef unsigned short bf16;
typedef short bf16x8 __attribute__((ext_vector_type(8)));
typedef short s16x4 __attribute__((ext_vector_type(4)));
typedef float f32x16 __attribute__((ext_vector_type(16)));
typedef float f32x4 __attribute__((ext_vector_type(4)));
typedef unsigned u32x4 __attribute__((ext_vector_type(4)));
constexpr int D = 128, NW = 8, QBLK = 32, KVBLK = 64, QB = NW * QBLK;
constexpr int SHM_V = KVBLK * D * 2, SHM_K = KVBLK * D * 2;
constexpr int BODY_LDS = 2 * SHM_V + 2 * SHM_K + NW * 64 * 4;
constexpr int A2_OFF = BODY_LDS, M2_OFF = A2_OFF + 8192, E2_OFF = M2_OFF + 8192, SCAN_OFF = E2_OFF + 8192, LDS_NEED = SCAN_OFF + 256;
constexpr float SCALE = 0.08838834764831845f, THR = 8.f;
#define KSWZ(row, colB) ((row) * 256 + ((colB) ^ (((row) & 7) << 4)))
#define SBAR() __builtin_amdgcn_sched_barrier(0)
__device__ __forceinline__ int v_st(int k, int c) { const int kk = (k & ~0xC) | ((k & 4) << 1) | ((k & 8) >> 1); return ((kk >> 3) * 4 + (c >> 5)) * 512 + ((kk & 7) * 32 + (c & 31)) * 2; }
__device__ __forceinline__ int v_rd_base(int lane) { return ((lane & 3) << 3) | (((lane >> 2) & 3) << 6) | (((lane >> 4) & 1) << 5) | (((lane >> 5) & 1) << 8); }
constexpr int v_rd_off(int d0, int ks, int half) { return d0 * 512 + ks * 4096 + half * 2048; }
__device__ __forceinline__ int crow(int r, int hi) { return (r & 3) + 8 * (r >> 2) + 4 * hi; }
__device__ __forceinline__ unsigned cvtpk(float lo, float hi) { unsigned r; asm volatile("v_cvt_pk_bf16_f32 %0, %1, %2" : "=v"(r) : "v"(lo), "v"(hi)); return r; }
__device__ __forceinline__ bf16x8 load8(const bf16* p) { return *reinterpret_cast<const bf16x8*>(p); }
template <int MODE> __device__ __forceinline__ void mask_tile(f32x16& p0, f32x16& p1, int dq) {
    const float NEG = MODE == 0 ? -__builtin_inff() : 0.f;
#pragma unroll
    for (int r = 0; r < 16; ++r) { const int c = (r & 3) + 8 * (r >> 2);
        if (dq - c < 0) p0[r] = NEG;
        if (dq - c - 32 < 0) p1[r] = NEG; }
}
__device__ __forceinline__ void partialSM(f32x16& p0, f32x16& p1, float& m_reg, float& mn, float& alpha) {
    float pmax = p0[0];
#pragma unroll
    for (int r = 1; r < 16; ++r) pmax = fmaxf(pmax, p0[r]);
#pragma unroll
    for (int r = 0; r < 16; ++r) pmax = fmaxf(pmax, p1[r]);
    { auto rr = __builtin_amdgcn_permlane32_swap(__float_as_uint(pmax), __float_as_uint(pmax), false, false);
      pmax = fmaxf(__uint_as_float(rr[0]), __uint_as_float(rr[1])); }
    constexpr float C2 = 1.4426950408889634f * SCALE;
    if (__builtin_expect(__all((pmax - m_reg) * SCALE <= THR), 1)) { mn = m_reg; alpha = 1.f; }
    else { mn = fmaxf(m_reg, pmax); alpha = __builtin_amdgcn_exp2f((m_reg - mn) * C2); m_reg = mn; }
    const float mnL = -mn * C2;
#pragma unroll
    for (int r = 0; r < 16; ++r) p0[r] = fmaf(p0[r], C2, mnL);
#pragma unroll
    for (int r = 0; r < 16; ++r) p1[r] = fmaf(p1[r], C2, mnL);
#pragma unroll
    for (int r = 0; r < 16; ++r) p0[r] = __builtin_amdgcn_exp2f(p0[r]);
}
__device__ __forceinline__ void partialM(f32x16& p0, f32x16& p1, const float* a2k, float M2t, int hi) {
#pragma unroll
    for (int g = 0; g < 4; ++g) { const f32x4 a = *(const f32x4*)(a2k + 8 * g + 4 * hi);
#pragma unroll
        for (int j = 0; j < 4; ++j) p0[4 * g + j] *= __builtin_amdgcn_exp2f(fminf(a[j] - M2t, 0.f)); }
    SBAR();
#pragma unroll
    for (int g = 0; g < 4; ++g) { const f32x4 b = *(const f32x4*)(a2k + 32 + 8 * g + 4 * hi);
#pragma unroll
        for (int j = 0; j < 4; ++j) p1[4 * g + j] *= __builtin_amdgcn_exp2f(fminf(b[j] - M2t, 0.f)); }
}
#define AB_PK4(P, B_, OUT) do { unsigned a0 = cvtpk(P[B_+0], P[B_+1]), a1 = cvtpk(P[B_+2], P[B_+3]);                          \
        unsigned b0 = cvtpk(P[B_+4], P[B_+5]), b1 = cvtpk(P[B_+6], P[B_+7]);                                             \
        auto r0 = __builtin_amdgcn_permlane32_swap(a0, b0, false, false); auto r1 = __builtin_amdgcn_permlane32_swap(a1, b1, false, false); \
        u32x4 w = {r0[0], r1[0], r0[1], r1[1]}; OUT = *reinterpret_cast<bf16x8*>(&w); } while (0)
template <int MODE> __device__ __forceinline__ void finishSM(f32x16& p0, f32x16& p1, float alpha, float& l_reg, bf16x8& pa0, bf16x8& pa1, bf16x8& pa2, bf16x8& pa3) {
    if (MODE == 0) {
#pragma unroll
        for (int r = 0; r < 16; ++r) p1[r] = __builtin_amdgcn_exp2f(p1[r]); }
    float ps = 0;
#pragma unroll
    for (int r = 0; r < 16; ++r) ps += p0[r];
#pragma unroll
    for (int r = 0; r < 16; ++r) ps += p1[r];
    { auto rr = __builtin_amdgcn_permlane32_swap(__float_as_uint(ps), __float_as_uint(ps), false, false);
      ps = __uint_as_float(rr[0]) + __uint_as_float(rr[1]); }
    l_reg = l_reg * alpha + ps;
    AB_PK4(p0, 0, pa0); AB_PK4(p0, 8, pa1); AB_PK4(p1, 0, pa2); AB_PK4(p1, 8, pa3);
}
template <int KB>
__device__ __forceinline__ void qkt(f32x16& p0, f32x16& p1, const char* K_lds, int r32, int hi, const bf16x8* qr) {
    p0 = f32x16{}; p1 = f32x16{};
    const char* kb[4];
#pragma unroll
    for (int dd = 0; dd < 4; ++dd) kb[dd] = K_lds + KB * SHM_K + KSWZ(r32, (dd * 16 + hi * 8) * 2);
#pragma unroll
    for (int d0 = 0; d0 < 8; ++d0) { const char* a = kb[d0 & 3] + (d0 >> 2) * 128;
        bf16x8 b0 = *reinterpret_cast<const bf16x8*>(a);
        bf16x8 b1 = *reinterpret_cast<const bf16x8*>(a + 32 * 256);
        p0 = __builtin_amdgcn_mfma_f32_32x32x16_bf16(b0, qr[d0], p0, 0, 0, 0);
        p1 = __builtin_amdgcn_mfma_f32_32x32x16_bf16(b1, qr[d0], p1, 0, 0, 0); }
}
template <int VB>
__device__ __forceinline__ void pv_tile(f32x16* o, int vb0, bf16x8 pa0, bf16x8 pa1, bf16x8 pa2, bf16x8 pa3) {
#define TRRD(dst, off) asm volatile("ds_read_b64_tr_b16 %0, %1 offset:%2" : "=&v"(dst) : "v"(vb0), "i"(off) : "memory")
#define PV_D0(d0) do { s16x4 l0, l1, l2, l3, h0, h1, h2, h3; constexpr int b_ = VB * SHM_V + v_rd_off(d0, 0, 0); \
        TRRD(l0, b_); TRRD(h0, b_ + 2048); TRRD(l1, b_ + 4096); TRRD(h1, b_ + 6144); TRRD(l2, b_ + 8192); TRRD(h2, b_ + 10240); TRRD(l3, b_ + 12288); TRRD(h3, b_ + 14336); \
        asm volatile("s_waitcnt lgkmcnt(0)" ::: "memory"); SBAR();   \
        o[d0] = __builtin_amdgcn_mfma_f32_32x32x16_bf16(pa0, (bf16x8){l0[0], l0[1], l0[2], l0[3], h0[0], h0[1], h0[2], h0[3]}, o[d0], 0, 0, 0);   \
        o[d0] = __builtin_amdgcn_mfma_f32_32x32x16_bf16(pa1, (bf16x8){l1[0], l1[1], l1[2], l1[3], h1[0], h1[1], h1[2], h1[3]}, o[d0], 0, 0, 0);   \
        o[d0] = __builtin_amdgcn_mfma_f32_32x32x16_bf16(pa2, (bf16x8){l2[0], l2[1], l2[2], l2[3], h2[0], h2[1], h2[2], h2[3]}, o[d0], 0, 0, 0);   \
        o[d0] = __builtin_amdgcn_mfma_f32_32x32x16_bf16(pa3, (bf16x8){l3[0], l3[1], l3[2], l3[3], h3[0], h3[1], h3[2], h3[3]}, o[d0], 0, 0, 0); } while (0)
    PV_D0(0); PV_D0(1); PV_D0(2); PV_D0(3);
#undef PV_D0
#undef TRRD
}
template <int KB>
__device__ __forceinline__ void qkt2(f32x16& p0, f32x16& p1, const char* K_lds, int r32, int hi, const bf16x8* qr) {
    p0 = f32x16{}; p1 = f32x16{};
    int ka[4];
#pragma unroll
    for (int dd = 0; dd < 4; ++dd) ka[dd] = (int)(uintptr_t)K_lds + KB * SHM_K + KSWZ(r32, (dd * 16 + hi * 8) * 2);
#define KRD(dst, addr, off) asm volatile("ds_read_b128 %0, %1 offset:%2" : "=&v"(dst) : "v"(addr), "i"(off) : "memory")
#define QK_RD(X, Y, b) do { KRD(X[0], ka[(2 * (b)) & 3], ((2 * (b)) >> 2) * 128); KRD(Y[0], ka[(2 * (b)) & 3], ((2 * (b)) >> 2) * 128 + 32 * 256); \
        KRD(X[1], ka[(2 * (b) + 1) & 3], ((2 * (b) + 1) >> 2) * 128); KRD(Y[1], ka[(2 * (b) + 1) & 3], ((2 * (b) + 1) >> 2) * 128 + 32 * 256); } while (0)
#define QK_MM(X, Y, b) do { p0 = __builtin_amdgcn_mfma_f32_32x32x16_bf16(X[0], qr[2 * (b)], p0, 0, 0, 0); p1 = __builtin_amdgcn_mfma_f32_32x32x16_bf16(Y[0], qr[2 * (b)], p1, 0, 0, 0); \
        p0 = __builtin_amdgcn_mfma_f32_32x32x16_bf16(X[1], qr[2 * (b) + 1], p0, 0, 0, 0); p1 = __builtin_amdgcn_mfma_f32_32x32x16_bf16(Y[1], qr[2 * (b) + 1], p1, 0, 0, 0); } while (0)
    bf16x8 xa[2], ya[2], xb[2], yb[2];
    QK_RD(xa, ya, 0); QK_RD(xb, yb, 1);
    asm volatile("s_waitcnt lgkmcnt(4)" ::: "memory"); SBAR(); QK_MM(xa, ya, 0); SBAR(); QK_RD(xa, ya, 2);
    asm volatile("s_waitcnt lgkmcnt(4)" ::: "memory"); SBAR(); QK_MM(xb, yb, 1); SBAR(); QK_RD(xb, yb, 3);
    asm volatile("s_waitcnt lgkmcnt(4)" ::: "memory"); SBAR(); QK_MM(xa, ya, 2); SBAR();
    asm volatile("s_waitcnt lgkmcnt(0)" ::: "memory"); SBAR(); QK_MM(xb, yb, 3);
#undef QK_MM
#undef QK_RD
#undef KRD
}
template <int VB, bool PF>
__device__ __forceinline__ void pv_tile2(f32x16* o, int vb0, bf16x8 pa0, bf16x8 pa1, bf16x8 pa2, bf16x8 pa3) {
#define TRRD(dst, off) asm volatile("ds_read_b64_tr_b16 %0, %1 offset:%2" : "=&v"(dst) : "v"(vb0), "i"(off) : "memory")
#define PV_RD(L, H, ks) do { constexpr int b_ = VB * SHM_V + (ks) * 4096; TRRD(L[0], b_); TRRD(H[0], b_ + 2048); TRRD(L[1], b_ + 512); TRRD(H[1], b_ + 512 + 2048); \
        TRRD(L[2], b_ + 1024); TRRD(H[2], b_ + 1024 + 2048); TRRD(L[3], b_ + 1536); TRRD(H[3], b_ + 1536 + 2048); } while (0)
#define PV_MM(L, H, PA) do { _Pragma("unroll") for (int d0 = 0; d0 < 4; ++d0) \
        o[d0] = __builtin_amdgcn_mfma_f32_32x32x16_bf16(PA, (bf16x8){L[d0][0], L[d0][1], L[d0][2], L[d0][3], H[d0][0], H[d0][1], H[d0][2], H[d0][3]}, o[d0], 0, 0, 0); } while (0)
    s16x4 la[4], ha[4];
    if constexpr (PF) {
        s16x4 lb[4], hb[4];
        PV_RD(la, ha, 0); PV_RD(lb, hb, 1);
        asm volatile("s_waitcnt lgkmcnt(8)" ::: "memory"); SBAR(); PV_MM(la, ha, pa0); SBAR();
        PV_RD(la, ha, 2);
        asm volatile("s_waitcnt lgkmcnt(8)" ::: "memory"); SBAR(); PV_MM(lb, hb, pa1); SBAR();
        PV_RD(lb, hb, 3);
        asm volatile("s_waitcnt lgkmcnt(8)" ::: "memory"); SBAR(); PV_MM(la, ha, pa2); SBAR();
        asm volatile("s_waitcnt lgkmcnt(0)" ::: "memory"); SBAR(); PV_MM(lb, hb, pa3);
    } else {
        PV_RD(la, ha, 0); asm volatile("s_waitcnt lgkmcnt(0)" ::: "memory"); SBAR(); PV_MM(la, ha, pa0); SBAR();
        PV_RD(la, ha, 1); asm volatile("s_waitcnt lgkmcnt(0)" ::: "memory"); SBAR(); PV_MM(la, ha, pa1); SBAR();
        PV_RD(la, ha, 2); asm volatile("s_waitcnt lgkmcnt(0)" ::: "memory"); SBAR(); PV_MM(la, ha, pa2); SBAR();
        PV_RD(la, ha, 3); asm volatile("s_waitcnt lgkmcnt(0)" ::: "memory"); SBAR(); PV_MM(la, ha, pa3);
    }
#undef PV_MM
#undef PV_RD
#undef TRRD
}
struct BlockRef { const bf16* Q; const bf16* K; const bf16* V; float* O; int P0; const bf16* Cst; const float* nst; };
struct Seam { bf16x8 qr[8]; bf16x8 st_v0, st_v1, st_k0, st_k1; bf16x8 sb_v0, sb_v1, sb_k0, sb_k1; };
#define VMW() asm volatile("s_waitcnt vmcnt(0)" ::: "memory")
#define VMWN(n) asm volatile("s_waitcnt vmcnt(%0)" :: "i"(n) : "memory")
#define SLOAD_H(Kp, Vp, k0) do { const bf16* vb_ = (Vp) + (size_t)((k0) + wid * 4) * VP; const bf16* kb_ = (Kp) + (size_t)((k0) + wid * 4) * KP;    \
                         S.st_v0 = load8(vb_ + lov); S.st_v1 = load8(vb_ + 32 * VP + lov); S.st_k0 = load8(kb_ + lok); S.st_k1 = load8(kb_ + 32 * KP + lok); } while (0)
#define SWRITE_HK(bf) do { *(bf16x8*)(K_lds + (bf) * SHM_K + kws) = S.st_k0; *(bf16x8*)(K_lds + (bf) * SHM_K + kws + 32 * 256) = S.st_k1; } while (0)
#define SWRITE_HV(bf) do { *(bf16x8*)(V_lds + (bf) * SHM_V + vst0) = S.st_v0; *(bf16x8*)(V_lds + (bf) * SHM_V + vst1) = S.st_v1; } while (0)
#define SWRITE_H(bf) do { SWRITE_HV(bf); SWRITE_HK(bf); } while (0)
template <int QP, int KP, int VP>
__device__ __forceinline__ void prime(const BlockRef& cur, char* lds, Seam& S, const int tid, const int k0) {
    const int wid = __builtin_amdgcn_readfirstlane(tid >> 6), lane = tid & 63, r32 = lane & 31, hi = lane >> 5;
    const int sr = tid >> 4, sc = (tid & 15) * 8, kws = KSWZ(sr, sc * 2); char* K_lds = lds + 2 * SHM_V;
    const unsigned lov = (unsigned)((lane >> 4) * VP + sc), lok = (unsigned)((lane >> 4) * KP + sc), loq = (unsigned)(r32 * QP + hi * 8);
    { const bf16* qb_ = cur.Q + (size_t)(wid * QBLK) * QP;
#pragma unroll
      for (int d0 = 0; d0 < 8; ++d0) S.qr[d0] = load8(qb_ + d0 * 16 + loq); }
    SLOAD_H(cur.K, cur.V, k0); VMW(); SWRITE_HK(0);
    __syncthreads();
}
template <int MODE, int QP, int KP, int VP, int OP>
__device__ __forceinline__ void block(const BlockRef& cur, const BlockRef& nxt, char* lds, Seam& S, const int tid) {
    const int wid = __builtin_amdgcn_readfirstlane(tid >> 6), lane = tid & 63, r32 = lane & 31, hi = lane >> 5;
    const int T0 = (MODE == 1) ? cur.P0 / KVBLK : 0;
    int NT = (MODE == 1) ? QB / KVBLK : cur.P0 / KVBLK + QB / KVBLK;
    if (MODE == 1) asm volatile("" : "+s"(NT));
    const int qlo = cur.P0 + wid * QBLK, qm = qlo + r32 - 4 * hi;
    char* V_lds = lds; char* K_lds = lds + 2 * SHM_V;
    float* ws = (float*)(lds + 2 * SHM_V + 2 * SHM_K) + wid * 64; float* li_l = ws, * al_l = ws + 32;
    const float* a2 = (const float*)(lds + A2_OFF);
    float M2t = 0.f;
    if (MODE == 1) M2t = ((const float*)(lds + M2_OFF))[qlo + r32];
    float m_reg = -1e30f, l_reg = 0; f32x16 o[4] = {};
    const int sr = tid >> 4, sc = (tid & 15) * 8, vst0 = v_st(sr, sc), vst1 = v_st(32 + sr, sc), kws = KSWZ(sr, sc * 2);
    const int vb0 = (int)(uintptr_t)V_lds + v_rd_base(lane);
    const unsigned lov = (unsigned)((lane >> 4) * VP + sc), lok = (unsigned)((lane >> 4) * KP + sc), loq = (unsigned)(r32 * QP + hi * 8), loo = (unsigned)(4 * hi * OP + r32);
    const bf16* Kh = cur.K; const bf16* Vh = cur.V;
#define RESC(a) do { if (MODE == 0) { if (__any((a) < 1.f)) { if (hi == 0) al_l[r32] = (a); asm volatile("s_waitcnt lgkmcnt(0)" ::: "memory");              \
                     for (int d_ = 0; d_ < 4; ++d_) for (int r = 0; r < 16; ++r) o[d_][r] *= al_l[crow(r, hi)]; } } } while (0)
#define KBASE(t) ((T0 + (t)) * KVBLK)
#define MASKT(P0_, P1_, t) do { const int kb_ = KBASE(t); if (kb_ + KVBLK - 1 > qlo) mask_tile<MODE>(P0_, P1_, qm - kb_); } while (0)
#define PARTIAL(P0_, P1_, mnX, alX, t) do { if (MODE == 0) partialSM(P0_, P1_, m_reg, mnX, alX); else { alX = 1.f; partialM(P0_, P1_, a2 + KBASE(t), M2t, hi); } } while (0)
    constexpr int NQL = 8;
#define SEAM_K0() do { VMWN(NQL); SWRITE_HK(0); SBAR(); } while (0)
    f32x16 pA0, pA1, pB0, pB1; float mnA, mnB, alA, alB; bf16x8 pa0, pa1, pa2, pa3;
    if (MODE == 1 && cur.Cst != nullptr) {
        const bf16* Cp = cur.Cst + (size_t)(wid * 4) * 256; const unsigned loc = (unsigned)((lane >> 4) * 256 + sc);
        const bf16x8 c0 = load8(Cp + loc), c1 = load8(Cp + 32 * 256 + loc), c2 = load8(Cp + 64 * 256 + loc), c3 = load8(Cp + 96 * 256 + loc);
        float dn = 0.f;
#pragma unroll
        for (int d0 = 0; d0 < 8; ++d0) { const f32x4 n0 = *(const f32x4*)(cur.nst + 16 * d0 + 8 * hi), n1 = *(const f32x4*)(cur.nst + 16 * d0 + 8 * hi + 4);
            const u32x4 qw = *reinterpret_cast<const u32x4*>(&S.qr[d0]);
            dn += __uint_as_float(qw.x << 16) * n0[0] + __uint_as_float(qw.x & 0xffff0000u) * n0[1] + __uint_as_float(qw.y << 16) * n0[2] + __uint_as_float(qw.y & 0xffff0000u) * n0[3];
            dn += __uint_as_float(qw.z << 16) * n1[0] + __uint_as_float(qw.z & 0xffff0000u) * n1[1] + __uint_as_float(qw.w << 16) * n1[2] + __uint_as_float(qw.w & 0xffff0000u) * n1[3]; }
        { auto rr = __builtin_amdgcn_permlane32_swap(__float_as_uint(dn), __float_as_uint(dn), false, false); dn = __uint_as_float(rr[0]) + __uint_as_float(rr[1]); }
        VMW();
        *(bf16x8*)(V_lds + vst0) = c0; *(bf16x8*)(V_lds + vst1) = c1; *(bf16x8*)(V_lds + SHM_V + vst0) = c2; *(bf16x8*)(V_lds + SHM_V + vst1) = c3;
        __syncthreads();
        pv_tile<0>(o, vb0, S.qr[0], S.qr[1], S.qr[2], S.qr[3]); pv_tile<1>(o, vb0, S.qr[4], S.qr[5], S.qr[6], S.qr[7]);
        const float st = __builtin_amdgcn_exp2f(((const float*)(lds + M2_OFF))[cur.P0 - 1] - M2t);
        l_reg = st * dn;
        if (hi == 0) al_l[r32] = st;
        asm volatile("s_waitcnt lgkmcnt(0)" ::: "memory");
#pragma unroll
        for (int d_ = 0; d_ < 4; ++d_)
#pragma unroll
            for (int r = 0; r < 16; ++r) o[d_][r] *= al_l[crow(r, hi)];
        __syncthreads();
    }
    SWRITE_HV(0); SBAR();
    if (NT > 1) { SLOAD_H(Kh, Vh, KBASE(1)); }
    SBAR(); qkt<0>(pA0, pA1, K_lds, r32, hi, S.qr);
    MASKT(pA0, pA1, 0); PARTIAL(pA0, pA1, mnA, alA, 0);
    if (NT > 1) { VMW(); SWRITE_H(1); }
    __syncthreads();
#define HALF_STEP(PX0, PX1, mnX, alX, PY0, PY1, alY, t, KB, VB, SB) do {                                                      \
        SBAR(); qkt<KB>(PX0, PX1, K_lds, r32, hi, S.qr);                                             \
        finishSM<MODE>(PY0, PY1, alY, l_reg, pa0, pa1, pa2, pa3); SBAR();                                                           \
        if ((t) + 1 < NT) { SLOAD_H(Kh, Vh, KBASE((t) + 1)); SBAR(); }                                               \
        pv_tile<VB>(o, vb0, pa0, pa1, pa2, pa3); MASKT(PX0, PX1, (t)); PARTIAL(PX0, PX1, mnX, alX, (t));                                        \
        __syncthreads();                                                                                                      \
        if ((t) + 1 < NT) { VMW(); SWRITE_H(SB); }                                                                          \
        RESC(alX); __syncthreads(); } while (0)
    for (int t = 1; t + 1 < NT; t += 2) {
        HALF_STEP(pB0, pB1, mnB, alB, pA0, pA1, alA, t, 1, 0, 0);
        HALF_STEP(pA0, pA1, mnA, alA, pB0, pB1, alB, t + 1, 0, 1, 1);
    }
    const bool even = (NT & 1) == 0;
    if (even) { SBAR(); qkt<1>(pB0, pB1, K_lds, r32, hi, S.qr); SBAR(); }
    SLOAD_H(nxt.K, nxt.V, (MODE == 1) ? nxt.P0 : 0); SBAR();
    { const bf16* qb_ = nxt.Q + (size_t)(wid * QBLK) * QP;
#pragma unroll
      for (int d0 = 0; d0 < 8; ++d0) S.qr[d0] = load8(qb_ + d0 * 16 + loq); }
    SBAR();
    finishSM<MODE>(pA0, pA1, alA, l_reg, pa0, pa1, pa2, pa3); SBAR();
    pv_tile<0>(o, vb0, pa0, pa1, pa2, pa3);
    if (even) { MASKT(pB0, pB1, NT - 1); PARTIAL(pB0, pB1, mnB, alB, NT - 1); __syncthreads(); RESC(alB);
        finishSM<MODE>(pB0, pB1, alB, l_reg, pa0, pa1, pa2, pa3); SBAR(); pv_tile<1>(o, vb0, pa0, pa1, pa2, pa3); }
    SBAR(); SEAM_K0();
    if (hi == 0) li_l[r32] = (MODE == 0) ? l_reg : fmaxf(fabsf(l_reg), __builtin_amdgcn_exp2f(((const float*)(lds + E2_OFF))[qlo + r32]));
    asm volatile("s_waitcnt lgkmcnt(0)" ::: "memory");
    float rli[16];
#pragma unroll
    for (int r = 0; r < 16; ++r) rli[r] = __builtin_amdgcn_rcpf(li_l[crow(r, hi)]);
    float* Ow = cur.O + (size_t)(wid * QBLK) * OP;
#pragma unroll
    for (int r = 0; r < 16; ++r) { float* Or = Ow + (size_t)((r & 3) + 8 * (r >> 2)) * OP;
#pragma unroll
        for (int d0 = 0; d0 < 4; ++d0) Or[d0 * 32 + loo] = o[d0][r] * rli[r]; }
    __syncthreads();
#undef RESC
#undef KBASE
#undef MASKT
#undef PARTIAL
#undef SEAM_K0
#undef HALF_STEP
}

#define PP_BAR() do { asm volatile("s_waitcnt lgkmcnt(0)" ::: "memory"); __builtin_amdgcn_s_barrier(); asm volatile("" ::: "memory"); SBAR(); } while (0)
constexpr int SB_OFF = 98304;
static_assert(LDS_NEED <= SB_OFF && SB_OFF + 2 * SHM_V <= 131072, "lds map");
template <int MODE, int QP, int KP, int VP>
__device__ __forceinline__ void prime2(const BlockRef& cur, char* lds, Seam& S, const int tid) {
    const int wid = __builtin_amdgcn_readfirstlane(tid >> 6), lane = tid & 63, r32 = lane & 31, hi = lane >> 5;
    const int sr = tid >> 4, sc = (tid & 15) * 8, kws = KSWZ(sr, sc * 2); char* K_lds = lds + 2 * SHM_V;
    const unsigned lov = (unsigned)((lane >> 4) * VP + sc), lok = (unsigned)((lane >> 4) * KP + sc), loq = (unsigned)(r32 * QP + hi * 8);
    const int k0 = (MODE == 1) ? cur.P0 : 0;
    { const bf16* qb_ = cur.Q + (size_t)(wid * QBLK) * QP;
#pragma unroll
      for (int d0 = 0; d0 < 8; ++d0) S.qr[d0] = load8(qb_ + d0 * 16 + loq); }
    { const bf16* kb_ = cur.K + (size_t)(k0 + wid * 4) * KP; S.st_k0 = load8(kb_ + lok); S.st_k1 = load8(kb_ + 32 * KP + lok); }
    *(bf16x8*)(K_lds + kws) = S.st_k0; *(bf16x8*)(K_lds + kws + 32 * 256) = S.st_k1;
    SBAR();
    { const bf16* kb_ = cur.K + (size_t)(k0 + KVBLK + wid * 4) * KP; const bf16* vb_ = cur.V + (size_t)(k0 + wid * 4) * VP;
      S.st_k0 = load8(kb_ + lok); S.st_k1 = load8(kb_ + 32 * KP + lok); S.st_v0 = load8(vb_ + lov); S.st_v1 = load8(vb_ + 32 * VP + lov);
      if (MODE == 0) { S.sb_k0 = load8(kb_ + (size_t)KVBLK * KP + lok); S.sb_k1 = load8(kb_ + (size_t)(KVBLK + 32) * KP + lok); S.sb_v0 = load8(vb_ + (size_t)KVBLK * VP + lov); S.sb_v1 = load8(vb_ + (size_t)(KVBLK + 32) * VP + lov); } }
    PP_BAR();
    if (wid >= 4) PP_BAR();
}
__device__ __forceinline__ void pp_realign(const int tid) { if (__builtin_amdgcn_readfirstlane(tid >> 6) < 4) PP_BAR(); }
template <int MODE, int QP, int KP, int VP, int OP>
__device__ __forceinline__ void block2(const BlockRef& cur, const BlockRef& nxt, char* lds, Seam& S, const int tid) {
    const int wid = __builtin_amdgcn_readfirstlane(tid >> 6), lane = tid & 63, r32 = lane & 31, hi = lane >> 5;
    const int T0 = (MODE == 1) ? cur.P0 / KVBLK : 0, T0n = (MODE == 1) ? nxt.P0 / KVBLK : 0;
    int NT = (MODE == 1) ? QB / KVBLK : cur.P0 / KVBLK + QB / KVBLK;
    if (MODE == 1) asm volatile("" : "+s"(NT));
    const int qlo = cur.P0 + wid * QBLK, qm = qlo + r32 - 4 * hi;
    char* V_lds = lds; char* K_lds = lds + 2 * SHM_V;
    float* ws = (float*)(lds + 2 * SHM_V + 2 * SHM_K) + wid * 64; float* li_l = ws, * al_l = ws + 32;
    const float* a2 = (const float*)(lds + A2_OFF);
    float M2t = 0.f;
    if (MODE == 1) M2t = ((const float*)(lds + M2_OFF))[qlo + r32];
    float m_reg = -1e30f, l_reg = 0; f32x16 o[4] = {};
    const int sr = tid >> 4, sc = (tid & 15) * 8, vst0 = v_st(sr, sc), vst1 = v_st(32 + sr, sc), kws = KSWZ(sr, sc * 2);
    const int vb0 = (int)(uintptr_t)V_lds + v_rd_base(lane);
    const unsigned lov = (unsigned)((lane >> 4) * VP + sc), lok = (unsigned)((lane >> 4) * KP + sc), loq = (unsigned)(r32 * QP + hi * 8), loo = (unsigned)(4 * hi * OP + r32);
#define KBASE2(t) ((T0 + (t)) * KVBLK)
#define LOADKV(K0, K1, V0, V1, kt, vt) do { const bool kn_ = (kt) >= NT, vn_ = (vt) >= NT;                                                            \
        const bf16* kb_ = (kn_ ? nxt.K : cur.K) + (size_t)(((kn_ ? T0n - NT : T0) + (kt)) * KVBLK + wid * 4) * KP;                                   \
        const bf16* vb_ = (vn_ ? nxt.V : cur.V) + (size_t)(((vn_ ? T0n - NT : T0) + (vt)) * KVBLK + wid * 4) * VP;                                   \
        K0 = load8(kb_ + lok); K1 = load8(kb_ + 32 * KP + lok); V0 = load8(vb_ + lov); V1 = load8(vb_ + 32 * VP + lov); } while (0)
#define WRITEKV(K0, K1, V0, V1, kbuf, vbuf) do { *(bf16x8*)(K_lds + (kbuf) * SHM_K + kws) = K0; *(bf16x8*)(K_lds + (kbuf) * SHM_K + kws + 32 * 256) = K1;    \
        *(bf16x8*)(V_lds + (vbuf) * SHM_V + vst0) = V0; *(bf16x8*)(V_lds + (vbuf) * SHM_V + vst1) = V1; } while (0)
#define WRITE_A(kbuf, vbuf) WRITEKV(S.st_k0, S.st_k1, S.st_v0, S.st_v1, kbuf, vbuf)
#define WRITE_B(kbuf, vbuf) WRITEKV(S.sb_k0, S.sb_k1, S.sb_v0, S.sb_v1, kbuf, vbuf)
#define LOAD_A(kt, vt) LOADKV(S.st_k0, S.st_k1, S.st_v0, S.st_v1, kt, vt)
#define LOAD_B(kt, vt) LOADKV(S.sb_k0, S.sb_k1, S.sb_v0, S.sb_v1, kt, vt)
    f32x16 p0, p1; float mn, al; bf16x8 pa0, pa1, pa2, pa3;
#define VV_STAGE(t) do { { const int kb_ = KBASE2(t); if (kb_ + KVBLK - 1 > qlo) mask_tile<MODE>(p0, p1, qm - kb_); }                                 \
        if (MODE == 0) { partialSM(p0, p1, m_reg, mn, al);                                                                                             \
            if (__any(al < 1.f)) { if (hi == 0) al_l[r32] = al; asm volatile("s_waitcnt lgkmcnt(0)" ::: "memory");                                     \
                _Pragma("unroll") for (int d_ = 0; d_ < 4; ++d_) _Pragma("unroll") for (int r = 0; r < 16; ++r) o[d_][r] *= al_l[crow(r, hi)]; } }                  \
        else { al = 1.f; partialM(p0, p1, a2 + KBASE2(t), M2t, hi); }                                                                                  \
        finishSM<MODE>(p0, p1, al, l_reg, pa0, pa1, pa2, pa3); } while (0)
    if (MODE == 1 && cur.Cst != nullptr) {
        const bf16* Cp = cur.Cst + (size_t)(wid * 4) * 256; const unsigned loc = (unsigned)((lane >> 4) * 256 + sc);
        const bf16x8 c0 = load8(Cp + loc), c1 = load8(Cp + 32 * 256 + loc), c2 = load8(Cp + 64 * 256 + loc), c3 = load8(Cp + 96 * 256 + loc);
        *(bf16x8*)(lds + SB_OFF + vst0) = c0; *(bf16x8*)(lds + SB_OFF + vst1) = c1; *(bf16x8*)(lds + SB_OFF + SHM_V + vst0) = c2; *(bf16x8*)(lds + SB_OFF + SHM_V + vst1) = c3;
        PP_BAR();
        float dn = 0.f;
#pragma unroll
        for (int d0 = 0; d0 < 8; ++d0) { const f32x4 n0 = *(const f32x4*)(cur.nst + 16 * d0 + 8 * hi), n1 = *(const f32x4*)(cur.nst + 16 * d0 + 8 * hi + 4);
            const u32x4 qw = *reinterpret_cast<const u32x4*>(&S.qr[d0]);
            dn += __uint_as_float(qw.x << 16) * n0[0] + __uint_as_float(qw.x & 0xffff0000u) * n0[1] + __uint_as_float(qw.y << 16) * n0[2] + __uint_as_float(qw.y & 0xffff0000u) * n0[3];
            dn += __uint_as_float(qw.z << 16) * n1[0] + __uint_as_float(qw.z & 0xffff0000u) * n1[1] + __uint_as_float(qw.w << 16) * n1[2] + __uint_as_float(qw.w & 0xffff0000u) * n1[3]; }
        { auto rr = __builtin_amdgcn_permlane32_swap(__float_as_uint(dn), __float_as_uint(dn), false, false); dn = __uint_as_float(rr[0]) + __uint_as_float(rr[1]); }
        PP_BAR();
        pv_tile2<0, MODE == 0>(o, vb0 + SB_OFF, S.qr[0], S.qr[1], S.qr[2], S.qr[3]); pv_tile2<1, MODE == 0>(o, vb0 + SB_OFF, S.qr[4], S.qr[5], S.qr[6], S.qr[7]);
        const float st = __builtin_amdgcn_exp2f(((const float*)(lds + M2_OFF))[cur.P0 - 1] - M2t);
        l_reg = st * dn;
        if (hi == 0) al_l[r32] = st;
        asm volatile("s_waitcnt lgkmcnt(0)" ::: "memory");
#pragma unroll
        for (int d_ = 0; d_ < 4; ++d_)
#pragma unroll
            for (int r = 0; r < 16; ++r) o[d_][r] *= al_l[crow(r, hi)];
        PP_BAR();
    }
    for (int t = 0; t < NT; t += 2) {
        WRITE_A(1, 0); SBAR(); if (MODE == 0) LOAD_A(t + 3, t + 2); else LOAD_A(t + 2, t + 1); SBAR();
        if (t > 0) pv_tile2<1, MODE == 0>(o, vb0, pa0, pa1, pa2, pa3);
        qkt2<0>(p0, p1, K_lds, r32, hi, S.qr);
        PP_BAR();
        VV_STAGE(t);
        PP_BAR();
        if (MODE == 0) { WRITE_B(0, 1); SBAR(); LOAD_B(t + 4, t + 3); } else { WRITE_A(0, 1); SBAR(); LOAD_A(t + 3, t + 2); } SBAR();
        pv_tile2<0, MODE == 0>(o, vb0, pa0, pa1, pa2, pa3);
        qkt2<1>(p0, p1, K_lds, r32, hi, S.qr);
        PP_BAR();
        VV_STAGE(t + 1);
        PP_BAR();
    }
    { const bf16* qb_ = nxt.Q + (size_t)(wid * QBLK) * QP;
#pragma unroll
      for (int d0 = 0; d0 < 8; ++d0) S.qr[d0] = load8(qb_ + d0 * 16 + loq); }
    SBAR();
    pv_tile2<1, MODE == 0>(o, vb0, pa0, pa1, pa2, pa3);
    PP_BAR();
    if (hi == 0) li_l[r32] = (MODE == 0) ? l_reg : fmaxf(fabsf(l_reg), __builtin_amdgcn_exp2f(((const float*)(lds + E2_OFF))[qlo + r32]));
    asm volatile("s_waitcnt lgkmcnt(0)" ::: "memory");
    float rli[16];
#pragma unroll
    for (int r = 0; r < 16; ++r) rli[r] = __builtin_amdgcn_rcpf(li_l[crow(r, hi)]);
    { bf16* Ow = (bf16*)cur.O + (size_t)(wid * QBLK) * OP;
#pragma unroll
      for (int r = 0; r < 16; ++r) { bf16* Or = Ow + (size_t)((r & 3) + 8 * (r >> 2)) * OP;
#pragma unroll
          for (int d0 = 0; d0 < 4; ++d0) { const float v = o[d0][r] * rli[r];
              const float nb = __uint_as_float(__builtin_amdgcn_update_dpp(0u, __float_as_uint(v), 0xB1, 0xf, 0xf, false));
              if ((r32 & 1) == 0) *(unsigned*)(Or + d0 * 32 + loo) = cvtpk(v, nb); } } }
    PP_BAR();
#undef KBASE2
#undef LOADKV
#undef WRITEKV
#undef WRITE_A
#undef WRITE_B
#undef LOAD_A
#undef LOAD_B
#undef VV_STAGE
}
#undef VMW
#undef VMWN
#undef SLOAD_H
#undef SWRITE_HK
#undef SWRITE_HV
#undef SWRITE_H
}

constexpr int NWAVES = 8;
constexpr int BATCH = 4, SEQ = 2048, DM = 2048, DEPTH = 4, MTOK = BATCH * SEQ;
constexpr int NIN = 16400, NING = 16384, GATE_COL = 6144, DFF = 5632, NUP = 2 * DFF;
constexpr float EPS = 1e-6f;
constexpr int NPH_L = 7, NPHASE = 2 + DEPTH * NPH_L;
constexpr size_t MiB = 1u << 20;
constexpr size_t WS_CTL = 0, CTL_ZERO_BYTES = 1 * MiB;
constexpr size_t WS_ROPE = 1 * MiB;
constexpr size_t WS_BIASG = WS_ROPE + 512 * 1024;
constexpr size_t WS_GATES = 2 * MiB;
constexpr size_t WS_ROWSS_B = 3 * MiB - 64 * 1024;
constexpr size_t WS_ROWSS = 3 * MiB;
constexpr size_t WS_WIN = 4 * MiB, SZ_WIN = 64 * MiB;
constexpr size_t WS_WBM = WS_WIN + 4 * SZ_WIN, SZ_WSQ = 8 * MiB;
constexpr size_t WS_WBD = WS_WBM + 4 * SZ_WSQ, WS_WO = WS_WBD + 4 * SZ_WSQ;
constexpr size_t WS_WUP = WS_WO + 4 * SZ_WSQ, SZ_WUP = 44 * MiB;
constexpr size_t WS_WDN = WS_WUP + 4 * SZ_WUP, SZ_WDN = 22 * MiB;
constexpr size_t WS_H = WS_WDN + 4 * SZ_WDN;
constexpr size_t WS_GWF = WS_H;
constexpr size_t WS_XN = WS_H + 64 * MiB;
constexpr size_t WS_MQ = WS_XN + 32 * MiB, WS_MK = WS_MQ + 16 * MiB, WS_MV = WS_MK + 16 * MiB, WS_SMO = WS_MV + 32 * MiB;
constexpr size_t WS_AQ = WS_SMO + 32 * MiB, WS_AK = WS_AQ + 32 * MiB, WS_AV = WS_AK + 32 * MiB, WS_SG = WS_AV + 32 * MiB;
constexpr size_t WS_OATT = WS_SG + 64 * MiB;
constexpr size_t WS_HRAW = WS_OATT + 128 * MiB;
constexpr size_t WS_HMN = WS_HRAW + 64 * MiB, WS_HAN = WS_HMN + 32 * MiB;
constexpr size_t WS_P = WS_HAN + 32 * MiB;
constexpr size_t WS_Y = WS_P + 64 * MiB;
constexpr size_t WS_FXC = WS_Y + 32 * MiB, WS_FXV = WS_FXC + 3 * MiB, WS_FXG = WS_FXV + 3 * MiB;
constexpr size_t WS_U = WS_FXG + 3 * MiB;
constexpr size_t WS_CST = WS_U + 88 * MiB;
constexpr size_t WS_NST = WS_CST + 16 * MiB;
constexpr size_t WS_END = WS_NST + 1 * MiB;
constexpr int CW_TMO = 0, CW_CODE = 1, CW_BAR = 4096, CW_GCNT = 200000, CW_SFLAG = 210000, CW_TICK = 240000, CW_ATICK = 250000;
constexpr int LDS_BYTES = 131072 + 2048, MISC_OFF = 131072;
static_assert(ab::LDS_NEED <= 131072, "lds");

#define GAS __attribute__((address_space(1)))
#define LAS __attribute__((address_space(3)))
typedef unsigned short bf16;
typedef unsigned v4u __attribute__((ext_vector_type(4)));
typedef unsigned v2u __attribute__((ext_vector_type(2)));
typedef float f32x4 __attribute__((ext_vector_type(4)));
typedef GAS unsigned gu32;
#define RLX_AGENT __ATOMIC_RELAXED, __HIP_MEMORY_SCOPE_AGENT
#define LDS_WAIT() asm volatile("s_waitcnt lgkmcnt(0)" ::: "memory")
#define VM_WAIT() asm volatile("s_waitcnt vmcnt(0)" ::: "memory")
__device__ __forceinline__ unsigned pk2(float lo, float hi) { return pg8::cvt_pk_bf16(lo, hi); }

#define XB_TMO      128
#define XB_XCNT(j)  (256  + 64 * (j))
#define XB_XSUB(j)  (1280 + 64 * (j))
#define XB_XGEN(j)  (2304 + 64 * (j))
#define XB_TOP      3328
#define XB_TOPGEN   3392
#define XCD_BAR_WORDS 3456
#define XB_SPIN_CAP (1u << 18)
__device__ __forceinline__ unsigned xb_ld(unsigned* p)              { return __hip_atomic_load(p, __ATOMIC_RELAXED, __HIP_MEMORY_SCOPE_AGENT); }
__device__ __forceinline__ unsigned xb_add(unsigned* p, unsigned v) { return __hip_atomic_fetch_add(p, v, __ATOMIC_RELAXED, __HIP_MEMORY_SCOPE_AGENT); }
__device__ __forceinline__ unsigned xb_xcc_id() { return (unsigned)__builtin_amdgcn_s_getreg((3 << 11) | 20) & 0xFu; }
#define XB_SPIN(cond, bar) do { unsigned _sp = 0; while (cond) { __builtin_amdgcn_s_sleep(1); \
    if ((++_sp & 255u) == 0u) { if (xb_ld(&(bar)[XB_TMO])) break; if (_sp > XB_SPIN_CAP) { atomicAdd(&(bar)[XB_TMO], 1u); break; } } } } while (0)
struct XcdBarrier { unsigned* bar; unsigned x; volatile LAS unsigned* st; };
__device__ __forceinline__ XcdBarrier xcd_barrier_post(unsigned* bar, volatile LAS unsigned* st) {
    XcdBarrier b; b.bar = bar; b.x = xb_xcc_id(); b.st = st;
    if (threadIdx.x == 0) (void)xb_add(&bar[XB_XCNT(b.x)], 1u);
    return b;
}
__device__ __forceinline__ void xcd_barrier_complete(unsigned* bar, unsigned x, unsigned& nloc, unsigned& nx) {
    const unsigned G = gridDim.x * gridDim.y * gridDim.z;
    unsigned sum, cnt, mine, sp = 0u;
    for (;;) {
        sum = 0u; cnt = 0u; mine = 0u;
#pragma unroll
        for (unsigned j = 0; j < 16; ++j) { const unsigned c = xb_ld(&bar[XB_XCNT(j)]); sum += c; cnt += (c > 0u) ? 1u : 0u; mine = (j == x) ? c : mine; }
        if (sum == G) break;
        __builtin_amdgcn_s_sleep(1);
        if ((++sp & 255u) == 0u) { if (xb_ld(&bar[XB_TMO])) break; if (sp > XB_SPIN_CAP) { atomicAdd(&bar[XB_TMO], 1u); break; } }
    }
    nloc = mine > 0u ? mine : 1u; nx = cnt > 0u ? cnt : 1u;
}
__device__ __forceinline__ void xcd_barrier(const XcdBarrier& b) {
    asm volatile("s_waitcnt vmcnt(0)" ::: "memory");
    __syncthreads();
    if (threadIdx.x == 0) {
        unsigned* bar = b.bar;
        __builtin_amdgcn_s_waitcnt(0);
        unsigned nloc = b.st[0], nx = b.st[1];
        if (nloc == 0u) { xcd_barrier_complete(bar, b.x, nloc, nx); b.st[0] = nloc; b.st[1] = nx; }
        const unsigned old = xb_add(&bar[XB_XSUB(b.x)], 1u);
        const unsigned gen = old / nloc;
        if (old + 1u == (gen + 1u) * nloc) {
            __builtin_amdgcn_fence(__ATOMIC_RELEASE, "agent");
            asm volatile("s_waitcnt vmcnt(0)" ::: "memory");
            const unsigned og = xb_add(&bar[XB_TOP], 1u);
            const unsigned tg = og / nx;
            if (og + 1u == (tg + 1u) * nx) xb_add(&bar[XB_TOPGEN], 1u);
            else XB_SPIN(xb_ld(&bar[XB_TOPGEN]) == tg, bar);
            __builtin_amdgcn_fence(__ATOMIC_ACQUIRE, "agent");
            xb_add(&bar[XB_XGEN(b.x)], 1u);
            asm volatile("s_waitcnt vmcnt(0)" ::: "memory");
        } else {
            XB_SPIN(xb_ld(&bar[XB_XGEN(b.x)]) == gen, bar);
            __builtin_amdgcn_fence(__ATOMIC_ACQUIRE, "agent");
            asm volatile("s_waitcnt vmcnt(0)" ::: "memory");
        }
    }
    __syncthreads();
}

#ifndef TPS
#define TPS 0
#define TPS_WG 0
#endif
#define TPS_POINT(n) do { if (TPS == (n) && F.bid == TPS_WG) F.tp += __builtin_amdgcn_s_memrealtime() - F.tp0; } while (0)
struct Frame {
    LAS unsigned char* lds; unsigned char* ldsg;
    int tid, lane, wave, bid, vcu, G;
    unsigned char* ws;
    unsigned long long tp, tp0;
};
enum { I_X = 0, I_NORM_MIX, I_W_IN, I_B_IN, I_M_NORM, I_A_NORM, I_LAM_QK, I_W_BM, I_W_BD, I_W_O, I_NORM_FFN, I_W_UP, I_CONV_W, I_CONV_B, I_W_DOWN, I_NORM_FINAL, I_OUT, I_NPTR };
constexpr int PTAB_OFF = 131072 + 256;
__device__ __forceinline__ const float* inp(const Frame& F, int i) {
    const LAS unsigned* t = (const LAS unsigned*)(F.lds + PTAB_OFF) + 2 * i;
    const unsigned lo = __builtin_amdgcn_readfirstlane(t[0]), hi = __builtin_amdgcn_readfirstlane(t[1]);
    return (const float*)(const GAS float*)(((unsigned long long)hi << 32) | lo);
}
template <int CTRL, int RM> __device__ __forceinline__ float dppf(float old, float src) {
    return __uint_as_float(__builtin_amdgcn_update_dpp(__float_as_uint(old), __float_as_uint(src), CTRL, RM, 0xf, false)); }
__device__ __forceinline__ float wave_sum(float v) {
    v += dppf<0xB1, 0xf>(0.f, v); v += dppf<0x4E, 0xf>(0.f, v); v += dppf<0x141, 0xf>(0.f, v); v += dppf<0x140, 0xf>(0.f, v);
    { auto rr = __builtin_amdgcn_permlane16_swap(__float_as_uint(v), __float_as_uint(v), false, false); v = __uint_as_float(rr[0]) + __uint_as_float(rr[1]); }
    { auto rr = __builtin_amdgcn_permlane32_swap(__float_as_uint(v), __float_as_uint(v), false, false); v = __uint_as_float(rr[0]) + __uint_as_float(rr[1]); }
    return v;
}
__device__ __forceinline__ float wave_scan_sum(float v) {
    v += dppf<0x111, 0xf>(0.f, v); v += dppf<0x112, 0xf>(0.f, v); v += dppf<0x114, 0xf>(0.f, v); v += dppf<0x118, 0xf>(0.f, v);
    v += dppf<0x142, 0xa>(0.f, v); v += dppf<0x143, 0xc>(0.f, v); return v;
}
__device__ __forceinline__ float wave_scan_max(float v) {
    const float NEG = -__builtin_inff();
    v = fmaxf(v, dppf<0x111, 0xf>(NEG, v)); v = fmaxf(v, dppf<0x112, 0xf>(NEG, v)); v = fmaxf(v, dppf<0x114, 0xf>(NEG, v)); v = fmaxf(v, dppf<0x118, 0xf>(NEG, v));
    v = fmaxf(v, dppf<0x142, 0xa>(NEG, v)); v = fmaxf(v, dppf<0x143, 0xc>(NEG, v)); return v;
}

struct CvtJob { const float* W; bf16* Bt; const float* gain; int Nsrc, K, k0, srccol0, dstrow0, rope; };
constexpr int IT_IN = 32 * 256, IT_SQ = 32 * 32, IT_UP = 32 * 176, IT_DN = 88 * 32, IT_LAYER = IT_IN + 3 * IT_SQ + IT_UP + IT_DN, IT_TOTAL = DEPTH * IT_LAYER, IT_A = IT_IN + 3 * IT_SQ;
__host__ __device__ __forceinline__ int tail_idle(int G) { const int nu = (MTOK / 256) * (NUP / 256), rounds = (nu + G - 1) / G, busy = nu - (rounds - 1) * G; const int idle = G - busy; return idle >= 64 ? idle : 0; }
__device__ __forceinline__ void cvt_decode(const Frame& F, int it, CvtJob& j) {
    const int l = it / IT_LAYER; int r = it - l * IT_LAYER; j.rope = 0; j.gain = nullptr;
    if (r < IT_IN) { const int nb = r >> 5, kt = r & 31, n0 = nb * 64;
        j.W = inp(F, I_W_IN) + (size_t)l * DM * NIN; j.Bt = (bf16*)(F.ws + WS_WIN + (size_t)l * SZ_WIN); j.Nsrc = NIN; j.K = DM; j.k0 = kt * 64; j.gain = inp(F, I_NORM_MIX) + (size_t)l * DM;
        j.srccol0 = n0 < GATE_COL ? n0 : n0 + 16; j.dstrow0 = n0; j.rope = (n0 >= 6144 && n0 < 10240 && (n0 & 127) == 0) ? 1 : 0; return; }
    r -= IT_IN;
    if (r < 3 * IT_SQ) { const int w = r / IT_SQ; r -= w * IT_SQ; const int nb = r >> 5, kt = r & 31;
        j.W = (w == 0 ? inp(F, I_W_BM) : (w == 1 ? inp(F, I_W_BD) : inp(F, I_W_O))) + (size_t)l * DM * DM;
        j.Bt = (bf16*)(F.ws + (w == 0 ? WS_WBM : (w == 1 ? WS_WBD : WS_WO)) + (size_t)l * SZ_WSQ); j.Nsrc = DM; j.K = DM; j.k0 = kt * 64; j.srccol0 = nb * 64; j.dstrow0 = nb * 64; return; }
    r -= 3 * IT_SQ;
    if (r < IT_UP) { const int nb = r >> 5, kt = r & 31, n0 = nb * 64, pn = n0 >> 8, w = n0 & 255;
        j.W = inp(F, I_W_UP) + (size_t)l * DM * NUP; j.Bt = (bf16*)(F.ws + WS_WUP + (size_t)l * SZ_WUP); j.Nsrc = NUP; j.K = DM; j.k0 = kt * 64; j.gain = inp(F, I_NORM_FFN) + (size_t)l * DM;
        j.srccol0 = (w < 128) ? pn * 128 + w : DFF + pn * 128 + (w - 128); j.dstrow0 = n0; return; }
    r -= IT_UP;
    { const int nb = r / 88, kt = r - nb * 88;
      j.W = inp(F, I_W_DOWN) + (size_t)l * DFF * DM; j.Bt = (bf16*)(F.ws + WS_WDN + (size_t)l * SZ_WDN); j.Nsrc = DM; j.K = DFF; j.k0 = kt * 64; j.srccol0 = nb * 64; j.dstrow0 = nb * 64; }
}
__device__ __forceinline__ void cvt_load(const CvtJob& j, int lane, f32x4 (&v)[16], float (&gn)[16]) {
    const float* p = j.W + (size_t)(j.k0 + (lane >> 4)) * j.Nsrc + j.srccol0 + (lane & 15) * 4;
#pragma unroll
    for (int i = 0; i < 16; ++i) v[i] = *(const f32x4*)(p + (size_t)(4 * i) * j.Nsrc);
#pragma unroll
    for (int i = 0; i < 16; ++i) gn[i] = j.gain ? j.gain[j.k0 + (lane >> 4) + 4 * i] : 1.0f;
}
__device__ __forceinline__ void cvt_store(const CvtJob& j, int lane, const f32x4 (&v)[16], const float (&gn)[16], LAS float* scr) {
#pragma unroll
    for (int i = 0; i < 16; ++i) { const int r = (lane >> 4) + 4 * i, n = (lane & 15) * 4; *(LAS f32x4*)(scr + r * 64 + (n ^ ((i >> 1) << 2))) = v[i] * gn[i]; }
    LDS_WAIT(); asm volatile("" ::: "memory");
    const int c = lane & 7;
#pragma unroll
    for (int i = 0; i < 8; ++i) { const int n = (lane >> 3) + 8 * i; const LAS float* s = scr + (8 * c) * 64 + (n ^ (c << 2));
        v4u o; o.x = pk2(s[0 * 64], s[1 * 64]); o.y = pk2(s[2 * 64], s[3 * 64]); o.z = pk2(s[4 * 64], s[5 * 64]); o.w = pk2(s[6 * 64], s[7 * 64]);
        int nd = n; if (j.rope && n < 32) nd = (n < 16) ? 2 * n : 2 * (n - 16) + 1;
        *(v4u*)(j.Bt + (size_t)(j.dstrow0 + nd) * j.K + j.k0 + 8 * c) = o; }
    LDS_WAIT(); asm volatile("" ::: "memory");
}
__device__ __forceinline__ void sincos_d(double ang, float& s, float& c) {
    const double TWO_PI = 6.283185307179586476925286766559; const double k = rint(ang / TWO_PI); const double r = ang - k * TWO_PI; const double r2 = r * r;
    double ts = 1.0, tc = 1.0, ss = 1.0, cc = 1.0;
#pragma unroll
    for (int i = 1; i <= 16; ++i) { tc = -tc * r2 / (double)((2 * i - 1) * (2 * i)); ts = -ts * r2 / (double)((2 * i) * (2 * i + 1)); cc += tc; ss += ts; }
    s = (float)(ss * r); c = (float)cc;
}
__device__ __forceinline__ void cvt_run(Frame& F, int it0, int n, int w, int nw) {
    LAS float* scr = (LAS float*)(F.lds + F.wave * 16384);
    const int per = (n + nw - 1) / nw; int it = it0 + w * per; const int it1 = (it + per < it0 + n) ? it + per : it0 + n;
    CvtJob j0, j1; f32x4 v0[16], v1[16]; float g0[16], g1[16];
    if (it < it1) { cvt_decode(F, it, j0); cvt_load(j0, F.lane, v0, g0); }
    for (; it < it1; it += 2) {
        if (it + 1 < it1) { cvt_decode(F, it + 1, j1); cvt_load(j1, F.lane, v1, g1); }
        cvt_store(j0, F.lane, v0, g0, scr);
        if (it + 1 >= it1) break;
        if (it + 2 < it1) { cvt_decode(F, it + 2, j0); cvt_load(j0, F.lane, v0, g0); }
        cvt_store(j1, F.lane, v1, g1, scr);
    }
}
__device__ __forceinline__ void p0_prologue(Frame& F) {
    const int gw = F.bid * NWAVES + F.wave, NGW = F.G * NWAVES;
    cvt_run(F, 0, tail_idle(F.G) ? IT_A : IT_LAYER, gw, NGW);
    const int gt = F.bid * 512 + F.tid, NGT = F.G * 512;
    { float* bg = (float*)(F.ws + WS_BIASG);
      for (int i = gt; i < DEPTH * NING; i += NGT) { const int l = i >> 14, n = i & (NING - 1); int src = n < GATE_COL ? n : n + 16;
          if (n >= 6144 && n < 10240 && (n & 127) < 32) { const int p = n & 127, dim = (p & 1) ? 16 + (p >> 1) : (p >> 1); src = (n & ~127) + dim + 16; }
          bg[i] = inp(F, I_B_IN)[(size_t)l * NIN + src]; } }
    { unsigned short* gwf = (unsigned short*)(F.ws + WS_GWF);
      for (int i = gt; i < DEPTH * DM * 4; i += NGT) { const int l = i >> 13, k = (i >> 2) & (DM - 1), q = i & 3;
          const f32x4 w = *(const f32x4*)(inp(F, I_W_IN) + (size_t)l * DM * NIN + (size_t)k * NIN + GATE_COL + 4 * q) * inp(F, I_NORM_MIX)[l * DM + k];
          const int ks = k >> 5, kq = (k >> 3) & 3, e = k & 7;
#pragma unroll
          for (int j = 0; j < 4; ++j) { const unsigned hi = pk2(w[j], 0.f) & 0xffffu; const unsigned lo = pk2(w[j] - __uint_as_float(hi << 16), 0.f) & 0xffffu;
              const size_t o = ((((size_t)l * 64 + ks) * 2) * 64 + 16 * kq + 4 * q + j) * 8 + e;
              gwf[o] = (unsigned short)hi; gwf[o + 64 * 8] = (unsigned short)lo; } } }
    { float* rp = (float*)(F.ws + WS_ROPE);
      for (int i = gt; i < SEQ * 16; i += NGT) { const int pos = i >> 4, k = i & 15; const double inv = exp2(-(double)k * (18.931568569324174 / 16.0));
          float s, c; sincos_d((double)pos * inv, s, c); rp[pos * 32 + k] = c; rp[pos * 32 + 16 + k] = s; } }
    { bf16* xn = (bf16*)(F.ws + WS_XN); pg8::u64_t* rb = (pg8::u64_t*)(F.ws + WS_ROWSS_B); const float* x = inp(F, I_X);
      for (int row = gw; row < MTOK; row += NGW) { const f32x4* xr = (const f32x4*)(x + (size_t)row * DM) + F.lane; v2u* o8 = (v2u*)(xn + (size_t)row * DM) + F.lane; float ss = 0.f;
          f32x4 xv8[8];
#pragma unroll
          for (int j = 0; j < 8; ++j) xv8[j] = xr[64 * j];
#pragma unroll
          for (int j = 0; j < 8; ++j) { const f32x4 v = xv8[j]; v2u w; w.x = pk2(v.x, v.y); w.y = pk2(v.z, v.w); o8[64 * j] = w;
              ss += (pg8::bf_lo(w.x) * pg8::bf_lo(w.x) + pg8::bf_hi(w.x) * pg8::bf_hi(w.x)) + (pg8::bf_lo(w.y) * pg8::bf_lo(w.y) + pg8::bf_hi(w.y) * pg8::bf_hi(w.y)); }
          ss = wave_sum(ss); if (F.lane == 0) rb[row] = pg8::ss_fix(ss); } }
}

__device__ __forceinline__ void gates_step(Frame& F, int l, gu32* cnt) {
    const float* bl = inp(F, I_B_IN) + (size_t)l * NIN;
    const bf16* hb = (const bf16*)(F.ws + WS_XN); const pg8::u64_t* rowss = (const pg8::u64_t*)(F.ws + WS_ROWSS_B); float* gates = (float*)(F.ws + WS_GATES);
    const bf16* gwf = (const bf16*)(F.ws + WS_GWF) + (size_t)l * (64 * 2 * 64 * 8);
    LAS float* RED = (LAS float*)F.lds;
    const int fr = F.lane & 15, fq = F.lane >> 4;
    const int orow = F.tid >> 4, on = F.tid & 15;
    const float bgl = bl[GATE_COL + on];
    for (int rb = F.bid; rb < MTOK / 32; rb += F.G) { const int r0 = rb * 32;
        v4u a[2][8], b[8][2];
#pragma unroll
        for (int ks = 0; ks < 8; ++ks)
#pragma unroll
            for (int t = 0; t < 2; ++t) a[t][ks] = *(const v4u*)(hb + (size_t)(r0 + 16 * t + fr) * DM + 256 * F.wave + 32 * ks + 8 * fq);
#pragma unroll
        for (int ks = 0; ks < 8; ++ks)
#pragma unroll
            for (int hl = 0; hl < 2; ++hl) b[ks][hl] = *(const v4u*)(gwf + ((size_t)((8 * F.wave + ks) * 2 + hl) * 64 + F.lane) * 8);
        const pg8::u64_t rsu = rowss[r0 + orow];
        f32x4 acc[2]; acc[0] = acc[1] = (f32x4){0.f, 0.f, 0.f, 0.f};
#pragma unroll
        for (int ks = 0; ks < 8; ++ks)
#pragma unroll
            for (int hl = 0; hl < 2; ++hl)
#pragma unroll
                for (int t = 0; t < 2; ++t) acc[t] = __builtin_amdgcn_mfma_f32_16x16x32_bf16(__builtin_bit_cast(pg8::bf16x8, a[t][ks]), __builtin_bit_cast(pg8::bf16x8, b[ks][hl]), acc[t], 0, 0, 0);
#pragma unroll
        for (int t = 0; t < 2; ++t) *(LAS f32x4*)(RED + ((F.wave * 2 + t) * 64 + F.lane) * 4) = acc[t];
        __syncthreads();
        { const int t = orow >> 4, q = (orow >> 2) & 3, r = orow & 3; float sum = 0.f;
#pragma unroll
          for (int w = 0; w < 8; ++w) sum += RED[((w * 2 + t) * 64 + 16 * q + on) * 4 + r];
          const float rs = 1.0f / sqrtf(pg8::ss_f32(rsu) * (1.0f / DM) + EPS);
          __hip_atomic_store(gates + (size_t)(r0 + orow) * 16 + on, sum * rs + bgl, RLX_AGENT); }
        __syncthreads();
    }
    VM_WAIT(); __syncthreads();
    if (F.tid == 0) __hip_atomic_fetch_add(cnt, 1u, RLX_AGENT);
}
__device__ __forceinline__ void gates_wait(Frame& F, gu32* cnt) {
    if (threadIdx.x == 0) { unsigned sp = 0; gu32* tmo = (gu32*)(F.ws + WS_CTL) + CW_TMO;
        while (__hip_atomic_load(cnt, RLX_AGENT) < (unsigned)F.G) { __builtin_amdgcn_s_sleep(2); if (++sp > (1u << 22)) { __hip_atomic_store(tmo, 1u, RLX_AGENT); break; } }
        __builtin_amdgcn_fence(__ATOMIC_ACQUIRE, "agent"); VM_WAIT(); }
    __syncthreads();
}

__device__ __forceinline__ float logsigmoidf_(float x) { return fminf(x, 0.f) - log1pf(__expf(-fabsf(x))); }
__device__ __forceinline__ void mlstm_prep(Frame& F, int b, int hh) {
    const float* gates = (const float*)(F.ws + WS_GATES);
    float* a2 = (float*)(F.ldsg + ab::A2_OFF); float* M2 = (float*)(F.ldsg + ab::M2_OFF); float* e2 = (float*)(F.ldsg + ab::E2_OFF); float* sc = (float*)(F.ldsg + ab::SCAN_OFF);
    int tid_ = F.tid; asm volatile("" : "+v"(tid_));
    const int lane_ = tid_ & 63;
    float lf[4], ig[4];
#pragma unroll
    for (int e = 0; e < 4; ++e) { const size_t idx = (size_t)(b * SEQ + 4 * tid_ + e) * 16; ig[e] = gates[idx + hh]; lf[e] = logsigmoidf_(gates[idx + 8 + hh]); }
    float c[4]; c[0] = lf[0]; c[1] = c[0] + lf[1]; c[2] = c[1] + lf[2]; c[3] = c[2] + lf[3];
    const float incl = wave_scan_sum(c[3]);
    if (lane_ == 63) sc[F.wave] = incl;
    __syncthreads();
    float wp = 0.f;
    for (int w = 0; w < F.wave; ++w) wp += sc[w];
    const float base = wp + incl - c[3];
    float Bv[4], av[4], mx[4];
#pragma unroll
    for (int e = 0; e < 4; ++e) { Bv[e] = base + c[e]; av[e] = ig[e] - Bv[e]; }
    mx[0] = av[0]; mx[1] = fmaxf(mx[0], av[1]); mx[2] = fmaxf(mx[1], av[2]); mx[3] = fmaxf(mx[2], av[3]);
    const float im = wave_scan_max(mx[3]);
    if (lane_ == 63) sc[16 + F.wave] = im;
    const float ex = dppf<0x138, 0xf>(-__builtin_inff(), im);
    __syncthreads();
    float wm = -__builtin_inff();
    for (int w = 0; w < F.wave; ++w) wm = fmaxf(wm, sc[16 + w]);
    const float pre = fmaxf(wm, ex);
    const float L2E = 1.4426950408889634f;
#pragma unroll
    for (int e = 0; e < 4; ++e) { const float M = fmaxf(pre, mx[e]); const int t = 4 * tid_ + e; a2[t] = av[e] * L2E; M2[t] = M * L2E; e2[t] = -(Bv[e] + M) * L2E; }
    __syncthreads();
}
__device__ __forceinline__ ab::BlockRef att_ref(Frame& F, int qt) {
    const int q = qt >> 8, t = qt & 255, hv = 16 * q + (t & 15), qb = 7 - (t >> 4), vh = hv & 1, c = (hv >> 1) & 1, hh = (hv >> 2) & 7, b = hv >> 5;
    ab::BlockRef r;
    r.Q = (const bf16*)(F.ws + WS_AQ) + (size_t)(b * SEQ + qb * 256) * 2048 + hh * 256 + c * 128;
    r.K = (const bf16*)(F.ws + WS_AK) + (size_t)(b * SEQ) * 2048 + hh * 256 + c * 128;
    r.V = (const bf16*)(F.ws + WS_AV) + (size_t)(b * SEQ) * 2048 + hh * 256 + vh * 128;
    r.O = (float*)((bf16*)(F.ws + WS_OATT) + (size_t)(b * SEQ + qb * 256) * 4096 + hh * 512 + c * 256 + vh * 128);
    r.P0 = qb * 256; r.Cst = nullptr; r.nst = nullptr; return r;
}
__device__ __forceinline__ ab::BlockRef mls_ref(Frame& F, int t) {
    const int bh = t >> 4, qb = (t >> 1) & 7, vh = t & 1, hh = bh & 7, b = bh >> 3;
    ab::BlockRef r;
    r.Q = (const bf16*)(F.ws + WS_MQ) + (size_t)(b * SEQ + qb * 256) * 1024 + hh * 128;
    r.K = (const bf16*)(F.ws + WS_MK) + (size_t)(b * SEQ) * 1024 + hh * 128;
    r.V = (const bf16*)(F.ws + WS_MV) + (size_t)(b * SEQ) * 2048 + hh * 256 + vh * 128;
    r.O = (float*)((bf16*)(F.ws + WS_HRAW) + (size_t)(b * SEQ + qb * 256) * 2048 + hh * 256 + vh * 128);
    r.P0 = qb * 256;
    r.Cst = qb ? (const bf16*)(F.ws + WS_CST) + ((size_t)(bh * 7 + qb - 1) * 128) * 256 + vh * 128 : nullptr;
    r.nst = qb ? (const float*)(F.ws + WS_NST) + (size_t)(bh * 7 + qb - 1) * 128 : nullptr;
    return r;
}
__device__ __forceinline__ ab::bf16x8 scale8(ab::bf16x8 v, float w) {
    ab::u32x4 q = *reinterpret_cast<ab::u32x4*>(&v); ab::u32x4 o;
    o.x = ab::cvtpk(__uint_as_float(q.x << 16) * w, __uint_as_float(q.x & 0xffff0000u) * w); o.y = ab::cvtpk(__uint_as_float(q.y << 16) * w, __uint_as_float(q.y & 0xffff0000u) * w);
    o.z = ab::cvtpk(__uint_as_float(q.z << 16) * w, __uint_as_float(q.z & 0xffff0000u) * w); o.w = ab::cvtpk(__uint_as_float(q.w << 16) * w, __uint_as_float(q.w & 0xffff0000u) * w);
    return *reinterpret_cast<ab::bf16x8*>(&o);
}
__device__ __forceinline__ float sum8(ab::bf16x8 v) {
    const ab::u32x4 q = *reinterpret_cast<const ab::u32x4*>(&v);
    return ((__uint_as_float(q.x << 16) + __uint_as_float(q.x & 0xffff0000u)) + (__uint_as_float(q.y << 16) + __uint_as_float(q.y & 0xffff0000u)))
         + ((__uint_as_float(q.z << 16) + __uint_as_float(q.z & 0xffff0000u)) + (__uint_as_float(q.w << 16) + __uint_as_float(q.w & 0xffff0000u)));
}
__device__ __forceinline__ void mls_scan(Frame& F, int bh, const int tid) {
    using namespace ab;
    char* lds = (char*)F.ldsg; const int b = bh >> 3, hh = bh & 7;
    const float* a2 = (const float*)(lds + A2_OFF); const float* M2 = (const float*)(lds + M2_OFF);
    const int wid = __builtin_amdgcn_readfirstlane(tid >> 6), lane = tid & 63, r32 = lane & 31, hi = lane >> 5, dgrp = wid & 3, vh = wid >> 2;
    const int sr = tid >> 4, sc = (tid & 15) * 8, vst0 = v_st(sr, sc), vst1 = v_st(32 + sr, sc);
    const bf16* Kp = (const bf16*)(F.ws + WS_MK) + (size_t)(b * SEQ) * 1024 + hh * 128;
    const bf16* Vp = (const bf16*)(F.ws + WS_MV) + (size_t)(b * SEQ) * 2048 + hh * 256;
    bf16* Cst = (bf16*)(F.ws + WS_CST) + (size_t)(bh * 7) * 128 * 256; float* nst = (float*)(F.ws + WS_NST) + (size_t)(bh * 7) * 128;
    const unsigned lok = (unsigned)((lane >> 4) * 1024 + sc), lov = (unsigned)((lane >> 4) * 2048 + sc);
    f32x16 C[4] = {}; float nacc = 0.f;
    const int vbA = (int)(uintptr_t)lds + v_rd_base(lane) + dgrp * 512;
    const int vbB = (int)(uintptr_t)lds + v_rd_base(lane) + 16384 * (1 + vh);
    bf16x8 ka[4], kb[4], va[4], vb[4], vc[4], vd[4];
#define SC_LOAD(i, s0) do { const bf16* kp_ = Kp + (size_t)((s0) + wid * 4) * 1024; const bf16* vp_ = Vp + (size_t)((s0) + wid * 4) * 2048; \
        ka[i] = load8(kp_ + lok); kb[i] = load8(kp_ + 32 * 1024 + lok); va[i] = load8(vp_ + lov); vb[i] = load8(vp_ + 32 * 2048 + lov); vc[i] = load8(vp_ + 128 + lov); vd[i] = load8(vp_ + 32 * 2048 + 128 + lov); } while (0)
#define SC_TRRD(dst, base, off) asm volatile("ds_read_b64_tr_b16 %0, %1 offset:%2" : "=&v"(dst) : "v"(base), "i"(off) : "memory")
#define SC_D0(d0) do { s16x4 l0, l1, l2, l3, h0, h1, h2, h3; constexpr int b_ = (d0) * 512; \
            SC_TRRD(l0, vbB, b_); SC_TRRD(h0, vbB, b_ + 2048); SC_TRRD(l1, vbB, b_ + 4096); SC_TRRD(h1, vbB, b_ + 6144); SC_TRRD(l2, vbB, b_ + 8192); SC_TRRD(h2, vbB, b_ + 10240); SC_TRRD(l3, vbB, b_ + 12288); SC_TRRD(h3, vbB, b_ + 14336); \
            asm volatile("s_waitcnt lgkmcnt(0)" ::: "memory"); SBAR(); \
            C[d0] = __builtin_amdgcn_mfma_f32_32x32x16_bf16(A0, (bf16x8){l0[0], l0[1], l0[2], l0[3], h0[0], h0[1], h0[2], h0[3]}, C[d0], 0, 0, 0); \
            C[d0] = __builtin_amdgcn_mfma_f32_32x32x16_bf16(A1, (bf16x8){l1[0], l1[1], l1[2], l1[3], h1[0], h1[1], h1[2], h1[3]}, C[d0], 0, 0, 0); \
            C[d0] = __builtin_amdgcn_mfma_f32_32x32x16_bf16(A2, (bf16x8){l2[0], l2[1], l2[2], l2[3], h2[0], h2[1], h2[2], h2[3]}, C[d0], 0, 0, 0); \
            C[d0] = __builtin_amdgcn_mfma_f32_32x32x16_bf16(A3, (bf16x8){l3[0], l3[1], l3[2], l3[3], h3[0], h3[1], h3[2], h3[3]}, C[d0], 0, 0, 0); } while (0)
#pragma unroll
    for (int i = 0; i < 4; ++i) SC_LOAD(i, 64 * i);
    for (int j = 0; j < 7; ++j) {
        const float mNew = M2[256 * (j + 1) - 1];
        if (j > 0) { const float dec = __builtin_amdgcn_exp2f(M2[256 * j - 1] - mNew);
#pragma unroll
            for (int d_ = 0; d_ < 4; ++d_)
#pragma unroll
                for (int r = 0; r < 16; ++r) C[d_][r] *= dec;
            nacc *= dec; }
#pragma unroll
        for (int tt = 0; tt < 4; ++tt) {
            const int s0 = 256 * j + 64 * tt;
            const float w0 = __builtin_amdgcn_exp2f(a2[s0 + sr] - mNew), w1 = __builtin_amdgcn_exp2f(a2[s0 + 32 + sr] - mNew);
            if (j < 6) { asm volatile("s_waitcnt vmcnt(18)" ::: "memory"); } else { asm volatile("s_waitcnt vmcnt(0)" ::: "memory"); }
            const bf16x8 ks0 = scale8(ka[tt], w0), ks1 = scale8(kb[tt], w1);
            __syncthreads();
            *(bf16x8*)(lds + vst0) = ks0; *(bf16x8*)(lds + vst1) = ks1;
            *(bf16x8*)(lds + 16384 + vst0) = va[tt]; *(bf16x8*)(lds + 16384 + vst1) = vb[tt]; *(bf16x8*)(lds + 32768 + vst0) = vc[tt]; *(bf16x8*)(lds + 32768 + vst1) = vd[tt];
            SBAR();
            if (j < 6) SC_LOAD(tt, s0 + 256);
            __syncthreads();
            s16x4 al0, ah0, al1, ah1, al2, ah2, al3, ah3;
            SC_TRRD(al0, vbA, 0); SC_TRRD(ah0, vbA, 2048); SC_TRRD(al1, vbA, 4096); SC_TRRD(ah1, vbA, 6144); SC_TRRD(al2, vbA, 8192); SC_TRRD(ah2, vbA, 10240); SC_TRRD(al3, vbA, 12288); SC_TRRD(ah3, vbA, 14336);
            asm volatile("s_waitcnt lgkmcnt(0)" ::: "memory"); SBAR();
            const bf16x8 A0 = (bf16x8){al0[0], al0[1], al0[2], al0[3], ah0[0], ah0[1], ah0[2], ah0[3]}, A1 = (bf16x8){al1[0], al1[1], al1[2], al1[3], ah1[0], ah1[1], ah1[2], ah1[3]};
            const bf16x8 A2 = (bf16x8){al2[0], al2[1], al2[2], al2[3], ah2[0], ah2[1], ah2[2], ah2[3]}, A3 = (bf16x8){al3[0], al3[1], al3[2], al3[3], ah3[0], ah3[1], ah3[2], ah3[3]};
            if (vh == 0) nacc += (sum8(A0) + sum8(A1)) + (sum8(A2) + sum8(A3));
            SC_D0(0); SC_D0(1); SC_D0(2); SC_D0(3);
        }
        { float nt = nacc; auto rr = __builtin_amdgcn_permlane32_swap(__float_as_uint(nt), __float_as_uint(nt), false, false); nt = __uint_as_float(rr[0]) + __uint_as_float(rr[1]);
          if (vh == 0 && hi == 0) nst[j * 128 + 32 * dgrp + r32] = nt; }
        bf16* Cj = Cst + ((size_t)j * 128 + 32 * dgrp) * 256 + 128 * vh; const unsigned loc = (unsigned)(4 * hi * 256 + r32);
#pragma unroll
        for (int r = 0; r < 16; ++r) { bf16* Cr = Cj + (size_t)((r & 3) + 8 * (r >> 2)) * 256;
#pragma unroll
            for (int d0 = 0; d0 < 4; ++d0) { const float v = C[d0][r]; const float nb = dppf<0xB1, 0xf>(0.f, v);
                if ((r32 & 1) == 0) *(unsigned*)(Cr + d0 * 32 + loc) = cvtpk(v, nb); } }
    }
#undef SC_LOAD
#undef SC_TRRD
#undef SC_D0
}
__device__ __forceinline__ void mls_finalise(Frame& F, int l, int bh, int qb) {
    int tid_ = threadIdx.x; asm volatile("" : "+v"(tid_)); const int lane_ = tid_ & 63;
    const int b = bh >> 3, hh = bh & 7; const bf16* hraw = (const bf16*)(F.ws + WS_HRAW); const bf16* smo = (const bf16*)(F.ws + WS_SMO); bf16* hmn = (bf16*)(F.ws + WS_HMN);
    const f32x4 g = *(const f32x4*)(inp(F, I_M_NORM) + (size_t)l * 2048 + hh * 256 + 4 * lane_);
    const size_t base = (size_t)(b * SEQ + qb * 256 + F.wave * 32) * 2048 + hh * 256 + 4 * lane_;
#pragma unroll 1
    for (int r0 = 0; r0 < 32; r0 += 16) {
        v2u hv[16], sw[16];
#pragma unroll
        for (int r = 0; r < 16; ++r) { hv[r] = *(const v2u*)(hraw + base + (size_t)(r0 + r) * 2048); sw[r] = *(const v2u*)(smo + base + (size_t)(r0 + r) * 2048); }
#pragma unroll
        for (int r = 0; r < 16; ++r) { const f32x4 x = (f32x4){pg8::bf_lo(hv[r].x), pg8::bf_hi(hv[r].x), pg8::bf_lo(hv[r].y), pg8::bf_hi(hv[r].y)};
            const float rs = 1.0f / sqrtf(wave_sum((x.x * x.x + x.y * x.y) + (x.z * x.z + x.w * x.w)) * (1.0f / 256.0f) + EPS);
            const f32x4 sg = (f32x4){pg8::bf_lo(sw[r].x), pg8::bf_hi(sw[r].x), pg8::bf_lo(sw[r].y), pg8::bf_hi(sw[r].y)};
            const f32x4 o = x * rs * g * sg; v2u w; w.x = pk2(o.x, o.y); w.y = pk2(o.z, o.w); *(v2u*)(hmn + base + (size_t)(r0 + r) * 2048) = w; }
    }
}
__device__ __forceinline__ void wait_word_ge(Frame& F, gu32* w, unsigned need) {
    if (threadIdx.x == 0) { unsigned sp = 0; gu32* tmo = (gu32*)(F.ws + WS_CTL) + CW_TMO;
        while (__hip_atomic_load(w, RLX_AGENT) < need) { __builtin_amdgcn_s_sleep(2); if (++sp > (1u << 22)) { __hip_atomic_store(tmo, 1u, RLX_AGENT); break; } }
        __builtin_amdgcn_fence(__ATOMIC_ACQUIRE, "agent"); VM_WAIT(); }
    __syncthreads();
}
__device__ __forceinline__ void mix_phase(Frame& F, int l, int rep) {
    char* lds = (char*)F.ldsg;
    constexpr int NMLS = 512, NSCAN = 32, NCVT = 64, NCVT1 = 64;
    gu32* ctl = (gu32*)(F.ws + WS_CTL);
    gu32* gcnt = ctl + CW_GCNT + 64 * (l + 4 * rep); gu32* sflag = ctl + CW_SFLAG + 64 * ((l + 4 * rep) * 32); gu32* tick = ctl + CW_TICK + 64 * (l + 4 * rep);
    if (TPS) F.tp0 = __builtin_amdgcn_s_memrealtime();
    gates_step(F, l, gcnt);
    TPS_POINT(1);
    { const bool tl = tail_idle(F.G) != 0; const int ncvt = (!tl || l == 0) ? NCVT : NCVT1;
      if (l + 1 < DEPTH && rep == 0 && F.bid >= NSCAN && F.bid < NSCAN + ncvt) {
        const int c0 = !tl ? (l + 1) * IT_LAYER : (l == 0 ? IT_A : (l + 1) * IT_LAYER), cn = !tl ? IT_LAYER : (l == 0 ? IT_LAYER : IT_A);
        cvt_run(F, c0, cn, (F.bid - NSCAN) * NWAVES + F.wave, ncvt * NWAVES);
        VM_WAIT(); __syncthreads();
      } }
    if (F.bid < NSCAN) {
        gates_wait(F, gcnt);
        int tid_s = threadIdx.x; asm volatile("" : "+v"(tid_s));
        mlstm_prep(F, F.bid >> 3, F.bid & 7);
        mls_scan(F, F.bid, tid_s);
        VM_WAIT(); __syncthreads();
        if (threadIdx.x == 0) { __builtin_amdgcn_fence(__ATOMIC_RELEASE, "agent"); VM_WAIT(); __hip_atomic_store(sflag + 64 * F.bid, 1u, RLX_AGENT); }
        __syncthreads();
        TPS_POINT(2);
    }
#ifndef NO_ATT
    { volatile LAS unsigned* tw = (volatile LAS unsigned*)(F.lds + MISC_OFF) + 16; gu32* atick = ctl + CW_ATICK + 64 * (8 * (l + 4 * rep));
      const int q0 = (int)(xb_xcc_id() & 7u); int qdone = 0;
#define TAKE_ATT(dst) do { if (threadIdx.x == 0) { int r_ = -1; for (int i_ = 0; i_ < 8; ++i_) { const int q_ = (q0 + i_) & 7; if (qdone & (1 << q_)) continue;               \
            const unsigned t_ = __hip_atomic_fetch_add(atick + 64 * q_, 1u, RLX_AGENT); if (t_ < 128u) { r_ = (q_ << 8) | (int)t_; break; } qdone |= 1 << q_; } tw[0] = (unsigned)r_; } \
        PP_BAR(); dst = __builtin_amdgcn_readfirstlane((int)tw[0]); PP_BAR(); } while (0)
      int qt; TAKE_ATT(qt);
      if (qt >= 0) {
          ab::BlockRef cur = att_ref(F, qt); ab::Seam S;
          int tid_a = threadIdx.x; asm volatile("" : "+v"(tid_a));
          if (F.wave < 4) __builtin_amdgcn_s_setprio(1);
          ab::prime2<0, 2048, 2048, 2048>(cur, lds, S, tid_a);
          for (;;) {
              int qn; TAKE_ATT(qn);
              const bool last = qn < 0;
              const ab::BlockRef nxt = last ? cur : att_ref(F, qn);
              ab::block2<0, 2048, 2048, 2048, 4096>(cur, nxt, lds, S, tid_a);
              if (last) break;
              cur = nxt;
          }
          ab::pp_realign(tid_a);
          __builtin_amdgcn_s_setprio(0);
      }
#undef TAKE_ATT
    }
#endif
    VM_WAIT(); __syncthreads();
    TPS_POINT(3);
#ifndef NO_MLS
    gates_wait(F, gcnt);
    TPS_POINT(4);
    { volatile LAS unsigned* tw = (volatile LAS unsigned*)(F.lds + MISC_OFF) + 16;
#define TAKE_TICKET(dst) do { if (threadIdx.x == 0) tw[0] = __hip_atomic_fetch_add(tick, 1u, RLX_AGENT); __syncthreads(); dst = __builtin_amdgcn_readfirstlane((int)tw[0]); __syncthreads(); } while (0)
      for (;;) {
          int t2; TAKE_TICKET(t2);
          if (t2 >= NMLS / 2) break;
          int tid_m = threadIdx.x; asm volatile("" : "+v"(tid_m));
          const int bh = t2 >> 3;
          mlstm_prep(F, bh >> 3, bh & 7); wait_word_ge(F, sflag + 64 * bh, 1u);
          const ab::BlockRef c0 = mls_ref(F, 2 * t2), c1 = mls_ref(F, 2 * t2 + 1); ab::Seam S;
          if (F.wave < 4) __builtin_amdgcn_s_setprio(1);
          ab::prime2<1, 1024, 1024, 2048>(c0, lds, S, tid_m);
          ab::block2<1, 1024, 1024, 2048, 2048>(c0, c1, lds, S, tid_m);
          ab::block2<1, 1024, 1024, 2048, 2048>(c1, c1, lds, S, tid_m);
          ab::pp_realign(tid_m);
          __builtin_amdgcn_s_setprio(0);
          VM_WAIT(); __syncthreads();
          mls_finalise(F, l, bh, t2 & 7);
      }
#undef TAKE_TICKET
    }
    VM_WAIT(); __syncthreads();
#endif
    TPS_POINT(5);
}

__device__ __forceinline__ void fin_phase(Frame& F, int l) {
    const float* lq = inp(F, I_LAM_QK) + (size_t)l * 512;
    const float s1 = wave_sum(lq[F.lane] * lq[128 + F.lane] + lq[64 + F.lane] * lq[192 + F.lane]);
    const float s2 = wave_sum(lq[256 + F.lane] * lq[384 + F.lane] + lq[320 + F.lane] * lq[448 + F.lane]);
    const float lam_init = l == 0 ? 0.2f : (l == 1 ? 0.3555090675909693f : (l == 2 ? 0.4707130183435842f : 0.5560582041556406f));
    const float lam = expf(s1) - expf(s2) + lam_init, post = 1.0f - lam_init;
    const bf16* oat = (const bf16*)(F.ws + WS_OATT); bf16* han = (bf16*)(F.ws + WS_HAN);
    { pg8::u64_t* rowss = (pg8::u64_t*)(F.ws + WS_ROWSS); pg8::u64_t* rowsb = (pg8::u64_t*)(F.ws + WS_ROWSS_B); for (int i = F.bid * 512 + F.tid; i < MTOK; i += F.G * 512) { rowss[i] = 0ull; rowsb[i] = 0ull; } }
    const int gw = F.bid * NWAVES + F.wave, NGW = F.G * NWAVES;
    const float* ag = inp(F, I_A_NORM) + (size_t)l * 2048;
    f32x4 agv[8];
#pragma unroll
    for (int hh = 0; hh < 8; ++hh) agv[hh] = *(const f32x4*)(ag + hh * 256 + 4 * F.lane);
    for (int row = gw; row < MTOK; row += 2 * NGW) {
        const bool two = row + NGW < MTOK; v2u ra[2][8], rc[2][8];
#pragma unroll
        for (int r = 0; r < 2; ++r) if (r == 0 || two) { const size_t ro = (size_t)(row + r * NGW) * 4096;
#pragma unroll
            for (int hh = 0; hh < 8; ++hh) { ra[r][hh] = *(const v2u*)(oat + ro + hh * 512 + 4 * F.lane); rc[r][hh] = *(const v2u*)(oat + ro + hh * 512 + 256 + 4 * F.lane); } }
#pragma unroll
        for (int r = 0; r < 2; ++r) if (r == 0 || two) {
#pragma unroll
            for (int hh = 0; hh < 8; ++hh) { const int col = hh * 256 + 4 * F.lane; const v2u a = ra[r][hh], c = rc[r][hh];
                const f32x4 v = (f32x4){pg8::bf_lo(a.x), pg8::bf_hi(a.x), pg8::bf_lo(a.y), pg8::bf_hi(a.y)} - (f32x4){pg8::bf_lo(c.x), pg8::bf_hi(c.x), pg8::bf_lo(c.y), pg8::bf_hi(c.y)} * lam;
                const float rs = 1.0f / sqrtf(wave_sum((v.x * v.x + v.y * v.y) + (v.z * v.z + v.w * v.w)) * (1.0f / 256.0f) + EPS);
                const f32x4 g = agv[hh];
                const f32x4 o = v * rs * g * post; v2u w; w.x = pk2(o.x, o.y); w.y = pk2(o.z, o.w); *(v2u*)(han + (size_t)(row + r * NGW) * 2048 + col) = w; } }
    }
}

__device__ __forceinline__ void conv_fixup_panel(Frame& F, int l, int pm) {
    const float* fxc = (const float*)(F.ws + WS_FXC); const float* fxv = (const float*)(F.ws + WS_FXV); const float* fxg = (const float*)(F.ws + WS_FXG); bf16* u = (bf16*)(F.ws + WS_U);
    const float* cw = inp(F, I_CONV_W) + (size_t)l * 3 * DFF;
    constexpr int NI = 2 * 2 * (DFF / 4) / 512;
    static_assert(2 * 2 * (DFF / 4) == NI * 512, "fix-up item count");
#pragma unroll
    for (int i0 = 0; i0 < NI; i0 += 4) {
        f32x4 cp[4], vv[4], ga[4], gb[4], wa[4], wb[4]; int blkv[4], colv[4], rhov[4];
#pragma unroll
        for (int k = 0; k < 4; ++k) if (i0 + k < NI) { const int i = F.tid + (i0 + k) * 512, c4 = i % (DFF / 4), rr = i / (DFF / 4), rho = rr & 1, blk = pm * 2 + (rr >> 1), col = c4 * 4, pb = (blk & 15) ? blk - 1 : blk;
            blkv[k] = blk; colv[k] = col; rhov[k] = rho;
            cp[k] = *(const f32x4*)(fxc + ((size_t)blk * 2 + rho) * DFF + col); vv[k] = *(const f32x4*)(fxv + ((size_t)blk * 2 + rho) * DFF + col);
            ga[k] = *(const f32x4*)(fxg + ((size_t)pb * 2 + 1) * DFF + col); gb[k] = *(const f32x4*)(fxg + ((size_t)pb * 2) * DFF + col);
            wa[k] = *(const f32x4*)(cw + col); wb[k] = *(const f32x4*)(cw + DFF + col); }
#pragma unroll
        for (int k = 0; k < 4; ++k) if (i0 + k < NI) {
            if ((blkv[k] & 15) == 0) continue;
            const f32x4 cv = rhov[k] == 0 ? cp[k] + wb[k] * ga[k] + wa[k] * gb[k] : cp[k] + wa[k] * ga[k];
            f32x4 o;
#pragma unroll
            for (int j = 0; j < 4; ++j) o[j] = cv[j] * pg8::sigmoidf_fast(cv[j]) * vv[k][j];
            v2u w; w.x = pk2(o[0], o[1]); w.y = pk2(o[2], o[3]);
            *(v2u*)(u + ((size_t)blkv[k] * 128 + rhov[k]) * DFF + colv[k]) = w; }
    }
}

__device__ __forceinline__ void out_phase(Frame& F) {
    const bf16* h = (const bf16*)(F.ws + WS_XN); const float* gf = inp(F, I_NORM_FINAL); float* out = (float*)inp(F, I_OUT);
    const int gw = F.bid * NWAVES + F.wave, NGW = F.G * NWAVES;
    f32x4 gv[8];
#pragma unroll
    for (int j = 0; j < 8; ++j) gv[j] = *((const f32x4*)gf + 64 * j + F.lane);
    for (int row = gw; row < MTOK; row += NGW) { const v2u* xr = (const v2u*)(h + (size_t)row * DM) + F.lane; f32x4 xv[8]; float ss = 0.f;
#pragma unroll
        for (int j = 0; j < 8; ++j) { const v2u a = xr[64 * j]; xv[j] = (f32x4){pg8::bf_lo(a.x), pg8::bf_hi(a.x), pg8::bf_lo(a.y), pg8::bf_hi(a.y)}; ss += (xv[j].x * xv[j].x + xv[j].y * xv[j].y) + (xv[j].z * xv[j].z + xv[j].w * xv[j].w); }
        const float rs = 1.0f / sqrtf(wave_sum(ss) * (1.0f / DM) + EPS); f32x4* o = (f32x4*)(out + (size_t)row * DM) + F.lane;
#pragma unroll
        for (int j = 0; j < 8; ++j) o[64 * j] = xv[j] * rs * gv[j]; }
}

__device__ __forceinline__ int nrep_opaque(int n) { asm volatile("" : "+s"(n)); return n; }
struct Args { const float* in[16]; float* out; unsigned char* ws; int ph_lo, ph_hi, li, pad; };
__global__ void __launch_bounds__(NWAVES * 64, 2) fwd(Args args) {
    extern __shared__ __attribute__((aligned(16))) unsigned char lds[];
    Frame F;
    F.lds = (LAS unsigned char*)lds; F.ldsg = lds;
    F.tid = threadIdx.x; F.lane = F.tid & 63; F.wave = __builtin_amdgcn_readfirstlane(F.tid >> 6);
    F.G = gridDim.x; F.bid = blockIdx.x; F.vcu = (F.G % 8 == 0) ? (F.bid % 8) * (F.G / 8) + F.bid / 8 : F.bid;
    F.ws = args.ws; F.tp = 0ull; F.tp0 = 0ull;
    volatile LAS unsigned* MISC = (volatile LAS unsigned*)(F.lds + MISC_OFF);
    for (int u = F.tid; u < 64; u += NWAVES * 64) MISC[u] = 0u;
    if (F.tid < I_NPTR) { const unsigned long long p = (F.tid == I_OUT) ? (unsigned long long)args.out : (unsigned long long)args.in[F.tid & 15];
        ((LAS unsigned*)(F.lds + PTAB_OFF))[2 * F.tid] = (unsigned)p; ((LAS unsigned*)(F.lds + PTAB_OFF))[2 * F.tid + 1] = (unsigned)(p >> 32); }
    __syncthreads();
    gu32* ctl = (gu32*)(F.ws + WS_CTL);
    XcdBarrier bar = xcd_barrier_post((unsigned*)(ctl + CW_BAR) + args.li * XCD_BAR_WORDS, MISC + 8);
    const int lo = args.ph_lo, hi = args.ph_hi;
#ifndef PH_MASK
#define PH_MASK 0xFFFF
#endif
#define EN(j) ((PH_MASK >> (j)) & 1)
#ifndef PROBE_REP
#define PROBE_REP 0
#endif
#define NREP(j) nrep_opaque(1 + ((PROBE_REP >> (j)) & 1))
#define IN(k) (lo <= (k) && (k) < hi)
#define LAUNDER() do { unsigned long long z_ = 0ull; asm volatile("" : "+s"(z_), "+s"(F.vcu), "+s"(F.bid), "+s"(F.G)); F.ws = args.ws + z_; F.tid = threadIdx.x; asm volatile("" : "+v"(F.tid)); F.lane = F.tid & 63; } while (0)
#define SEAM(k) do { if (IN(k) && IN((k) + 1)) xcd_barrier(bar); } while (0)
#ifndef TP_MASK
#define TP_MASK 0
#endif
#ifndef TP_MULT
#define TP_MULT 4
#endif
    unsigned long long tp_acc = 0ull, tp0_ = 0ull; (void)tp0_;
#define TP_B(j) do { if ((TP_MASK >> (j)) & 1) tp0_ = __builtin_amdgcn_s_memrealtime(); } while (0)
#define TP_E(j) do { if ((TP_MASK >> (j)) & 1) tp_acc += __builtin_amdgcn_s_memrealtime() - tp0_; } while (0)
    if (EN(12) && IN(0)) { TP_B(12); for (int rep_ = 0; rep_ < NREP(12); ++rep_) { LAUNDER(); p0_prologue(F); } SEAM(0); TP_E(12); }
    for (int l = 0; l < DEPTH; ++l) {
        const int pb = 1 + l * NPH_L;
        bf16* XN = (bf16*)(F.ws + WS_XN);
        if (EN(0) && IN(pb + 0)) { TP_B(0); for (int rep_ = 0; rep_ < NREP(0); ++rep_) { LAUNDER();
            pg8::Gemm g{XN, (const bf16*)(F.ws + WS_WIN + (size_t)l * SZ_WIN), MTOK, NING, DM, nullptr, nullptr}; pg8::StaticOrder S; S.init(MTOK, NING, F.G, F.bid);
            pg8::EpiInProj E{(bf16*)(F.ws + WS_MQ), (bf16*)(F.ws + WS_MK), (bf16*)(F.ws + WS_MV), (bf16*)(F.ws + WS_SMO), (bf16*)(F.ws + WS_AQ), (bf16*)(F.ws + WS_AK), (bf16*)(F.ws + WS_AV), (bf16*)(F.ws + WS_SG),
                             (const float*)(F.ws + WS_BIASG) + (size_t)l * NING, (const float*)(F.ws + WS_ROPE), (const pg8::u64_t*)(F.ws + WS_ROWSS_B)};
            pg8::gemm_phase<pg8::EpiInProj, pg8::StaticOrder, true, true>(F.lds, g, S, E, F.tid);
            } SEAM(pb + 0); TP_E(0); }
        if (EN(1) && IN(pb + 1)) { TP_B(1); for (int rep_ = 0; rep_ < NREP(1); ++rep_) { LAUNDER(); mix_phase(F, l, rep_); } SEAM(pb + 1); TP_E(1); }
        if (EN(2) && IN(pb + 2)) { TP_B(2); for (int rep_ = 0; rep_ < NREP(2); ++rep_) { LAUNDER(); fin_phase(F, l); } SEAM(pb + 2); TP_E(2); }
        if (EN(3) && IN(pb + 3)) { TP_B(3); for (int rep_ = 0; rep_ < NREP(3); ++rep_) { LAUNDER();
            pg8::Gemm g{(const bf16*)(F.ws + WS_HMN), (const bf16*)(F.ws + WS_WBM + (size_t)l * SZ_WSQ), MTOK, DM, DM, (const bf16*)(F.ws + WS_HAN), (const bf16*)(F.ws + WS_WBD + (size_t)l * SZ_WSQ)};
            pg8::PairOrder S; S.init(MTOK, DM, F.G, F.bid);
            pg8::EpiMerge E{(bf16*)(F.ws + WS_Y), (const bf16*)(F.ws + WS_SG)};
            pg8::gemm_phase<pg8::EpiMerge, pg8::PairOrder, true, true>(F.lds, g, S, E, F.tid);
            } SEAM(pb + 3); TP_E(3); }
        if (EN(4) && IN(pb + 4)) { TP_B(4); for (int rep_ = 0; rep_ < NREP(4); ++rep_) { LAUNDER();
            pg8::Gemm g{(const bf16*)(F.ws + WS_Y), (const bf16*)(F.ws + WS_WO + (size_t)l * SZ_WSQ), MTOK, DM, DM, nullptr, nullptr}; pg8::StaticOrder S; S.init(MTOK, DM, F.G, F.bid);
            if (rep_ == 0) { pg8::EpiRes<true> E{XN, DM, (pg8::u64_t*)(F.ws + WS_ROWSS)};
            pg8::gemm_phase<pg8::EpiRes<true>, pg8::StaticOrder, false, true>(F.lds, g, S, E, F.tid); }
            else { pg8::EpiRes<false> E{(bf16*)(F.ws + WS_P), DM, nullptr};
            pg8::gemm_phase<pg8::EpiRes<false>, pg8::StaticOrder, false, true>(F.lds, g, S, E, F.tid); }
            } SEAM(pb + 4); TP_E(4); }
        if (EN(5) && IN(pb + 5)) { TP_B(5); for (int rep_ = 0; rep_ < NREP(5); ++rep_) { LAUNDER();
            pg8::Gemm g{XN, (const bf16*)(F.ws + WS_WUP + (size_t)l * SZ_WUP), MTOK, NUP, DM, nullptr, nullptr}; pg8::StaticOrder S; S.init(MTOK, NUP, F.G, F.bid);
            pg8::EpiUpConv E{(bf16*)(F.ws + WS_U), DFF, (const pg8::u64_t*)(F.ws + WS_ROWSS), inp(F, I_CONV_W) + (size_t)l * 3 * DFF, inp(F, I_CONV_B) + (size_t)l * DFF,
                             (float*)(F.ws + WS_FXC), (float*)(F.ws + WS_FXV), (float*)(F.ws + WS_FXG)};
            pg8::gemm_phase<pg8::EpiUpConv, pg8::StaticOrder, true, true, true>(F.lds, g, S, E, F.tid);
            { const int idle = tail_idle(F.G);
              if (idle && l + 1 < DEPTH && rep_ == 0 && F.bid >= F.G - idle) { VM_WAIT(); __syncthreads();
                  cvt_run(F, (l + 1) * IT_LAYER + IT_A, IT_LAYER - IT_A, (F.bid - (F.G - idle)) * NWAVES + F.wave, idle * NWAVES); VM_WAIT(); } }
            } SEAM(pb + 5); TP_E(5); }
        if (EN(6) && IN(pb + 6)) { TP_B(6); for (int rep_ = 0; rep_ < NREP(6); ++rep_) { LAUNDER();
            pg8::Gemm g{(const bf16*)(F.ws + WS_U), (const bf16*)(F.ws + WS_WDN + (size_t)l * SZ_WDN), MTOK, DM, DFF, nullptr, nullptr}; pg8::StaticOrder S; S.init(MTOK, DM, F.G, F.bid);
            { pg8::Unit fu; for (int i = 0; S.next(i, fu); ++i) conv_fixup_panel(F, l, fu.pm); VM_WAIT(); __syncthreads(); }
            if (rep_ == 0) { pg8::EpiRes<true> E{XN, DM, (pg8::u64_t*)(F.ws + WS_ROWSS_B)};
            pg8::gemm_phase<pg8::EpiRes<true>, pg8::StaticOrder, false, true>(F.lds, g, S, E, F.tid); }
            else { pg8::EpiRes<false> E{(bf16*)(F.ws + WS_P), DM, nullptr};
            pg8::gemm_phase<pg8::EpiRes<false>, pg8::StaticOrder, false, true>(F.lds, g, S, E, F.tid); }
            } SEAM(pb + 6); TP_E(6); }
    }
    if (EN(11) && IN(NPHASE - 1)) { TP_B(11); LAUNDER(); out_phase(F); TP_E(11); }
    if (TPS && F.bid == TPS_WG) { const unsigned long long tgt = __builtin_amdgcn_s_memrealtime() + TP_MULT * F.tp; while (__builtin_amdgcn_s_memrealtime() < tgt) __builtin_amdgcn_s_sleep(8); }
    if (TP_MASK && F.bid == 0) { const unsigned long long tgt = __builtin_amdgcn_s_memrealtime() + TP_MULT * tp_acc; while (__builtin_amdgcn_s_memrealtime() < tgt) __builtin_amdgcn_s_sleep(8); }
#undef IN
#undef SEAM
}

extern "C" void kernel_launch(void* const* d_in, const int* in_sizes, int n_in, void* d_out, int out_size, void* d_ws, size_t ws_size, hipStream_t stream) {
    static int grid = 0;
    if (grid == 0) {
        if (n_in != 16 || in_sizes[0] != MTOK * DM || out_size != MTOK * DM || ws_size < WS_END) {
            fprintf(stderr, "kernel_launch: unexpected shapes (n_in %d, in0 %d, out %d, ws %zu, need %zu)\n", n_in, n_in > 0 ? in_sizes[0] : -1, out_size, ws_size, (size_t)WS_END); grid = -1; return; }
        int dev = 0, cus = 0, per_cu = 0;
        if (hipGetDevice(&dev) != hipSuccess || hipDeviceGetAttribute(&cus, hipDeviceAttributeMultiprocessorCount, dev) != hipSuccess) { grid = -1; return; }
        if (hipFuncSetAttribute((const void*)fwd, hipFuncAttributeMaxDynamicSharedMemorySize, LDS_BYTES) != hipSuccess) { fprintf(stderr, "kernel_launch: hipFuncSetAttribute failed\n"); grid = -1; return; }
        if (hipOccupancyMaxActiveBlocksPerMultiprocessor(&per_cu, (const void*)fwd, NWAVES * 64, LDS_BYTES) != hipSuccess || per_cu < 1)
            fprintf(stderr, "kernel_launch: note: occupancy query reports %d workgroups per CU\n", per_cu);
        (void)hipGetLastError();
        grid = cus;
    }
    if (grid < 0) return;
    if (hipMemsetAsync((char*)d_ws + WS_CTL, 0, CTL_ZERO_BYTES, stream) != hipSuccess) return;
    Args a{};
    for (int i = 0; i < 16; ++i) a.in[i] = (const float*)d_in[i];
    a.out = (float*)d_out; a.ws = (unsigned char*)d_ws;
#if MK_SPLIT
    for (int p = 0; p < NPHASE; ++p) { a.ph_lo = p; a.ph_hi = p + 1; a.li = p; hipLaunchKernelGGL(fwd, dim3(grid), dim3(NWAVES * 64), LDS_BYTES, stream, a); }
#else
    a.ph_lo = 0; a.ph_hi = NPHASE; a.li = 0;
    hipLaunchKernelGGL(fwd, dim3(grid), dim3(NWAVES * 64), LDS_BYTES, stream, a);
#endif
    const hipError_t le = hipPeekAtLastError();
    if (le != hipSuccess) fprintf(stderr, "kernel_launch: launch failed: %s\n", hipGetErrorName(le));
}
```

```cpp
#include <hip/hip_runtime.h>
#include <cstdio>
#include <cstdint>

#ifndef MK_SPLIT
#define MK_SPLIT 0
#define TP_MASK 0x0
#define TPS 0
#define TPS_WG 0
#endif

namespace pg8 {
#define PG8_LAS __attribute__((address_space(3)))
typedef unsigned short bf16_t;
typedef short bf16x8 __attribute__((ext_vector_type(8)));
typedef float f32x4 __attribute__((ext_vector_type(4)));
typedef float f32x2 __attribute__((ext_vector_type(2)));
typedef unsigned u32x4 __attribute__((ext_vector_type(4)));
typedef unsigned u32x2 __attribute__((ext_vector_type(2)));
constexpr int BM = 256, BK = 64, HALF = 128, HTB = HALF * BK * 2, STAGE_BYTES = 8 * HTB, NXCD = 8, WGM = 8;

__host__ __device__ __forceinline__ int lds_byte(int r, int c) { const int st = (r >> 4) * 2 + (c >> 5), rr = r & 15, cc = c & 31, ob = rr * 64 + cc * 2; return st * 1024 + (ob ^ (((ob >> 9) & 1) << 5)); }
__host__ __device__ __forceinline__ void stage_rc(int b, int& R, int& C) { const int st = b / 1024, sb = b % 1024, swz = sb ^ (((sb >> 9) & 1) << 5); R = (st >> 1) * 16 + swz / 64; C = (st & 1) * 32 + (swz % 64) / 2; }
__host__ __device__ __forceinline__ int perm32(int rho) { const int n = rho >> 4, i = rho & 15; return 8 * (i >> 2) + 4 * n + (i & 3); }

struct Unit { int pm, pn, sel; };
struct Gemm { const bf16_t* A; const bf16_t* Bt; int M, N, K; const bf16_t* A1; const bf16_t* Bt1; };

struct StaticOrder {
    int nM, nN, nwg, G, c;
    __host__ __device__ __forceinline__ void init(int M, int N, int G_, int c_) { nM = M / BM; nN = N / BM; nwg = nM * nN; G = G_; c = c_; }
    __host__ __device__ __forceinline__ bool next(int i, Unit& u) const {
        const long L = (long)i * G + c; if (L >= nwg) return false;
        int wgid = (int)L; { const int q = nwg / NXCD, r = nwg % NXCD, xcd = wgid % NXCD, off = wgid / NXCD; wgid = (xcd < r ? xcd * (q + 1) : r * (q + 1) + (xcd - r) * q) + off; }
        const int nig = WGM * nN, gid = wgid / nig, fm = gid * WGM, gsz = (nM - fm) < WGM ? (nM - fm) : WGM;
        u.pm = fm + ((wgid % nig) % gsz); u.pn = (wgid % nig) / gsz; u.sel = 0; return true;
    }
    __device__ __forceinline__ void a_ready(const Unit&) const {}
    __device__ __forceinline__ void done(const Unit&) const {}
};
struct PairOrder : StaticOrder {
    __host__ __device__ __forceinline__ bool next(int i, Unit& u) const { if (!StaticOrder::next(i >> 1, u)) return false; u.sel = i & 1; return true; }
};

__device__ __forceinline__ unsigned cvt_pk_bf16(float lo, float hi) { unsigned r; asm volatile("v_cvt_pk_bf16_f32 %0, %1, %2" : "=v"(r) : "v"(lo), "v"(hi)); return r; }
__device__ __forceinline__ float bf_lo(unsigned w) { return __uint_as_float(w << 16); }
__device__ __forceinline__ float bf_hi(unsigned w) { return __uint_as_float(w & 0xffff0000u); }
__device__ __forceinline__ float sigmoidf_fast(float x) { return __builtin_amdgcn_rcpf(1.0f + __builtin_amdgcn_exp2f(-1.4426950408889634f * x)); }
typedef unsigned long long u64_t;
__device__ __forceinline__ u64_t ss_fix(float ss) { const double d = (double)ss * 16777216.0; const unsigned hi = (unsigned)(d * (1.0 / 4294967296.0)); const unsigned lo = (unsigned)__builtin_fma(-(double)hi, 4294967296.0, d); return ((u64_t)hi << 32) | lo; }
__device__ __forceinline__ float ss_f32(u64_t v) { return (float)(__builtin_fma((double)(unsigned)(v >> 32), 4294967296.0, (double)(unsigned)v) * (1.0 / 16777216.0)); }

struct EpiInProj {
    static constexpr bool PERM = true, AFTER_DRAIN = false, CHAIN = false;
    bf16_t *mq, *mk, *mv, *smo, *aq, *ak, *av, *sg; const float* bias; const float* rope; const u64_t* rowss;
    __device__ __forceinline__ void operator()(const f32x4 (&acc)[2][2][4][2], const Unit& u, int wr, int wc, int fr, int fq) const {
        const int pn = u.pn; bf16_t* base; int ldc, colt, kind = 0; float sc = 1.f;
        if (pn < 4) { base = mq; ldc = 1024; colt = pn * 256; }
        else if (pn < 8) { base = mk; ldc = 1024; colt = (pn - 4) * 256; sc = 0.08838834764831845f; }
        else if (pn < 16) { base = mv; ldc = 2048; colt = (pn - 8) * 256; }
        else if (pn < 24) { base = smo; ldc = 2048; colt = (pn - 16) * 256; kind = 2; }
        else if (pn < 32) { base = aq; ldc = 2048; colt = (pn - 24) * 256; kind = 1; }
        else if (pn < 40) { base = ak; ldc = 2048; colt = (pn - 32) * 256; kind = 1; }
        else if (pn < 48) { base = av; ldc = 2048; colt = (pn - 40) * 256; }
        else { base = sg; ldc = 4096; colt = (pn - 48) * 256; kind = 2; }
        const int row0 = u.pm * BM + wr * 64 + fr, col0 = colt + wc * 32 + 8 * fq, bcol0 = pn * BM + wc * 32 + 8 * fq;
        f32x4 bv[2][2];
#pragma unroll
        for (int bj = 0; bj < 2; ++bj)
#pragma unroll
            for (int n = 0; n < 2; ++n) bv[bj][n] = *(const f32x4*)(bias + bcol0 + bj * HALF + 4 * n);
        const bool dorope = (kind == 1) && (wc == 0);
        u64_t rsu[2][4]; float rsv[2][4];
#pragma unroll
        for (int ai = 0; ai < 2; ++ai)
#pragma unroll
            for (int m = 0; m < 4; ++m) rsu[ai][m] = rowss[row0 + ai * HALF + m * 16];
#pragma unroll
        for (int ai = 0; ai < 2; ++ai)
#pragma unroll
            for (int m = 0; m < 4; ++m) rsv[ai][m] = ss_f32(rsu[ai][m]);
#pragma unroll
        for (int ai = 0; ai < 2; ++ai) {
            f32x4 cvv[4], svv[4];
#pragma unroll
            for (int m = 0; m < 4; ++m) { cvv[m] = (f32x4){1.f, 1.f, 1.f, 1.f}; svv[m] = (f32x4){0.f, 0.f, 0.f, 0.f}; }
            if (dorope) {
#pragma unroll
                for (int m = 0; m < 4; ++m) { const float* cs = rope + (size_t)((row0 + ai * HALF + m * 16) & 2047) * 32 + 4 * fq; cvv[m] = *(const f32x4*)cs; svv[m] = *(const f32x4*)(cs + 16); } }
#pragma unroll
            for (int m = 0; m < 4; ++m) { const int row = row0 + ai * HALF + m * 16; bf16_t* rowp = base + (size_t)row * ldc + col0;
                const float rs = 1.0f / sqrtf(rsv[ai][m] * (1.0f / 2048.0f) + 1e-6f);
                const f32x4 cv = cvv[m], sv = svv[m];
#pragma unroll
                for (int bj = 0; bj < 2; ++bj) { f32x4 v0 = (acc[ai][bj][m][0] * rs + bv[bj][0]) * sc, v1 = (acc[ai][bj][m][1] * rs + bv[bj][1]) * sc;
                    if (dorope) { f32x4 r0, r1;
                        r0[0] = v0[0] * cv[0] - v0[1] * sv[0]; r0[1] = v0[1] * cv[0] + v0[0] * sv[0]; r0[2] = v0[2] * cv[1] - v0[3] * sv[1]; r0[3] = v0[3] * cv[1] + v0[2] * sv[1];
                        r1[0] = v1[0] * cv[2] - v1[1] * sv[2]; r1[1] = v1[1] * cv[2] + v1[0] * sv[2]; r1[2] = v1[2] * cv[3] - v1[3] * sv[3]; r1[3] = v1[3] * cv[3] + v1[2] * sv[3];
                        v0 = r0; v1 = r1; }
                    if (kind == 2) {
#pragma unroll
                        for (int j = 0; j < 4; ++j) { v0[j] = sigmoidf_fast(v0[j]); v1[j] = sigmoidf_fast(v1[j]); } }
                    u32x4 w; w.x = cvt_pk_bf16(v0[0], v0[1]); w.y = cvt_pk_bf16(v0[2], v0[3]); w.z = cvt_pk_bf16(v1[0], v1[1]); w.w = cvt_pk_bf16(v1[2], v1[3]);
                    *(u32x4*)(rowp + bj * HALF) = w; } } }
    }
};
template <int CTRL> __device__ __forceinline__ f32x4 dpp4(const f32x4 v) { f32x4 r;
#pragma unroll
    for (int j = 0; j < 4; ++j) r[j] = __uint_as_float(__builtin_amdgcn_update_dpp(0u, __float_as_uint(v[j]), CTRL, 0xf, 0xf, false));
    return r; }
struct EpiUpConv {
    static constexpr bool PERM = true, AFTER_DRAIN = false, CHAIN = false;
    bf16_t* u; int ldc; const u64_t* rowss; const float* cw; const float* cb; float *fxc, *fxv, *fxg;
    __device__ __forceinline__ void operator()(const f32x4 (&acc)[2][2][4][2], const Unit& un, int wr, int wc, int fr, int fq) const {
        const int col0 = un.pn * HALF + wc * 32 + 8 * fq, blk = un.pm * 2 + wr, rowb = blk * 128 + fr;
        f32x4 w0[2], w1[2], w2[2], bb[2];
#pragma unroll
        for (int n = 0; n < 2; ++n) { w0[n] = *(const f32x4*)(cw + col0 + 4 * n); w1[n] = *(const f32x4*)(cw + ldc + col0 + 4 * n); w2[n] = *(const f32x4*)(cw + 2 * ldc + col0 + 4 * n); bb[n] = *(const f32x4*)(cb + col0 + 4 * n); }
        f32x4 p1[2], p2[2];
        p1[0] = p1[1] = p2[0] = p2[1] = (f32x4){0.f, 0.f, 0.f, 0.f};
        u64_t rsu[8]; float rsv[8];
#pragma unroll
        for (int q = 0; q < 8; ++q) rsu[q] = rowss[rowb + 16 * q];
#pragma unroll
        for (int q = 0; q < 8; ++q) rsv[q] = ss_f32(rsu[q]);
#pragma unroll
        for (int q = 0; q < 8; ++q) { const int ai = q >> 2, m = q & 3, row = rowb + 16 * q;
            const float rs = 1.0f / sqrtf(rsv[q] * (1.0f / 2048.0f) + 1e-6f);
            u32x4 w;
#pragma unroll
            for (int n = 0; n < 2; ++n) { const f32x4 g = acc[ai][0][m][n] * rs, v = acc[ai][1][m][n] * rs;
                const f32x4 r1 = dpp4<0x121>(g), r2 = dpp4<0x122>(g);
                f32x4 g1, g2;
#pragma unroll
                for (int j = 0; j < 4; ++j) { g1[j] = fr >= 1 ? r1[j] : p1[n][j]; g2[j] = fr >= 2 ? r2[j] : p2[n][j]; }
                p1[n] = r1; p2[n] = r2;
                const f32x4 cv = w0[n] * g2 + w1[n] * g1 + w2[n] * g + bb[n];
                f32x4 o;
#pragma unroll
                for (int j = 0; j < 4; ++j) o[j] = cv[j] * sigmoidf_fast(cv[j]) * v[j];
                if (n == 0) { w.x = cvt_pk_bf16(o[0], o[1]); w.y = cvt_pk_bf16(o[2], o[3]); } else { w.z = cvt_pk_bf16(o[0], o[1]); w.w = cvt_pk_bf16(o[2], o[3]); }
                if (q == 0 && fr < 2) { *(f32x4*)(fxc + ((size_t)blk * 2 + fr) * ldc + col0 + 4 * n) = cv; *(f32x4*)(fxv + ((size_t)blk * 2 + fr) * ldc + col0 + 4 * n) = v; }
                if (q == 7 && fr >= 14) *(f32x4*)(fxg + ((size_t)blk * 2 + (fr - 14)) * ldc + col0 + 4 * n) = g; }
            *(u32x4*)(u + (size_t)row * ldc + col0) = w; }
    }
};
struct EpiMerge {
    static constexpr bool PERM = false, AFTER_DRAIN = false, CHAIN = true;
    bf16_t* y; const bf16_t* sg;
    __device__ __forceinline__ void mid(f32x4 (&acc)[2][2][4][2], const Unit& u, int wr, int wc, int fr, int fq) const {
        const int row0 = u.pm * BM + wr * 64 + fr, col0 = u.pn * BM + wc * 32 + 4 * fq;
#pragma unroll
        for (int ai = 0; ai < 2; ++ai)
#pragma unroll
            for (int m = 0; m < 4; ++m) { const int row = row0 + ai * HALF + m * 16;
                u32x2 gm[2][2], gd[2][2];
#pragma unroll
                for (int bj = 0; bj < 2; ++bj)
#pragma unroll
                    for (int n = 0; n < 2; ++n) { const int col = col0 + bj * HALF + n * 16; gm[bj][n] = *(const u32x2*)(sg + (size_t)row * 4096 + col); gd[bj][n] = *(const u32x2*)(sg + (size_t)row * 4096 + 2048 + col); }
#pragma unroll
                for (int bj = 0; bj < 2; ++bj)
#pragma unroll
                    for (int n = 0; n < 2; ++n) { const u32x2 a = gm[bj][n], d = gd[bj][n];
                        const f32x4 num = (f32x4){bf_lo(a.x), bf_hi(a.x), bf_lo(a.y), bf_hi(a.y)}, den = (f32x4){bf_lo(d.x), bf_hi(d.x), bf_lo(d.y), bf_hi(d.y)};
#pragma unroll
                        for (int j = 0; j < 4; ++j) acc[ai][bj][m][n][j] *= num[j] * __builtin_amdgcn_rcpf(fmaxf(den[j], 1e-30f)); } }
    }
    __device__ __forceinline__ void operator()(const f32x4 (&acc)[2][2][4][2], const Unit& u, int wr, int wc, int fr, int fq) const {
        const int row0 = u.pm * BM + wr * 64 + fr, col0 = u.pn * BM + wc * 32 + 4 * fq;
#pragma unroll
        for (int ai = 0; ai < 2; ++ai)
#pragma unroll
            for (int mp = 0; mp < 2; ++mp) {
                u32x2 gw[2][2][2];
#pragma unroll
                for (int mm = 0; mm < 2; ++mm)
#pragma unroll
                    for (int bj = 0; bj < 2; ++bj)
#pragma unroll
                        for (int n = 0; n < 2; ++n) gw[mm][bj][n] = *(const u32x2*)(sg + (size_t)(row0 + ai * HALF + (2 * mp + mm) * 16) * 4096 + 2048 + col0 + bj * HALF + n * 16);
#pragma unroll
                for (int mm = 0; mm < 2; ++mm)
#pragma unroll
                    for (int bj = 0; bj < 2; ++bj)
#pragma unroll
                        for (int n = 0; n < 2; ++n) { const int m = 2 * mp + mm, row = row0 + ai * HALF + m * 16, col = col0 + bj * HALF + n * 16;
                            const u32x2 g2 = gw[mm][bj][n]; f32x4 g = (f32x4){bf_lo(g2.x), bf_hi(g2.x), bf_lo(g2.y), bf_hi(g2.y)};
#pragma unroll
                            for (int j = 0; j < 4; ++j) g[j] = fmaxf(g[j], 1e-30f);
                            const f32x4 v = acc[ai][bj][m][n] * g;
                            u32x2 w; w.x = cvt_pk_bf16(v[0], v[1]); w.y = cvt_pk_bf16(v[2], v[3]); *(u32x2*)(y + (size_t)row * 2048 + col) = w; }
                asm volatile("" ::: "memory"); }
    }
};
template <bool STATS> struct EpiRes {
    static constexpr bool PERM = true, AFTER_DRAIN = false, CHAIN = false;
    bf16_t* hb; int ldc; u64_t* rowss;
    __device__ __forceinline__ void operator()(const f32x4 (&acc)[2][2][4][2], const Unit& u, int wr, int wc, int fr, int fq) const {
        const int row0 = u.pm * BM + wr * 64 + fr, col0 = u.pn * BM + wc * 32 + 8 * fq;
#pragma unroll
        for (int ai = 0; ai < 2; ++ai) {
            u32x4 hv[4][2];
#pragma unroll
            for (int m = 0; m < 4; ++m)
#pragma unroll
                for (int bj = 0; bj < 2; ++bj) hv[m][bj] = *(const u32x4*)(hb + (size_t)(row0 + ai * HALF + m * 16) * ldc + col0 + bj * HALF);
#pragma unroll
            for (int m = 0; m < 4; ++m) { const int row = row0 + ai * HALF + m * 16; float ss = 0.f;
#pragma unroll
                for (int bj = 0; bj < 2; ++bj) { const u32x4 x = hv[m][bj]; const f32x4 a0 = acc[ai][bj][m][0], a1 = acc[ai][bj][m][1]; u32x4 w;
                    w.x = cvt_pk_bf16(bf_lo(x.x) + a0[0], bf_hi(x.x) + a0[1]); w.y = cvt_pk_bf16(bf_lo(x.y) + a0[2], bf_hi(x.y) + a0[3]);
                    w.z = cvt_pk_bf16(bf_lo(x.z) + a1[0], bf_hi(x.z) + a1[1]); w.w = cvt_pk_bf16(bf_lo(x.w) + a1[2], bf_hi(x.w) + a1[3]);
                    *(u32x4*)(hb + (size_t)row * ldc + col0 + bj * HALF) = w;
                    if (STATS) { ss += (bf_lo(w.x) * bf_lo(w.x) + bf_hi(w.x) * bf_hi(w.x)) + (bf_lo(w.y) * bf_lo(w.y) + bf_hi(w.y) * bf_hi(w.y));
                                 ss += (bf_lo(w.z) * bf_lo(w.z) + bf_hi(w.z) * bf_hi(w.z)) + (bf_lo(w.w) * bf_lo(w.w) + bf_hi(w.w) * bf_hi(w.w)); } }
                if (STATS) {
                    { auto rr = __builtin_amdgcn_permlane16_swap(__float_as_uint(ss), __float_as_uint(ss), false, false); ss = __uint_as_float(rr[0]) + __uint_as_float(rr[1]); }
                    { auto rr = __builtin_amdgcn_permlane32_swap(__float_as_uint(ss), __float_as_uint(ss), false, false); ss = __uint_as_float(rr[0]) + __uint_as_float(rr[1]); }
                    if (fq == 0) __hip_atomic_fetch_add(rowss + row, ss_fix(ss), __ATOMIC_RELAXED, __HIP_MEMORY_SCOPE_AGENT); } }
            asm volatile("" ::: "memory"); }
    }
};

template <class Epi, class Sched, bool ALIGN_EPI = false, bool SP2 = false, bool APERM = false>
__device__ __forceinline__ void gemm_phase(PG8_LAS unsigned char* lds, const Gemm g, const Sched& S, const Epi& E, const int tid) {
    const int wid = __builtin_amdgcn_readfirstlane(tid >> 6), lane = tid & 63, wr = wid >> 2, wc = wid & 3, fr = lane & 15, fq = lane >> 4;
    const int K = g.K, nt = K / BK;
    unsigned voffA[2], voffB[2];
#pragma unroll
    for (int i = 0; i < 2; ++i) { int R, C; stage_rc(tid * 16 + i * 8192, R, C); const int Rb = Epi::PERM ? ((R & ~31) + perm32(R & 31)) : R;
        const int Ra = APERM ? ((R >> 6) * 128 + (R & 63)) : R;
        voffA[i] = (unsigned)(Ra * K + C) * 2u; voffB[i] = (unsigned)(Rb * K + C) * 2u; }
    const size_t kstep = (size_t)(BK * 2);
    const size_t hstep = (size_t)HALF * K * 2;
    const size_t hstepA = APERM ? (size_t)64 * K * 2 : hstep;
    const size_t tstep = 2 * hstep;
    const unsigned ldsw = (unsigned)wid * 1024u;
    const int aoff = lds_byte(wr * 64 + fr, fq * 8), boff = lds_byte(wc * 32 + fr, fq * 8);
#define PG8_SA(b, h) (((b) * 2 + (h)) * HTB)
#define PG8_SB(b, h) ((4 + (b) * 2 + (h)) * HTB)
#define PG8_STAGE(bufoff, gbase, voff) do { _Pragma("unroll") for (int _i = 0; _i < 2; ++_i) \
        __builtin_amdgcn_global_load_lds((const unsigned*)((const char*)(gbase) + (voff)[_i]), (PG8_LAS unsigned*)(lds + (bufoff) + ldsw + _i * 8192), 16, 0, 0); } while (0)
#define PG8_LDA(dst, b, h) do { _Pragma("unroll") for (int m = 0; m < 4; ++m) _Pragma("unroll") for (int k = 0; k < 2; ++k) dst[m][k] = *(const PG8_LAS bf16x8*)(lds + PG8_SA(b, h) + aoff + m * 2048 + k * 1024); } while (0)
#define PG8_LDB(dst, b, h) do { _Pragma("unroll") for (int n = 0; n < 2; ++n) _Pragma("unroll") for (int k = 0; k < 2; ++k) dst[n][k] = *(const PG8_LAS bf16x8*)(lds + PG8_SB(b, h) + boff + n * 2048 + k * 1024); } while (0)
#define PG8_MMA(ai, bj, At, Bt) do { __builtin_amdgcn_s_setprio(1); _Pragma("unroll") for (int m = 0; m < 4; ++m) _Pragma("unroll") for (int n = 0; n < 2; ++n) _Pragma("unroll") for (int k = 0; k < 2; ++k) \
        acc[ai][bj][m][n] = __builtin_amdgcn_mfma_f32_16x16x32_bf16(Bt[n][k], At[m][k], acc[ai][bj][m][n], 0, 0, 0); __builtin_amdgcn_s_setprio(0); } while (0)
#define PG8_WAIT_V(n) asm volatile("s_waitcnt vmcnt(" #n ")" ::: "memory")
#define PG8_WAIT_L(n) asm volatile("s_waitcnt lgkmcnt(" #n ")" ::: "memory")
#define PG8_BAR __builtin_amdgcn_s_barrier()
#define PG8_SCHED __builtin_amdgcn_sched_barrier(0)
    Unit cur, nxt; int ui = 0;
    if (!S.next(0, cur)) return;
    f32x4 acc[2][2][4][2];
#pragma unroll
    for (int a = 0; a < 2; ++a)
#pragma unroll
        for (int b = 0; b < 2; ++b)
#pragma unroll
            for (int m = 0; m < 4; ++m)
#pragma unroll
                for (int n = 0; n < 2; ++n) acc[a][b][m][n] = (f32x4){0.f, 0.f, 0.f, 0.f};
    bf16x8 At[4][2], B0[2][2], B1[2][2];
    const char* cA = (const char*)(cur.sel ? g.A1 : g.A) + (size_t)cur.pm * tstep; const char* cB = (const char*)(cur.sel ? g.Bt1 : g.Bt) + (size_t)cur.pn * tstep;
    S.a_ready(cur);
    if constexpr (SP2) {
        PG8_STAGE(PG8_SB(0, 0), cB, voffB); PG8_STAGE(PG8_SB(0, 1), cB + hstep, voffB); PG8_STAGE(PG8_SA(0, 0), cA, voffA); PG8_STAGE(PG8_SA(0, 1), cA + hstepA, voffA);
        if (wr == 1) PG8_BAR;
        PG8_WAIT_V(2); PG8_BAR;
        PG8_STAGE(PG8_SB(1, 0), cB + kstep, voffB); PG8_STAGE(PG8_SA(1, 0), cA + kstep, voffA); PG8_STAGE(PG8_SB(1, 1), cB + hstep + kstep, voffB);
        PG8_WAIT_V(6); PG8_BAR;
    } else {
        PG8_STAGE(PG8_SB(0, 0), cB, voffB); PG8_STAGE(PG8_SA(0, 0), cA, voffA); PG8_STAGE(PG8_SB(0, 1), cB + hstep, voffB); PG8_STAGE(PG8_SA(0, 1), cA + hstepA, voffA);
        if (wr == 1) PG8_BAR;
        PG8_WAIT_V(4); PG8_BAR;
        PG8_STAGE(PG8_SB(1, 0), cB + kstep, voffB); PG8_STAGE(PG8_SA(1, 0), cA + kstep, voffA); PG8_STAGE(PG8_SB(1, 1), cB + hstep + kstep, voffB);
        PG8_WAIT_V(6); PG8_BAR;
    }
    for (;;) {
        const bool has_next = S.next(ui + 1, nxt);
        const char* nA = has_next ? (const char*)(nxt.sel ? g.A1 : g.A) + (size_t)nxt.pm * tstep : cA; const char* nB = has_next ? (const char*)(nxt.sel ? g.Bt1 : g.Bt) + (size_t)nxt.pn * tstep : cB;
        for (int t = 0; t < nt; t += 2) {
            const bool last = (t == nt - 2);
            const char* a1 = cA + (size_t)(t + 1) * kstep;
            const char* a2 = last ? nA : cA + (size_t)(t + 2) * kstep; const char* b2 = last ? nB : cB + (size_t)(t + 2) * kstep;
            const char* a3 = a2 + kstep; const char* b3 = b2 + kstep;
            if (last && has_next) S.a_ready(nxt);
            if constexpr (SP2) {
            PG8_LDB(B0, 0, 0); PG8_LDB(B1, 0, 1); PG8_SCHED; PG8_LDA(At, 0, 0); PG8_STAGE(PG8_SA(1, 1), a1 + hstepA, voffA);
            PG8_WAIT_V(8); PG8_WAIT_L(0); PG8_BAR; PG8_MMA(0, 0, At, B0); PG8_MMA(0, 1, At, B1); PG8_BAR; PG8_SCHED;
            PG8_LDA(At, 0, 1); PG8_STAGE(PG8_SB(0, 0), b2, voffB); PG8_STAGE(PG8_SB(0, 1), b2 + hstep, voffB); PG8_STAGE(PG8_SA(0, 0), a2, voffA);
            PG8_WAIT_V(8); PG8_WAIT_L(0); PG8_BAR; PG8_MMA(1, 0, At, B0); PG8_MMA(1, 1, At, B1); PG8_BAR; PG8_SCHED;
            PG8_LDB(B0, 1, 0); PG8_LDB(B1, 1, 1); PG8_SCHED; PG8_LDA(At, 1, 0); PG8_STAGE(PG8_SA(0, 1), a2 + hstepA, voffA);
            PG8_WAIT_V(8); PG8_WAIT_L(0); PG8_BAR; PG8_MMA(0, 0, At, B0); PG8_MMA(0, 1, At, B1); PG8_BAR; PG8_SCHED;
            PG8_LDA(At, 1, 1); PG8_STAGE(PG8_SB(1, 0), b3, voffB); PG8_STAGE(PG8_SB(1, 1), b3 + hstep, voffB); PG8_STAGE(PG8_SA(1, 0), a3, voffA);
            PG8_WAIT_V(8); PG8_WAIT_L(0); PG8_BAR; PG8_MMA(1, 0, At, B0); PG8_MMA(1, 1, At, B1); PG8_BAR; PG8_SCHED;
            } else {
            PG8_LDB(B0, 0, 0); PG8_SCHED; PG8_LDA(At, 0, 0); PG8_STAGE(PG8_SA(1, 1), a1 + hstepA, voffA);
            PG8_WAIT_L(8); PG8_BAR; PG8_WAIT_L(0); PG8_MMA(0, 0, At, B0); PG8_BAR; PG8_SCHED;
            PG8_LDB(B1, 0, 1); PG8_STAGE(PG8_SB(0, 0), b2, voffB);
            PG8_BAR; PG8_WAIT_L(0); PG8_MMA(0, 1, At, B1); PG8_BAR;
            PG8_LDA(At, 0, 1); PG8_STAGE(PG8_SA(0, 0), a2, voffA);
            PG8_BAR; PG8_WAIT_L(0); PG8_MMA(1, 0, At, B0); PG8_BAR; PG8_SCHED;
            PG8_STAGE(PG8_SB(0, 1), b2 + hstep, voffB);
            PG8_WAIT_V(6); PG8_BAR; PG8_MMA(1, 1, At, B1); PG8_BAR;
            PG8_LDB(B0, 1, 0); PG8_SCHED; PG8_LDA(At, 1, 0); PG8_STAGE(PG8_SA(0, 1), a2 + hstepA, voffA);
            PG8_WAIT_L(8); PG8_BAR; PG8_WAIT_L(0); PG8_MMA(0, 0, At, B0); PG8_BAR; PG8_SCHED;
            PG8_LDB(B1, 1, 1); PG8_STAGE(PG8_SB(1, 0), b3, voffB);
            PG8_BAR; PG8_WAIT_L(0); PG8_MMA(0, 1, At, B1); PG8_BAR;
            PG8_LDA(At, 1, 1); PG8_STAGE(PG8_SA(1, 0), a3, voffA);
            PG8_BAR; PG8_WAIT_L(0); PG8_MMA(1, 0, At, B0); PG8_BAR; PG8_SCHED;
            PG8_STAGE(PG8_SB(1, 1), b3 + hstep, voffB);
            PG8_WAIT_V(6); PG8_BAR; PG8_MMA(1, 1, At, B1); PG8_BAR;
            }
        }
        if constexpr (ALIGN_EPI) { if (wr == 0) PG8_BAR; }
        bool chained = false;
        if constexpr (Epi::CHAIN) { if (cur.sel == 0) { E.mid(acc, cur, wr, wc, fr, fq); chained = true; } }
        if (!chained) { E(acc, cur, wr, wc, fr, fq); S.done(cur); }
        if (!has_next) break;
        if (!chained) {
#pragma unroll
        for (int a = 0; a < 2; ++a)
#pragma unroll
            for (int b = 0; b < 2; ++b)
#pragma unroll
                for (int m = 0; m < 4; ++m)
#pragma unroll
                    for (int n = 0; n < 2; ++n) acc[a][b][m][n] = (f32x4){0.f, 0.f, 0.f, 0.f};
        }
        cur = nxt; cA = nA; cB = nB; ++ui;
        if constexpr (ALIGN_EPI) { if (wr == 1) PG8_BAR; }
    }
    PG8_WAIT_V(0);
    if constexpr (!ALIGN_EPI) { if (wr == 0) PG8_BAR; }
    PG8_BAR;
#undef PG8_SA
#undef PG8_SB
#undef PG8_STAGE
#undef PG8_LDA
#undef PG8_LDB
#undef PG8_MMA
#undef PG8_WAIT_V
#undef PG8_WAIT_L
#undef PG8_BAR
#undef PG8_SCHED
}
}

namespace ab {
typedef unsigned short bf16;
typedef short bf16x8 __attribute__((ext_vector_type(8)));
typedef short s16x4 __attribute__((ext_vector_type(4)));
typedef float f32x16 __attribute__((ext_vector_type(16)));
typedef float f32x4 __attribute__((ext_vector_type(4)));
typedef unsigned u32x4 __attribute__((ext_vector_type(4)));
constexpr int D = 128, NW = 8, QBLK = 32, KVBLK = 64, QB = NW * QBLK;
constexpr int SHM_V = KVBLK * D * 2, SHM_K = KVBLK * D * 2;
constexpr int BODY_LDS = 2 * SHM_V + 2 * SHM_K + NW * 64 * 4;
constexpr int A2_OFF = BODY_LDS, M2_OFF = A2_OFF + 8192, E2_OFF = M2_OFF + 8192, SCAN_OFF = E2_OFF + 8192, LDS_NEED = SCAN_OFF + 256;
constexpr float SCALE = 0.08838834764831845f, THR = 8.f;
#define KSWZ(row, colB) ((row) * 256 + ((colB) ^ (((row) & 7) << 4)))
#define SBAR() __builtin_amdgcn_sched_barrier(0)
__device__ __forceinline__ int v_st(int k, int c) { const int kk = (k & ~0xC) | ((k & 4) << 1) | ((k & 8) >> 1); return ((kk >> 3) * 4 + (c >> 5)) * 512 + ((kk & 7) * 32 + (c & 31)) * 2; }
__device__ __forceinline__ int v_rd_base(int lane) { return ((lane & 3) << 3) | (((lane >> 2) & 3) << 6) | (((lane >> 4) & 1) << 5) | (((lane >> 5) & 1) << 8); }
constexpr int v_rd_off(int d0, int ks, int half) { return d0 * 512 + ks * 4096 + half * 2048; }
__device__ __forceinline__ int crow(int r, int hi) { return (r & 3) + 8 * (r >> 2) + 4 * hi; }
__device__ __forceinline__ unsigned cvtpk(float lo, float hi) { unsigned r; asm volatile("v_cvt_pk_bf16_f32 %0, %1, %2" : "=v"(r) : "v"(lo), "v"(hi)); return r; }
__device__ __forceinline__ bf16x8 load8(const bf16* p) { return *reinterpret_cast<const bf16x8*>(p); }
template <int MODE> __device__ __forceinline__ void mask_tile(f32x16& p0, f32x16& p1, int dq) {
    const float NEG = MODE == 0 ? -__builtin_inff() : 0.f;
#pragma unroll
    for (int r = 0; r < 16; ++r) { const int c = (r & 3) + 8 * (r >> 2);
        if (dq - c < 0) p0[r] = NEG;
        if (dq - c - 32 < 0) p1[r] = NEG; }
}
__device__ __forceinline__ void partialSM(f32x16& p0, f32x16& p1, float& m_reg, float& mn, float& alpha) {
    float pmax = p0[0];
#pragma unroll
    for (int r = 1; r < 16; ++r) pmax = fmaxf(pmax, p0[r]);
#pragma unroll
    for (int r = 0; r < 16; ++r) pmax = fmaxf(pmax, p1[r]);
    { auto rr = __builtin_amdgcn_permlane32_swap(__float_as_uint(pmax), __float_as_uint(pmax), false, false);
      pmax = fmaxf(__uint_as_float(rr[0]), __uint_as_float(rr[1])); }
    constexpr float C2 = 1.4426950408889634f * SCALE;
    if (__builtin_expect(__all((pmax - m_reg) * SCALE <= THR), 1)) { mn = m_reg; alpha = 1.f; }
    else { mn = fmaxf(m_reg, pmax); alpha = __builtin_amdgcn_exp2f((m_reg - mn) * C2); m_reg = mn; }
    const float mnL = -mn * C2;
#pragma unroll
    for (int r = 0; r < 16; ++r) p0[r] = fmaf(p0[r], C2, mnL);
#pragma unroll
    for (int r = 0; r < 16; ++r) p1[r] = fmaf(p1[r], C2, mnL);
#pragma unroll
    for (int r = 0; r < 16; ++r) p0[r] = __builtin_amdgcn_exp2f(p0[r]);
}
__device__ __forceinline__ void partialM(f32x16& p0, f32x16& p1, const float* a2k, float M2t, int hi) {
#pragma unroll
    for (int g = 0; g < 4; ++g) { const f32x4 a = *(const f32x4*)(a2k + 8 * g + 4 * hi);
#pragma unroll
        for (int j = 0; j < 4; ++j) p0[4 * g + j] *= __builtin_amdgcn_exp2f(fminf(a[j] - M2t, 0.f)); }
    SBAR();
#pragma unroll
    for (int g = 0; g < 4; ++g) { const f32x4 b = *(const f32x4*)(a2k + 32 + 8 * g + 4 * hi);
#pragma unroll
        for (int j = 0; j < 4; ++j) p1[4 * g + j] *= __builtin_amdgcn_exp2f(fminf(b[j] - M2t, 0.f)); }
}
#define AB_PK4(P, B_, OUT) do { unsigned a0 = cvtpk(P[B_+0], P[B_+1]), a1 = cvtpk(P[B_+2], P[B_+3]);                          \
        unsigned b0 = cvtpk(P[B_+4], P[B_+5]), b1 = cvtpk(P[B_+6], P[B_+7]);                                             \
        auto r0 = __builtin_amdgcn_permlane32_swap(a0, b0, false, false); auto r1 = __builtin_amdgcn_permlane32_swap(a1, b1, false, false); \
        u32x4 w = {r0[0], r1[0], r0[1], r1[1]}; OUT = *reinterpret_cast<bf16x8*>(&w); } while (0)
template <int MODE> __device__ __forceinline__ void finishSM(f32x16& p0, f32x16& p1, float alpha, float& l_reg, bf16x8& pa0, bf16x8& pa1, bf16x8& pa2, bf16x8& pa3) {
    if (MODE == 0) {
#pragma unroll
        for (int r = 0; r < 16; ++r) p1[r] = __builtin_amdgcn_exp2f(p1[r]); }
    float ps = 0;
#pragma unroll
    for (int r = 0; r < 16; ++r) ps += p0[r];
#pragma unroll
    for (int r = 0; r < 16; ++r) ps += p1[r];
    { auto rr = __builtin_amdgcn_permlane32_swap(__float_as_uint(ps), __float_as_uint(ps), false, false);
      ps = __uint_as_float(rr[0]) + __uint_as_float(rr[1]); }
    l_reg = l_reg * alpha + ps;
    AB_PK4(p0, 0, pa0); AB_PK4(p0, 8, pa1); AB_PK4(p1, 0, pa2); AB_PK4(p1, 8, pa3);
}
template <int KB>
__device__ __forceinline__ void qkt(f32x16& p0, f32x16& p1, const char* K_lds, int r32, int hi, const bf16x8* qr) {
    p0 = f32x16{}; p1 = f32x16{};
    const char* kb[4];
#pragma unroll
    for (int dd = 0; dd < 4; ++dd) kb[dd] = K_lds + KB * SHM_K + KSWZ(r32, (dd * 16 + hi * 8) * 2);
#pragma unroll
    for (int d0 = 0; d0 < 8; ++d0) { const char* a = kb[d0 & 3] + (d0 >> 2) * 128;
        bf16x8 b0 = *reinterpret_cast<const bf16x8*>(a);
        bf16x8 b1 = *reinterpret_cast<const bf16x8*>(a + 32 * 256);
        p0 = __builtin_amdgcn_mfma_f32_32x32x16_bf16(b0, qr[d0], p0, 0, 0, 0);
        p1 = __builtin_amdgcn_mfma_f32_32x32x16_bf16(b1, qr[d0], p1, 0, 0, 0); }
}
template <int VB>
__device__ __forceinline__ void pv_tile(f32x16* o, int vb0, bf16x8 pa0, bf16x8 pa1, bf16x8 pa2, bf16x8 pa3) {
#define TRRD(dst, off) asm volatile("ds_read_b64_tr_b16 %0, %1 offset:%2" : "=&v"(dst) : "v"(vb0), "i"(off) : "memory")
#define PV_D0(d0) do { s16x4 l0, l1, l2, l3, h0, h1, h2, h3; constexpr int b_ = VB * SHM_V + v_rd_off(d0, 0, 0); \
        TRRD(l0, b_); TRRD(h0, b_ + 2048); TRRD(l1, b_ + 4096); TRRD(h1, b_ + 6144); TRRD(l2, b_ + 8192); TRRD(h2, b_ + 10240); TRRD(l3, b_ + 12288); TRRD(h3, b_ + 14336); \
        asm volatile("s_waitcnt lgkmcnt(0)" ::: "memory"); SBAR();   \
        o[d0] = __builtin_amdgcn_mfma_f32_32x32x16_bf16(pa0, (bf16x8){l0[0], l0[1], l0[2], l0[3], h0[0], h0[1], h0[2], h0[3]}, o[d0], 0, 0, 0);   \
        o[d0] = __builtin_amdgcn_mfma_f32_32x32x16_bf16(pa1, (bf16x8){l1[0], l1[1], l1[2], l1[3], h1[0], h1[1], h1[2], h1[3]}, o[d0], 0, 0, 0);   \
        o[d0] = __builtin_amdgcn_mfma_f32_32x32x16_bf16(pa2, (bf16x8){l2[0], l2[1], l2[2], l2[3], h2[0], h2[1], h2[2], h2[3]}, o[d0], 0, 0, 0);   \
        o[d0] = __builtin_amdgcn_mfma_f32_32x32x16_bf16(pa3, (bf16x8){l3[0], l3[1], l3[2], l3[3], h3[0], h3[1], h3[2], h3[3]}, o[d0], 0, 0, 0); } while (0)
    PV_D0(0); PV_D0(1); PV_D0(2); PV_D0(3);
#undef PV_D0
#undef TRRD
}
template <int KB>
__device__ __forceinline__ void qkt2(f32x16& p0, f32x16& p1, const char* K_lds, int r32, int hi, const bf16x8* qr) {
    p0 = f32x16{}; p1 = f32x16{};
    int ka[4];
#pragma unroll
    for (int dd = 0; dd < 4; ++dd) ka[dd] = (int)(uintptr_t)K_lds + KB * SHM_K + KSWZ(r32, (dd * 16 + hi * 8) * 2);
#define KRD(dst, addr, off) asm volatile("ds_read_b128 %0, %1 offset:%2" : "=&v"(dst) : "v"(addr), "i"(off) : "memory")
#define QK_RD(X, Y, b) do { KRD(X[0], ka[(2 * (b)) & 3], ((2 * (b)) >> 2) * 128); KRD(Y[0], ka[(2 * (b)) & 3], ((2 * (b)) >> 2) * 128 + 32 * 256); \
        KRD(X[1], ka[(2 * (b) + 1) & 3], ((2 * (b) + 1) >> 2) * 128); KRD(Y[1], ka[(2 * (b) + 1) & 3], ((2 * (b) + 1) >> 2) * 128 + 32 * 256); } while (0)
#define QK_MM(X, Y, b) do { p0 = __builtin_amdgcn_mfma_f32_32x32x16_bf16(X[0], qr[2 * (b)], p0, 0, 0, 0); p1 = __builtin_amdgcn_mfma_f32_32x32x16_bf16(Y[0], qr[2 * (b)], p1, 0, 0, 0); \
        p0 = __builtin_amdgcn_mfma_f32_32x32x16_bf16(X[1], qr[2 * (b) + 1], p0, 0, 0, 0); p1 = __builtin_amdgcn_mfma_f32_32x32x16_bf16(Y[1], qr[2 * (b) + 1], p1, 0, 0, 0); } while (0)
    bf16x8 xa[2], ya[2], xb[2], yb[2];
    QK_RD(xa, ya, 0); QK_RD(xb, yb, 1);
    asm volatile("s_waitcnt lgkmcnt(4)" ::: "memory"); SBAR(); QK_MM(xa, ya, 0); SBAR(); QK_RD(xa, ya, 2);
    asm volatile("s_waitcnt lgkmcnt(4)" ::: "memory"); SBAR(); QK_MM(xb, yb, 1); SBAR(); QK_RD(xb, yb, 3);
    asm volatile("s_waitcnt lgkmcnt(4)" ::: "memory"); SBAR(); QK_MM(xa, ya, 2); SBAR();
    asm volatile("s_waitcnt lgkmcnt(0)" ::: "memory"); SBAR(); QK_MM(xb, yb, 3);
#undef QK_MM
#undef QK_RD
#undef KRD
}
template <int VB, bool PF>
__device__ __forceinline__ void pv_tile2(f32x16* o, int vb0, bf16x8 pa0, bf16x8 pa1, bf16x8 pa2, bf16x8 pa3) {
#define TRRD(dst, off) asm volatile("ds_read_b64_tr_b16 %0, %1 offset:%2" : "=&v"(dst) : "v"(vb0), "i"(off) : "memory")
#define PV_RD(L, H, ks) do { constexpr int b_ = VB * SHM_V + (ks) * 4096; TRRD(L[0], b_); TRRD(H[0], b_ + 2048); TRRD(L[1], b_ + 512); TRRD(H[1], b_ + 512 + 2048); \
        TRRD(L[2], b_ + 1024); TRRD(H[2], b_ + 1024 + 2048); TRRD(L[3], b_ + 1536); TRRD(H[3], b_ + 1536 + 2048); } while (0)
#define PV_MM(L, H, PA) do { _Pragma("unroll") for (int d0 = 0; d0 < 4; ++d0) \
        o[d0] = __builtin_amdgcn_mfma_f32_32x32x16_bf16(PA, (bf16x8){L[d0][0], L[d0][1], L[d0][2], L[d0][3], H[d0][0], H[d0][1], H[d0][2], H[d0][3]}, o[d0], 0, 0, 0); } while (0)
    s16x4 la[4], ha[4];
    if constexpr (PF) {
        s16x4 lb[4], hb[4];
        PV_RD(la, ha, 0); PV_RD(lb, hb, 1);
        asm volatile("s_waitcnt lgkmcnt(8)" ::: "memory"); SBAR(); PV_MM(la, ha, pa0); SBAR();
        PV_RD(la, ha, 2);
        asm volatile("s_waitcnt lgkmcnt(8)" ::: "memory"); SBAR(); PV_MM(lb, hb, pa1); SBAR();
        PV_RD(lb, hb, 3);
        asm volatile("s_waitcnt lgkmcnt(8)" ::: "memory"); SBAR(); PV_MM(la, ha, pa2); SBAR();
        asm volatile("s_waitcnt lgkmcnt(0)" ::: "memory"); SBAR(); PV_MM(lb, hb, pa3);
    } else {
        PV_RD(la, ha, 0); asm volatile("s_waitcnt lgkmcnt(0)" ::: "memory"); SBAR(); PV_MM(la, ha, pa0); SBAR();
        PV_RD(la, ha, 1); asm volatile("s_waitcnt lgkmcnt(0)" ::: "memory"); SBAR(); PV_MM(la, ha, pa1); SBAR();
        PV_RD(la, ha, 2); asm volatile("s_waitcnt lgkmcnt(0)" ::: "memory"); SBAR(); PV_MM(la, ha, pa2); SBAR();
        PV_RD(la, ha, 3); asm volatile("s_waitcnt lgkmcnt(0)" ::: "memory"); SBAR(); PV_MM(la, ha, pa3);
    }
#undef PV_MM
#undef PV_RD
#undef TRRD
}
struct BlockRef { const bf16* Q; const bf16* K; const bf16* V; float* O; int P0; const bf16* Cst; const float* nst; };
struct Seam { bf16x8 qr[8]; bf16x8 st_v0, st_v1, st_k0, st_k1; bf16x8 sb_v0, sb_v1, sb_k0, sb_k1; };
#define VMW() asm volatile("s_waitcnt vmcnt(0)" ::: "memory")
#define VMWN(n) asm volatile("s_waitcnt vmcnt(%0)" :: "i"(n) : "memory")
#define SLOAD_H(Kp, Vp, k0) do { const bf16* vb_ = (Vp) + (size_t)((k0) + wid * 4) * VP; const bf16* kb_ = (Kp) + (size_t)((k0) + wid * 4) * KP;    \
                         S.st_v0 = load8(vb_ + lov); S.st_v1 = load8(vb_ + 32 * VP + lov); S.st_k0 = load8(kb_ + lok); S.st_k1 = load8(kb_ + 32 * KP + lok); } while (0)
#define SWRITE_HK(bf) do { *(bf16x8*)(K_lds + (bf) * SHM_K + kws) = S.st_k0; *(bf16x8*)(K_lds + (bf) * SHM_K + kws + 32 * 256) = S.st_k1; } while (0)
#define SWRITE_HV(bf) do { *(bf16x8*)(V_lds + (bf) * SHM_V + vst0) = S.st_v0; *(bf16x8*)(V_lds + (bf) * SHM_V + vst1) = S.st_v1; } while (0)
#define SWRITE_H(bf) do { SWRITE_HV(bf); SWRITE_HK(bf); } while (0)
template <int QP, int KP, int VP>
__device__ __forceinline__ void prime(const BlockRef& cur, char* lds, Seam& S, const int tid, const int k0) {
    const int wid = __builtin_amdgcn_readfirstlane(tid >> 6), lane = tid & 63, r32 = lane & 31, hi = lane >> 5;
    const int sr = tid >> 4, sc = (tid & 15) * 8, kws = KSWZ(sr, sc * 2); char* K_lds = lds + 2 * SHM_V;
    const unsigned lov = (unsigned)((lane >> 4) * VP + sc), lok = (unsigned)((lane >> 4) * KP + sc), loq = (unsigned)(r32 * QP + hi * 8);
    { const bf16* qb_ = cur.Q + (size_t)(wid * QBLK) * QP;
#pragma unroll
      for (int d0 = 0; d0 < 8; ++d0) S.qr[d0] = load8(qb_ + d0 * 16 + loq); }
    SLOAD_H(cur.K, cur.V, k0); VMW(); SWRITE_HK(0);
    __syncthreads();
}
template <int MODE, int QP, int KP, int VP, int OP>
__device__ __forceinline__ void block(const BlockRef& cur, const BlockRef& nxt, char* lds, Seam& S, const int tid) {
    const int wid = __builtin_amdgcn_readfirstlane(tid >> 6), lane = tid & 63, r32 = lane & 31, hi = lane >> 5;
    const int T0 = (MODE == 1) ? cur.P0 / KVBLK : 0;
    int NT = (MODE == 1) ? QB / KVBLK : cur.P0 / KVBLK + QB / KVBLK;
    if (MODE == 1) asm volatile("" : "+s"(NT));
    const int qlo = cur.P0 + wid * QBLK, qm = qlo + r32 - 4 * hi;
    char* V_lds = lds; char* K_lds = lds + 2 * SHM_V;
    float* ws = (float*)(lds + 2 * SHM_V + 2 * SHM_K) + wid * 64; float* li_l = ws, * al_l = ws + 32;
    const float* a2 = (const float*)(lds + A2_OFF);
    float M2t = 0.f;
    if (MODE == 1) M2t = ((const float*)(lds + M2_OFF))[qlo + r32];
    float m_reg = -1e30f, l_reg = 0; f32x16 o[4] = {};
    const int sr = tid >> 4, sc = (tid & 15) * 8, vst0 = v_st(sr, sc), vst1 = v_st(32 + sr, sc), kws = KSWZ(sr, sc * 2);
    const int vb0 = (int)(uintptr_t)V_lds + v_rd_base(lane);
    const unsigned lov = (unsigned)((lane >> 4) * VP + sc), lok = (unsigned)((lane >> 4) * KP + sc), loq = (unsigned)(r32 * QP + hi * 8), loo = (unsigned)(4 * hi * OP + r32);
    const bf16* Kh = cur.K; const bf16* Vh = cur.V;
#define RESC(a) do { if (MODE == 0) { if (__any((a) < 1.f)) { if (hi == 0) al_l[r32] = (a); asm volatile("s_waitcnt lgkmcnt(0)" ::: "memory");              \
                     for (int d_ = 0; d_ < 4; ++d_) for (int r = 0; r < 16; ++r) o[d_][r] *= al_l[crow(r, hi)]; } } } while (0)
#define KBASE(t) ((T0 + (t)) * KVBLK)
#define MASKT(P0_, P1_, t) do { const int kb_ = KBASE(t); if (kb_ + KVBLK - 1 > qlo) mask_tile<MODE>(P0_, P1_, qm - kb_); } while (0)
#define PARTIAL(P0_, P1_, mnX, alX, t) do { if (MODE == 0) partialSM(P0_, P1_, m_reg, mnX, alX); else { alX = 1.f; partialM(P0_, P1_, a2 + KBASE(t), M2t, hi); } } while (0)
    constexpr int NQL = 8;
#define SEAM_K0() do { VMWN(NQL); SWRITE_HK(0); SBAR(); } while (0)
    f32x16 pA0, pA1, pB0, pB1; float mnA, mnB, alA, alB; bf16x8 pa0, pa1, pa2, pa3;
    if (MODE == 1 && cur.Cst != nullptr) {
        const bf16* Cp = cur.Cst + (size_t)(wid * 4) * 256; const unsigned loc = (unsigned)((lane >> 4) * 256 + sc);
        const bf16x8 c0 = load8(Cp + loc), c1 = load8(Cp + 32 * 256 + loc), c2 = load8(Cp + 64 * 256 + loc), c3 = load8(Cp + 96 * 256 + loc);
        float dn = 0.f;
#pragma unroll
        for (int d0 = 0; d0 < 8; ++d0) { const f32x4 n0 = *(const f32x4*)(cur.nst + 16 * d0 + 8 * hi), n1 = *(const f32x4*)(cur.nst + 16 * d0 + 8 * hi + 4);
            const u32x4 qw = *reinterpret_cast<const u32x4*>(&S.qr[d0]);
            dn += __uint_as_float(qw.x << 16) * n0[0] + __uint_as_float(qw.x & 0xffff0000u) * n0[1] + __uint_as_float(qw.y << 16) * n0[2] + __uint_as_float(qw.y & 0xffff0000u) * n0[3];
            dn += __uint_as_float(qw.z << 16) * n1[0] + __uint_as_float(qw.z & 0xffff0000u) * n1[1] + __uint_as_float(qw.w << 16) * n1[2] + __uint_as_float(qw.w & 0xffff0000u) * n1[3]; }
        { auto rr = __builtin_amdgcn_permlane32_swap(__float_as_uint(dn), __float_as_uint(dn), false, false); dn = __uint_as_float(rr[0]) + __uint_as_float(rr[1]); }
        VMW();
        *(bf16x8*)(V_lds + vst0) = c0; *(bf16x8*)(V_lds + vst1) = c1; *(bf16x8*)(V_lds + SHM_V + vst0) = c2; *(bf16x8*)(V_lds + SHM_V + vst1) = c3;
        __syncthreads();
        pv_tile<0>(o, vb0, S.qr[0], S.qr[1], S.qr[2], S.qr[3]); pv_tile<1>(o, vb0, S.qr[4], S.qr[5], S.qr[6], S.qr[7]);
        const float st = __builtin_amdgcn_exp2f(((const float*)(lds + M2_OFF))[cur.P0 - 1] - M2t);
        l_reg = st * dn;
        if (hi == 0) al_l[r32] = st;
        asm volatile("s_waitcnt lgkmcnt(0)" ::: "memory");
#pragma unroll
        for (int d_ = 0; d_ < 4; ++d_)
#pragma unroll
            for (int r = 0; r < 16; ++r) o[d_][r] *= al_l[crow(r, hi)];
        __syncthreads();
    }
    SWRITE_HV(0); SBAR();
    if (NT > 1) { SLOAD_H(Kh, Vh, KBASE(1)); }
    SBAR(); qkt<0>(pA0, pA1, K_lds, r32, hi, S.qr);
    MASKT(pA0, pA1, 0); PARTIAL(pA0, pA1, mnA, alA, 0);
    if (NT > 1) { VMW(); SWRITE_H(1); }
    __syncthreads();
#define HALF_STEP(PX0, PX1, mnX, alX, PY0, PY1, alY, t, KB, VB, SB) do {                                                      \
        SBAR(); qkt<KB>(PX0, PX1, K_lds, r32, hi, S.qr);                                             \
        finishSM<MODE>(PY0, PY1, alY, l_reg, pa0, pa1, pa2, pa3); SBAR();                                                           \
        if ((t) + 1 < NT) { SLOAD_H(Kh, Vh, KBASE((t) + 1)); SBAR(); }                                               \
        pv_tile<VB>(o, vb0, pa0, pa1, pa2, pa3); MASKT(PX0, PX1, (t)); PARTIAL(PX0, PX1, mnX, alX, (t));                                        \
        __syncthreads();                                                                                                      \
        if ((t) + 1 < NT) { VMW(); SWRITE_H(SB); }                                                                          \
        RESC(alX); __syncthreads(); } while (0)
    for (int t = 1; t + 1 < NT; t += 2) {
        HALF_STEP(pB0, pB1, mnB, alB, pA0, pA1, alA, t, 1, 0, 0);
        HALF_STEP(pA0, pA1, mnA, alA, pB0, pB1, alB, t + 1, 0, 1, 1);
    }
    const bool even = (NT & 1) == 0;
    if (even) { SBAR(); qkt<1>(pB0, pB1, K_lds, r32, hi, S.qr); SBAR(); }
    SLOAD_H(nxt.K, nxt.V, (MODE == 1) ? nxt.P0 : 0); SBAR();
    { const bf16* qb_ = nxt.Q + (size_t)(wid * QBLK) * QP;
#pragma unroll
      for (int d0 = 0; d0 < 8; ++d0) S.qr[d0] = load8(qb_ + d0 * 16 + loq); }
    SBAR();
    finishSM<MODE>(pA0, pA1, alA, l_reg, pa0, pa1, pa2, pa3); SBAR();
    pv_tile<0>(o, vb0, pa0, pa1, pa2, pa3);
    if (even) { MASKT(pB0, pB1, NT - 1); PARTIAL(pB0, pB1, mnB, alB, NT - 1); __syncthreads(); RESC(alB);
        finishSM<MODE>(pB0, pB1, alB, l_reg, pa0, pa1, pa2, pa3); SBAR(); pv_tile<1>(o, vb0, pa0, pa1, pa2, pa3); }
    SBAR(); SEAM_K0();
    if (hi == 0) li_l[r32] = (MODE == 0) ? l_reg : fmaxf(fabsf(l_reg), __builtin_amdgcn_exp2f(((const float*)(lds + E2_OFF))[qlo + r32]));
    asm volatile("s_waitcnt lgkmcnt(0)" ::: "memory");
    float rli[16];
#pragma unroll
    for (int r = 0; r < 16; ++r) rli[r] = __builtin_amdgcn_rcpf(li_l[crow(r, hi)]);
    float* Ow = cur.O + (size_t)(wid * QBLK) * OP;
#pragma unroll
    for (int r = 0; r < 16; ++r) { float* Or = Ow + (size_t)((r & 3) + 8 * (r >> 2)) * OP;
#pragma unroll
        for (int d0 = 0; d0 < 4; ++d0) Or[d0 * 32 + loo] = o[d0][r] * rli[r]; }
    __syncthreads();
#undef RESC
#undef KBASE
#undef MASKT
#undef PARTIAL
#undef SEAM_K0
#undef HALF_STEP
}

#define PP_BAR() do { asm volatile("s_waitcnt lgkmcnt(0)" ::: "memory"); __builtin_amdgcn_s_barrier(); asm volatile("" ::: "memory"); SBAR(); } while (0)
constexpr int SB_OFF = 98304;
static_assert(LDS_NEED <= SB_OFF && SB_OFF + 2 * SHM_V <= 131072, "lds map");
template <int MODE, int QP, int KP, int VP>
__device__ __forceinline__ void prime2(const BlockRef& cur, char* lds, Seam& S, const int tid) {
    const int wid = __builtin_amdgcn_readfirstlane(tid >> 6), lane = tid & 63, r32 = lane & 31, hi = lane >> 5;
    const int sr = tid >> 4, sc = (tid & 15) * 8, kws = KSWZ(sr, sc * 2); char* K_lds = lds + 2 * SHM_V;
    const unsigned lov = (unsigned)((lane >> 4) * VP + sc), lok = (unsigned)((lane >> 4) * KP + sc), loq = (unsigned)(r32 * QP + hi * 8);
    const int k0 = (MODE == 1) ? cur.P0 : 0;
    { const bf16* qb_ = cur.Q + (size_t)(wid * QBLK) * QP;
#pragma unroll
      for (int d0 = 0; d0 < 8; ++d0) S.qr[d0] = load8(qb_ + d0 * 16 + loq); }
    { const bf16* kb_ = cur.K + (size_t)(k0 + wid * 4) * KP; S.st_k0 = load8(kb_ + lok); S.st_k1 = load8(kb_ + 32 * KP + lok); }
    *(bf16x8*)(K_lds + kws) = S.st_k0; *(bf16x8*)(K_lds + kws + 32 * 256) = S.st_k1;
    SBAR();
    { const bf16* kb_ = cur.K + (size_t)(k0 + KVBLK + wid * 4) * KP; const bf16* vb_ = cur.V + (size_t)(k0 + wid * 4) * VP;
      S.st_k0 = load8(kb_ + lok); S.st_k1 = load8(kb_ + 32 * KP + lok); S.st_v0 = load8(vb_ + lov); S.st_v1 = load8(vb_ + 32 * VP + lov);
      if (MODE == 0) { S.sb_k0 = load8(kb_ + (size_t)KVBLK * KP + lok); S.sb_k1 = load8(kb_ + (size_t)(KVBLK + 32) * KP + lok); S.sb_v0 = load8(vb_ + (size_t)KVBLK * VP + lov); S.sb_v1 = load8(vb_ + (size_t)(KVBLK + 32) * VP + lov); } }
    PP_BAR();
    if (wid >= 4) PP_BAR();
}
__device__ __forceinline__ void pp_realign(const int tid) { if (__builtin_amdgcn_readfirstlane(tid >> 6) < 4) PP_BAR(); }
template <int MODE, int QP, int KP, int VP, int OP>
__device__ __forceinline__ void block2(const BlockRef& cur, const BlockRef& nxt, char* lds, Seam& S, const int tid) {
    const int wid = __builtin_amdgcn_readfirstlane(tid >> 6), lane = tid & 63, r32 = lane & 31, hi = lane >> 5;
    const int T0 = (MODE == 1) ? cur.P0 / KVBLK : 0, T0n = (MODE == 1) ? nxt.P0 / KVBLK : 0;
    int NT = (MODE == 1) ? QB / KVBLK : cur.P0 / KVBLK + QB / KVBLK;
    if (MODE == 1) asm volatile("" : "+s"(NT));
    const int qlo = cur.P0 + wid * QBLK, qm = qlo + r32 - 4 * hi;
    char* V_lds = lds; char* K_lds = lds + 2 * SHM_V;
    float* ws = (float*)(lds + 2 * SHM_V + 2 * SHM_K) + wid * 64; float* li_l = ws, * al_l = ws + 32;
    const float* a2 = (const float*)(lds + A2_OFF);
    float M2t = 0.f;
    if (MODE == 1) M2t = ((const float*)(lds + M2_OFF))[qlo + r32];
    float m_reg = -1e30f, l_reg = 0; f32x16 o[4] = {};
    const int sr = tid >> 4, sc = (tid & 15) * 8, vst0 = v_st(sr, sc), vst1 = v_st(32 + sr, sc), kws = KSWZ(sr, sc * 2);
    const int vb0 = (int)(uintptr_t)V_lds + v_rd_base(lane);
    const unsigned lov = (unsigned)((lane >> 4) * VP + sc), lok = (unsigned)((lane >> 4) * KP + sc), loq = (unsigned)(r32 * QP + hi * 8), loo = (unsigned)(4 * hi * OP + r32);
#define KBASE2(t) ((T0 + (t)) * KVBLK)
#define LOADKV(K0, K1, V0, V1, kt, vt) do { const bool kn_ = (kt) >= NT, vn_ = (vt) >= NT;                                                            \
        const bf16* kb_ = (kn_ ? nxt.K : cur.K) + (size_t)(((kn_ ? T0n - NT : T0) + (kt)) * KVBLK + wid * 4) * KP;                                   \
        const bf16* vb_ = (vn_ ? nxt.V : cur.V) + (size_t)(((vn_ ? T0n - NT : T0) + (vt)) * KVBLK + wid * 4) * VP;                                   \
        K0 = load8(kb_ + lok); K1 = load8(kb_ + 32 * KP + lok); V0 = load8(vb_ + lov); V1 = load8(vb_ + 32 * VP + lov); } while (0)
#define WRITEKV(K0, K1, V0, V1, kbuf, vbuf) do { *(bf16x8*)(K_lds + (kbuf) * SHM_K + kws) = K0; *(bf16x8*)(K_lds + (kbuf) * SHM_K + kws + 32 * 256) = K1;    \
        *(bf16x8*)(V_lds + (vbuf) * SHM_V + vst0) = V0; *(bf16x8*)(V_lds + (vbuf) * SHM_V + vst1) = V1; } while (0)
#define WRITE_A(kbuf, vbuf) WRITEKV(S.st_k0, S.st_k1, S.st_v0, S.st_v1, kbuf, vbuf)
#define WRITE_B(kbuf, vbuf) WRITEKV(S.sb_k0, S.sb_k1, S.sb_v0, S.sb_v1, kbuf, vbuf)
#define LOAD_A(kt, vt) LOADKV(S.st_k0, S.st_k1, S.st_v0, S.st_v1, kt, vt)
#define LOAD_B(kt, vt) LOADKV(S.sb_k0, S.sb_k1, S.sb_v0, S.sb_v1, kt, vt)
    f32x16 p0, p1; float mn, al; bf16x8 pa0, pa1, pa2, pa3;
#define VV_STAGE(t) do { { const int kb_ = KBASE2(t); if (kb_ + KVBLK - 1 > qlo) mask_tile<MODE>(p0, p1, qm - kb_); }                                 \
        if (MODE == 0) { partialSM(p0, p1, m_reg, mn, al);                                                                                             \
            if (__any(al < 1.f)) { if (hi == 0) al_l[r32] = al; asm volatile("s_waitcnt lgkmcnt(0)" ::: "memory");                                     \
                _Pragma("unroll") for (int d_ = 0; d_ < 4; ++d_) _Pragma("unroll") for (int r = 0; r < 16; ++r) o[d_][r] *= al_l[crow(r, hi)]; } }                  \
        else { al = 1.f; partialM(p0, p1, a2 + KBASE2(t), M2t, hi); }                                                                                  \
        finishSM<MODE>(p0, p1, al, l_reg, pa0, pa1, pa2, pa3); } while (0)
    if (MODE == 1 && cur.Cst != nullptr) {
        const bf16* Cp = cur.Cst + (size_t)(wid * 4) * 256; const unsigned loc = (unsigned)((lane >> 4) * 256 + sc);
        const bf16x8 c0 = load8(Cp + loc), c1 = load8(Cp + 32 * 256 + loc), c2 = load8(Cp + 64 * 256 + loc), c3 = load8(Cp + 96 * 256 + loc);
        *(bf16x8*)(lds + SB_OFF + vst0) = c0; *(bf16x8*)(lds + SB_OFF + vst1) = c1; *(bf16x8*)(lds + SB_OFF + SHM_V + vst0) = c2; *(bf16x8*)(lds + SB_OFF + SHM_V + vst1) = c3;
        PP_BAR();
        float dn = 0.f;
#pragma unroll
        for (int d0 = 0; d0 < 8; ++d0) { const f32x4 n0 = *(const f32x4*)(cur.nst + 16 * d0 + 8 * hi), n1 = *(const f32x4*)(cur.nst + 16 * d0 + 8 * hi + 4);
            const u32x4 qw = *reinterpret_cast<const u32x4*>(&S.qr[d0]);
            dn += __uint_as_float(qw.x << 16) * n0[0] + __uint_as_float(qw.x & 0xffff0000u) * n0[1] + __uint_as_float(qw.y << 16) * n0[2] + __uint_as_float(qw.y & 0xffff0000u) * n0[3];
            dn += __uint_as_float(qw.z << 16) * n1[0] + __uint_as_float(qw.z & 0xffff0000u) * n1[1] + __uint_as_float(qw.w << 16) * n1[2] + __uint_as_float(qw.w & 0xffff0000u) * n1[3]; }
        { auto rr = __builtin_amdgcn_permlane32_swap(__float_as_uint(dn), __float_as_uint(dn), false, false); dn = __uint_as_float(rr[0]) + __uint_as_float(rr[1]); }
        PP_BAR();
        pv_tile2<0, MODE == 0>(o, vb0 + SB_OFF, S.qr[0], S.qr[1], S.qr[2], S.qr[3]); pv_tile2<1, MODE == 0>(o, vb0 + SB_OFF, S.qr[4], S.qr[5], S.qr[6], S.qr[7]);
        const float st = __builtin_amdgcn_exp2f(((const float*)(lds + M2_OFF))[cur.P0 - 1] - M2t);
        l_reg = st * dn;
        if (hi == 0) al_l[r32] = st;
        asm volatile("s_waitcnt lgkmcnt(0)" ::: "memory");
#pragma unroll
        for (int d_ = 0; d_ < 4; ++d_)
#pragma unroll
            for (int r = 0; r < 16; ++r) o[d_][r] *= al_l[crow(r, hi)];
        PP_BAR();
    }
    for (int t = 0; t < NT; t += 2) {
        WRITE_A(1, 0); SBAR(); if (MODE == 0) LOAD_A(t + 3, t + 2); else LOAD_A(t + 2, t + 1); SBAR();
        if (t > 0) pv_tile2<1, MODE == 0>(o, vb0, pa0, pa1, pa2, pa3);
        qkt2<0>(p0, p1, K_lds, r32, hi, S.qr);
        PP_BAR();
        VV_STAGE(t);
        PP_BAR();
        if (MODE == 0) { WRITE_B(0, 1); SBAR(); LOAD_B(t + 4, t + 3); } else { WRITE_A(0, 1); SBAR(); LOAD_A(t + 3, t + 2); } SBAR();
        pv_tile2<0, MODE == 0>(o, vb0, pa0, pa1, pa2, pa3);
        qkt2<1>(p0, p1, K_lds, r32, hi, S.qr);
        PP_BAR();
        VV_STAGE(t + 1);
        PP_BAR();
    }
    { const bf16* qb_ = nxt.Q + (size_t)(wid * QBLK) * QP;
#pragma unroll
      for (int d0 = 0; d0 < 8; ++d0) S.qr[d0] = load8(qb_ + d0 * 16 + loq); }
    SBAR();
    pv_tile2<1, MODE == 0>(o, vb0, pa0, pa1, pa2, pa3);
    PP_BAR();
    if (hi == 0) li_l[r32] = (MODE == 0) ? l_reg : fmaxf(fabsf(l_reg), __builtin_amdgcn_exp2f(((const float*)(lds + E2_OFF))[qlo + r32]));
    asm volatile("s_waitcnt lgkmcnt(0)" ::: "memory");
    float rli[16];
#pragma unroll
    for (int r = 0; r < 16; ++r) rli[r] = __builtin_amdgcn_rcpf(li_l[crow(r, hi)]);
    { bf16* Ow = (bf16*)cur.O + (size_t)(wid * QBLK) * OP;
#pragma unroll
      for (int r = 0; r < 16; ++r) { bf16* Or = Ow + (size_t)((r & 3) + 8 * (r >> 2)) * OP;
#pragma unroll
          for (int d0 = 0; d0 < 4; ++d0) { const float v = o[d0][r] * rli[r];
              const float nb = __uint_as_float(__builtin_amdgcn_update_dpp(0u, __float_as_uint(v), 0xB1, 0xf, 0xf, false));
              if ((r32 & 1) == 0) *(unsigned*)(Or + d0 * 32 + loo) = cvtpk(v, nb); } } }
    PP_BAR();
#undef KBASE2
#undef LOADKV
#undef WRITEKV
#undef WRITE_A
#undef WRITE_B
#undef LOAD_A
#undef LOAD_B
#undef VV_STAGE
}
#undef VMW
#undef VMWN
#undef SLOAD_H
#undef SWRITE_HK
#undef SWRITE_HV
#undef SWRITE_H
}

constexpr int NWAVES = 8;
constexpr int BATCH = 4, SEQ = 2048, DM = 2048, DEPTH = 4, MTOK = BATCH * SEQ;
constexpr int NIN = 16400, NING = 16384, GATE_COL = 6144, DFF = 5632, NUP = 2 * DFF;
constexpr float EPS = 1e-6f;
constexpr int NPH_L = 7, NPHASE = 2 + DEPTH * NPH_L;
constexpr size_t MiB = 1u << 20;
constexpr size_t WS_CTL = 0, CTL_ZERO_BYTES = 1 * MiB;
constexpr size_t WS_ROPE = 1 * MiB;
constexpr size_t WS_BIASG = WS_ROPE + 512 * 1024;
constexpr size_t WS_GATES = 2 * MiB;
constexpr size_t WS_ROWSS_B = 3 * MiB - 64 * 1024;
constexpr size_t WS_ROWSS = 3 * MiB;
constexpr size_t WS_WIN = 4 * MiB, SZ_WIN = 64 * MiB;
constexpr size_t WS_WBM = WS_WIN + 4 * SZ_WIN, SZ_WSQ = 8 * MiB;
constexpr size_t WS_WBD = WS_WBM + 4 * SZ_WSQ, WS_WO = WS_WBD + 4 * SZ_WSQ;
constexpr size_t WS_WUP = WS_WO + 4 * SZ_WSQ, SZ_WUP = 44 * MiB;
constexpr size_t WS_WDN = WS_WUP + 4 * SZ_WUP, SZ_WDN = 22 * MiB;
constexpr size_t WS_H = WS_WDN + 4 * SZ_WDN;
constexpr size_t WS_GWF = WS_H;
constexpr size_t WS_XN = WS_H + 64 * MiB;
constexpr size_t WS_MQ = WS_XN + 32 * MiB, WS_MK = WS_MQ + 16 * MiB, WS_MV = WS_MK + 16 * MiB, WS_SMO = WS_MV + 32 * MiB;
constexpr size_t WS_AQ = WS_SMO + 32 * MiB, WS_AK = WS_AQ + 32 * MiB, WS_AV = WS_AK + 32 * MiB, WS_SG = WS_AV + 32 * MiB;
constexpr size_t WS_OATT = WS_SG + 64 * MiB;
constexpr size_t WS_HRAW = WS_OATT + 128 * MiB;
constexpr size_t WS_HMN = WS_HRAW + 64 * MiB, WS_HAN = WS_HMN + 32 * MiB;
constexpr size_t WS_P = WS_HAN + 32 * MiB;
constexpr size_t WS_Y = WS_P + 64 * MiB;
constexpr size_t WS_FXC = WS_Y + 32 * MiB, WS_FXV = WS_FXC + 3 * MiB, WS_FXG = WS_FXV + 3 * MiB;
constexpr size_t WS_U = WS_FXG + 3 * MiB;
constexpr size_t WS_CST = WS_U + 88 * MiB;
constexpr size_t WS_NST = WS_CST + 16 * MiB;
constexpr size_t WS_END = WS_NST + 1 * MiB;
constexpr int CW_TMO = 0, CW_CODE = 1, CW_BAR = 4096, CW_GCNT = 200000, CW_SFLAG = 210000, CW_TICK = 240000, CW_ATICK = 250000;
constexpr int LDS_BYTES = 131072 + 2048, MISC_OFF = 131072;
static_assert(ab::LDS_NEED <= 131072, "lds");

#define GAS __attribute__((address_space(1)))
#define LAS __attribute__((address_space(3)))
typedef unsigned short bf16;
typedef unsigned v4u __attribute__((ext_vector_type(4)));
typedef unsigned v2u __attribute__((ext_vector_type(2)));
typedef float f32x4 __attribute__((ext_vector_type(4)));
typedef GAS unsigned gu32;
#define RLX_AGENT __ATOMIC_RELAXED, __HIP_MEMORY_SCOPE_AGENT
#define LDS_WAIT() asm volatile("s_waitcnt lgkmcnt(0)" ::: "memory")
#define VM_WAIT() asm volatile("s_waitcnt vmcnt(0)" ::: "memory")
__device__ __forceinline__ unsigned pk2(float lo, float hi) { return pg8::cvt_pk_bf16(lo, hi); }

#define XB_TMO      128
#define XB_XCNT(j)  (256  + 64 * (j))
#define XB_XSUB(j)  (1280 + 64 * (j))
#define XB_XGEN(j)  (2304 + 64 * (j))
#define XB_TOP      3328
#define XB_TOPGEN   3392
#define XCD_BAR_WORDS 3456
#define XB_SPIN_CAP (1u << 18)
__device__ __forceinline__ unsigned xb_ld(unsigned* p)              { return __hip_atomic_load(p, __ATOMIC_RELAXED, __HIP_MEMORY_SCOPE_AGENT); }
__device__ __forceinline__ unsigned xb_add(unsigned* p, unsigned v) { return __hip_atomic_fetch_add(p, v, __ATOMIC_RELAXED, __HIP_MEMORY_SCOPE_AGENT); }
__device__ __forceinline__ unsigned xb_xcc_id() { return (unsigned)__builtin_amdgcn_s_getreg((3 << 11) | 20) & 0xFu; }
#define XB_SPIN(cond, bar) do { unsigned _sp = 0; while (cond) { __builtin_amdgcn_s_sleep(1); \
    if ((++_sp & 255u) == 0u) { if (xb_ld(&(bar)[XB_TMO])) break; if (_sp > XB_SPIN_CAP) { atomicAdd(&(bar)[XB_TMO], 1u); break; } } } } while (0)
struct XcdBarrier { unsigned* bar; unsigned x; volatile LAS unsigned* st; };
__device__ __forceinline__ XcdBarrier xcd_barrier_post(unsigned* bar, volatile LAS unsigned* st) {
    XcdBarrier b; b.bar = bar; b.x = xb_xcc_id(); b.st = st;
    if (threadIdx.x == 0) (void)xb_add(&bar[XB_XCNT(b.x)], 1u);
    return b;
}
__device__ __forceinline__ void xcd_barrier_complete(unsigned* bar, unsigned x, unsigned& nloc, unsigned& nx) {
    const unsigned G = gridDim.x * gridDim.y * gridDim.z;
    unsigned sum, cnt, mine, sp = 0u;
    for (;;) {
        sum = 0u; cnt = 0u; mine = 0u;
#pragma unroll
        for (unsigned j = 0; j < 16; ++j) { const unsigned c = xb_ld(&bar[XB_XCNT(j)]); sum += c; cnt += (c > 0u) ? 1u : 0u; mine = (j == x) ? c : mine; }
        if (sum == G) break;
        __builtin_amdgcn_s_sleep(1);
        if ((++sp & 255u) == 0u) { if (xb_ld(&bar[XB_TMO])) break; if (sp > XB_SPIN_CAP) { atomicAdd(&bar[XB_TMO], 1u); break; } }
    }
    nloc = mine > 0u ? mine : 1u; nx = cnt > 0u ? cnt : 1u;
}
__device__ __forceinline__ void xcd_barrier(const XcdBarrier& b) {
    asm volatile("s_waitcnt vmcnt(0)" ::: "memory");
    __syncthreads();
    if (threadIdx.x == 0) {
        unsigned* bar = b.bar;
        __builtin_amdgcn_s_waitcnt(0);
        unsigned nloc = b.st[0], nx = b.st[1];
        if (nloc == 0u) { xcd_barrier_complete(bar, b.x, nloc, nx); b.st[0] = nloc; b.st[1] = nx; }
        const unsigned old = xb_add(&bar[XB_XSUB(b.x)], 1u);
        const unsigned gen = old / nloc;
        if (old + 1u == (gen + 1u) * nloc) {
            __builtin_amdgcn_fence(__ATOMIC_RELEASE, "agent");
            asm volatile("s_waitcnt vmcnt(0)" ::: "memory");
            const unsigned og = xb_add(&bar[XB_TOP], 1u);
            const unsigned tg = og / nx;
            if (og + 1u == (tg + 1u) * nx) xb_add(&bar[XB_TOPGEN], 1u);
            else XB_SPIN(xb_ld(&bar[XB_TOPGEN]) == tg, bar);
            __builtin_amdgcn_fence(__ATOMIC_ACQUIRE, "agent");
            xb_add(&bar[XB_XGEN(b.x)], 1u);
            asm volatile("s_waitcnt vmcnt(0)" ::: "memory");
        } else {
            XB_SPIN(xb_ld(&bar[XB_XGEN(b.x)]) == gen, bar);
            __builtin_amdgcn_fence(__ATOMIC_ACQUIRE, "agent");
            asm volatile("s_waitcnt vmcnt(0)" ::: "memory");
        }
    }
    __syncthreads();
}

#ifndef TPS
#define TPS 0
#define TPS_WG 0
#endif
#define TPS_POINT(n) do { if (TPS == (n) && F.bid == TPS_WG) F.tp += __builtin_amdgcn_s_memrealtime() - F.tp0; } while (0)
struct Frame {
    LAS unsigned char* lds; unsigned char* ldsg;
    int tid, lane, wave, bid, vcu, G;
    unsigned char* ws;
    unsigned long long tp, tp0;
};
enum { I_X = 0, I_NORM_MIX, I_W_IN, I_B_IN, I_M_NORM, I_A_NORM, I_LAM_QK, I_W_BM, I_W_BD, I_W_O, I_NORM_FFN, I_W_UP, I_CONV_W, I_CONV_B, I_W_DOWN, I_NORM_FINAL, I_OUT, I_NPTR };
constexpr int PTAB_OFF = 131072 + 256;
__device__ __forceinline__ const float* inp(const Frame& F, int i) {
    const LAS unsigned* t = (const LAS unsigned*)(F.lds + PTAB_OFF) + 2 * i;
    const unsigned lo = __builtin_amdgcn_readfirstlane(t[0]), hi = __builtin_amdgcn_readfirstlane(t[1]);
    return (const float*)(const GAS float*)(((unsigned long long)hi << 32) | lo);
}
template <int CTRL, int RM> __device__ __forceinline__ float dppf(float old, float src) {
    return __uint_as_float(__builtin_amdgcn_update_dpp(__float_as_uint(old), __float_as_uint(src), CTRL, RM, 0xf, false)); }
__device__ __forceinline__ float wave_sum(float v) {
    v += dppf<0xB1, 0xf>(0.f, v); v += dppf<0x4E, 0xf>(0.f, v); v += dppf<0x141, 0xf>(0.f, v); v += dppf<0x140, 0xf>(0.f, v);
    { auto rr = __builtin_amdgcn_permlane16_swap(__float_as_uint(v), __float_as_uint(v), false, false); v = __uint_as_float(rr[0]) + __uint_as_float(rr[1]); }
    { auto rr = __builtin_amdgcn_permlane32_swap(__float_as_uint(v), __float_as_uint(v), false, false); v = __uint_as_float(rr[0]) + __uint_as_float(rr[1]); }
    return v;
}
__device__ __forceinline__ float wave_scan_sum(float v) {
    v += dppf<0x111, 0xf>(0.f, v); v += dppf<0x112, 0xf>(0.f, v); v += dppf<0x114, 0xf>(0.f, v); v += dppf<0x118, 0xf>(0.f, v);
    v += dppf<0x142, 0xa>(0.f, v); v += dppf<0x143, 0xc>(0.f, v); return v;
}
__device__ __forceinline__ float wave_scan_max(float v) {
    const float NEG = -__builtin_inff();
    v = fmaxf(v, dppf<0x111, 0xf>(NEG, v)); v = fmaxf(v, dppf<0x112, 0xf>(NEG, v)); v = fmaxf(v, dppf<0x114, 0xf>(NEG, v)); v = fmaxf(v, dppf<0x118, 0xf>(NEG, v));
    v = fmaxf(v, dppf<0x142, 0xa>(NEG, v)); v = fmaxf(v, dppf<0x143, 0xc>(NEG, v)); return v;
}

struct CvtJob { const float* W; bf16* Bt; const float* gain; int Nsrc, K, k0, srccol0, dstrow0, rope, hasg; };
constexpr int IT_IN = 32 * 256, IT_SQ = 32 * 32, IT_UP = 32 * 176, IT_DN = 88 * 32, IT_LAYER = IT_IN + 3 * IT_SQ + IT_UP + IT_DN, IT_TOTAL = DEPTH * IT_LAYER, IT_A = IT_IN + 3 * IT_SQ;
__host__ __device__ __forceinline__ int tail_idle(int G) { const int nu = (MTOK / 256) * (NUP / 256), rounds = (nu + G - 1) / G, busy = nu - (rounds - 1) * G; const int idle = G - busy; return idle >= 64 ? idle : 0; }
__device__ __forceinline__ void cvt_decode(const Frame& F, int it, CvtJob& j) {
    const int l = it / IT_LAYER; int r = it - l * IT_LAYER; j.rope = 0; j.gain = inp(F, I_NORM_MIX); j.hasg = 0;
    if (r < IT_IN) { const int nb = r >> 5, kt = r & 31, n0 = nb * 64;
        j.W = inp(F, I_W_IN) + (size_t)l * DM * NIN; j.Bt = (bf16*)(F.ws + WS_WIN + (size_t)l * SZ_WIN); j.Nsrc = NIN; j.K = DM; j.k0 = kt * 64; j.gain = inp(F, I_NORM_MIX) + (size_t)l * DM; j.hasg = 1;
        j.srccol0 = n0 < GATE_COL ? n0 : n0 + 16; j.dstrow0 = n0; j.rope = (n0 >= 6144 && n0 < 10240 && (n0 & 127) == 0) ? 1 : 0; return; }
    r -= IT_IN;
    if (r < 3 * IT_SQ) { const int w = r / IT_SQ; r -= w * IT_SQ; const int nb = r >> 5, kt = r & 31;
        j.W = (w == 0 ? inp(F, I_W_BM) : (w == 1 ? inp(F, I_W_BD) : inp(F, I_W_O))) + (size_t)l * DM * DM;
        j.Bt = (bf16*)(F.ws + (w == 0 ? WS_WBM : (w == 1 ? WS_WBD : WS_WO)) + (size_t)l * SZ_WSQ); j.Nsrc = DM; j.K = DM; j.k0 = kt * 64; j.srccol0 = nb * 64; j.dstrow0 = nb * 64; return; }
    r -= 3 * IT_SQ;
    if (r < IT_UP) { const int nb = r >> 5, kt = r & 31, n0 = nb * 64, pn = n0 >> 8, w = n0 & 255;
        j.W = inp(F, I_W_UP) + (size_t)l * DM * NUP; j.Bt = (bf16*)(F.ws + WS_WUP + (size_t)l * SZ_WUP); j.Nsrc = NUP; j.K = DM; j.k0 = kt * 64; j.gain = inp(F, I_NORM_FFN) + (size_t)l * DM; j.hasg = 1;
        j.srccol0 = (w < 128) ? pn * 128 + w : DFF + pn * 128 + (w - 128); j.dstrow0 = n0; return; }
    r -= IT_UP;
    { const int nb = r / 88, kt = r - nb * 88;
      j.W = inp(F, I_W_DOWN) + (size_t)l * DFF * DM; j.Bt = (bf16*)(F.ws + WS_WDN + (size_t)l * SZ_WDN); j.Nsrc = DM; j.K = DFF; j.k0 = kt * 64; j.srccol0 = nb * 64; j.dstrow0 = nb * 64; }
}
__device__ __forceinline__ void cvt_load(const CvtJob& j, int lane, f32x4 (&v)[16], float (&gn)[16]) {
    const float* p = j.W + (size_t)(j.k0 + (lane >> 4)) * j.Nsrc + j.srccol0 + (lane & 15) * 4;
#pragma unroll
    for (int i = 0; i < 16; ++i) v[i] = *(const f32x4*)(p + (size_t)(4 * i) * j.Nsrc);
#pragma unroll
    for (int i = 0; i < 16; ++i) gn[i] = j.gain[j.k0 + (lane >> 4) + 4 * i];
}
__device__ __forceinline__ void cvt_store(const CvtJob& j, int lane, const f32x4 (&v)[16], const float (&gn)[16], LAS float* scr) {
#pragma unroll
    for (int i = 0; i < 16; ++i) { const int r = (lane >> 4) + 4 * i, n = (lane & 15) * 4; *(LAS f32x4*)(scr + r * 64 + (n ^ ((i >> 1) << 2))) = v[i] * (j.hasg ? gn[i] : 1.0f); }
    LDS_WAIT(); asm volatile("" ::: "memory");
    const int c = lane & 7;
#pragma unroll
    for (int i = 0; i < 8; ++i) { const int n = (lane >> 3) + 8 * i; const LAS float* s = scr + (8 * c) * 64 + (n ^ (c << 2));
        v4u o; o.x = pk2(s[0 * 64], s[1 * 64]); o.y = pk2(s[2 * 64], s[3 * 64]); o.z = pk2(s[4 * 64], s[5 * 64]); o.w = pk2(s[6 * 64], s[7 * 64]);
        int nd = n; if (j.rope && n < 32) nd = (n < 16) ? 2 * n : 2 * (n - 16) + 1;
        *(v4u*)(j.Bt + (size_t)(j.dstrow0 + nd) * j.K + j.k0 + 8 * c) = o; }
    LDS_WAIT(); asm volatile("" ::: "memory");
}
__device__ __forceinline__ void sincos_d(double ang, float& s, float& c) {
    const double TWO_PI = 6.283185307179586476925286766559; const double k = rint(ang / TWO_PI); const double r = ang - k * TWO_PI; const double r2 = r * r;
    double ts = 1.0, tc = 1.0, ss = 1.0, cc = 1.0;
#pragma unroll
    for (int i = 1; i <= 16; ++i) { tc = -tc * r2 / (double)((2 * i - 1) * (2 * i)); ts = -ts * r2 / (double)((2 * i) * (2 * i + 1)); cc += tc; ss += ts; }
    s = (float)(ss * r); c = (float)cc;
}
__device__ __forceinline__ void cvt_run(Frame& F, int it0, int n, int w, int nw) {
    LAS float* scr = (LAS float*)(F.lds + F.wave * 16384);
    const int per = (n + nw - 1) / nw; int it = it0 + w * per; const int it1 = (it + per < it0 + n) ? it + per : it0 + n;
    CvtJob j0, j1; f32x4 v0[16], v1[16]; float g0[16], g1[16];
    if (it < it1) { cvt_decode(F, it, j0); cvt_load(j0, F.lane, v0, g0); }
    for (; it < it1; it += 2) {
        if (it + 1 < it1) { cvt_decode(F, it + 1, j1); cvt_load(j1, F.lane, v1, g1); }
        cvt_store(j0, F.lane, v0, g0, scr);
        if (it + 1 >= it1) break;
        if (it + 2 < it1) { cvt_decode(F, it + 2, j0); cvt_load(j0, F.lane, v0, g0); }
        cvt_store(j1, F.lane, v1, g1, scr);
    }
}
__device__ __forceinline__ void p0_prologue(Frame& F) {
    const int gw = F.bid * NWAVES + F.wave, NGW = F.G * NWAVES;
    cvt_run(F, 0, tail_idle(F.G) ? IT_A : IT_LAYER, gw, NGW);
    const int gt = F.bid * 512 + F.tid, NGT = F.G * 512;
    { float* bg = (float*)(F.ws + WS_BIASG);
      for (int i = gt; i < DEPTH * NING; i += NGT) { const int l = i >> 14, n = i & (NING - 1); int src = n < GATE_COL ? n : n + 16;
          if (n >= 6144 && n < 10240 && (n & 127) < 32) { const int p = n & 127, dim = (p & 1) ? 16 + (p >> 1) : (p >> 1); src = (n & ~127) + dim + 16; }
          bg[i] = inp(F, I_B_IN)[(size_t)l * NIN + src]; } }
    { unsigned short* gwf = (unsigned short*)(F.ws + WS_GWF);
      for (int i = gt; i < DEPTH * DM * 4; i += NGT) { const int l = i >> 13, k = (i >> 2) & (DM - 1), q = i & 3;
          const f32x4 w = *(const f32x4*)(inp(F, I_W_IN) + (size_t)l * DM * NIN + (size_t)k * NIN + GATE_COL + 4 * q) * inp(F, I_NORM_MIX)[l * DM + k];
          const int ks = k >> 5, kq = (k >> 3) & 3, e = k & 7;
#pragma unroll
          for (int j = 0; j < 4; ++j) { const unsigned hi = pk2(w[j], 0.f) & 0xffffu; const unsigned lo = pk2(w[j] - __uint_as_float(hi << 16), 0.f) & 0xffffu;
              const size_t o = ((((size_t)l * 64 + ks) * 2) * 64 + 16 * kq + 4 * q + j) * 8 + e;
              gwf[o] = (unsigned short)hi; gwf[o + 64 * 8] = (unsigned short)lo; } } }
    { float* rp = (float*)(F.ws + WS_ROPE);
      for (int i = gt; i < SEQ * 16; i += NGT) { const int pos = i >> 4, k = i & 15; const double inv = exp2(-(double)k * (18.931568569324174 / 16.0));
          float s, c; sincos_d((double)pos * inv, s, c); rp[pos * 32 + k] = c; rp[pos * 32 + 16 + k] = s; } }
    { bf16* xn = (bf16*)(F.ws + WS_XN); pg8::u64_t* rb = (pg8::u64_t*)(F.ws + WS_ROWSS_B); const float* x = inp(F, I_X);
      for (int row = gw; row < MTOK; row += NGW) { const f32x4* xr = (const f32x4*)(x + (size_t)row * DM) + F.lane; v2u* o8 = (v2u*)(xn + (size_t)row * DM) + F.lane; float ss = 0.f;
          f32x4 xv8[8];
#pragma unroll
          for (int j = 0; j < 8; ++j) xv8[j] = xr[64 * j];
#pragma unroll
          for (int j = 0; j < 8; ++j) { const f32x4 v = xv8[j]; v2u w; w.x = pk2(v.x, v.y); w.y = pk2(v.z, v.w); o8[64 * j] = w;
              ss += (pg8::bf_lo(w.x) * pg8::bf_lo(w.x) + pg8::bf_hi(w.x) * pg8::bf_hi(w.x)) + (pg8::bf_lo(w.y) * pg8::bf_lo(w.y) + pg8::bf_hi(w.y) * pg8::bf_hi(w.y)); }
          ss = wave_sum(ss); if (F.lane == 0) rb[row] = pg8::ss_fix(ss); } }
}

__device__ __forceinline__ void gates_step(Frame& F, int l, gu32* cnt) {
    const float* bl = inp(F, I_B_IN) + (size_t)l * NIN;
    const bf16* hb = (const bf16*)(F.ws + WS_XN); const pg8::u64_t* rowss = (const pg8::u64_t*)(F.ws + WS_ROWSS_B); float* gates = (float*)(F.ws + WS_GATES);
    const bf16* gwf = (const bf16*)(F.ws + WS_GWF) + (size_t)l * (64 * 2 * 64 * 8);
    LAS float* RED = (LAS float*)F.lds;
    const int fr = F.lane & 15, fq = F.lane >> 4;
    const int orow = F.tid >> 4, on = F.tid & 15;
    const float bgl = bl[GATE_COL + on];
    for (int rb = F.bid; rb < MTOK / 32; rb += F.G) { const int r0 = rb * 32;
        v4u a[2][8], b[8][2];
#pragma unroll
        for (int ks = 0; ks < 8; ++ks)
#pragma unroll
            for (int t = 0; t < 2; ++t) a[t][ks] = *(const v4u*)(hb + (size_t)(r0 + 16 * t + fr) * DM + 256 * F.wave + 32 * ks + 8 * fq);
#pragma unroll
        for (int ks = 0; ks < 8; ++ks)
#pragma unroll
            for (int hl = 0; hl < 2; ++hl) b[ks][hl] = *(const v4u*)(gwf + ((size_t)((8 * F.wave + ks) * 2 + hl) * 64 + F.lane) * 8);
        const pg8::u64_t rsu = rowss[r0 + orow];
        f32x4 acc[2]; acc[0] = acc[1] = (f32x4){0.f, 0.f, 0.f, 0.f};
#pragma unroll
        for (int ks = 0; ks < 8; ++ks)
#pragma unroll
            for (int hl = 0; hl < 2; ++hl)
#pragma unroll
                for (int t = 0; t < 2; ++t) acc[t] = __builtin_amdgcn_mfma_f32_16x16x32_bf16(__builtin_bit_cast(pg8::bf16x8, a[t][ks]), __builtin_bit_cast(pg8::bf16x8, b[ks][hl]), acc[t], 0, 0, 0);
#pragma unroll
        for (int t = 0; t < 2; ++t) *(LAS f32x4*)(RED + ((F.wave * 2 + t) * 64 + F.lane) * 4) = acc[t];
        __syncthreads();
        { const int t = orow >> 4, q = (orow >> 2) & 3, r = orow & 3; float sum = 0.f;
#pragma unroll
          for (int w = 0; w < 8; ++w) sum += RED[((w * 2 + t) * 64 + 16 * q + on) * 4 + r];
          const float rs = 1.0f / sqrtf(pg8::ss_f32(rsu) * (1.0f / DM) + EPS);
          __hip_atomic_store(gates + (size_t)(r0 + orow) * 16 + on, sum * rs + bgl, RLX_AGENT); }
        __syncthreads();
    }
    VM_WAIT(); __syncthreads();
    if (F.tid == 0) __hip_atomic_fetch_add(cnt, 1u, RLX_AGENT);
}
__device__ __forceinline__ void gates_wait(Frame& F, gu32* cnt) {
    if (threadIdx.x == 0) { unsigned sp = 0; gu32* tmo = (gu32*)(F.ws + WS_CTL) + CW_TMO;
        while (__hip_atomic_load(cnt, RLX_AGENT) < (unsigned)F.G) { __builtin_amdgcn_s_sleep(2); if (++sp > (1u << 22)) { __hip_atomic_store(tmo, 1u, RLX_AGENT); break; } }
        __builtin_amdgcn_fence(__ATOMIC_ACQUIRE, "agent"); VM_WAIT(); }
    __syncthreads();
}

__device__ __forceinline__ float logsigmoidf_(float x) { return fminf(x, 0.f) - log1pf(__expf(-fabsf(x))); }
__device__ __forceinline__ void mlstm_prep(Frame& F, int b, int hh) {
    const float* gates = (const float*)(F.ws + WS_GATES);
    float* a2 = (float*)(F.ldsg + ab::A2_OFF); float* M2 = (float*)(F.ldsg + ab::M2_OFF); float* e2 = (float*)(F.ldsg + ab::E2_OFF); float* sc = (float*)(F.ldsg + ab::SCAN_OFF);
    int tid_ = F.tid; asm volatile("" : "+v"(tid_));
    const int lane_ = tid_ & 63;
    float lf[4], ig[4];
#pragma unroll
    for (int e = 0; e < 4; ++e) { const size_t idx = (size_t)(b * SEQ + 4 * tid_ + e) * 16; ig[e] = gates[idx + hh]; lf[e] = logsigmoidf_(gates[idx + 8 + hh]); }
    float c[4]; c[0] = lf[0]; c[1] = c[0] + lf[1]; c[2] = c[1] + lf[2]; c[3] = c[2] + lf[3];
    const float incl = wave_scan_sum(c[3]);
    if (lane_ == 63) sc[F.wave] = incl;
    __syncthreads();
    float wp = 0.f;
    for (int w = 0; w < F.wave; ++w) wp += sc[w];
    const float base = wp + incl - c[3];
    float Bv[4], av[4], mx[4];
#pragma unroll
    for (int e = 0; e < 4; ++e) { Bv[e] = base + c[e]; av[e] = ig[e] - Bv[e]; }
    mx[0] = av[0]; mx[1] = fmaxf(mx[0], av[1]); mx[2] = fmaxf(mx[1], av[2]); mx[3] = fmaxf(mx[2], av[3]);
    const float im = wave_scan_max(mx[3]);
    if (lane_ == 63) sc[16 + F.wave] = im;
    const float ex = dppf<0x138, 0xf>(-__builtin_inff(), im);
    __syncthreads();
    float wm = -__builtin_inff();
    for (int w = 0; w < F.wave; ++w) wm = fmaxf(wm, sc[16 + w]);
    const float pre = fmaxf(wm, ex);
    const float L2E = 1.4426950408889634f;
#pragma unroll
    for (int e = 0; e < 4; ++e) { const float M = fmaxf(pre, mx[e]); const int t = 4 * tid_ + e; a2[t] = av[e] * L2E; M2[t] = M * L2E; e2[t] = -(Bv[e] + M) * L2E; }
    __syncthreads();
}
__device__ __forceinline__ ab::BlockRef att_ref(Frame& F, int qt) {
    const int q = qt >> 8, t = qt & 255, hv = 16 * q + (t & 15), qb = 7 - (t >> 4), vh = hv & 1, c = (hv >> 1) & 1, hh = (hv >> 2) & 7, b = hv >> 5;
    ab::BlockRef r;
    r.Q = (const bf16*)(F.ws + WS_AQ) + (size_t)(b * SEQ + qb * 256) * 2048 + hh * 256 + c * 128;
    r.K = (const bf16*)(F.ws + WS_AK) + (size_t)(b * SEQ) * 2048 + hh * 256 + c * 128;
    r.V = (const bf16*)(F.ws + WS_AV) + (size_t)(b * SEQ) * 2048 + hh * 256 + vh * 128;
    r.O = (float*)((bf16*)(F.ws + WS_OATT) + (size_t)(b * SEQ + qb * 256) * 4096 + hh * 512 + c * 256 + vh * 128);
    r.P0 = qb * 256; r.Cst = nullptr; r.nst = nullptr; return r;
}
__device__ __forceinline__ ab::BlockRef mls_ref(Frame& F, int t) {
    const int bh = t >> 4, qb = (t >> 1) & 7, vh = t & 1, hh = bh & 7, b = bh >> 3;
    ab::BlockRef r;
    r.Q = (const bf16*)(F.ws + WS_MQ) + (size_t)(b * SEQ + qb * 256) * 1024 + hh * 128;
    r.K = (const bf16*)(F.ws + WS_MK) + (size_t)(b * SEQ) * 1024 + hh * 128;
    r.V = (const bf16*)(F.ws + WS_MV) + (size_t)(b * SEQ) * 2048 + hh * 256 + vh * 128;
    r.O = (float*)((bf16*)(F.ws + WS_HRAW) + (size_t)(b * SEQ + qb * 256) * 2048 + hh * 256 + vh * 128);
    r.P0 = qb * 256;
    r.Cst = qb ? (const bf16*)(F.ws + WS_CST) + ((size_t)(bh * 7 + qb - 1) * 128) * 256 + vh * 128 : nullptr;
    r.nst = qb ? (const float*)(F.ws + WS_NST) + (size_t)(bh * 7 + qb - 1) * 128 : nullptr;
    return r;
}
__device__ __forceinline__ ab::bf16x8 scale8(ab::bf16x8 v, float w) {
    ab::u32x4 q = *reinterpret_cast<ab::u32x4*>(&v); ab::u32x4 o;
    o.x = ab::cvtpk(__uint_as_float(q.x << 16) * w, __uint_as_float(q.x & 0xffff0000u) * w); o.y = ab::cvtpk(__uint_as_float(q.y << 16) * w, __uint_as_float(q.y & 0xffff0000u) * w);
    o.z = ab::cvtpk(__uint_as_float(q.z << 16) * w, __uint_as_float(q.z & 0xffff0000u) * w); o.w = ab::cvtpk(__uint_as_float(q.w << 16) * w, __uint_as_float(q.w & 0xffff0000u) * w);
    return *reinterpret_cast<ab::bf16x8*>(&o);
}
__device__ __forceinline__ float sum8(ab::bf16x8 v) {
    const ab::u32x4 q = *reinterpret_cast<const ab::u32x4*>(&v);
    return ((__uint_as_float(q.x << 16) + __uint_as_float(q.x & 0xffff0000u)) + (__uint_as_float(q.y << 16) + __uint_as_float(q.y & 0xffff0000u)))
         + ((__uint_as_float(q.z << 16) + __uint_as_float(q.z & 0xffff0000u)) + (__uint_as_float(q.w << 16) + __uint_as_float(q.w & 0xffff0000u)));
}
__device__ __forceinline__ void mls_scan(Frame& F, int bh, const int tid) {
    using namespace ab;
    char* lds = (char*)F.ldsg; const int b = bh >> 3, hh = bh & 7;
    const float* a2 = (const float*)(lds + A2_OFF); const float* M2 = (const float*)(lds + M2_OFF);
    const int wid = __builtin_amdgcn_readfirstlane(tid >> 6), lane = tid & 63, r32 = lane & 31, hi = lane >> 5, dgrp = wid & 3, vh = wid >> 2;
    const int sr = tid >> 4, sc = (tid & 15) * 8, vst0 = v_st(sr, sc), vst1 = v_st(32 + sr, sc);
    const bf16* Kp = (const bf16*)(F.ws + WS_MK) + (size_t)(b * SEQ) * 1024 + hh * 128;
    const bf16* Vp = (const bf16*)(F.ws + WS_MV) + (size_t)(b * SEQ) * 2048 + hh * 256;
    bf16* Cst = (bf16*)(F.ws + WS_CST) + (size_t)(bh * 7) * 128 * 256; float* nst = (float*)(F.ws + WS_NST) + (size_t)(bh * 7) * 128;
    const unsigned lok = (unsigned)((lane >> 4) * 1024 + sc), lov = (unsigned)((lane >> 4) * 2048 + sc);
    f32x16 C[4] = {}; float nacc = 0.f;
    const int vbA = (int)(uintptr_t)lds + v_rd_base(lane) + dgrp * 512;
    const int vbB = (int)(uintptr_t)lds + v_rd_base(lane) + 16384 * (1 + vh);
    bf16x8 ka[4], kb[4], va[4], vb[4], vc[4], vd[4];
#define SC_LOAD(i, s0) do { const bf16* kp_ = Kp + (size_t)((s0) + wid * 4) * 1024; const bf16* vp_ = Vp + (size_t)((s0) + wid * 4) * 2048; \
        ka[i] = load8(kp_ + lok); kb[i] = load8(kp_ + 32 * 1024 + lok); va[i] = load8(vp_ + lov); vb[i] = load8(vp_ + 32 * 2048 + lov); vc[i] = load8(vp_ + 128 + lov); vd[i] = load8(vp_ + 32 * 2048 + 128 + lov); } while (0)
#define SC_TRRD(dst, base, off) asm volatile("ds_read_b64_tr_b16 %0, %1 offset:%2" : "=&v"(dst) : "v"(base), "i"(off) : "memory")
#define SC_D0(d0) do { s16x4 l0, l1, l2, l3, h0, h1, h2, h3; constexpr int b_ = (d0) * 512; \
            SC_TRRD(l0, vbB, b_); SC_TRRD(h0, vbB, b_ + 2048); SC_TRRD(l1, vbB, b_ + 4096); SC_TRRD(h1, vbB, b_ + 6144); SC_TRRD(l2, vbB, b_ + 8192); SC_TRRD(h2, vbB, b_ + 10240); SC_TRRD(l3, vbB, b_ + 12288); SC_TRRD(h3, vbB, b_ + 14336); \
            asm volatile("s_waitcnt lgkmcnt(0)" ::: "memory"); SBAR(); \
            C[d0] = __builtin_amdgcn_mfma_f32_32x32x16_bf16(A0, (bf16x8){l0[0], l0[1], l0[2], l0[3], h0[0], h0[1], h0[2], h0[3]}, C[d0], 0, 0, 0); \
            C[d0] = __builtin_amdgcn_mfma_f32_32x32x16_bf16(A1, (bf16x8){l1[0], l1[1], l1[2], l1[3], h1[0], h1[1], h1[2], h1[3]}, C[d0], 0, 0, 0); \
            C[d0] = __builtin_amdgcn_mfma_f32_32x32x16_bf16(A2, (bf16x8){l2[0], l2[1], l2[2], l2[3], h2[0], h2[1], h2[2], h2[3]}, C[d0], 0, 0, 0); \
            C[d0] = __builtin_amdgcn_mfma_f32_32x32x16_bf16(A3, (bf16x8){l3[0], l3[1], l3[2], l3[3], h3[0], h3[1], h3[2], h3[3]}, C[d0], 0, 0, 0); } while (0)
#pragma unroll
    for (int i = 0; i < 4; ++i) SC_LOAD(i, 64 * i);
    for (int j = 0; j < 7; ++j) {
        const float mNew = M2[256 * (j + 1) - 1];
        if (j > 0) { const float dec = __builtin_amdgcn_exp2f(M2[256 * j - 1] - mNew);
#pragma unroll
            for (int d_ = 0; d_ < 4; ++d_)
#pragma unroll
                for (int r = 0; r < 16; ++r) C[d_][r] *= dec;
            nacc *= dec; }
#pragma unroll
        for (int tt = 0; tt < 4; ++tt) {
            const int s0 = 256 * j + 64 * tt;
            const float w0 = __builtin_amdgcn_exp2f(a2[s0 + sr] - mNew), w1 = __builtin_amdgcn_exp2f(a2[s0 + 32 + sr] - mNew);
            if (j < 6) { asm volatile("s_waitcnt vmcnt(18)" ::: "memory"); } else { asm volatile("s_waitcnt vmcnt(0)" ::: "memory"); }
            const bf16x8 ks0 = scale8(ka[tt], w0), ks1 = scale8(kb[tt], w1);
            __syncthreads();
            *(bf16x8*)(lds + vst0) = ks0; *(bf16x8*)(lds + vst1) = ks1;
            *(bf16x8*)(lds + 16384 + vst0) = va[tt]; *(bf16x8*)(lds + 16384 + vst1) = vb[tt]; *(bf16x8*)(lds + 32768 + vst0) = vc[tt]; *(bf16x8*)(lds + 32768 + vst1) = vd[tt];
            SBAR();
            if (j < 6) SC_LOAD(tt, s0 + 256);
            __syncthreads();
            s16x4 al0, ah0, al1, ah1, al2, ah2, al3, ah3;
            SC_TRRD(al0, vbA, 0); SC_TRRD(ah0, vbA, 2048); SC_TRRD(al1, vbA, 4096); SC_TRRD(ah1, vbA, 6144); SC_TRRD(al2, vbA, 8192); SC_TRRD(ah2, vbA, 10240); SC_TRRD(al3, vbA, 12288); SC_TRRD(ah3, vbA, 14336);
            asm volatile("s_waitcnt lgkmcnt(0)" ::: "memory"); SBAR();
            const bf16x8 A0 = (bf16x8){al0[0], al0[1], al0[2], al0[3], ah0[0], ah0[1], ah0[2], ah0[3]}, A1 = (bf16x8){al1[0], al1[1], al1[2], al1[3], ah1[0], ah1[1], ah1[2], ah1[3]};
            const bf16x8 A2 = (bf16x8){al2[0], al2[1], al2[2], al2[3], ah2[0], ah2[1], ah2[2], ah2[3]}, A3 = (bf16x8){al3[0], al3[1], al3[2], al3[3], ah3[0], ah3[1], ah3[2], ah3[3]};
            if (vh == 0) nacc += (sum8(A0) + sum8(A1)) + (sum8(A2) + sum8(A3));
            SC_D0(0); SC_D0(1); SC_D0(2); SC_D0(3);
        }
        { float nt = nacc; auto rr = __builtin_amdgcn_permlane32_swap(__float_as_uint(nt), __float_as_uint(nt), false, false); nt = __uint_as_float(rr[0]) + __uint_as_float(rr[1]);
          if (vh == 0 && hi == 0) nst[j * 128 + 32 * dgrp + r32] = nt; }
        bf16* Cj = Cst + ((size_t)j * 128 + 32 * dgrp) * 256 + 128 * vh; const unsigned loc = (unsigned)(4 * hi * 256 + r32);
#pragma unroll
        for (int r = 0; r < 16; ++r) { bf16* Cr = Cj + (size_t)((r & 3) + 8 * (r >> 2)) * 256;
#pragma unroll
            for (int d0 = 0; d0 < 4; ++d0) { const float v = C[d0][r]; const float nb = dppf<0xB1, 0xf>(0.f, v);
                if ((r32 & 1) == 0) *(unsigned*)(Cr + d0 * 32 + loc) = cvtpk(v, nb); } }
    }
#undef SC_LOAD
#undef SC_TRRD
#undef SC_D0
}
__device__ __forceinline__ void mls_finalise(Frame& F, int l, int bh, int qb) {
    int tid_ = threadIdx.x; asm volatile("" : "+v"(tid_)); const int lane_ = tid_ & 63;
    const int b = bh >> 3, hh = bh & 7; const bf16* hraw = (const bf16*)(F.ws + WS_HRAW); const bf16* smo = (const bf16*)(F.ws + WS_SMO); bf16* hmn = (bf16*)(F.ws + WS_HMN);
    const f32x4 g = *(const f32x4*)(inp(F, I_M_NORM) + (size_t)l * 2048 + hh * 256 + 4 * lane_);
    const size_t base = (size_t)(b * SEQ + qb * 256 + F.wave * 32) * 2048 + hh * 256 + 4 * lane_;
#pragma unroll 1
    for (int r0 = 0; r0 < 32; r0 += 16) {
        v2u hv[16], sw[16];
#pragma unroll
        for (int r = 0; r < 16; ++r) { hv[r] = *(const v2u*)(hraw + base + (size_t)(r0 + r) * 2048); sw[r] = *(const v2u*)(smo + base + (size_t)(r0 + r) * 2048); }
#pragma unroll
        for (int r = 0; r < 16; ++r) { const f32x4 x = (f32x4){pg8::bf_lo(hv[r].x), pg8::bf_hi(hv[r].x), pg8::bf_lo(hv[r].y), pg8::bf_hi(hv[r].y)};
            const float rs = 1.0f / sqrtf(wave_sum((x.x * x.x + x.y * x.y) + (x.z * x.z + x.w * x.w)) * (1.0f / 256.0f) + EPS);
            const f32x4 sg = (f32x4){pg8::bf_lo(sw[r].x), pg8::bf_hi(sw[r].x), pg8::bf_lo(sw[r].y), pg8::bf_hi(sw[r].y)};
            const f32x4 o = x * rs * g * sg; v2u w; w.x = pk2(o.x, o.y); w.y = pk2(o.z, o.w); *(v2u*)(hmn + base + (size_t)(r0 + r) * 2048) = w; }
    }
}
__device__ __forceinline__ void wait_word_ge(Frame& F, gu32* w, unsigned need) {
    if (threadIdx.x == 0) { unsigned sp = 0; gu32* tmo = (gu32*)(F.ws + WS_CTL) + CW_TMO;
        while (__hip_atomic_load(w, RLX_AGENT) < need) { __builtin_amdgcn_s_sleep(2); if (++sp > (1u << 22)) { __hip_atomic_store(tmo, 1u, RLX_AGENT); break; } }
        __builtin_amdgcn_fence(__ATOMIC_ACQUIRE, "agent"); VM_WAIT(); }
    __syncthreads();
}
__device__ __forceinline__ void mix_phase(Frame& F, int l, int rep) {
    char* lds = (char*)F.ldsg;
    constexpr int NMLS = 512, NSCAN = 32, NCVT = 64, NCVT1 = 64;
    gu32* ctl = (gu32*)(F.ws + WS_CTL);
    gu32* gcnt = ctl + CW_GCNT + 64 * (l + 4 * rep); gu32* sflag = ctl + CW_SFLAG + 64 * ((l + 4 * rep) * 32); gu32* tick = ctl + CW_TICK + 64 * (l + 4 * rep);
    if (TPS) F.tp0 = __builtin_amdgcn_s_memrealtime();
    gates_step(F, l, gcnt);
    TPS_POINT(1);
    { const bool tl = tail_idle(F.G) != 0; const int ncvt = (!tl || l == 0) ? NCVT : NCVT1;
      if (l + 1 < DEPTH && rep == 0 && F.bid >= NSCAN && F.bid < NSCAN + ncvt) {
        const int c0 = !tl ? (l + 1) * IT_LAYER : (l == 0 ? IT_A : (l + 1) * IT_LAYER), cn = !tl ? IT_LAYER : (l == 0 ? IT_LAYER : IT_A);
        cvt_run(F, c0, cn, (F.bid - NSCAN) * NWAVES + F.wave, ncvt * NWAVES);
        VM_WAIT(); __syncthreads();
      } }
    if (F.bid < NSCAN) {
        gates_wait(F, gcnt);
        int tid_s = threadIdx.x; asm volatile("" : "+v"(tid_s));
        mlstm_prep(F, F.bid >> 3, F.bid & 7);
        mls_scan(F, F.bid, tid_s);
        VM_WAIT(); __syncthreads();
        if (threadIdx.x == 0) { __builtin_amdgcn_fence(__ATOMIC_RELEASE, "agent"); VM_WAIT(); __hip_atomic_store(sflag + 64 * F.bid, 1u, RLX_AGENT); }
        __syncthreads();
        TPS_POINT(2);
    }
#ifndef NO_ATT
    { volatile LAS unsigned* tw = (volatile LAS unsigned*)(F.lds + MISC_OFF) + 16; gu32* atick = ctl + CW_ATICK + 64 * (8 * (l + 4 * rep));
      const int q0 = (int)(xb_xcc_id() & 7u); int qdone = 0;
#define TAKE_ATT(dst) do { if (threadIdx.x == 0) { int r_ = -1; for (int i_ = 0; i_ < 8; ++i_) { const int q_ = (q0 + i_) & 7; if (qdone & (1 << q_)) continue;               \
            const unsigned t_ = __hip_atomic_fetch_add(atick + 64 * q_, 1u, RLX_AGENT); if (t_ < 128u) { r_ = (q_ << 8) | (int)t_; break; } qdone |= 1 << q_; } tw[0] = (unsigned)r_; } \
        PP_BAR(); dst = __builtin_amdgcn_readfirstlane((int)tw[0]); PP_BAR(); } while (0)
      int qt; TAKE_ATT(qt);
      if (qt >= 0) {
          ab::BlockRef cur = att_ref(F, qt); ab::Seam S;
          int tid_a = threadIdx.x; asm volatile("" : "+v"(tid_a));
          ab::prime2<0, 2048, 2048, 2048>(cur, lds, S, tid_a);
          for (;;) {
              int qn; TAKE_ATT(qn);
              const bool last = qn < 0;
              const ab::BlockRef nxt = last ? cur : att_ref(F, qn);
              ab::block2<0, 2048, 2048, 2048, 4096>(cur, nxt, lds, S, tid_a);
              if (last) break;
              cur = nxt;
          }
          ab::pp_realign(tid_a);
      }
#undef TAKE_ATT
    }
#endif
    VM_WAIT(); __syncthreads();
    TPS_POINT(3);
#ifndef NO_MLS
    gates_wait(F, gcnt);
    TPS_POINT(4);
    { volatile LAS unsigned* tw = (volatile LAS unsigned*)(F.lds + MISC_OFF) + 16;
#define TAKE_TICKET(dst) do { if (threadIdx.x == 0) tw[0] = __hip_atomic_fetch_add(tick, 1u, RLX_AGENT); __syncthreads(); dst = __builtin_amdgcn_readfirstlane((int)tw[0]); __syncthreads(); } while (0)
      for (;;) {
          int t2; TAKE_TICKET(t2);
          if (t2 >= NMLS / 2) break;
          int tid_m = threadIdx.x; asm volatile("" : "+v"(tid_m));
          const int bh = t2 >> 3;
          mlstm_prep(F, bh >> 3, bh & 7); wait_word_ge(F, sflag + 64 * bh, 1u);
          const ab::BlockRef c0 = mls_ref(F, 2 * t2), c1 = mls_ref(F, 2 * t2 + 1); ab::Seam S;
          ab::prime2<1, 1024, 1024, 2048>(c0, lds, S, tid_m);
          ab::block2<1, 1024, 1024, 2048, 2048>(c0, c1, lds, S, tid_m);
          ab::block2<1, 1024, 1024, 2048, 2048>(c1, c1, lds, S, tid_m);
          ab::pp_realign(tid_m);
          VM_WAIT(); __syncthreads();
          mls_finalise(F, l, bh, t2 & 7);
      }
#undef TAKE_TICKET
    }
    VM_WAIT(); __syncthreads();
#endif
    TPS_POINT(5);
}

__device__ __forceinline__ void fin_phase(Frame& F, int l) {
    const float* lq = inp(F, I_LAM_QK) + (size_t)l * 512;
    const float s1 = wave_sum(lq[F.lane] * lq[128 + F.lane] + lq[64 + F.lane] * lq[192 + F.lane]);
    const float s2 = wave_sum(lq[256 + F.lane] * lq[384 + F.lane] + lq[320 + F.lane] * lq[448 + F.lane]);
    const float lam_init = l == 0 ? 0.2f : (l == 1 ? 0.3555090675909693f : (l == 2 ? 0.4707130183435842f : 0.5560582041556406f));
    const float lam = expf(s1) - expf(s2) + lam_init, post = 1.0f - lam_init;
    const bf16* oat = (const bf16*)(F.ws + WS_OATT); bf16* han = (bf16*)(F.ws + WS_HAN);
    { pg8::u64_t* rowss = (pg8::u64_t*)(F.ws + WS_ROWSS); pg8::u64_t* rowsb = (pg8::u64_t*)(F.ws + WS_ROWSS_B); for (int i = F.bid * 512 + F.tid; i < MTOK; i += F.G * 512) { rowss[i] = 0ull; rowsb[i] = 0ull; } }
    const int gw = F.bid * NWAVES + F.wave, NGW = F.G * NWAVES;
    const float* ag = inp(F, I_A_NORM) + (size_t)l * 2048;
    f32x4 agv[8];
#pragma unroll
    for (int hh = 0; hh < 8; ++hh) agv[hh] = *(const f32x4*)(ag + hh * 256 + 4 * F.lane);
    for (int row = gw; row < MTOK; row += 2 * NGW) {
        const bool two = row + NGW < MTOK; v2u ra[2][8], rc[2][8];
#pragma unroll
        for (int r = 0; r < 2; ++r) if (r == 0 || two) { const size_t ro = (size_t)(row + r * NGW) * 4096;
#pragma unroll
            for (int hh = 0; hh < 8; ++hh) { ra[r][hh] = *(const v2u*)(oat + ro + hh * 512 + 4 * F.lane); rc[r][hh] = *(const v2u*)(oat + ro + hh * 512 + 256 + 4 * F.lane); } }
#pragma unroll
        for (int r = 0; r < 2; ++r) if (r == 0 || two) {
#pragma unroll
            for (int hh = 0; hh < 8; ++hh) { const int col = hh * 256 + 4 * F.lane; const v2u a = ra[r][hh], c = rc[r][hh];
                const f32x4 v = (f32x4){pg8::bf_lo(a.x), pg8::bf_hi(a.x), pg8::bf_lo(a.y), pg8::bf_hi(a.y)} - (f32x4){pg8::bf_lo(c.x), pg8::bf_hi(c.x), pg8::bf_lo(c.y), pg8::bf_hi(c.y)} * lam;
                const float rs = 1.0f / sqrtf(wave_sum((v.x * v.x + v.y * v.y) + (v.z * v.z + v.w * v.w)) * (1.0f / 256.0f) + EPS);
                const f32x4 g = agv[hh];
                const f32x4 o = v * rs * g * post; v2u w; w.x = pk2(o.x, o.y); w.y = pk2(o.z, o.w); *(v2u*)(han + (size_t)(row + r * NGW) * 2048 + col) = w; } }
    }
}

__device__ __forceinline__ void conv_fixup_panel(Frame& F, int l, int pm) {
    const float* fxc = (const float*)(F.ws + WS_FXC); const float* fxv = (const float*)(F.ws + WS_FXV); const float* fxg = (const float*)(F.ws + WS_FXG); bf16* u = (bf16*)(F.ws + WS_U);
    const float* cw = inp(F, I_CONV_W) + (size_t)l * 3 * DFF;
    constexpr int NI = 2 * 2 * (DFF / 4) / 512;
    static_assert(2 * 2 * (DFF / 4) == NI * 512, "fix-up item count");
#pragma unroll
    for (int i0 = 0; i0 < NI; i0 += 4) {
        f32x4 cp[4], vv[4], ga[4], gb[4], wa[4], wb[4]; int blkv[4], colv[4], rhov[4];
#pragma unroll
        for (int k = 0; k < 4; ++k) if (i0 + k < NI) { const int i = F.tid + (i0 + k) * 512, c4 = i % (DFF / 4), rr = i / (DFF / 4), rho = rr & 1, blk = pm * 2 + (rr >> 1), col = c4 * 4, pb = (blk & 15) ? blk - 1 : blk;
            blkv[k] = blk; colv[k] = col; rhov[k] = rho;
            cp[k] = *(const f32x4*)(fxc + ((size_t)blk * 2 + rho) * DFF + col); vv[k] = *(const f32x4*)(fxv + ((size_t)blk * 2 + rho) * DFF + col);
            ga[k] = *(const f32x4*)(fxg + ((size_t)pb * 2 + 1) * DFF + col); gb[k] = *(const f32x4*)(fxg + ((size_t)pb * 2) * DFF + col);
            wa[k] = *(const f32x4*)(cw + col); wb[k] = *(const f32x4*)(cw + DFF + col); }
#pragma unroll
        for (int k = 0; k < 4; ++k) if (i0 + k < NI) {
            if ((blkv[k] & 15) == 0) continue;
            const f32x4 cv = rhov[k] == 0 ? cp[k] + wb[k] * ga[k] + wa[k] * gb[k] : cp[k] + wa[k] * ga[k];
            f32x4 o;
#pragma unroll
            for (int j = 0; j < 4; ++j) o[j] = cv[j] * pg8::sigmoidf_fast(cv[j]) * vv[k][j];
            v2u w; w.x = pk2(o[0], o[1]); w.y = pk2(o[2], o[3]);
            *(v2u*)(u + ((size_t)blkv[k] * 128 + rhov[k]) * DFF + colv[k]) = w; }
    }
}

__device__ __forceinline__ void out_phase(Frame& F) {
    const bf16* h = (const bf16*)(F.ws + WS_XN); const float* gf = inp(F, I_NORM_FINAL); float* out = (float*)inp(F, I_OUT);
    const int gw = F.bid * NWAVES + F.wave, NGW = F.G * NWAVES;
    f32x4 gv[8];
#pragma unroll
    for (int j = 0; j < 8; ++j) gv[j] = *((const f32x4*)gf + 64 * j + F.lane);
    for (int row = gw; row < MTOK; row += NGW) { const v2u* xr = (const v2u*)(h + (size_t)row * DM) + F.lane; f32x4 xv[8]; float ss = 0.f;
#pragma unroll
        for (int j = 0; j < 8; ++j) { const v2u a = xr[64 * j]; xv[j] = (f32x4){pg8::bf_lo(a.x), pg8::bf_hi(a.x), pg8::bf_lo(a.y), pg8::bf_hi(a.y)}; ss += (xv[j].x * xv[j].x + xv[j].y * xv[j].y) + (xv[j].z * xv[j].z + xv[j].w * xv[j].w); }
        const float rs = 1.0f / sqrtf(wave_sum(ss) * (1.0f / DM) + EPS); f32x4* o = (f32x4*)(out + (size_t)row * DM) + F.lane;
#pragma unroll
        for (int j = 0; j < 8; ++j) o[64 * j] = xv[j] * rs * gv[j]; }
}

__device__ __forceinline__ int nrep_opaque(int n) { asm volatile("" : "+s"(n)); return n; }
struct Args { const float* in[16]; float* out; unsigned char* ws; int ph_lo, ph_hi, li, pad; };
__global__ void __launch_bounds__(NWAVES * 64, 2) fwd(Args args) {
    extern __shared__ __attribute__((aligned(16))) unsigned char lds[];
    Frame F;
    F.lds = (LAS unsigned char*)lds; F.ldsg = lds;
    F.tid = threadIdx.x; F.lane = F.tid & 63; F.wave = __builtin_amdgcn_readfirstlane(F.tid >> 6);
    F.G = gridDim.x; F.bid = blockIdx.x; F.vcu = (F.G % 8 == 0) ? (F.bid % 8) * (F.G / 8) + F.bid / 8 : F.bid;
    F.ws = args.ws; F.tp = 0ull; F.tp0 = 0ull;
    volatile LAS unsigned* MISC = (volatile LAS unsigned*)(F.lds + MISC_OFF);
    for (int u = F.tid; u < 64; u += NWAVES * 64) MISC[u] = 0u;
    if (F.tid < I_NPTR) { const unsigned long long p = (F.tid == I_OUT) ? (unsigned long long)args.out : (unsigned long long)args.in[F.tid & 15];
        ((LAS unsigned*)(F.lds + PTAB_OFF))[2 * F.tid] = (unsigned)p; ((LAS unsigned*)(F.lds + PTAB_OFF))[2 * F.tid + 1] = (unsigned)(p >> 32); }
    __syncthreads();
    gu32* ctl = (gu32*)(F.ws + WS_CTL);
    XcdBarrier bar = xcd_barrier_post((unsigned*)(ctl + CW_BAR) + args.li * XCD_BAR_WORDS, MISC + 8);
    const int lo = args.ph_lo, hi = args.ph_hi;
#ifndef PH_MASK
#define PH_MASK 0xFFFF
#endif
#define EN(j) ((PH_MASK >> (j)) & 1)
#ifndef PROBE_REP
#define PROBE_REP 0
#endif
#define NREP(j) nrep_opaque(1 + ((PROBE_REP >> (j)) & 1))
#define IN(k) (lo <= (k) && (k) < hi)
#define LAUNDER() do { unsigned long long z_ = 0ull; asm volatile("" : "+s"(z_), "+s"(F.vcu), "+s"(F.bid), "+s"(F.G)); F.ws = args.ws + z_; F.tid = threadIdx.x; asm volatile("" : "+v"(F.tid)); F.lane = F.tid & 63; } while (0)
#define SEAM(k) do { if (IN(k) && IN((k) + 1)) xcd_barrier(bar); } while (0)
#ifndef TP_MASK
#define TP_MASK 0
#endif
#ifndef TP_MULT
#define TP_MULT 4
#endif
    unsigned long long tp_acc = 0ull, tp0_ = 0ull; (void)tp0_;
#define TP_B(j) do { if ((TP_MASK >> (j)) & 1) tp0_ = __builtin_amdgcn_s_memrealtime(); } while (0)
#define TP_E(j) do { if ((TP_MASK >> (j)) & 1) tp_acc += __builtin_amdgcn_s_memrealtime() - tp0_; } while (0)
    if (EN(12) && IN(0)) { TP_B(12); for (int rep_ = 0; rep_ < NREP(12); ++rep_) { LAUNDER(); p0_prologue(F); } SEAM(0); TP_E(12); }
    for (int l = 0; l < DEPTH; ++l) {
        const int pb = 1 + l * NPH_L;
        bf16* XN = (bf16*)(F.ws + WS_XN);
        if (EN(0) && IN(pb + 0)) { TP_B(0); for (int rep_ = 0; rep_ < NREP(0); ++rep_) { LAUNDER();
            pg8::Gemm g{XN, (const bf16*)(F.ws + WS_WIN + (size_t)l * SZ_WIN), MTOK, NING, DM, nullptr, nullptr}; pg8::StaticOrder S; S.init(MTOK, NING, F.G, F.bid);
            pg8::EpiInProj E{(bf16*)(F.ws + WS_MQ), (bf16*)(F.ws + WS_MK), (bf16*)(F.ws + WS_MV), (bf16*)(F.ws + WS_SMO), (bf16*)(F.ws + WS_AQ), (bf16*)(F.ws + WS_AK), (bf16*)(F.ws + WS_AV), (bf16*)(F.ws + WS_SG),
                             (const float*)(F.ws + WS_BIASG) + (size_t)l * NING, (const float*)(F.ws + WS_ROPE), (const pg8::u64_t*)(F.ws + WS_ROWSS_B)};
            pg8::gemm_phase<pg8::EpiInProj, pg8::StaticOrder, true, true>(F.lds, g, S, E, F.tid);
            } SEAM(pb + 0); TP_E(0); }
        if (EN(1) && IN(pb + 1)) { TP_B(1); for (int rep_ = 0; rep_ < NREP(1); ++rep_) { LAUNDER(); mix_phase(F, l, rep_); } SEAM(pb + 1); TP_E(1); }
        if (EN(2) && IN(pb + 2)) { TP_B(2); for (int rep_ = 0; rep_ < NREP(2); ++rep_) { LAUNDER(); fin_phase(F, l); } SEAM(pb + 2); TP_E(2); }
        if (EN(3) && IN(pb + 3)) { TP_B(3); for (int rep_ = 0; rep_ < NREP(3); ++rep_) { LAUNDER();
            pg8::Gemm g{(const bf16*)(F.ws + WS_HMN), (const bf16*)(F.ws + WS_WBM + (size_t)l * SZ_WSQ), MTOK, DM, DM, (const bf16*)(F.ws + WS_HAN), (const bf16*)(F.ws + WS_WBD + (size_t)l * SZ_WSQ)};
            pg8::PairOrder S; S.init(MTOK, DM, F.G, F.bid);
            pg8::EpiMerge E{(bf16*)(F.ws + WS_Y), (const bf16*)(F.ws + WS_SG)};
            pg8::gemm_phase<pg8::EpiMerge, pg8::PairOrder, true, true>(F.lds, g, S, E, F.tid);
            } SEAM(pb + 3); TP_E(3); }
        if (EN(4) && IN(pb + 4)) { TP_B(4); for (int rep_ = 0; rep_ < NREP(4); ++rep_) { LAUNDER();
            pg8::Gemm g{(const bf16*)(F.ws + WS_Y), (const bf16*)(F.ws + WS_WO + (size_t)l * SZ_WSQ), MTOK, DM, DM, nullptr, nullptr}; pg8::StaticOrder S; S.init(MTOK, DM, F.G, F.bid);
            if (rep_ == 0) { pg8::EpiRes<true> E{XN, DM, (pg8::u64_t*)(F.ws + WS_ROWSS)};
            pg8::gemm_phase<pg8::EpiRes<true>, pg8::StaticOrder, false, true>(F.lds, g, S, E, F.tid); }
            else { pg8::EpiRes<false> E{(bf16*)(F.ws + WS_P), DM, nullptr};
            pg8::gemm_phase<pg8::EpiRes<false>, pg8::StaticOrder, false, true>(F.lds, g, S, E, F.tid); }
            } SEAM(pb + 4); TP_E(4); }
        if (EN(5) && IN(pb + 5)) { TP_B(5); for (int rep_ = 0; rep_ < NREP(5); ++rep_) { LAUNDER();
            pg8::Gemm g{XN, (const bf16*)(F.ws + WS_WUP + (size_t)l * SZ_WUP), MTOK, NUP, DM, nullptr, nullptr}; pg8::StaticOrder S; S.init(MTOK, NUP, F.G, F.bid);
            pg8::EpiUpConv E{(bf16*)(F.ws + WS_U), DFF, (const pg8::u64_t*)(F.ws + WS_ROWSS), inp(F, I_CONV_W) + (size_t)l * 3 * DFF, inp(F, I_CONV_B) + (size_t)l * DFF,
                             (float*)(F.ws + WS_FXC), (float*)(F.ws + WS_FXV), (float*)(F.ws + WS_FXG)};
            pg8::gemm_phase<pg8::EpiUpConv, pg8::StaticOrder, true, true, true>(F.lds, g, S, E, F.tid);
            { const int idle = tail_idle(F.G);
              if (idle && l + 1 < DEPTH && rep_ == 0 && F.bid >= F.G - idle) { VM_WAIT(); __syncthreads();
                  cvt_run(F, (l + 1) * IT_LAYER + IT_A, IT_LAYER - IT_A, (F.bid - (F.G - idle)) * NWAVES + F.wave, idle * NWAVES); VM_WAIT(); } }
            } SEAM(pb + 5); TP_E(5); }
        if (EN(6) && IN(pb + 6)) { TP_B(6); for (int rep_ = 0; rep_ < NREP(6); ++rep_) { LAUNDER();
            pg8::Gemm g{(const bf16*)(F.ws + WS_U), (const bf16*)(F.ws + WS_WDN + (size_t)l * SZ_WDN), MTOK, DM, DFF, nullptr, nullptr}; pg8::StaticOrder S; S.init(MTOK, DM, F.G, F.bid);
            { pg8::Unit fu; for (int i = 0; S.next(i, fu); ++i) conv_fixup_panel(F, l, fu.pm); VM_WAIT(); __syncthreads(); }
            if (rep_ == 0) { pg8::EpiRes<true> E{XN, DM, (pg8::u64_t*)(F.ws + WS_ROWSS_B)};
            pg8::gemm_phase<pg8::EpiRes<true>, pg8::StaticOrder, false, true>(F.lds, g, S, E, F.tid); }
            else { pg8::EpiRes<false> E{(bf16*)(F.ws + WS_P), DM, nullptr};
            pg8::gemm_phase<pg8::EpiRes<false>, pg8::StaticOrder, false, true>(F.lds, g, S, E, F.tid); }
            } SEAM(pb + 6); TP_E(6); }
    }
    if (EN(11) && IN(NPHASE - 1)) { TP_B(11); LAUNDER(); out_phase(F); TP_E(11); }
    if (TPS && F.bid == TPS_WG) { const unsigned long long tgt = __builtin_amdgcn_s_memrealtime() + TP_MULT * F.tp; while (__builtin_amdgcn_s_memrealtime() < tgt) __builtin_amdgcn_s_sleep(8); }
    if (TP_MASK && F.bid == 0) { const unsigned long long tgt = __builtin_amdgcn_s_memrealtime() + TP_MULT * tp_acc; while (__builtin_amdgcn_s_memrealtime() < tgt) __builtin_amdgcn_s_sleep(8); }
#undef IN
#undef SEAM
}

extern "C" void kernel_launch(void* const* d_in, const int* in_sizes, int n_in, void* d_out, int out_size, void* d_ws, size_t ws_size, hipStream_t stream) {
    static int grid = 0;
    if (grid == 0) {
        if (n_in != 16 || in_sizes[0] != MTOK * DM || out_size != MTOK * DM || ws_size < WS_END) {
            fprintf(stderr, "kernel_launch: unexpected shapes (n_in %d, in0 %d, out %d, ws %zu, need %zu)\n", n_in, n_in > 0 ? in_sizes[0] : -1, out_size, ws_size, (size_t)WS_END); grid = -1; return; }
        int dev = 0, cus = 0, per_cu = 0;
        if (hipGetDevice(&dev) != hipSuccess || hipDeviceGetAttribute(&cus, hipDeviceAttributeMultiprocessorCount, dev) != hipSuccess) { grid = -1; return; }
        if (hipFuncSetAttribute((const void*)fwd, hipFuncAttributeMaxDynamicSharedMemorySize, LDS_BYTES) != hipSuccess) { fprintf(stderr, "kernel_launch: hipFuncSetAttribute failed\n"); grid = -1; return; }
        if (hipOccupancyMaxActiveBlocksPerMultiprocessor(&per_cu, (const void*)fwd, NWAVES * 64, LDS_BYTES) != hipSuccess || per_cu < 1)
            fprintf(stderr, "kernel_launch: note: occupancy query reports %d workgroups per CU\n", per_cu);
        (void)hipGetLastError();
        grid = cus;
    }
    if (grid < 0) return;
    if (hipMemsetAsync((char*)d_ws + WS_CTL, 0, CTL_ZERO_BYTES, stream) != hipSuccess) return;
    Args a{};
    for (int i = 0; i < 16; ++i) a.in[i] = (const float*)d_in[i];
    a.out = (float*)d_out; a.ws = (unsigned char*)d_ws;
#if MK_SPLIT
    for (int p = 0; p < NPHASE; ++p) { a.ph_lo = p; a.ph_hi = p + 1; a.li = p; hipLaunchKernelGGL(fwd, dim3(grid), dim3(NWAVES * 64), LDS_BYTES, stream, a); }
#else
    a.ph_lo = 0; a.ph_hi = NPHASE; a.li = 0;
    hipLaunchKernelGGL(fwd, dim3(grid), dim3(NWAVES * 64), LDS_BYTES, stream, a);
#endif
    const hipError_t le = hipPeekAtLastError();
    if (le != hipSuccess) fprintf(stderr, "kernel_launch: launch failed: %s\n", hipGetErrorName(le));
}
```
